# Optimizing an MI355X kernel written in HIP

```python
import jax, jax.numpy as jnp
from jax import lax
import numpy as np

D_MODEL = 4096
BATCH = 4
SEQ = 4096
DEPTH = 1

GRID_W = 64
CTX_LEN = 256
EPS = 1e-6

MLSTM_HEADS = 8
MLSTM_WIDTH = D_MODEL // 2
MLSTM_DV = MLSTM_WIDTH // MLSTM_HEADS
MLSTM_DK = MLSTM_DV // 2
CHUNK = 64
CONV_WIDTH = D_MODEL - MLSTM_WIDTH
CONV_K = 3
Q_COLS = MLSTM_HEADS * MLSTM_DK
O_COLS = MLSTM_WIDTH
K_COLS = MLSTM_HEADS * MLSTM_DK
V_COLS = MLSTM_WIDTH
GATE_COLS = 4 * MLSTM_HEADS
CTX_COL0 = Q_COLS + O_COLS + 3 * CONV_WIDTH
IN_COLS = CTX_COL0 + K_COLS + V_COLS + GATE_COLS
N_GROUPS = 4
EXPERTS_PER_GROUP = 4
N_EXPERTS = N_GROUPS * EXPERTS_PER_GROUP
TOP_K_IN_GROUP = 2
D_FF_EXPERT = D_MODEL // 4

kernel_name = "hybrid_mlstm_shortconv_hiermoe_ctxprefix"


def _rms_norm(x, g):
    xf = x.astype(jnp.float32)
    y = xf * lax.rsqrt(jnp.mean(xf * xf, axis=-1, keepdims=True) + EPS)
    return (y * g.astype(jnp.float32)).astype(x.dtype)


def _heads(a, d):
    b, s, _ = a.shape
    return a.reshape(b, s, -1, d).transpose(0, 2, 1, 3)


def _kvg(a, b_gates):
    k = _heads(a[..., :K_COLS], MLSTM_DK).astype(jnp.float32)
    v = _heads(a[..., K_COLS:K_COLS + V_COLS], MLSTM_DV).astype(jnp.float32)
    g = (a[..., K_COLS + V_COLS:] + b_gates).astype(jnp.float32)
    b, s, _ = g.shape
    g = g.reshape(b, s, 4, MLSTM_HEADS).transpose(2, 0, 3, 1)
    g = jnp.stack([g[0], jax.nn.log_sigmoid(g[1]), g[2], jax.nn.log_sigmoid(g[3])])
    return k, v, g


def _to_chunks(a):
    b, h, s = a.shape[:3]
    return jnp.moveaxis(a.reshape(b, h, s // CHUNK, CHUNK, *a.shape[3:]), 2, 0)


def _zero_state(b):
    return (jnp.zeros((b, MLSTM_HEADS, MLSTM_DV, MLSTM_DK), jnp.float32),
            jnp.zeros((b, MLSTM_HEADS, MLSTM_DK), jnp.float32),
            jnp.zeros((b, MLSTM_HEADS), jnp.float32))


def _chunk_state_update(state, k, v, ig, lf):
    C, n, m = state
    bcum = jnp.cumsum(lf, axis=-1)
    g = bcum[..., -1]
    log_w = g[..., None] - bcum + ig
    m_new = jnp.maximum(g + m, jnp.max(log_w, axis=-1))
    w = jnp.exp(log_w - m_new[..., None])
    decay = jnp.exp(g + m - m_new)
    C_new = decay[..., None, None] * C + jnp.einsum("bhs,bhsv,bhsd->bhvd", w, v, k)
    n_new = decay[..., None] * n + jnp.einsum("bhs,bhsd->bhd", w, k)
    return (C_new, n_new, m_new)


def _chunk_output(state, q, k, v, ig, lf):
    C, n, m = state
    bcum = jnp.cumsum(lf, axis=-1)
    tril = jnp.tril(jnp.ones((CHUNK, CHUNK), dtype=bool))
    log_d = jnp.where(tril, bcum[..., :, None] - bcum[..., None, :] + ig[..., None, :], -jnp.inf)
    log_inter = bcum + m[..., None]
    m_t = jnp.maximum(log_inter, jnp.max(log_d, axis=-1))
    d = jnp.exp(log_d - m_t[..., None])
    w_inter = jnp.exp(log_inter - m_t)
    s = jnp.einsum("bhtd,bhsd->bhts", q, k) * d
    num = jnp.einsum("bhts,bhsv->bhtv", s, v) + w_inter[..., None] * jnp.einsum("bhvd,bhtd->bhtv", C, q)
    den = jnp.sum(s, axis=-1) + w_inter * jnp.einsum("bhd,bhtd->bht", n, q)
    return num / jnp.maximum(jnp.abs(den), jnp.exp(-m_t))[..., None]


def _mlstm_context_state(k, v, ig, lf):
    def step(state, xs):
        return _chunk_state_update(state, *xs), None
    state, _ = lax.scan(step, _zero_state(k.shape[0]),
                        (_to_chunks(k), _to_chunks(v), _to_chunks(ig), _to_chunks(lf)))
    return state


def _mlstm_latent(state, q, k, v, ig, lf):
    def step(st, xs):
        qc, kc, vc, igc, lfc = xs
        h = _chunk_output(st, qc, kc, vc, igc, lfc)
        return _chunk_state_update(st, kc, vc, igc, lfc), h
    _, hs = lax.scan(step, state, (_to_chunks(q), _to_chunks(k), _to_chunks(v),
                                   _to_chunks(ig), _to_chunks(lf)))
    b, h, s = q.shape[:3]
    return jnp.moveaxis(hs, 0, 2).reshape(b, h, s, MLSTM_DV)


def _mlstm_direction(q, k, v, ig, lf, ck, cv, cig, clf):
    state = _mlstm_context_state(ck, cv, cig, clf)
    return _mlstm_latent(state, q, k, v, ig, lf)


def _centred_conv3(u, w, axis):
    n = u.shape[axis]
    pad = [(0, 0)] * u.ndim
    pad[axis] = (1, 1)
    up = jnp.pad(u, pad)
    y = w[0] * lax.slice_in_dim(up, 0, n, axis=axis)
    for j in range(1, CONV_K):
        y = y + w[j] * lax.slice_in_dim(up, j, j + n, axis=axis)
    return y


def _token_mixers(xm, cm, w_in, b_gates, conv_w, head_norm, rows):
    b, s, _ = xm.shape
    proj = jnp.dot(xm, w_in)
    o1 = Q_COLS
    o2 = o1 + O_COLS
    o3 = o2 + CONV_WIDTH
    o4 = o3 + CONV_WIDTH
    q = _heads(proj[..., :o1], MLSTM_DK).astype(jnp.float32) * (MLSTM_DK ** -0.5)
    o_gate = proj[..., o1:o2]
    cb = proj[..., o2:o3]
    cc = proj[..., o3:o4]
    cx = proj[..., o4:CTX_COL0]
    k, v, g = _kvg(proj[..., CTX_COL0:], b_gates)
    ck, cv, cg = _kvg(jnp.dot(cm, w_in[:, CTX_COL0:]), b_gates)

    h_fwd = _mlstm_direction(q, k, v, g[0], g[1], ck, cv, cg[0], cg[1])
    flp = lambda a: jnp.flip(a, axis=2)
    h_bwd = flp(_mlstm_direction(flp(q), flp(k), flp(v), flp(g[2]), flp(g[3]),
                                 flp(ck), flp(cv), flp(cg[2]), flp(cg[3])))
    h = h_fwd + h_bwd
    h = h * lax.rsqrt(jnp.mean(h * h, axis=-1, keepdims=True) + EPS)
    h = h * head_norm.astype(jnp.float32).reshape(MLSTM_HEADS, 1, MLSTM_DV)
    h = h.transpose(0, 2, 1, 3).reshape(b, s, MLSTM_WIDTH).astype(xm.dtype)
    y_a = jax.nn.sigmoid(o_gate) * h

    u = (cc * cx).reshape(b, rows, GRID_W, CONV_WIDTH)
    half = CONV_WIDTH // 2
    y_row = _centred_conv3(u[..., :half], conv_w[:, :half], axis=2)
    y_col = _centred_conv3(u[..., half:], conv_w[:, half:], axis=1)
    y_b = cb * jnp.concatenate([y_row, y_col], axis=-1).reshape(b, s, CONV_WIDTH)

    return jnp.concatenate([y_a, y_b], axis=-1)


def _hier_moe(xf, w_rg, b_rg, w_re, b_re, w_e_in, w_e_out):
    b, s, d = xf.shape
    xt = xf.reshape(b * s, d)
    g_logits = (jnp.dot(xt, w_rg) + b_rg).astype(jnp.float32)
    g_sel = jnp.argmax(g_logits, axis=-1)
    p_sel = jnp.max(jax.nn.softmax(g_logits, axis=-1), axis=-1, keepdims=True)
    e_logits = (jnp.dot(xt, w_re) + b_re).astype(jnp.float32).reshape(-1, N_GROUPS, EXPERTS_PER_GROUP)
    e_grp = jnp.einsum("tge,tg->te", e_logits, jax.nn.one_hot(g_sel, N_GROUPS, dtype=jnp.float32))
    top_v, top_i = lax.top_k(e_grp, TOP_K_IN_GROUP)
    w_top = jax.nn.softmax(top_v, axis=-1) * p_sel
    idx = g_sel[:, None] * EXPERTS_PER_GROUP + top_i
    gates = jnp.einsum("tk,tke->et", w_top,
                       jax.nn.one_hot(idx, N_EXPERTS, dtype=jnp.float32)).astype(xt.dtype)

    def expert(acc, p):
        w1, w2, ge = p
        a, u = jnp.split(jnp.dot(xt, w1), 2, axis=-1)
        return acc + ge[:, None] * jnp.dot(jax.nn.silu(a) * u, w2), None

    y, _ = lax.scan(expert, jnp.zeros_like(xt), (w_e_in, w_e_out, gates))
    return y.reshape(b, s, d)


def setup_inputs(seed: int = 0) -> dict:
    key = jax.random.key(seed)
    ks = jax.random.split(key, 20)
    nrm = jax.random.normal
    f32 = jnp.float32
    D = D_MODEL
    gate_base = jnp.repeat(jnp.array([0.0, 3.0, 0.0, 3.0], f32), MLSTM_HEADS)
    return {
        "x": nrm(ks[0], (BATCH, SEQ, D), f32),
        "c": nrm(ks[1], (BATCH, D), f32),
        "ctx": nrm(ks[2], (BATCH, CTX_LEN, D), f32),
        "c_ctx": nrm(ks[3], (D,), f32),
        "w_ada": nrm(ks[4], (DEPTH, D, 6 * D), f32) * (0.5 * D ** -0.5),
        "b_ada": nrm(ks[5], (DEPTH, 6 * D), f32) * 0.02,
        "norm1": 1.0 + 0.05 * nrm(ks[6], (DEPTH, D), f32),
        "w_in": nrm(ks[7], (DEPTH, D, IN_COLS), f32) * D ** -0.5,
        "b_gates": gate_base + 0.5 * nrm(ks[8], (DEPTH, GATE_COLS), f32),
        "conv_w": nrm(ks[9], (DEPTH, CONV_K, CONV_WIDTH), f32) * CONV_K ** -0.5,
        "head_norm": 1.0 + 0.05 * nrm(ks[10], (DEPTH, MLSTM_WIDTH), f32),
        "w_out": nrm(ks[11], (DEPTH, D, D), f32) * D ** -0.5,
        "norm2": 1.0 + 0.05 * nrm(ks[12], (DEPTH, D), f32),
        "w_router_group": nrm(ks[13], (DEPTH, D, N_GROUPS), f32) * D ** -0.5,
        "b_router_group": nrm(ks[14], (DEPTH, N_GROUPS), f32) * 0.01,
        "w_router_expert": nrm(ks[15], (DEPTH, D, N_EXPERTS), f32) * D ** -0.5,
        "b_router_expert": nrm(ks[16], (DEPTH, N_EXPERTS), f32) * 0.01,
        "w_expert_in": nrm(ks[17], (DEPTH, N_EXPERTS, D, 2 * D_FF_EXPERT), f32) * D ** -0.5,
        "w_expert_out": nrm(ks[18], (DEPTH, N_EXPERTS, D_FF_EXPERT, D), f32) * D_FF_EXPERT ** -0.5,
        "final_norm": 1.0 + 0.05 * nrm(ks[19], (D,), f32),
    }


def reference(x, c, ctx, c_ctx, w_ada, b_ada, norm1, w_in, b_gates, conv_w, head_norm, w_out, norm2,
              w_router_group, b_router_group, w_router_expert, b_router_expert,
              w_expert_in, w_expert_out, final_norm):
    b, s, _ = x.shape
    rows = s // GRID_W
    for l in range(DEPTH):
        ada = jnp.dot(jax.nn.silu(c), w_ada[l]) + b_ada[l]
        shift1, scale1, gate1, shift2, scale2, gate2 = jnp.split(ada, 6, axis=-1)
        ada_ctx = jnp.dot(jax.nn.silu(c_ctx), w_ada[l][:, :2 * D_MODEL]) + b_ada[l][:2 * D_MODEL]
        shift_c, scale_c = jnp.split(ada_ctx, 2)
        xm = _rms_norm(x, norm1[l]) * (1 + scale1[:, None]) + shift1[:, None]
        cm = _rms_norm(ctx, norm1[l]) * (1 + scale_c) + shift_c
        mix = _token_mixers(xm, cm, w_in[l], b_gates[l], conv_w[l], head_norm[l], rows)
        x = x + gate1[:, None] * jnp.dot(mix, w_out[l])
        xf = _rms_norm(x, norm2[l]) * (1 + scale2[:, None]) + shift2[:, None]
        x = x + gate2[:, None] * _hier_moe(xf, w_router_group[l], b_router_group[l],
                                           w_router_expert[l], b_router_expert[l],
                                           w_expert_in[l], w_expert_out[l])
    return _rms_norm(x, final_norm)
```

```cpp
#include <hip/hip_runtime.h>
#include <cstdio>
#include <cstdint>

#ifndef MK_MODE
#define MK_MODE 2
#endif

namespace pg8 {
#define PG8_LAS __attribute__((address_space(3)))
typedef unsigned short bf16_t;
typedef short bf16x8 __attribute__((ext_vector_type(8)));
typedef float f32x4 __attribute__((ext_vector_type(4)));
typedef unsigned u32x4 __attribute__((ext_vector_type(4)));
constexpr int BM = 256, BK = 64, HALF = 128, HTB = HALF * BK * 2, STAGE_BYTES = 8 * HTB, NXCD = 8, WGM = 8;

__host__ __device__ __forceinline__ int lds_byte(int r, int c) { const int st = (r >> 4) * 2 + (c >> 5), rr = r & 15, cc = c & 31, ob = rr * 64 + cc * 2; return st * 1024 + (ob ^ (((ob >> 9) & 1) << 5)); }
__host__ __device__ __forceinline__ void stage_rc(int b, int& R, int& C) { const int st = b / 1024, sb = b % 1024, swz = sb ^ (((sb >> 9) & 1) << 5); R = (st >> 1) * 16 + swz / 64; C = (st & 1) * 32 + (swz % 64) / 2; }
__host__ __device__ __forceinline__ int perm32(int rho) { const int n = rho >> 4, i = rho & 15; return 8 * (i >> 2) + 4 * n + (i & 3); }

struct Unit { int pm, pn; };
struct Gemm { const bf16_t* A; const bf16_t* Bt; int M, N, K; };

typedef float f32x2_t __attribute__((ext_vector_type(2))); typedef __bf16 bf16x2_t __attribute__((ext_vector_type(2)));
__device__ __forceinline__ unsigned cvt_pk_bf16(float lo, float hi) { f32x2_t v = {lo, hi}; bf16x2_t b = __builtin_convertvector(v, bf16x2_t); return __builtin_bit_cast(unsigned, b); }

typedef int i32x8 __attribute__((ext_vector_type(8)));
typedef int i32x4 __attribute__((ext_vector_type(4)));
constexpr int TAB_OFF = STAGE_BYTES;
template <class Epi, class Sched, bool ALIGN_EPI, bool SP2, bool GATHER, bool MX, bool I8 = false, bool ROLL = false>
__device__ __forceinline__ void gemm_phase(PG8_LAS unsigned char* lds, const Gemm g, const Sched& S, const Epi& E, PG8_LAS unsigned* rowtab) {
    const int tid = threadIdx.x, wid = __builtin_amdgcn_readfirstlane(tid >> 6), lane = tid & 63, wr = wid >> 2, wc = wid & 3, fr = lane & 15, fq = lane >> 4;
    const int K = g.K, nt = K / BK;
    unsigned voffA[2], voffB[2]; int RA[2], CA[2];
#pragma unroll
    for (int i = 0; i < 2; ++i) { int R, C; stage_rc(tid * 16 + i * 8192, R, C); const int Rb = ((int)Epi::PERM == 2) ? (64 * (R >> 5) + 16 * ((R & 15) >> 2) + 4 * ((R >> 4) & 1) + (R & 3)) : (Epi::PERM ? ((R & ~31) + perm32(R & 31)) : R);
        voffA[i] = (unsigned)(R * K + C) * 2u; voffB[i] = (unsigned)(Rb * K + C) * 2u; RA[i] = R; CA[i] = C * 2; }
    const size_t kstep = (size_t)(BK * 2);
    const size_t hstep = (size_t)HALF * K * 2;
    const size_t tstep = 2 * hstep;
    const size_t hstepA = GATHER ? (size_t)0 : hstep;
    const size_t hstepB = ((int)Epi::PERM == 2) ? (size_t)8 * K * 2 : hstep;
    const unsigned ldsw = (unsigned)wid * 1024u;
    const int aoff = lds_byte(wr * 64 + fr, MX ? fq * 16 : fq * 8), boff = lds_byte(wc * 32 + fr, MX ? fq * 16 : fq * 8);
#define PG8_SA(b, h) (((b) * 2 + (h)) * HTB)
#define PG8_SB(b, h) ((4 + (b) * 2 + (h)) * HTB)
#define PG8_STAGE(bufoff, gbase, voff) do { _Pragma("unroll") for (int _i = 0; _i < 2; ++_i) \
        __builtin_amdgcn_global_load_lds((const unsigned*)((const char*)(gbase) + (voff)[_i]), (PG8_LAS unsigned*)(lds + (bufoff) + ldsw + _i * 8192), 16, 0, 0); } while (0)
#define PG8_LD32(p) ({ const u32x4 lo_ = *(const PG8_LAS u32x4*)(p), hi_ = *(const PG8_LAS u32x4*)((p) + 16); (i32x8){(int)lo_[0], (int)lo_[1], (int)lo_[2], (int)lo_[3], (int)hi_[0], (int)hi_[1], (int)hi_[2], (int)hi_[3]}; })
#define PG8_LDA(dst, b, h) do { if constexpr (MX) { _Pragma("unroll") for (int m = 0; m < 4; ++m) dst##X[m] = PG8_LD32(lds + PG8_SA(b, h) + aoff + m * 2048); } \
        else { _Pragma("unroll") for (int m = 0; m < 4; ++m) _Pragma("unroll") for (int k = 0; k < 2; ++k) dst[m][k] = *(const PG8_LAS bf16x8*)(lds + PG8_SA(b, h) + aoff + m * 2048 + k * 1024); } } while (0)
#define PG8_LDB(dst, b, h) do { if constexpr (MX) { _Pragma("unroll") for (int n = 0; n < 2; ++n) dst##X[n] = PG8_LD32(lds + PG8_SB(b, h) + boff + n * 2048); } \
        else { _Pragma("unroll") for (int n = 0; n < 2; ++n) _Pragma("unroll") for (int k = 0; k < 2; ++k) dst[n][k] = *(const PG8_LAS bf16x8*)(lds + PG8_SB(b, h) + boff + n * 2048 + k * 1024); } } while (0)
#define PG8_MMA(ai, bj, At, Bt) do { __builtin_amdgcn_s_setprio(1); if constexpr (MX) { _Pragma("unroll") for (int m = 0; m < 4; ++m) _Pragma("unroll") for (int n = 0; n < 2; ++n) \
        asm volatile("v_mfma_scale_f32_16x16x128_f8f6f4 %0, %1, %2, %0, %3, %3 op_sel_hi:[0,0,0]" : "+v"(acc[ai][bj][m][n]) : "v"(Bt##X[n]), "v"(At##X[m]), "v"(mxscale)); } \
        else if constexpr (I8) { _Pragma("unroll") for (int m = 0; m < 4; ++m) _Pragma("unroll") for (int n = 0; n < 2; ++n) _Pragma("unroll") for (int k = 0; k < 2; ++k) \
        acc[ai][bj][m][n] = __builtin_bit_cast(f32x4, __builtin_amdgcn_mfma_i32_16x16x64_i8(__builtin_bit_cast(i32x4, Bt[n][k]), __builtin_bit_cast(i32x4, At[m][k]), __builtin_bit_cast(i32x4, acc[ai][bj][m][n]), 0, 0, 0)); } \
        else { _Pragma("unroll") for (int m = 0; m < 4; ++m) _Pragma("unroll") for (int n = 0; n < 2; ++n) _Pragma("unroll") for (int k = 0; k < 2; ++k) \
        acc[ai][bj][m][n] = __builtin_amdgcn_mfma_f32_16x16x32_bf16(Bt[n][k], At[m][k], acc[ai][bj][m][n], 0, 0, 0); } __builtin_amdgcn_s_setprio(0); } while (0)
#define PG8_WAIT_V(n) asm volatile("s_waitcnt vmcnt(" #n ")" ::: "memory")
#define PG8_WAIT_VN(n) asm volatile("s_waitcnt vmcnt(%0)" :: "n"(n) : "memory")
#define PG8_ZERO(ai) do { _Pragma("unroll") for (int b_ = 0; b_ < 2; ++b_) _Pragma("unroll") for (int m_ = 0; m_ < 4; ++m_) _Pragma("unroll") for (int n_ = 0; n_ < 2; ++n_) acc[ai][b_][m_][n_] = (f32x4){0.f, 0.f, 0.f, 0.f}; } while (0)
#define PG8_TABP(u_) ((const PG8_LAS float*)(lds + TAB_OFF + ((u_) & 1) * 2048))
#define PG8_WAIT_L(n) asm volatile("s_waitcnt lgkmcnt(" #n ")" ::: "memory")
#define PG8_BAR __builtin_amdgcn_s_barrier()
#define PG8_SCHED __builtin_amdgcn_sched_barrier(0)
    static_assert(!ROLL || SP2, "rolling epilogue: eight-phase loop only");
    Unit cur, nxt; int ui = 0; bool pst = false;
    if (!S.next(0, cur)) return;
    f32x4 acc[2][2][4][2];
#pragma unroll
    for (int a = 0; a < 2; ++a)
#pragma unroll
        for (int b = 0; b < 2; ++b)
#pragma unroll
            for (int m = 0; m < 4; ++m)
#pragma unroll
                for (int n = 0; n < 2; ++n) acc[a][b][m][n] = (f32x4){0.f, 0.f, 0.f, 0.f};
    bf16x8 At[4][2], B0[2][2], B1[2][2]; i32x8 AtX[4], B0X[2], B1X[2]; const int mxscale = 0x7F7F7F7F;
    unsigned vc0[2], vc1[2], vn0[2], vn1[2];
    const char* cA = GATHER ? (const char*)g.A : (const char*)g.A + (size_t)cur.pm * tstep; const char* cB = (const char*)g.Bt + (size_t)cur.pn * tstep;
    if constexpr (GATHER) {
        if (tid < 256) rowtab[tid] = ROLL ? S.row_raw(cur, tid) : S.row_byteoff(cur, tid);
        asm volatile("s_waitcnt vmcnt(0) lgkmcnt(0)" ::: "memory"); PG8_BAR; asm volatile("" ::: "memory");
#pragma unroll
        for (int i = 0; i < 2; ++i) { vc0[i] = (ROLL ? S.row_off(rowtab[RA[i]]) : rowtab[RA[i]]) + (unsigned)CA[i]; vc1[i] = (ROLL ? S.row_off(rowtab[128 + RA[i]]) : rowtab[128 + RA[i]]) + (unsigned)CA[i]; vn0[i] = vc0[i]; vn1[i] = vc1[i]; }
    } else {
#pragma unroll
        for (int i = 0; i < 2; ++i) { vc0[i] = voffA[i]; vc1[i] = voffA[i]; vn0[i] = voffA[i]; vn1[i] = voffA[i]; }
    }
    S.a_ready(cur);
    if constexpr (SP2) {
        PG8_STAGE(PG8_SB(0, 0), cB, voffB); PG8_STAGE(PG8_SB(0, 1), cB + hstepB, voffB); PG8_STAGE(PG8_SA(0, 0), cA, vc0); PG8_STAGE(PG8_SA(0, 1), cA + hstepA, vc1);
        if (wr == 1) PG8_BAR;
        PG8_WAIT_V(2); PG8_BAR;
        PG8_STAGE(PG8_SB(1, 0), cB + kstep, voffB); PG8_STAGE(PG8_SA(1, 0), cA + kstep, vc0); PG8_STAGE(PG8_SB(1, 1), cB + hstepB + kstep, voffB);
        PG8_WAIT_V(6); PG8_BAR;
    } else {
        PG8_STAGE(PG8_SB(0, 0), cB, voffB); PG8_STAGE(PG8_SA(0, 0), cA, vc0); PG8_STAGE(PG8_SB(0, 1), cB + hstepB, voffB); PG8_STAGE(PG8_SA(0, 1), cA + hstepA, vc1);
        if (wr == 1) PG8_BAR;
        PG8_WAIT_V(4); PG8_BAR;
        PG8_STAGE(PG8_SB(1, 0), cB + kstep, voffB); PG8_STAGE(PG8_SA(1, 0), cA + kstep, vc0); PG8_STAGE(PG8_SB(1, 1), cB + hstepB + kstep, voffB);
        PG8_WAIT_V(6); PG8_BAR;
    }
    for (;;) {
        const bool has_next = S.next(ui + 1, nxt);
        const char* nA = GATHER ? (const char*)g.A : (has_next ? (const char*)g.A + (size_t)nxt.pm * tstep : cA); const char* nB = has_next ? (const char*)g.Bt + (size_t)nxt.pn * tstep : cB;
        if constexpr (GATHER && !ROLL) {
            if (has_next && tid < 256) rowtab[((ui + 1) & 1) * 256 + tid] = S.row_byteoff(nxt, tid);
        }
#pragma unroll 1
        for (int t = 0; t < nt; t += 2) {
            const bool last = (t == nt - 2);
            const char* a1 = cA + (size_t)(t + 1) * kstep;
            const char* a2 = last ? nA : cA + (size_t)(t + 2) * kstep; const char* b2 = last ? nB : cB + (size_t)(t + 2) * kstep;
            const char* a3 = a2 + kstep; const char* b3 = b2 + kstep;
            if (last && has_next) S.a_ready(nxt);
            if constexpr (GATHER) {
                if (last && has_next) {
                    PG8_LAS unsigned* rt = rowtab + ((ui + 1) & 1) * 256;
#pragma unroll
                    for (int i = 0; i < 2; ++i) { vn0[i] = (ROLL ? S.row_off(rt[RA[i]]) : rt[RA[i]]) + (unsigned)CA[i]; vn1[i] = (ROLL ? S.row_off(rt[128 + RA[i]]) : rt[128 + RA[i]]) + (unsigned)CA[i]; }
                }
            }
            unsigned w20[2], w21[2];
#pragma unroll
            for (int i = 0; i < 2; ++i) { w20[i] = last ? vn0[i] : vc0[i]; w21[i] = last ? vn1[i] : vc1[i]; }
            if constexpr (SP2 && ROLL) {
            const bool rf = (t == 0) && pst;
            PG8_LDB(B0, 0, 0); PG8_LDB(B1, 0, 1); PG8_SCHED; PG8_LDA(At, 0, 0); PG8_STAGE(PG8_SA(1, 1), a1 + hstepA, vc1);
            if (t == 2) {
                if constexpr (Epi::NTAB > 0) { if (Epi::NTAB > 1 || wid < 4) __builtin_amdgcn_global_load_lds((const unsigned*)E.tab_src(cur, tid), (PG8_LAS unsigned*)(lds + TAB_OFF + (ui & 1) * 2048 + wid * 256), 4, 0, 0); }
                if constexpr (GATHER) { if (has_next && wid < 4) __builtin_amdgcn_global_load_lds((const unsigned*)S.row_src(nxt, tid), (PG8_LAS unsigned*)(rowtab + ((ui + 1) & 1) * 256 + wid * 64), 4, 0, 0); }
            }
            if (rf) PG8_WAIT_VN(8 + 2 * Epi::NS); else PG8_WAIT_V(8);
            PG8_WAIT_L(0); PG8_BAR; PG8_MMA(0, 0, At, B0); PG8_MMA(0, 1, At, B1); PG8_BAR; PG8_SCHED;
            PG8_LDA(At, 0, 1); PG8_STAGE(PG8_SB(0, 0), b2, voffB); PG8_STAGE(PG8_SB(0, 1), b2 + hstepB, voffB); PG8_STAGE(PG8_SA(0, 0), a2, w20);
            if (rf) PG8_WAIT_VN(8 + 2 * Epi::NS); else PG8_WAIT_V(8);
            PG8_WAIT_L(0); PG8_BAR; PG8_MMA(1, 0, At, B0); PG8_MMA(1, 1, At, B1); PG8_BAR; PG8_SCHED;
            PG8_LDB(B0, 1, 0); PG8_LDB(B1, 1, 1); PG8_SCHED; PG8_LDA(At, 1, 0); PG8_STAGE(PG8_SA(0, 1), a2 + hstepA, w21);
            PG8_WAIT_V(8); PG8_WAIT_L(0); PG8_BAR; PG8_MMA(0, 0, At, B0); PG8_MMA(0, 1, At, B1); PG8_BAR; PG8_SCHED;
            PG8_LDA(At, 1, 1); PG8_STAGE(PG8_SB(1, 0), b3, voffB); PG8_STAGE(PG8_SB(1, 1), b3 + hstepB, voffB); PG8_STAGE(PG8_SA(1, 0), a3, w20);
            PG8_WAIT_V(8); PG8_WAIT_L(0); PG8_BAR; PG8_MMA(1, 0, At, B0); PG8_MMA(1, 1, At, B1); PG8_BAR; PG8_SCHED;
            } else if constexpr (SP2) {
            PG8_LDB(B0, 0, 0); PG8_LDB(B1, 0, 1); PG8_SCHED; PG8_LDA(At, 0, 0); PG8_STAGE(PG8_SA(1, 1), a1 + hstepA, vc1);
            PG8_WAIT_V(8); PG8_WAIT_L(0); PG8_BAR; PG8_MMA(0, 0, At, B0); PG8_MMA(0, 1, At, B1); PG8_BAR; PG8_SCHED;
            PG8_LDA(At, 0, 1); PG8_STAGE(PG8_SB(0, 0), b2, voffB); PG8_STAGE(PG8_SB(0, 1), b2 + hstepB, voffB); PG8_STAGE(PG8_SA(0, 0), a2, w20);
            PG8_WAIT_V(8); PG8_WAIT_L(0); PG8_BAR; PG8_MMA(1, 0, At, B0); PG8_MMA(1, 1, At, B1); PG8_BAR; PG8_SCHED;
            PG8_LDB(B0, 1, 0); PG8_LDB(B1, 1, 1); PG8_SCHED; PG8_LDA(At, 1, 0); PG8_STAGE(PG8_SA(0, 1), a2 + hstepA, w21);
            PG8_WAIT_V(8); PG8_WAIT_L(0); PG8_BAR; PG8_MMA(0, 0, At, B0); PG8_MMA(0, 1, At, B1); PG8_BAR; PG8_SCHED;
            PG8_LDA(At, 1, 1); PG8_STAGE(PG8_SB(1, 0), b3, voffB); PG8_STAGE(PG8_SB(1, 1), b3 + hstepB, voffB); PG8_STAGE(PG8_SA(1, 0), a3, w20);
            PG8_WAIT_V(8); PG8_WAIT_L(0); PG8_BAR; PG8_MMA(1, 0, At, B0); PG8_MMA(1, 1, At, B1); PG8_BAR; PG8_SCHED;
            } else {
            PG8_LDB(B0, 0, 0); PG8_SCHED; PG8_LDA(At, 0, 0); PG8_STAGE(PG8_SA(1, 1), a1 + hstepA, vc1);
            PG8_WAIT_L(8); PG8_BAR; PG8_WAIT_L(0); PG8_MMA(0, 0, At, B0); PG8_BAR; PG8_SCHED;
            PG8_LDB(B1, 0, 1); PG8_STAGE(PG8_SB(0, 0), b2, voffB);
            PG8_BAR; PG8_WAIT_L(0); PG8_MMA(0, 1, At, B1); PG8_BAR;
            PG8_LDA(At, 0, 1); PG8_STAGE(PG8_SA(0, 0), a2, w20);
            PG8_BAR; PG8_WAIT_L(0); PG8_MMA(1, 0, At, B0); PG8_BAR; PG8_SCHED;
            PG8_STAGE(PG8_SB(0, 1), b2 + hstepB, voffB);
            PG8_WAIT_V(6); PG8_BAR; PG8_MMA(1, 1, At, B1); PG8_BAR;
            PG8_LDB(B0, 1, 0); PG8_SCHED; PG8_LDA(At, 1, 0); PG8_STAGE(PG8_SA(0, 1), a2 + hstepA, w21);
            PG8_WAIT_L(8); PG8_BAR; PG8_WAIT_L(0); PG8_MMA(0, 0, At, B0); PG8_BAR; PG8_SCHED;
            PG8_LDB(B1, 1, 1); PG8_STAGE(PG8_SB(1, 0), b3, voffB);
            PG8_BAR; PG8_WAIT_L(0); PG8_MMA(0, 1, At, B1); PG8_BAR;
            PG8_LDA(At, 1, 1); PG8_STAGE(PG8_SA(1, 0), a3, w20);
            PG8_BAR; PG8_WAIT_L(0); PG8_MMA(1, 0, At, B0); PG8_BAR; PG8_SCHED;
            PG8_STAGE(PG8_SB(1, 1), b3 + hstepB, voffB);
            PG8_WAIT_V(6); PG8_BAR; PG8_MMA(1, 1, At, B1); PG8_BAR;
            }
        }
        if constexpr (ALIGN_EPI) { if (wr == 0) PG8_BAR; }
        if constexpr (ROLL) { int fr_ = fr, fq_ = fq; asm volatile("" : "+v"(fr_), "+v"(fq_)); E.half(acc, cur, 0, wr, wc, fr_, fq_, PG8_TABP(ui)); E.half(acc, cur, 1, wr, wc, fr_, fq_, PG8_TABP(ui)); pst = E.stores(cur, wc); }
        else E(acc, cur, wr, wc, fr, fq);
        S.done(cur);
        if (!has_next) break;
#pragma unroll
        for (int a = 0; a < 2; ++a)
#pragma unroll
            for (int b = 0; b < 2; ++b)
#pragma unroll
                for (int m = 0; m < 4; ++m)
#pragma unroll
                    for (int n = 0; n < 2; ++n) acc[a][b][m][n] = (f32x4){0.f, 0.f, 0.f, 0.f};
        cur = nxt; cA = nA; cB = nB; ++ui;
#pragma unroll
        for (int i = 0; i < 2; ++i) { vc0[i] = vn0[i]; vc1[i] = vn1[i]; }
        if constexpr (ALIGN_EPI) { if (wr == 1) PG8_BAR; }
    }
    PG8_WAIT_V(0);
    if constexpr (!ALIGN_EPI) { if (wr == 0) PG8_BAR; }
    PG8_BAR;
}
struct Gemm2 { const char* A0; const char* B0; unsigned rbA0, rbB0; int nt0; const char* A1; const char* B1; unsigned rbA1, rbB1; int nt1; };
constexpr int TAB2_BYTES = 4096;
template <class Epi, class Sched, bool ALIGN_EPI>
__device__ __forceinline__ void gemm_phase2(PG8_LAS unsigned char* lds, const Gemm2 g, const Sched& S, const Epi& E) {
    constexpr bool MX = false;
    const int tid = threadIdx.x, wid = __builtin_amdgcn_readfirstlane(tid >> 6), lane = tid & 63, wr = wid >> 2, wc = wid & 3, fr = lane & 15, fq = lane >> 4;
    unsigned vA0[2], vB0[2], vA1[2], vB1[2];
#pragma unroll
    for (int i = 0; i < 2; ++i) { int R, C; stage_rc(tid * 16 + i * 8192, R, C); const int Rb = Epi::PERM ? ((R & ~31) + perm32(R & 31)) : R;
        vA0[i] = (unsigned)R * g.rbA0 + (unsigned)C * 2u; vB0[i] = (unsigned)Rb * g.rbB0 + (unsigned)C * 2u; vA1[i] = (unsigned)R * g.rbA1 + (unsigned)C * 2u; vB1[i] = (unsigned)Rb * g.rbB1 + (unsigned)C * 2u; }
    const size_t kstep = (size_t)(BK * 2);
    const size_t hA0 = (size_t)HALF * g.rbA0, hB0 = (size_t)HALF * g.rbB0, hA1 = (size_t)HALF * g.rbA1, hB1 = (size_t)HALF * g.rbB1;
    const unsigned ldsw = (unsigned)wid * 1024u;
    const int aoff = lds_byte(wr * 64 + fr, fq * 8), boff = lds_byte(wc * 32 + fr, fq * 8);
#define PG8_MMA8(ai, bj, At, Bt) do { __builtin_amdgcn_s_setprio(1); _Pragma("unroll") for (int m = 0; m < 4; ++m) _Pragma("unroll") for (int n = 0; n < 2; ++n) _Pragma("unroll") for (int k = 0; k < 2; ++k) \
        acc[ai][bj][m][n] = __builtin_bit_cast(f32x4, __builtin_amdgcn_mfma_i32_16x16x64_i8(__builtin_bit_cast(i32x4, Bt[n][k]), __builtin_bit_cast(i32x4, At[m][k]), __builtin_bit_cast(i32x4, acc[ai][bj][m][n]), 0, 0, 0)); __builtin_amdgcn_s_setprio(0); } while (0)
#define PG8_MMAB(ai, bj, At, Bt) do { __builtin_amdgcn_s_setprio(1); _Pragma("unroll") for (int m = 0; m < 4; ++m) _Pragma("unroll") for (int n = 0; n < 2; ++n) _Pragma("unroll") for (int k = 0; k < 2; ++k) \
        acc[ai][bj][m][n] = __builtin_amdgcn_mfma_f32_16x16x32_bf16(Bt[n][k], At[m][k], acc[ai][bj][m][n], 0, 0, 0); __builtin_amdgcn_s_setprio(0); } while (0)
#define PG8_TAB2P(u_) ((const PG8_LAS float*)(lds + TAB_OFF + ((u_) & 1) * TAB2_BYTES))
#define PG8_SEG(NT, CA, CB, HA, HB, VA, VB, NA, NB, NHA, NHB, NVA, NVB, MMA, FIRSTSEG) \
    _Pragma("unroll 1") for (int t = 0; t < (NT); t += 2) { \
        const bool last = (t == (NT) - 2); \
        const char* a1 = (CA) + (size_t)(t + 1) * kstep; \
        const char* a2 = last ? (NA) : (CA) + (size_t)(t + 2) * kstep; const char* b2 = last ? (NB) : (CB) + (size_t)(t + 2) * kstep; \
        const char* a3 = a2 + kstep; const char* b3 = b2 + kstep; \
        const size_t hA2 = last ? (NHA) : (HA), hB2 = last ? (NHB) : (HB); \
        unsigned wa[2], wb[2]; \
        _Pragma("unroll") for (int i = 0; i < 2; ++i) { wa[i] = last ? (NVA)[i] : (VA)[i]; wb[i] = last ? (NVB)[i] : (VB)[i]; } \
        const bool rf = (FIRSTSEG) && (t == 0) && pst; \
        PG8_LDB(B0, 0, 0); PG8_LDB(B1, 0, 1); PG8_SCHED; PG8_LDA(At, 0, 0); PG8_STAGE(PG8_SA(1, 1), a1 + (HA), (VA)); \
        if ((FIRSTSEG) && t == 2) { for (int q = wid; q < 4 * Epi::NTAB; q += 8) __builtin_amdgcn_global_load_lds((const unsigned*)E.tab_src(cur, q * 64 + lane), (PG8_LAS unsigned*)(lds + TAB_OFF + (ui & 1) * TAB2_BYTES + q * 256), 4, 0, 0); } \
        if (rf) PG8_WAIT_VN(8 + 2 * Epi::NS); else PG8_WAIT_V(8); \
        PG8_WAIT_L(0); PG8_BAR; MMA(0, 0, At, B0); MMA(0, 1, At, B1); PG8_BAR; PG8_SCHED; \
        PG8_LDA(At, 0, 1); PG8_STAGE(PG8_SB(0, 0), b2, wb); PG8_STAGE(PG8_SB(0, 1), b2 + hB2, wb); PG8_STAGE(PG8_SA(0, 0), a2, wa); \
        if (rf) PG8_WAIT_VN(8 + 2 * Epi::NS); else PG8_WAIT_V(8); \
        PG8_WAIT_L(0); PG8_BAR; MMA(1, 0, At, B0); MMA(1, 1, At, B1); PG8_BAR; PG8_SCHED; \
        PG8_LDB(B0, 1, 0); PG8_LDB(B1, 1, 1); PG8_SCHED; PG8_LDA(At, 1, 0); PG8_STAGE(PG8_SA(0, 1), a2 + hA2, wa); \
        PG8_WAIT_V(8); PG8_WAIT_L(0); PG8_BAR; MMA(0, 0, At, B0); MMA(0, 1, At, B1); PG8_BAR; PG8_SCHED; \
        PG8_LDA(At, 1, 1); PG8_STAGE(PG8_SB(1, 0), b3, wb); PG8_STAGE(PG8_SB(1, 1), b3 + hB2, wb); PG8_STAGE(PG8_SA(1, 0), a3, wa); \
        PG8_WAIT_V(8); PG8_WAIT_L(0); PG8_BAR; MMA(1, 0, At, B0); MMA(1, 1, At, B1); PG8_BAR; PG8_SCHED; \
    }
    Unit cur, nxt; int ui = 0; bool pst = false;
    if (!S.next(0, cur)) return;
    f32x4 acc[2][2][4][2];
#pragma unroll
    for (int a = 0; a < 2; ++a) PG8_ZERO(a);
    bf16x8 At[4][2], B0[2][2], B1[2][2]; i32x8 AtX[4], B0X[2], B1X[2]; (void)AtX; (void)B0X; (void)B1X;
    const char* cA0 = g.A0 + (size_t)cur.pm * 2 * hA0; const char* cB0 = g.B0 + (size_t)cur.pn * 2 * hB0;
    const char* cA1 = g.A1 + (size_t)cur.pm * 2 * hA1; const char* cB1 = g.B1 + (size_t)cur.pn * 2 * hB1;
    PG8_STAGE(PG8_SB(0, 0), cB0, vB0); PG8_STAGE(PG8_SB(0, 1), cB0 + hB0, vB0); PG8_STAGE(PG8_SA(0, 0), cA0, vA0); PG8_STAGE(PG8_SA(0, 1), cA0 + hA0, vA0);
    if (wr == 1) PG8_BAR;
    PG8_WAIT_V(2); PG8_BAR;
    PG8_STAGE(PG8_SB(1, 0), cB0 + kstep, vB0); PG8_STAGE(PG8_SA(1, 0), cA0 + kstep, vA0); PG8_STAGE(PG8_SB(1, 1), cB0 + hB0 + kstep, vB0);
    PG8_WAIT_V(6); PG8_BAR;
    for (;;) {
        const bool has_next = S.next(ui + 1, nxt);
        const char* nA0 = has_next ? g.A0 + (size_t)nxt.pm * 2 * hA0 : cA0; const char* nB0 = has_next ? g.B0 + (size_t)nxt.pn * 2 * hB0 : cB0;
        PG8_SEG(g.nt0, cA0, cB0, hA0, hB0, vA0, vB0, cA1, cB1, hA1, hB1, vA1, vB1, PG8_MMA8, true)
        { int fr_ = fr, fq_ = fq; asm volatile("" : "+v"(fr_), "+v"(fq_)); E.mid(acc, cur, wr, wc, fr_, fq_, PG8_TAB2P(ui)); }
        PG8_SCHED;
        PG8_SEG(g.nt1, cA1, cB1, hA1, hB1, vA1, vB1, nA0, nB0, hA0, hB0, vA0, vB0, PG8_MMAB, false)
        if constexpr (ALIGN_EPI) { if (wr == 0) PG8_BAR; }
        { int fr_ = fr, fq_ = fq; asm volatile("" : "+v"(fr_), "+v"(fq_)); E.half(acc, cur, 0, wr, wc, fr_, fq_, PG8_TAB2P(ui)); E.half(acc, cur, 1, wr, wc, fr_, fq_, PG8_TAB2P(ui)); pst = E.stores(cur, wc); }
        if (!has_next) break;
#pragma unroll
        for (int a = 0; a < 2; ++a) PG8_ZERO(a);
        cur = nxt; cA0 = nA0; cB0 = nB0; cA1 = g.A1 + (size_t)cur.pm * 2 * hA1; cB1 = g.B1 + (size_t)cur.pn * 2 * hB1; ++ui;
        if constexpr (ALIGN_EPI) { if (wr == 1) PG8_BAR; }
    }
    PG8_WAIT_V(0);
    if constexpr (!ALIGN_EPI) { if (wr == 0) PG8_BAR; }
    PG8_BAR;
#undef PG8_SEG
#undef PG8_MMA8
#undef PG8_MMAB
#undef PG8_TAB2P
#undef PG8_SA
#undef PG8_SB
#undef PG8_STAGE
#undef PG8_LDA
#undef PG8_LD32
#undef PG8_LDB
#undef PG8_MMA
#undef PG8_WAIT_V
#undef PG8_WAIT_VN
#undef PG8_ZERO
#undef PG8_TABP
#undef PG8_WAIT_L
#undef PG8_BAR
#undef PG8_SCHED
}
}

#ifndef PG8_SP2
#define PG8_SP2 true
#endif
#ifndef PG8_ALIGN
#define PG8_ALIGN true
#endif
#ifndef PG8_ROLL
#define PG8_ROLL true
#endif
#ifndef PG8_ROLL2
#define PG8_ROLL2 PG8_ROLL
#endif
#ifndef PG8_ROLL5
#define PG8_ROLL5 PG8_ROLL
#endif
#ifndef PG8_ROLL7
#define PG8_ROLL7 PG8_ROLL
#endif
#ifndef PG8_ROLL8
#define PG8_ROLL8 PG8_ROLL
#endif

constexpr int NWAVES = 8, NTHR = 512;
constexpr int D = 4096, NB = 4, SEQ = 4096, T = NB * SEQ, CTXL = 256, TC = NB * CTXL, TA = T + TC;
constexpr int NH = 8, DK = 128, DV = 256;
constexpr int COL_Q = 0, COL_O = 1024, COL_CB = 3072, COL_CC = 5120, COL_CX = 7168, COL_K = 9216, COL_V = 10240, COL_G = 12288;
constexpr int NPROJ = 12288, IN_COLS = 12320, NPAD = 12544;
constexpr int NE = 16, FF = 1024, ADA_N = 6 * D;
constexpr int HM_ROWS = 2 * T + NE * 256;
constexpr float EPS = 1e-6f;

constexpr size_t MiB = 1u << 20;
constexpr size_t WS_CTL = 0, CTL_ZERO_BYTES = 1 * MiB;
constexpr size_t WS_ADA = 1 * MiB;
constexpr size_t WS_GATES = 2 * MiB;
constexpr size_t WS_ELIST = 5 * MiB;
constexpr size_t WS_EW = 6 * MiB;
constexpr size_t WS_WIN = 8 * MiB;
constexpr size_t WS_WOUT = 106 * MiB;
constexpr size_t WS_WE1 = 138 * MiB;
constexpr size_t WS_WE2 = 394 * MiB;
constexpr size_t WS_XM = 522 * MiB;
constexpr size_t WS_PROJ = 658 * MiB;
constexpr size_t WS_SLOT = WS_PROJ, WS_HMOE = WS_PROJ + 256 * MiB;
constexpr size_t WS_HF = 1066 * MiB, WS_HB = 1194 * MiB;
constexpr size_t WS_X1 = 1322 * MiB;
constexpr size_t WS_XM8 = 1578 * MiB;
constexpr size_t WS_WO8 = 1646 * MiB;
constexpr size_t WS_WI8 = 1646 * MiB;
constexpr size_t WS_SA = 1696 * MiB, WS_SB = WS_SA + 256 * 1024;
constexpr size_t WS_END = 1698 * MiB;
static_assert(WS_XM8 + (size_t)TA * D <= WS_WI8 && WS_WI8 + (size_t)NPAD * D <= WS_SA, "ws map int8");
static_assert(WS_GATES + (size_t)TA * 32 * 4 <= WS_ELIST && WS_WIN + (size_t)NPAD * D * 2 <= WS_WOUT && WS_XM + (size_t)TA * D * 2 <= WS_PROJ && WS_PROJ + (size_t)TA * NPROJ * 2 <= WS_HF, "ws map");
static_assert(WS_HMOE + (size_t)HM_ROWS * FF * 2 <= WS_HF, "ws map 2");
constexpr int CW_TMO = 0, CW_CODE = 1, CW_TQ = 1024, CW_CNT = 2048, CW_CMAX = 32768, CW_CMAX2 = 49152, CW_BAR = 4096, CW_RT = 16384;

constexpr int RING_BYTES = 131072;
constexpr int LDS_BYTES = 147456;
constexpr int LDSCTL_OFF = LDS_BYTES - 3072;
constexpr int MISC_OFF = LDSCTL_OFF + 320;
constexpr int MOE_OFF = LDSCTL_OFF + 512;
constexpr int ROWTAB_OFF = LDSCTL_OFF + 1024;

#define GAS __attribute__((address_space(1)))
#define LAS __attribute__((address_space(3)))
typedef unsigned short bf16;
typedef unsigned v4u __attribute__((ext_vector_type(4)));
typedef unsigned v2u __attribute__((ext_vector_type(2)));
typedef float f32x4 __attribute__((ext_vector_type(4)));
typedef GAS unsigned gu32;
#define RLX_AGENT __ATOMIC_RELAXED, __HIP_MEMORY_SCOPE_AGENT
#define LDS_WAIT() asm volatile("s_waitcnt lgkmcnt(0)" ::: "memory")
#define VM_WAIT() asm volatile("s_waitcnt vmcnt(0)" ::: "memory")
__device__ __forceinline__ unsigned pk2(float lo, float hi) { return pg8::cvt_pk_bf16(lo, hi); }
__device__ __forceinline__ float bf_lo(unsigned u) { return __uint_as_float(u << 16); }
__device__ __forceinline__ float bf_hi(unsigned u) { return __uint_as_float(u & 0xffff0000u); }
__device__ __forceinline__ float bf1(bf16 u) { return __uint_as_float(((unsigned)u) << 16); }
__device__ __forceinline__ unsigned pk4_fp8(float a, float b, float c, float d) { int p = __builtin_amdgcn_cvt_pk_fp8_f32(a, b, 0, false); p = __builtin_amdgcn_cvt_pk_fp8_f32(c, d, p, true); return (unsigned)p; }
__device__ __forceinline__ unsigned pk4_i8(float a, float b, float c, float d) { return ((unsigned)(int)rintf(a) & 255u) | (((unsigned)(int)rintf(b) & 255u) << 8) | (((unsigned)(int)rintf(c) & 255u) << 16) | ((unsigned)(int)rintf(d) << 24); }
constexpr float W1_SCALE = 64.f, W2_SCALE = 32.f, SLOT_SCALE = 16.f;
typedef float f32x2v __attribute__((ext_vector_type(2)));
__device__ __forceinline__ f32x4 fp8x4_to_f32(unsigned v) { const f32x2v lo = __builtin_amdgcn_cvt_pk_f32_fp8((int)v, false), hi = __builtin_amdgcn_cvt_pk_f32_fp8((int)v, true); return (f32x4){lo[0], lo[1], hi[0], hi[1]}; }
__device__ __forceinline__ float sigmoidf_(float x) { return __builtin_amdgcn_rcpf(1.f + __expf(-x)); }

#define XB_TMO      128
#define XB_XCNT(j)  (256  + 64 * (j))
#define XB_XSUB(j)  (1280 + 64 * (j))
#define XB_XGEN(j)  (2304 + 64 * (j))
#define XB_TOP      3328
#define XB_TOPGEN   3392
#define XCD_BAR_WORDS 3456
#define XB_SPIN_CAP (1u << 22)
__device__ __forceinline__ unsigned xb_ld(unsigned* p)              { return __hip_atomic_load(p, __ATOMIC_RELAXED, __HIP_MEMORY_SCOPE_AGENT); }
__device__ __forceinline__ unsigned xb_add(unsigned* p, unsigned v) { return __hip_atomic_fetch_add(p, v, __ATOMIC_RELAXED, __HIP_MEMORY_SCOPE_AGENT); }
__device__ __forceinline__ unsigned xb_xcc_id() { return (unsigned)__builtin_amdgcn_s_getreg((3 << 11) | 20) & 0xFu; }
#define XB_SPIN(cond, bar) do { unsigned _sp = 0; while (cond) { __builtin_amdgcn_s_sleep(1); \
    if ((++_sp & 255u) == 0u) { if (xb_ld(&(bar)[XB_TMO])) break; if (_sp > XB_SPIN_CAP) { atomicAdd(&(bar)[XB_TMO], 1u); break; } } } } while (0)
struct XcdBarrier { unsigned* bar; unsigned x; volatile LAS unsigned* st; };
__device__ __forceinline__ XcdBarrier xcd_barrier_post(unsigned* bar, volatile LAS unsigned* st) {
    XcdBarrier b; b.bar = bar; b.x = xb_xcc_id(); b.st = st;
    if (threadIdx.x == 0) (void)xb_add(&bar[XB_XCNT(b.x)], 1u);
    return b;
}
__device__ __forceinline__ void xcd_barrier_complete(unsigned* bar, unsigned x, unsigned& nloc, unsigned& nx) {
    const unsigned G = gridDim.x * gridDim.y * gridDim.z;
    unsigned sum, cnt, mine, sp = 0u;
    for (;;) {
        sum = 0u; cnt = 0u; mine = 0u;
#pragma unroll
        for (unsigned j = 0; j < 16; ++j) { const unsigned c = xb_ld(&bar[XB_XCNT(j)]); sum += c; cnt += (c > 0u) ? 1u : 0u; mine = (j == x) ? c : mine; }
        if (sum == G) break;
        __builtin_amdgcn_s_sleep(1);
        if ((++sp & 255u) == 0u) { if (xb_ld(&bar[XB_TMO])) break; if (sp > XB_SPIN_CAP) { atomicAdd(&bar[XB_TMO], 1u); break; } }
    }
    nloc = mine > 0u ? mine : 1u; nx = cnt > 0u ? cnt : 1u;
}
__device__ __forceinline__ void xcd_barrier(const XcdBarrier& b) {
    asm volatile("s_waitcnt vmcnt(0)" ::: "memory");
    __syncthreads();
    if (threadIdx.x == 0) {
        unsigned* bar = b.bar;
        __builtin_amdgcn_s_waitcnt(0);
        unsigned nloc = b.st[0], nx = b.st[1];
        if (nloc == 0u) { xcd_barrier_complete(bar, b.x, nloc, nx); b.st[0] = nloc; b.st[1] = nx; }
        const unsigned old = xb_add(&bar[XB_XSUB(b.x)], 1u);
        const unsigned gen = old / nloc;
        if (old + 1u == (gen + 1u) * nloc) {
            __builtin_amdgcn_fence(__ATOMIC_RELEASE, "agent");
            asm volatile("s_waitcnt vmcnt(0)" ::: "memory");
            const unsigned og = xb_add(&bar[XB_TOP], 1u);
            const unsigned tg = og / nx;
            if (og + 1u == (tg + 1u) * nx) xb_add(&bar[XB_TOPGEN], 1u);
            else XB_SPIN(xb_ld(&bar[XB_TOPGEN]) == tg, bar);
            __builtin_amdgcn_fence(__ATOMIC_ACQUIRE, "agent");
            xb_add(&bar[XB_XGEN(b.x)], 1u);
            asm volatile("s_waitcnt vmcnt(0)" ::: "memory");
        } else {
            XB_SPIN(xb_ld(&bar[XB_XGEN(b.x)]) == gen, bar);
            __builtin_amdgcn_fence(__ATOMIC_ACQUIRE, "agent");
            asm volatile("s_waitcnt vmcnt(0)" ::: "memory");
        }
    }
    __syncthreads();
}

struct Frame {
    LAS unsigned char* lds;
    volatile LAS unsigned* MISC;
    gu32* ctl;
    int tid, lane, wave;
    int vcu, G;
    const float *x, *c, *ctx, *cctx, *w_ada, *b_ada, *norm1, *w_in, *b_gates, *conv_w, *head_norm, *w_out, *norm2, *w_rg, *b_rg, *w_re, *b_re, *w_e1, *w_e2, *fnorm;
    float* out;
    float *ADA, *GATES, *EW;
    bf16 *DELTA, *X1B;
    unsigned char *XM8, *WO8, *MIXA8, *WOA8; signed char* WI8; float *SA, *SB, *SB2;
    bf16 *HF, *HB;
    int* ELIST;
    bf16 *WIN, *WOUT, *WE1, *WE2, *XM, *PROJ, *MIX, *XF, *SLOT, *HMOE;
};

template <int CTRL, int ROWMASK> __device__ __forceinline__ float dpp_f(float old, float src) {
    return __builtin_bit_cast(float, __builtin_amdgcn_update_dpp(__builtin_bit_cast(int, old), __builtin_bit_cast(int, src), CTRL, ROWMASK, 0xf, false)); }
__device__ __forceinline__ float wave_incl_sum(float v) {
    v += dpp_f<0x111, 0xf>(0.f, v); v += dpp_f<0x112, 0xf>(0.f, v); v += dpp_f<0x114, 0xf>(0.f, v); v += dpp_f<0x118, 0xf>(0.f, v);
    v += dpp_f<0x142, 0xa>(0.f, v); v += dpp_f<0x143, 0xc>(0.f, v); return v; }
__device__ __forceinline__ float wave_incl_max(float v) {
    constexpr float NI = -3.0e38f;
    v = fmaxf(v, dpp_f<0x111, 0xf>(NI, v)); v = fmaxf(v, dpp_f<0x112, 0xf>(NI, v)); v = fmaxf(v, dpp_f<0x114, 0xf>(NI, v)); v = fmaxf(v, dpp_f<0x118, 0xf>(NI, v));
    v = fmaxf(v, dpp_f<0x142, 0xa>(NI, v)); v = fmaxf(v, dpp_f<0x143, 0xc>(NI, v)); return v; }
__device__ __forceinline__ float lane_bcast(float v, int l) { return __builtin_bit_cast(float, __builtin_amdgcn_readlane(__builtin_bit_cast(int, v), l)); }
__device__ __forceinline__ float wave_sum(float v) { return lane_bcast(wave_incl_sum(v), 63); }
__device__ __forceinline__ float wave_max(float v) { return lane_bcast(wave_incl_max(v), 63); }

__device__ __forceinline__ void p0_ada(Frame& F) {
    LAS float* sil = (LAS float*)F.lds;
    LAS float* red = (LAS float*)(F.lds + 81920);
    for (int i = F.tid; i < 5 * D; i += NTHR) { const int b = i >> 12, k = i & (D - 1); const float cv = b < 4 ? F.c[b * D + k] : F.cctx[k]; sil[i] = cv / (1.f + expf(-cv)); }
    __syncthreads();
    const int cq = F.tid % 24, rg = F.tid / 24;
    for (int item = F.vcu; item < ADA_N / 96; item += F.G) {
        const int col0 = item * 96;
        float acc[5][4];
#pragma unroll
        for (int b = 0; b < 5; ++b)
#pragma unroll
            for (int j = 0; j < 4; ++j) acc[b][j] = 0.f;
        if (rg < 21) {
            const float* wp = F.w_ada + col0 + 4 * cq;
#pragma unroll 13
            for (int r = rg; r < D; r += 21) {
                const f32x4 w = *(const f32x4*)(wp + (size_t)r * ADA_N);
#pragma unroll
                for (int b = 0; b < 5; ++b) { const float s = sil[b * D + r];
#pragma unroll
                    for (int j = 0; j < 4; ++j) acc[b][j] += s * w[j]; }
            }
#pragma unroll
            for (int b = 0; b < 5; ++b)
#pragma unroll
                for (int j = 0; j < 4; ++j) red[rg * 480 + b * 96 + 4 * cq + j] = acc[b][j];
        }
        __syncthreads();
        if (F.tid < 480) { const int b = F.tid / 96, cc = F.tid % 96; float s = 0.f;
#pragma unroll
            for (int q = 0; q < 21; ++q) s += red[q * 480 + F.tid];
            F.ADA[b * ADA_N + col0 + cc] = s + F.b_ada[col0 + cc]; }
        __syncthreads();
    }
}
__device__ __forceinline__ int win_row(int n) {
    if (n < COL_CC || n >= COL_K) return n;
    const int rel = n - COL_CC, au = rel >> 11, r = rel & 2047;
    return COL_CC + 256 * (r >> 7) + 128 * au + (r & 127);
}
struct TItem { const float* W; bf16* WT; const void* cmax; unsigned* cmo; int K, N, nblk, row_off, item, map, f8; float scale; };
template <int KIND>
__device__ __forceinline__ TItem titem_decode(Frame& F, int r) {
    constexpr int I_E1 = (D / 64) * (2 * FF / 32), I_E2 = (FF / 64) * (D / 32);
    TItem t; t.cmax = (const void*)(F.ctl + CW_CMAX); t.cmo = nullptr;
    if (KIND == 8) { t.W = F.w_in; t.WT = (bf16*)F.WI8; t.K = D; t.N = IN_COLS; t.nblk = IN_COLS / 32; t.row_off = 0; t.item = (D / 64) * (IN_COLS / 32) - 1 - r; t.map = 2; t.f8 = 2; t.scale = 1.f; }
    else if (KIND == 0) { t.W = F.w_in; t.WT = F.WIN; t.K = D; t.N = IN_COLS; t.nblk = IN_COLS / 32; t.row_off = 0; t.map = 0; t.f8 = 0; t.scale = 1.f;
        { constexpr int NBP = (IN_COLS - COL_K) / 32; const int kb = r / NBP, nbp = r % NBP; t.item = kb * (IN_COLS / 32) + COL_K / 32 + nbp; } }
    else if (KIND == 1) { t.W = F.w_out; t.WT = F.WOUT; t.K = D; t.N = D; t.nblk = D / 32; t.row_off = 0; t.item = r; t.map = 0; t.f8 = 0; t.scale = 1.f; t.cmo = (unsigned*)(F.ctl + CW_CMAX2); }
    else if (KIND == 2) { const int e = r / I_E1; t.W = F.w_e1 + (size_t)e * D * 2 * FF; t.WT = F.WE1; t.K = D; t.N = 2 * FF; t.nblk = 2 * FF / 32; t.row_off = e * 2 * FF; t.item = r % I_E1; t.map = 1; t.f8 = 1; t.scale = W1_SCALE; }
    else { const int e = r / I_E2; t.W = F.w_e2 + (size_t)e * FF * D; t.WT = F.WE2; t.K = FF; t.N = D; t.nblk = D / 32; t.row_off = e * D; t.item = r % I_E2; t.map = 0; t.f8 = 1; t.scale = W2_SCALE; }
    return t;
}
__device__ __forceinline__ void titem_load(const TItem& t, int lane, f32x4 (&v)[8]) {
    const int nblk = t.nblk, kb = t.item / nblk, nb = t.item % nblk, k0 = 64 * kb, n0 = 32 * nb;
    const float* p = t.W + (size_t)(k0 + (lane >> 3)) * t.N + n0 + 4 * (lane & 7);
#pragma unroll
    for (int i = 0; i < 8; ++i) v[i] = *(const f32x4*)(p + (size_t)(8 * i) * t.N);
}
__device__ __forceinline__ void titem_finish(const TItem& cur, LAS float* scr, int lane) {
    const int nblk = cur.nblk, kb = cur.item / nblk, nb = cur.item % nblk, k0 = 64 * kb, n0 = 32 * nb, c = lane & 7;
#pragma unroll
    for (int j = 0; j < 4; ++j) { const int n = (lane >> 3) + 8 * j; const LAS float* s = scr + (8 * c) * 33 + n;
        const int nn = n0 + n; int row;
        if (cur.map == 0) row = cur.row_off + nn;
        else if (cur.map == 2) row = win_row(nn);
        else { const int au = nn >> 10, r = nn & 1023; row = cur.row_off + 256 * (r >> 7) + 128 * au + (r & 127); }
        const float sc = cur.scale;
        if (cur.f8 == 2) { const float cm = __uint_as_float(((const unsigned*)cur.cmax)[nn]), iv = cm > 0.f ? 127.f / cm : 0.f;
            *(v2u*)((unsigned char*)cur.WT + (size_t)row * cur.K + k0 + 8 * c) = (v2u){pk4_i8(s[0 * 33] * iv, s[1 * 33] * iv, s[2 * 33] * iv, s[3 * 33] * iv), pk4_i8(s[4 * 33] * iv, s[5 * 33] * iv, s[6 * 33] * iv, s[7 * 33] * iv)}; }
        else if (cur.f8) { *(v2u*)((unsigned char*)cur.WT + (size_t)row * cur.K + k0 + 8 * c) = (v2u){pk4_fp8(s[0 * 33] * sc, s[1 * 33] * sc, s[2 * 33] * sc, s[3 * 33] * sc), pk4_fp8(s[4 * 33] * sc, s[5 * 33] * sc, s[6 * 33] * sc, s[7 * 33] * sc)}; }
        else { v4u o; o.x = pk2(s[0 * 33], s[1 * 33]); o.y = pk2(s[2 * 33], s[3 * 33]); o.z = pk2(s[4 * 33], s[5 * 33]); o.w = pk2(s[6 * 33], s[7 * 33]);
               *(v4u*)(cur.WT + (size_t)row * cur.K + k0 + 8 * c) = o;
               if (cur.cmo != nullptr && k0 < D / 2) {
                   unsigned mx = max(max(max((o.x & 0x7fffu) << 16, o.x & 0x7fff0000u), max((o.y & 0x7fffu) << 16, o.y & 0x7fff0000u)), max(max((o.z & 0x7fffu) << 16, o.z & 0x7fff0000u), max((o.w & 0x7fffu) << 16, o.w & 0x7fff0000u)));
                   mx = max(mx, (unsigned)__shfl_xor((int)mx, 1)); mx = max(mx, (unsigned)__shfl_xor((int)mx, 2)); mx = max(mx, (unsigned)__shfl_xor((int)mx, 4));
                   if (c == 0) (void)__hip_atomic_fetch_max(cur.cmo + nn, mx, RLX_AGENT); } } }
}
constexpr int TI_IN = (D / 64) * (IN_COLS / 32), TI_OUT = (D / 64) * (D / 32), TI_E1 = (D / 64) * (2 * FF / 32), TI_E2 = (FF / 64) * (D / 32);
template <int KIND>
__device__ __forceinline__ void transpose_range(Frame& F, LAS float* scr, int it0, int it_end, int stride) {
    const int lane = F.lane;
    f32x4 v[8];
    int it = it0;
    TItem cur = titem_decode<KIND>(F, it < it_end ? it : 0);
    if (it < it_end) titem_load(cur, lane, v);
    while (it < it_end) {
#pragma unroll
        for (int i = 0; i < 8; ++i) { const int kk = 8 * i + (lane >> 3); LAS float* s = scr + kk * 33 + 4 * (lane & 7); s[0] = v[i][0]; s[1] = v[i][1]; s[2] = v[i][2]; s[3] = v[i][3]; }
        const int nit = it + stride;
        TItem nxt = cur;
        if (nit < it_end) { nxt = titem_decode<KIND>(F, nit); titem_load(nxt, lane, v); }
        LDS_WAIT(); asm volatile("" ::: "memory");
        titem_finish(cur, scr, lane);
        LDS_WAIT(); asm volatile("" ::: "memory");
        cur = nxt; it = nit;
    }
}
__device__ __forceinline__ void p0_transposes(Frame& F) {
    LAS float* scr = (LAS float*)(F.lds + F.wave * 8704);
    const int gw = F.vcu * NWAVES + F.wave, NGW = F.G * NWAVES;
    transpose_range<1>(F, scr, gw, TI_OUT, NGW);
    {
        constexpr int NIT = (D / 64) * (IN_COLS / 32);
        const int lane = F.lane;
        auto cm_load = [&](int it, f32x4 (&w)[8]) __attribute__((always_inline)) {
            const int itc = it < NIT ? it : NIT - 1, kb = itc / (IN_COLS / 32), nb = itc % (IN_COLS / 32);
            const float* p = F.w_in + (size_t)(64 * kb + (lane >> 3)) * IN_COLS + 32 * nb + 4 * (lane & 7);
#pragma unroll
            for (int i = 0; i < 8; ++i) w[i] = *(const f32x4*)(p + (size_t)(8 * i) * IN_COLS);
        };
        auto cm_step = [&](int it, f32x4 (&cur)[8], f32x4 (&nxt)[8]) __attribute__((always_inline)) {
            cm_load(it + NGW, nxt);
            if (it < NIT) {
                const int nb = it % (IN_COLS / 32);
                f32x4 mx = (f32x4){0.f, 0.f, 0.f, 0.f};
#pragma unroll
                for (int i = 0; i < 8; ++i) { mx[0] = fmaxf(mx[0], fabsf(cur[i][0])); mx[1] = fmaxf(mx[1], fabsf(cur[i][1])); mx[2] = fmaxf(mx[2], fabsf(cur[i][2])); mx[3] = fmaxf(mx[3], fabsf(cur[i][3])); }
#pragma unroll
                for (int o = 8; o < 64; o <<= 1) { mx[0] = fmaxf(mx[0], __shfl_xor(mx[0], o)); mx[1] = fmaxf(mx[1], __shfl_xor(mx[1], o)); mx[2] = fmaxf(mx[2], __shfl_xor(mx[2], o)); mx[3] = fmaxf(mx[3], __shfl_xor(mx[3], o)); }
                if (lane < 8) { unsigned* cm = (unsigned*)(F.ctl + CW_CMAX) + 32 * nb + 4 * lane;
#pragma unroll
                    for (int j = 0; j < 4; ++j) asm volatile("global_atomic_umax %0, %1, off" :: "v"(cm + j), "v"(__float_as_uint(mx[j])) : "memory"); }
            }
        };
        f32x4 wa[8], wb[8];
        cm_load(gw, wa);
        for (int it = gw; it < NIT; it += 2 * NGW) { cm_step(it, wa, wb); cm_step(it + NGW, wb, wa); }
        asm volatile("s_waitcnt vmcnt(0) ; hidden atomics" ::: "memory");
    }
    { const size_t n16 = (size_t)(NPAD - IN_COLS) * D / 16; v4u* p = (v4u*)(F.WI8 + (size_t)IN_COLS * D);
      for (size_t i = (size_t)F.vcu * NTHR + F.tid; i < n16; i += (size_t)F.G * NTHR) p[i] = (v4u){0u, 0u, 0u, 0u}; }
}
__device__ __forceinline__ int expert_queue_items(int G) { const int tot = NE * (TI_E1 + TI_E2), p3 = (4 + SEQ / 64) * G * NWAVES / 2; return tot > p3 ? tot - p3 : 0; }
struct HItem { const float* src; unsigned char* dst; int N, Kb, map, row0; float scale; };
__device__ __forceinline__ HItem hitem_decode(Frame& F, int hi) {
    const int fi = hi >> 1, sub = hi & 1; HItem t;
    if (fi < NE * TI_E1) { const int e = fi / TI_E1, item = fi % TI_E1, kb = item >> 6, nb = item & 63, n0 = 32 * nb + 16 * sub;
        t.N = 2 * FF; t.Kb = D; t.map = 1; t.scale = W1_SCALE; t.src = F.w_e1 + (size_t)e * D * 2 * FF + (size_t)(64 * kb) * t.N + n0;
        const int au = n0 >> 10, r = n0 & 1023; t.row0 = e * 2 * FF + 256 * (r >> 7) + 128 * au + (r & 127); t.dst = (unsigned char*)F.WE1 + 64 * kb; }
    else { const int f2 = fi - NE * TI_E1, e = f2 / TI_E2, item = f2 % TI_E2, kb = item >> 7, nb = item & 127, n0 = 32 * nb + 16 * sub;
        t.N = D; t.Kb = FF; t.map = 0; t.scale = W2_SCALE; t.src = F.w_e2 + (size_t)e * FF * D + (size_t)(64 * kb) * t.N + n0;
        t.row0 = e * D + n0; t.dst = (unsigned char*)F.WE2 + 64 * kb; }
    return t;
}
__device__ __forceinline__ void hitem_load(const HItem& t, int lane, f32x4 (&v)[4]) {
    const float* p = t.src + (size_t)(lane >> 2) * t.N + 4 * (lane & 3);
#pragma unroll
    for (int i = 0; i < 4; ++i) v[i] = *(const f32x4*)(p + (size_t)(16 * i) * t.N);
}
__device__ __forceinline__ void hitem_to_lds(int lane, const f32x4 (&v)[4], LAS float* scr) {
#pragma unroll
    for (int i = 0; i < 4; ++i) { LAS float* s = scr + (16 * i + (lane >> 2)) * 17 + 4 * (lane & 3); s[0] = v[i][0]; s[1] = v[i][1]; s[2] = v[i][2]; s[3] = v[i][3]; }
}
__device__ __forceinline__ void hitem_store(const HItem& t, int lane, LAS float* scr) {
    LDS_WAIT(); asm volatile("" ::: "memory");
    const int n = lane & 15, kc = lane >> 4; const LAS float* s = scr + (16 * kc) * 17 + n; const float sc = t.scale;
    v4u o;
    o.x = pk4_fp8(s[0 * 17] * sc, s[1 * 17] * sc, s[2 * 17] * sc, s[3 * 17] * sc); o.y = pk4_fp8(s[4 * 17] * sc, s[5 * 17] * sc, s[6 * 17] * sc, s[7 * 17] * sc);
    o.z = pk4_fp8(s[8 * 17] * sc, s[9 * 17] * sc, s[10 * 17] * sc, s[11 * 17] * sc); o.w = pk4_fp8(s[12 * 17] * sc, s[13 * 17] * sc, s[14 * 17] * sc, s[15 * 17] * sc);
    *(v4u*)(t.dst + (size_t)(t.row0 + n) * t.Kb + 16 * kc) = o;
    LDS_WAIT(); asm volatile("" ::: "memory");
}
__device__ __forceinline__ void gstore8_hidden(void* p, v2u v) { asm volatile("global_store_dwordx2 %0, %1, off" :: "v"(p), "v"(v) : "memory"); }
__device__ __forceinline__ void gstore16_hidden(void* p, v4u v) { asm volatile("global_store_dwordx4 %0, %1, off" :: "v"(p), "v"(v) : "memory"); }
__device__ __forceinline__ void hitem_store_hidden(const HItem& t, int lane, LAS float* scr) {
    LDS_WAIT(); asm volatile("" ::: "memory");
    const int n = lane & 15, kc = lane >> 4; const LAS float* s = scr + (16 * kc) * 17 + n; const float sc = t.scale;
    v4u o;
    o.x = pk4_fp8(s[0 * 17] * sc, s[1 * 17] * sc, s[2 * 17] * sc, s[3 * 17] * sc); o.y = pk4_fp8(s[4 * 17] * sc, s[5 * 17] * sc, s[6 * 17] * sc, s[7 * 17] * sc);
    o.z = pk4_fp8(s[8 * 17] * sc, s[9 * 17] * sc, s[10 * 17] * sc, s[11 * 17] * sc); o.w = pk4_fp8(s[12 * 17] * sc, s[13 * 17] * sc, s[14 * 17] * sc, s[15 * 17] * sc);
    gstore16_hidden(t.dst + (size_t)(t.row0 + n) * t.Kb + 16 * kc, o);
    LDS_WAIT(); asm volatile("" ::: "memory");
}
__device__ __forceinline__ void hitem_read(int lane, const LAS float* scr, float (&hr)[16]) {
    const int n = lane & 15, kc = lane >> 4; const LAS float* s = scr + (16 * kc) * 17 + n;
#pragma unroll
    for (int j = 0; j < 16; ++j) hr[j] = s[j * 17];
}
__device__ __forceinline__ void hitem_pack_store(const HItem& t, int lane, const float (&hr)[16]) {
    const int n = lane & 15, kc = lane >> 4; const float sc = t.scale;
    v4u o;
    o.x = pk4_fp8(hr[0] * sc, hr[1] * sc, hr[2] * sc, hr[3] * sc); o.y = pk4_fp8(hr[4] * sc, hr[5] * sc, hr[6] * sc, hr[7] * sc);
    o.z = pk4_fp8(hr[8] * sc, hr[9] * sc, hr[10] * sc, hr[11] * sc); o.w = pk4_fp8(hr[12] * sc, hr[13] * sc, hr[14] * sc, hr[15] * sc);
    gstore16_hidden(t.dst + (size_t)(t.row0 + n) * t.Kb + 16 * kc, o);
}
constexpr int TQ_BATCH = 16;
static_assert((NE * TI_E1) % TQ_BATCH == 0 && (NE * TI_E2) % TQ_BATCH == 0, "queue batches stay inside one kind");
__device__ __forceinline__ void expert_transpose_queue(Frame& F) {
    LAS float* scr = (LAS float*)(F.lds + F.wave * 8704);
    for (;;) {
        int base = 0;
        if (F.lane == 0) base = (int)__hip_atomic_fetch_add((unsigned*)(F.ctl + CW_TQ), (unsigned)TQ_BATCH, RLX_AGENT);
        base = __builtin_amdgcn_readfirstlane(base);
        if (base >= expert_queue_items(F.G)) break;
        if (base < NE * TI_E1) transpose_range<2>(F, scr, base, base + TQ_BATCH, 1);
        else transpose_range<3>(F, scr, base - NE * TI_E1, base - NE * TI_E1 + TQ_BATCH, 1);
    }
}

__device__ __forceinline__ void p1_quant_weights(Frame& F) {
    __syncthreads();
    LAS float* scr = (LAS float*)(F.lds + F.wave * 8704);
    const int gw = F.vcu * NWAVES + F.wave, NGW = F.G * NWAVES;
    transpose_range<8>(F, scr, gw, (D / 64) * (IN_COLS / 32), NGW);
    for (int n = F.vcu * NTHR + F.tid; n < IN_COLS; n += F.G * NTHR) F.SB[win_row(n)] = __uint_as_float(((const unsigned*)(F.ctl + CW_CMAX))[n]) * (1.f / 127.f);
}
__device__ __forceinline__ void p1_quant_wout(Frame& F) {
    const int gw = F.vcu * NWAVES + F.wave, NGW = F.G * NWAVES, lane = F.lane;
    for (int n = gw; n < D; n += NGW) {
        const unsigned cmb = ((const unsigned*)(F.ctl + CW_CMAX2))[n]; const float cm = __uint_as_float(cmb), iv = cm > 0.f ? 127.f / cm : 0.f;
        const bf16* src = F.WOUT + (size_t)n * D; unsigned char* dst = F.WOA8 + (size_t)n * (D / 2);
        v4u v[4];
#pragma unroll
        for (int j = 0; j < 4; ++j) v[j] = *(const v4u*)(src + 512 * j + 8 * lane);
#pragma unroll
        for (int j = 0; j < 4; ++j) *(v2u*)(dst + 512 * j + 8 * lane) = (v2u){pk4_i8(bf_lo(v[j].x) * iv, bf_hi(v[j].x) * iv, bf_lo(v[j].y) * iv, bf_hi(v[j].y) * iv), pk4_i8(bf_lo(v[j].z) * iv, bf_hi(v[j].z) * iv, bf_lo(v[j].w) * iv, bf_hi(v[j].w) * iv)};
        if (lane == 0) F.SB2[n] = cm * (1.f / 127.f);
    }
}
__device__ __forceinline__ void p1_norm(Frame& F) {
    LAS float* fac = (LAS float*)F.lds; LAS float* sh = fac + D;
    const int gw = F.vcu * NWAVES + F.wave, NGW = F.G * NWAVES;
    for (int bb = 0; bb < 5; ++bb) {
        __syncthreads();
        for (int i = F.tid; i < D; i += NTHR) { fac[i] = F.norm1[i] * (1.f + F.ADA[bb * ADA_N + D + i]); sh[i] = F.ADA[bb * ADA_N + i]; }
        __syncthreads();
        const int nrows = bb < 4 ? SEQ : TC; const float* src = bb < 4 ? F.x + (size_t)bb * SEQ * D : F.ctx; const int drow0 = bb < 4 ? bb * SEQ : T;
        for (int r = gw; r < nrows; r += 2 * NGW) {
            int lane = F.lane; asm volatile("" : "+v"(lane));
            const int r2 = r + NGW; const bool has2 = r2 < nrows; const int r2c = has2 ? r2 : r;
            const f32x4* xa = (const f32x4*)(src + (size_t)r * D) + lane; const f32x4* xb = (const f32x4*)(src + (size_t)r2c * D) + lane;
            f32x4 va[16], vb[16]; float sa = 0.f, sb = 0.f;
#pragma unroll
            for (int j = 0; j < 16; ++j) { va[j] = xa[64 * j]; vb[j] = xb[64 * j]; }
#pragma unroll
            for (int j = 0; j < 16; ++j) { sa = fmaf(va[j][0], va[j][0], fmaf(va[j][1], va[j][1], fmaf(va[j][2], va[j][2], fmaf(va[j][3], va[j][3], sa))));
                                           sb = fmaf(vb[j][0], vb[j][0], fmaf(vb[j][1], vb[j][1], fmaf(vb[j][2], vb[j][2], fmaf(vb[j][3], vb[j][3], sb)))); }
            const float ra = rsqrtf(wave_sum(sa) * (1.f / D) + EPS), rb = rsqrtf(wave_sum(sb) * (1.f / D) + EPS);
#pragma unroll
            for (int j = 0; j < 16; ++j) { const f32x4 fa = *(const LAS f32x4*)(fac + 256 * j + 4 * lane), sv = *(const LAS f32x4*)(sh + 256 * j + 4 * lane);
                va[j] = va[j] * ra * fa + sv; vb[j] = vb[j] * rb * fa + sv; }
            {
                float ma = 0.f, mb = 0.f;
#pragma unroll
                for (int j = 0; j < 16; ++j) { ma = fmaxf(ma, fmaxf(fmaxf(fabsf(va[j][0]), fabsf(va[j][1])), fmaxf(fabsf(va[j][2]), fabsf(va[j][3])))); mb = fmaxf(mb, fmaxf(fmaxf(fabsf(vb[j][0]), fabsf(vb[j][1])), fmaxf(fabsf(vb[j][2]), fabsf(vb[j][3])))); }
                ma = wave_max(ma); mb = wave_max(mb);
                const float ia = ma > 0.f ? 127.f / ma : 0.f, ib = mb > 0.f ? 127.f / mb : 0.f;
                if (lane == 0) { F.SA[drow0 + r] = ma * (1.f / 127.f); if (has2) F.SA[drow0 + r2c] = mb * (1.f / 127.f); }
#pragma unroll
                for (int j = 0; j < 16; ++j) { ((unsigned*)(F.XM8 + (size_t)(drow0 + r) * D) + lane)[64 * j] = pk4_i8(va[j][0] * ia, va[j][1] * ia, va[j][2] * ia, va[j][3] * ia);
                    if (has2) ((unsigned*)(F.XM8 + (size_t)(drow0 + r2c) * D) + lane)[64 * j] = pk4_i8(vb[j][0] * ib, vb[j][1] * ib, vb[j][2] * ib, vb[j][3] * ib); }
            }
        }
    }
}

namespace ml {
constexpr int QP = 272, VP = 160, PP = 144, CP = 272;
constexpr int OFF_Q = 0, OFF_K = OFF_Q + 64 * QP, OFF_V = OFF_K + 64 * QP, OFF_VW = OFF_V + 64 * VP, OFF_P = OFF_VW + 64 * VP, OFF_CB = OFF_P + 64 * PP, CB_BYTES = 80 * CP, LDS_END = OFF_CB + 2 * CB_BYTES;
static_assert(LDS_END <= RING_BYTES, "mlstm LDS");
typedef short s16x4 __attribute__((ext_vector_type(4)));
typedef short bf16x8 __attribute__((ext_vector_type(8)));
__device__ __forceinline__ s16x4 tr(const LAS unsigned char* p) { return __builtin_bit_cast(s16x4, __builtin_amdgcn_ds_read_tr16_b64_v4i16((LAS s16x4*)p)); }
__device__ __forceinline__ bf16x8 trfrag(const LAS unsigned char* p, int pitch) { const s16x4 a = tr(p), b = tr(p + 4 * pitch); return (bf16x8){a[0], a[1], a[2], a[3], b[0], b[1], b[2], b[3]}; }
__device__ __forceinline__ bf16x8 ld16(const LAS unsigned char* p) { return *(const LAS bf16x8*)p; }
__device__ __forceinline__ int row_of(int c, int p, int dir, int b) {
    if (c < 4) { const int i = 64 * c + p; return T + b * CTXL + (dir ? (CTXL - 1 - i) : i); }
    const int i = 64 * (c - 4) + p; return b * SEQ + (dir ? (SEQ - 1 - i) : i);
}
}
#define ML_BAR() do { asm volatile("s_waitcnt lgkmcnt(0)" ::: "memory"); __builtin_amdgcn_s_barrier(); asm volatile("" ::: "memory"); } while (0)
__device__ __forceinline__ void p3_mlstm(Frame& F) {
    using namespace ml;
    LAS unsigned char* lds = F.lds;
    const int tid = F.tid, lane = F.lane, wave = F.wave, li = lane & 15, lg = lane >> 4, lq = (lane & 15) >> 2, lp = lane & 3;
    constexpr float QS = 0.08838834764831845f;
    constexpr int NCH = 4 + SEQ / 64;
    constexpr int SC_A = LDS_END, SC_M = SC_A + 256, SC_B = SC_M + 256;
    constexpr int HSCR_OFF = SC_B + 256;
    static_assert(HSCR_OFF + NWAVES * 4352 <= LDSCTL_OFF, "mlstm LDS");
    for (int unit = F.vcu; unit < NB * NH * 2 * 4; unit += F.G) {
        const int vq = unit & 3, dir = (unit >> 2) & 1, h = (unit >> 3) & 7, b = unit >> 6;
        bf16* HO = dir ? F.HB : F.HF;
        __syncthreads();
        unsigned z0 = 0u; asm volatile("" : "+v"(z0));
        for (int i = tid; i < CB_BYTES / 16; i += NTHR) *(LAS v4u*)(lds + OFF_CB + 16 * i) = (v4u){z0, z0, z0, z0};
        if (tid < 64) { *(LAS v4u*)(lds + OFF_V + tid * VP + 128) = (v4u){0x00003F80u | z0, z0, z0, z0}; *(LAS v4u*)(lds + OFF_V + tid * VP + 144) = (v4u){z0, z0, z0, z0};
                        *(LAS v4u*)(lds + OFF_VW + tid * VP + 128) = (v4u){z0, z0, z0, z0}; *(LAS v4u*)(lds + OFF_VW + tid * VP + 144) = (v4u){z0, z0, z0, z0}; }
        f32x4 Cacc[5];
#pragma unroll
        for (int i = 0; i < 5; ++i) Cacc[i] = (f32x4){0.f, 0.f, 0.f, 0.f};
        v4u rq[2], rk[2], rv; float ig, fp;
        rq[0] = rq[1] = (v4u){0u, 0u, 0u, 0u};
        const GAS bf16* pk_[2]; const GAS bf16* pv_; const GAS float* pg_;
#define ML_SETPTR(cc) do { const int cs_ = (cc); \
        _Pragma("unroll") for (int i = 0; i < 2; ++i) { const int id = tid + NTHR * i, p = id >> 4, ch = id & 15; pk_[i] = (const GAS bf16*)F.PROJ + (size_t)row_of(cs_, p, dir, b) * NPROJ + COL_K + h * DK + 8 * ch; } \
        { const int p = tid >> 3, ch = tid & 7; pv_ = (const GAS bf16*)F.PROJ + (size_t)row_of(cs_, p, dir, b) * NPROJ + COL_V + h * DV + vq * 64 + 8 * ch; } \
        pg_ = (const GAS float*)F.GATES + (size_t)row_of(cs_, lane, dir, b) * 32 + dir * 16 + h; } while (0)
#define ML_PREFETCH(cc) do { const int c_ = (cc); if (c_ == 0 || c_ == 4) ML_SETPTR(c_); \
        _Pragma("unroll") for (int i = 0; i < 2; ++i) { rk[i] = *(const GAS v4u*)pk_[i]; rq[i] = *(const GAS v4u*)(pk_[i] + (COL_Q - COL_K)); pk_[i] += pstep; } \
        rv = *(const GAS v4u*)pv_; pv_ += pstep; ig = pg_[0]; fp = pg_[8]; pg_ += gstep; } while (0)
        const long pstep = (dir ? -64 : 64) * (long)NPROJ, gstep = (dir ? -64 : 64) * 32;
        float bc, g, Ap, Mp, M63, wS, decay, wsv, m = 0.f;
#define ML_SCALARS(m_in) do { const float lf_ = fminf(fp, 0.f) - 0.6931471805599453f * __log2f(1.f + __expf(-fabsf(fp))); \
        bc = wave_incl_sum(lf_); g = lane_bcast(bc, 63); Ap = ig - bc; const float PA_ = wave_incl_max(Ap), Amax_ = lane_bcast(PA_, 63); \
        Mp = fmaxf((m_in), PA_); M63 = fmaxf((m_in), Amax_); wS = __expf(Ap - M63); decay = __expf((m_in) - M63); wsv = __shfl(wS, 8 * wave + (lane >> 3)); } while (0)
#define ML_STAGE() do { \
        _Pragma("unroll") for (int i = 0; i < 2; ++i) { const int id = tid + NTHR * i, p = id >> 4, ch = id & 15; \
            *(LAS v4u*)(lds + OFF_K + p * QP + 16 * ch) = rk[i]; *(LAS v4u*)(lds + OFF_Q + p * QP + 16 * ch) = rq[i]; } \
        { const int p = tid >> 3, ch = tid & 7; \
          *(LAS v4u*)(lds + OFF_V + p * VP + 16 * ch) = rv; \
          v4u o; o.x = pk2(bf_lo(rv.x) * wsv, bf_hi(rv.x) * wsv); o.y = pk2(bf_lo(rv.y) * wsv, bf_hi(rv.y) * wsv); o.z = pk2(bf_lo(rv.z) * wsv, bf_hi(rv.z) * wsv); o.w = pk2(bf_lo(rv.w) * wsv, bf_hi(rv.w) * wsv); \
          *(LAS v4u*)(lds + OFF_VW + p * VP + 16 * ch) = o; } \
        if (wave == 0) { *(LAS unsigned short*)(lds + OFF_VW + lane * VP + 128) = (unsigned short)(pk2(wS, 0.f) & 0xffffu); \
                         *(LAS float*)(lds + SC_A + 4 * lane) = Ap; *(LAS float*)(lds + SC_M + 4 * lane) = Mp; *(LAS float*)(lds + SC_B + 4 * lane) = bc; } } while (0)
        ML_PREFETCH(0);
        const int tt = wave >> 1, trow = 16 * tt + li, vt0 = (wave & 1) ? 2 : 0, dt = wave;
        const int hi0 = 2 * expert_queue_items(F.G) + (unit / F.G) * NCH * (F.G * NWAVES) + F.vcu * NWAVES + wave;
        LAS float* hscr = (LAS float*)(lds + HSCR_OFF + wave * 4352);
        ML_SCALARS(m);
        ML_BAR();
        ML_STAGE();
        constexpr int HLIM = 2 * NE * (TI_E1 + TI_E2);
        f32x4 hvA[4], hvB[4];
        { const int h0 = hi0 < HLIM ? hi0 : HLIM - 1; hitem_load(hitem_decode(F, h0), lane, hvA); }
        auto step = [&](const int c, f32x4 (&hvn)[4], f32x4 (&hvo)[4]) __attribute__((always_inline)) {
            const bool lat = c >= 4;
            ML_BAR();
            const float dec_c = decay, m_c = m, m_next = g + M63;
            ML_PREFETCH(c + 1);
            const int hi = hi0 + c * (F.G * NWAVES);
            const bool hact = hi < HLIM;
            f32x4 oacc[3];
#pragma unroll
            for (int j = 0; j < 3; ++j) oacc[j] = (f32x4){0.f, 0.f, 0.f, 0.f};
            float Mt = 0.f; v2u hout[2] = {(v2u){0u, 0u}, (v2u){0u, 0u}};
            if (lat) {
                bf16x8 Bq[4], Ak[2][4], Cf[3][4];
                const LAS unsigned char* cbo = lds + OFF_CB + (c & 1) * CB_BYTES;
#pragma unroll
                for (int ks = 0; ks < 4; ++ks) Bq[ks] = ld16(lds + OFF_Q + trow * QP + 64 * ks + 16 * lg);
#pragma unroll
                for (int sti = 0; sti < 2; ++sti)
#pragma unroll
                    for (int ks = 0; ks < 4; ++ks) Ak[sti][ks] = ld16(lds + OFF_K + (16 * (2 * (wave & 1) + sti) + li) * QP + 64 * ks + 16 * lg);
                Mt = *(const LAS float*)(lds + SC_M + 4 * trow);
                f32x4 A4[2];
#pragma unroll
                for (int sti = 0; sti < 2; ++sti) A4[sti] = *(const LAS f32x4*)(lds + SC_A + 4 * (16 * (2 * (wave & 1) + sti) + 4 * lg));
#pragma unroll
                for (int j = 0; j < 3; ++j)
#pragma unroll
                    for (int ks = 0; ks < 4; ++ks) Cf[j][ks] = ld16(cbo + (16 * (j < 2 ? vt0 + j : 4) + li) * CP + 64 * ks + 16 * lg);
                f32x4 sacc[2];
#pragma unroll
                for (int sti = 0; sti < 2; ++sti) { sacc[sti] = (f32x4){0.f, 0.f, 0.f, 0.f};
#pragma unroll
                    for (int ks = 0; ks < 4; ++ks) sacc[sti] = __builtin_amdgcn_mfma_f32_16x16x32_bf16(Ak[sti][ks], Bq[ks], sacc[sti], 0, 0, 0); }
#pragma unroll
                for (int ks = 0; ks < 4; ++ks)
#pragma unroll
                    for (int j = 0; j < 3; ++j) oacc[j] = __builtin_amdgcn_mfma_f32_16x16x32_bf16(Cf[j][ks], Bq[ks], oacc[j], 0, 0, 0);
#pragma unroll
                for (int sti = 0; sti < 2; ++sti) { const int st = 2 * (wave & 1) + sti; float v[4];
#pragma unroll
                    for (int r = 0; r < 4; ++r) { const int sp = 16 * st + 4 * lg + r; v[r] = sp <= trow ? sacc[sti][r] * QS * __expf(A4[sti][r] - Mt) : 0.f; }
                    *(LAS v2u*)(lds + OFF_P + trow * PP + 2 * (16 * st + 4 * lg)) = (v2u){pk2(v[0], v[1]), pk2(v[2], v[3])}; }
                const float e2 = __expf(m_c - Mt) * QS;
#pragma unroll
                for (int j = 0; j < 3; ++j) oacc[j] = oacc[j] * e2;
            }
            {
                bf16x8 At[2], Bt[5][2];
#pragma unroll
                for (int ks = 0; ks < 2; ++ks) At[ks] = trfrag(lds + OFF_K + (32 * ks + 8 * lg + lq) * QP + 32 * dt + 8 * lp, QP);
#pragma unroll
                for (int vt = 0; vt < 5; ++vt)
#pragma unroll
                    for (int ks = 0; ks < 2; ++ks) Bt[vt][ks] = trfrag(lds + OFF_VW + (32 * ks + 8 * lg + lq) * VP + 32 * vt + 8 * lp, VP);
#pragma unroll
                for (int vt = 0; vt < 5; ++vt) Cacc[vt] = Cacc[vt] * dec_c;
#pragma unroll
                for (int ks = 0; ks < 2; ++ks)
#pragma unroll
                    for (int vt = 0; vt < 5; ++vt) Cacc[vt] = __builtin_amdgcn_mfma_f32_16x16x32_bf16(At[ks], Bt[vt][ks], Cacc[vt], 0, 0, 0);
                LAS unsigned char* cbn = lds + OFF_CB + ((c + 1) & 1) * CB_BYTES;
#pragma unroll
                for (int vt = 0; vt < 5; ++vt) *(LAS v2u*)(cbn + (16 * vt + li) * CP + 2 * (16 * dt + 4 * lg)) = (v2u){pk2(Cacc[vt][0], Cacc[vt][1]), pk2(Cacc[vt][2], Cacc[vt][3])};
            }
            if (hact) hitem_to_lds(lane, hvo, hscr);
            { const int hn = hi + F.G * NWAVES; hitem_load(hitem_decode(F, hn < HLIM ? hn : HLIM - 1), lane, hvn); }
            ML_BAR();
            if (lat) {
                bf16x8 Pf[2], Vt[3][2];
#pragma unroll
                for (int ks = 0; ks < 2; ++ks) Pf[ks] = ld16(lds + OFF_P + trow * PP + 64 * ks + 16 * lg);
#pragma unroll
                for (int j = 0; j < 3; ++j)
#pragma unroll
                    for (int ks = 0; ks < 2; ++ks) Vt[j][ks] = trfrag(lds + OFF_V + (32 * ks + 8 * lg + lq) * VP + 32 * (j < 2 ? vt0 + j : 4) + 8 * lp, VP);
                const float bct = *(const LAS float*)(lds + SC_B + 4 * trow);
#pragma unroll
                for (int ks = 0; ks < 2; ++ks)
#pragma unroll
                    for (int j = 0; j < 3; ++j) oacc[j] = __builtin_amdgcn_mfma_f32_16x16x32_bf16(Vt[j][ks], Pf[ks], oacc[j], 0, 0, 0);
                const float den = __shfl(oacc[2][0], li);
                const float inv = __builtin_amdgcn_rcpf(fmaxf(fabsf(den), __expf(-(bct + Mt))));
#pragma unroll
                for (int j = 0; j < 2; ++j) { const f32x4 o = oacc[j] * inv; hout[j] = (v2u){pk2(o[0], o[1]), pk2(o[2], o[3])}; }
            }
            float hr[16];
            if (hact) hitem_read(lane, hscr, hr);
            m = m_next;
            if (c + 1 < NCH) ML_SCALARS(m);
            asm volatile("; chunk c+1 pieces are used here so that the wait for them sits in front of this step's stores" : "+v"(rk[0]), "+v"(rk[1]), "+v"(rq[0]), "+v"(rq[1]), "+v"(rv) :: "memory");
            if (lat) { bf16* hp = HO + (size_t)row_of(c, trow, dir, b) * 2048 + h * DV + vq * 64 + 4 * lg;
#pragma unroll
                for (int j = 0; j < 2; ++j) gstore8_hidden(hp + 16 * (vt0 + j), hout[j]); }
            if (hact) hitem_pack_store(hitem_decode(F, hi), lane, hr);
            ML_BAR();
            if (c + 1 < NCH) ML_STAGE();
        };
        static_assert(NCH % 2 == 0, "two steps per trip");
        for (int c = 0; c < NCH; c += 2) { step(c, hvB, hvA); step(c + 1, hvA, hvB); }
        asm volatile("s_waitcnt vmcnt(0) ; the hidden stores of the loop" ::: "memory");
#undef ML_PREFETCH
#undef ML_SETPTR
#undef ML_SCALARS
#undef ML_STAGE
    }
}

__device__ __forceinline__ void p4_mix(Frame& F) {
    const int gw = F.vcu * NWAVES + F.wave, NGW = F.G * NWAVES;
    LAS float* cwl = (LAS float*)F.lds; LAS float* hnl = cwl + 3 * 2048;
    __syncthreads();
    for (int i = F.tid; i < 3 * 2048 / 4; i += NTHR) *(LAS f32x4*)(cwl + 4 * i) = *(const f32x4*)(F.conv_w + 4 * i);
    for (int i = F.tid; i < 2048 / 4; i += NTHR) *(LAS f32x4*)(hnl + 4 * i) = *(const f32x4*)(F.head_norm + 4 * i);
    __syncthreads();
    for (int r = gw; r < T; r += NGW) {
        int lane = F.lane; asm volatile("" : "+v"(lane));
        const int s = r & (SEQ - 1), gr = s >> 6, gc = s & 63;
        const bf16* pr = F.PROJ + (size_t)r * NPROJ;
        bf16* mr = F.MIX + (size_t)r * D;
        {
            v2u ha[NH], hb[NH], og[NH];
#pragma unroll
            for (int hh = 0; hh < NH; ++hh) { const int idx = hh * DV + 4 * lane;
                ha[hh] = *(const v2u*)(F.HF + (size_t)r * 2048 + idx); hb[hh] = *(const v2u*)(F.HB + (size_t)r * 2048 + idx); og[hh] = *(const v2u*)(pr + COL_O + idx); }
            f32x4 hs[NH]; float ss[NH];
#pragma unroll
            for (int hh = 0; hh < NH; ++hh) { hs[hh] = (f32x4){bf_lo(ha[hh].x) + bf_lo(hb[hh].x), bf_hi(ha[hh].x) + bf_hi(hb[hh].x), bf_lo(ha[hh].y) + bf_lo(hb[hh].y), bf_hi(ha[hh].y) + bf_hi(hb[hh].y)};
                ss[hh] = (hs[hh][0] * hs[hh][0] + hs[hh][1] * hs[hh][1]) + (hs[hh][2] * hs[hh][2] + hs[hh][3] * hs[hh][3]); }
#pragma unroll
            for (int hh = 0; hh < NH; ++hh) ss[hh] = wave_sum(ss[hh]);
            float ym = 0.f;
#pragma unroll
            for (int hh = 0; hh < NH; ++hh) { const float rs = rsqrtf(ss[hh] * (1.f / DV) + EPS); const f32x4 hw = *(const LAS f32x4*)(hnl + hh * DV + 4 * lane);
                hs[hh][0] = hs[hh][0] * rs * hw[0] * sigmoidf_(bf_lo(og[hh].x)); hs[hh][1] = hs[hh][1] * rs * hw[1] * sigmoidf_(bf_hi(og[hh].x));
                hs[hh][2] = hs[hh][2] * rs * hw[2] * sigmoidf_(bf_lo(og[hh].y)); hs[hh][3] = hs[hh][3] * rs * hw[3] * sigmoidf_(bf_hi(og[hh].y));
                ym = fmaxf(ym, fmaxf(fmaxf(fabsf(hs[hh][0]), fabsf(hs[hh][1])), fmaxf(fabsf(hs[hh][2]), fabsf(hs[hh][3])))); }
            ym = wave_max(ym);
            const float iy = ym > 0.f ? 127.f / ym : 0.f;
            if (lane == 0) F.SA[r] = ym * (1.f / 127.f);
#pragma unroll
            for (int hh = 0; hh < NH; ++hh) *(unsigned*)(F.MIXA8 + (size_t)r * (D / 2) + hh * DV + 4 * lane) = pk4_i8(hs[hh][0] * iy, hs[hh][1] * iy, hs[hh][2] * iy, hs[hh][3] * iy);
        }
#pragma unroll
        for (int jb = 0; jb < 2; ++jb) {
            const int dt = jb == 0 ? 1 : 64;
            const bool vm = jb == 0 ? (gc > 0) : (gr > 0), vp = jb == 0 ? (gc < 63) : (gr < 63);
            const bf16* pm = vm ? pr - (size_t)dt * NPROJ : pr; const bf16* pp = vp ? pr + (size_t)dt * NPROJ : pr;
            const float fm = vm ? 1.f : 0.f, fp = vp ? 1.f : 0.f;
            v4u cu0[2], cb0[2], cum[2], cup[2];
#pragma unroll
            for (int q = 0; q < 2; ++q) { const int cch = 512 * (2 * jb + q) + 8 * lane;
                cu0[q] = *(const v4u*)(pr + COL_CC + cch); cb0[q] = *(const v4u*)(pr + COL_CB + cch);
                cum[q] = *(const v4u*)(pm + COL_CC + cch); cup[q] = *(const v4u*)(pp + COL_CC + cch); }
#pragma unroll
            for (int q = 0; q < 2; ++q) { const int cch = 512 * (2 * jb + q) + 8 * lane;
                const unsigned u0w[4] = {cu0[q].x, cu0[q].y, cu0[q].z, cu0[q].w}, umw[4] = {cum[q].x, cum[q].y, cum[q].z, cum[q].w}, upw[4] = {cup[q].x, cup[q].y, cup[q].z, cup[q].w}, cbw[4] = {cb0[q].x, cb0[q].y, cb0[q].z, cb0[q].w};
                unsigned o[4];
#pragma unroll
                for (int hq = 0; hq < 2; ++hq) { const f32x4 w0 = *(const LAS f32x4*)(cwl + cch + 4 * hq), w1 = *(const LAS f32x4*)(cwl + 2048 + cch + 4 * hq), w2 = *(const LAS f32x4*)(cwl + 4096 + cch + 4 * hq);
#pragma unroll
                    for (int e2 = 0; e2 < 2; ++e2) { const int wi = 2 * hq + e2;
                        const float ya = bf_lo(cbw[wi]) * (w0[2 * e2] * (bf_lo(umw[wi]) * fm) + w1[2 * e2] * bf_lo(u0w[wi]) + w2[2 * e2] * (bf_lo(upw[wi]) * fp));
                        const float yb = bf_hi(cbw[wi]) * (w0[2 * e2 + 1] * (bf_hi(umw[wi]) * fm) + w1[2 * e2 + 1] * bf_hi(u0w[wi]) + w2[2 * e2 + 1] * (bf_hi(upw[wi]) * fp));
                        o[wi] = pk2(ya, yb); } }
                *(v4u*)(mr + 2048 + cch) = (v4u){o[0], o[1], o[2], o[3]}; }
        }
    }
}

template <int Q>
__device__ __forceinline__ void p6_chunk(Frame& F, LAS float* wr, const LAS float* fac, const LAS float* sh, int row0, float rs0, float (&la)[20], int row1, float rs1, float (&lb)[20]) {
    const int lane = F.lane;
    __syncthreads();
    for (int cl = F.tid; cl < 1024; cl += NTHR) { const int cg = 1024 * Q + cl;
        const f32x4 g4 = *(const f32x4*)(F.w_rg + (size_t)cg * 4);
        wr[0 * 1024 + cl] = g4[0]; wr[1 * 1024 + cl] = g4[1]; wr[2 * 1024 + cl] = g4[2]; wr[3 * 1024 + cl] = g4[3];
#pragma unroll
        for (int p = 0; p < 4; ++p) { const f32x4 e4 = *(const f32x4*)(F.w_re + (size_t)cg * 16 + 4 * p);
            wr[(4 + 4 * p + 0) * 1024 + cl] = e4[0]; wr[(4 + 4 * p + 1) * 1024 + cl] = e4[1]; wr[(4 + 4 * p + 2) * 1024 + cl] = e4[2]; wr[(4 + 4 * p + 3) * 1024 + cl] = e4[3]; } }
    f32x4 xa[4], xb[4];
    { const v2u* d0 = (const v2u*)(F.X1B + (size_t)row0 * D) + lane; const v2u* d1 = (const v2u*)(F.X1B + (size_t)row1 * D) + lane;
      v2u q0[4], q1[4];
#pragma unroll
      for (int jj = 0; jj < 4; ++jj) { q0[jj] = d0[64 * (4 * Q + jj)]; q1[jj] = d1[64 * (4 * Q + jj)]; }
#pragma unroll
      for (int jj = 0; jj < 4; ++jj) { const int j = 4 * Q + jj; const f32x4 fa = *(const LAS f32x4*)(fac + 256 * j + 4 * lane), sv = *(const LAS f32x4*)(sh + 256 * j + 4 * lane);
          xa[jj] = (f32x4){bf_lo(q0[jj].x), bf_hi(q0[jj].x), bf_lo(q0[jj].y), bf_hi(q0[jj].y)} * rs0 * fa + sv;
          xb[jj] = (f32x4){bf_lo(q1[jj].x), bf_hi(q1[jj].x), bf_lo(q1[jj].y), bf_hi(q1[jj].y)} * rs1 * fa + sv; } }
    __syncthreads();
#pragma unroll
    for (int o = 0; o < 20; ++o) {
#pragma unroll
        for (int jj = 0; jj < 4; ++jj) { const f32x4 w4 = *(const LAS f32x4*)(wr + o * 1024 + 256 * jj + 4 * lane); const f32x4 a4 = xa[jj], b4 = xb[jj];
            la[o] = fmaf(a4[3], w4[3], fmaf(a4[2], w4[2], fmaf(a4[1], w4[1], fmaf(a4[0], w4[0], la[o]))));
            lb[o] = fmaf(b4[3], w4[3], fmaf(b4[2], w4[2], fmaf(b4[1], w4[1], fmaf(b4[0], w4[0], lb[o])))); }
        if ((o & 3) == 3) asm volatile("" ::: "memory");
    }
}
__device__ __forceinline__ float p6_row_pass1(Frame& F, int row0, bool act, const LAS float* fac, const LAS float* sh) {
    const int lane = F.lane;
    const v2u* da = (const v2u*)(F.X1B + (size_t)row0 * D) + lane;
    float sa = 0.f;
    v2u dd[16];
#pragma unroll
    for (int j = 0; j < 16; ++j) dd[j] = da[64 * j];
#pragma unroll
    for (int j = 0; j < 16; ++j) { const float a0 = bf_lo(dd[j].x), a1 = bf_hi(dd[j].x), a2 = bf_lo(dd[j].y), a3 = bf_hi(dd[j].y); sa = fmaf(a0, a0, fmaf(a1, a1, fmaf(a2, a2, fmaf(a3, a3, sa)))); }
    const float rsa = rsqrtf(wave_sum(sa) * (1.f / D) + EPS);
    unsigned* oa = (unsigned*)((unsigned char*)F.XF + (size_t)row0 * D) + lane;
#pragma unroll
    for (int j = 0; j < 16; ++j) { const f32x4 fa = *(const LAS f32x4*)(fac + 256 * j + 4 * lane), sv = *(const LAS f32x4*)(sh + 256 * j + 4 * lane);
        const f32x4 xn = (f32x4){bf_lo(dd[j].x), bf_hi(dd[j].x), bf_lo(dd[j].y), bf_hi(dd[j].y)} * rsa * fa + sv;
        if (act) oa[64 * j] = pk4_fp8(xn[0], xn[1], xn[2], xn[3]); }
    return rsa;
}
__device__ __forceinline__ void p6_route(Frame& F, float (&la)[20], bool act, LAS int* ri) {
    float gl[4], el[16];
#pragma unroll
    for (int o = 0; o < 4; ++o) gl[o] = la[o] + F.b_rg[o];
#pragma unroll
    for (int o = 0; o < 16; ++o) el[o] = la[4 + o] + F.b_re[o];
    int gs = 0; float gm = gl[0];
#pragma unroll
    for (int o = 1; o < 4; ++o) if (gl[o] > gm) { gm = gl[o]; gs = o; }
    float den = 0.f;
#pragma unroll
    for (int o = 0; o < 4; ++o) den += expf(gl[o] - gm);
    const float psel = 1.f / den;
    float ev[4];
#pragma unroll
    for (int o = 0; o < 4; ++o) ev[o] = gs == 0 ? el[o] : (gs == 1 ? el[4 + o] : (gs == 2 ? el[8 + o] : el[12 + o]));
    int i0 = 0; float v0 = ev[0];
#pragma unroll
    for (int o = 1; o < 4; ++o) if (ev[o] > v0) { v0 = ev[o]; i0 = o; }
    int i1 = -1; float v1 = -3.0e38f;
#pragma unroll
    for (int o = 0; o < 4; ++o) if (o != i0 && ev[o] > v1) { v1 = ev[o]; i1 = o; }
    const float e1x = expf(v1 - v0); const float w0 = psel / (1.f + e1x), w1 = psel * e1x / (1.f + e1x);
    if (F.lane == 0) { ri[0] = act ? gs * 4 + i0 : -1; ri[1] = act ? gs * 4 + i1 : -1; ri[2] = __float_as_int(w0); ri[3] = __float_as_int(w1); }
}
__device__ __forceinline__ void p6_norm_router(Frame& F) {
    LAS float* fac = (LAS float*)F.lds; LAS float* sh = fac + D;
    LAS float* wr = (LAS float*)(F.lds + 32768);
    LAS int* rinfo = (LAS int*)(F.lds + 32768 + 81920);
    const int wave = F.wave;
    const int nblk = T / 16, per = (nblk + F.G - 1) / F.G;
    int curb = -1;
    for (int it = 0; it < per; ++it) {
        const int rb = F.vcu * per + it;
        const bool act = rb < nblk;
        const int row0 = (act ? rb : 0) * 16 + wave, row1 = row0 + 8;
        const int b = row0 >> 12;
        if (b != curb) {
            __syncthreads();
            for (int i = F.tid; i < D; i += NTHR) { fac[i] = F.norm2[i] * (1.f + F.ADA[b * ADA_N + 4 * D + i]); sh[i] = F.ADA[b * ADA_N + 3 * D + i]; }
            curb = b;
            __syncthreads();
        }
        const float rs0 = p6_row_pass1(F, row0, act, fac, sh);
        const float rs1 = p6_row_pass1(F, row1, act, fac, sh);
        float la[20], lb[20];
#pragma unroll
        for (int o = 0; o < 20; ++o) { la[o] = 0.f; lb[o] = 0.f; }
        p6_chunk<0>(F, wr, fac, sh, row0, rs0, la, row1, rs1, lb); p6_chunk<1>(F, wr, fac, sh, row0, rs0, la, row1, rs1, lb);
        p6_chunk<2>(F, wr, fac, sh, row0, rs0, la, row1, rs1, lb); p6_chunk<3>(F, wr, fac, sh, row0, rs0, la, row1, rs1, lb);
        {
            LAS float* lgb = (LAS float*)(rinfo + 64) + wave * 40;
#pragma unroll
            for (int o = 0; o < 20; ++o) { la[o] = wave_sum(la[o]); lb[o] = wave_sum(lb[o]); }
            if (F.lane == 0) {
#pragma unroll
                for (int o = 0; o < 20; ++o) { lgb[o] = la[o]; lgb[20 + o] = lb[o]; } }
            LDS_WAIT(); asm volatile("" ::: "memory");
#pragma unroll 1
            for (int rr = 0; rr < 2; ++rr) { float lg[20];
#pragma unroll
                for (int o = 0; o < 20; ++o) lg[o] = lgb[20 * rr + o];
                p6_route(F, lg, act, rinfo + (8 * rr + wave) * 4); }
        }
        __syncthreads();
        if (F.tid < NE && act) {
            const int e = F.tid; int n = 0;
            for (int q = 0; q < 32; ++q) n += (rinfo[(q >> 1) * 4 + (q & 1)] == e) ? 1 : 0;
            if (n > 0) {
                int base = (int)__hip_atomic_fetch_add((unsigned*)(F.ctl + CW_CNT + 64 * e), (unsigned)n, RLX_AGENT);
                for (int q = 0; q < 32; ++q) if (rinfo[(q >> 1) * 4 + (q & 1)] == e) {
                    const int tok = rb * 16 + (q >> 1);
                    F.ELIST[e * T + base] = tok * 2 + (q & 1); F.EW[e * T + base] = __int_as_float(rinfo[(q >> 1) * 4 + 2 + (q & 1)]); ++base; }
            }
        }
        __syncthreads();
    }
}

__device__ __forceinline__ void p9_final(Frame& F) {
    LAS float* fnl = (LAS float*)F.lds; LAS float* g2l = fnl + D;
    __syncthreads();
    for (int i = F.tid; i < D / 4; i += NTHR) { *(LAS f32x4*)(fnl + 4 * i) = *(const f32x4*)(F.fnorm + 4 * i);
#pragma unroll
        for (int b = 0; b < NB; ++b) *(LAS f32x4*)(g2l + b * D + 4 * i) = *(const f32x4*)(F.ADA + b * ADA_N + 5 * D + 4 * i) * (1.f / SLOT_SCALE); }
    __syncthreads();
    const int gw = F.vcu * NWAVES + F.wave, NGW = F.G * NWAVES;
    for (int r = gw; r < T; r += NGW) {
        int lane = F.lane; asm volatile("" : "+v"(lane));
        const int b = r >> 12;
        const v4u* xr = (const v4u*)(F.X1B + (size_t)r * D) + lane;
        const v2u* s0 = (const v2u*)((const unsigned char*)F.SLOT + (size_t)r * D) + lane; const v2u* s1 = (const v2u*)((const unsigned char*)F.SLOT + (size_t)(T + r) * D) + lane;
        v4u xx[8]; v2u a0[8], a1[8];
#pragma unroll
        for (int j = 0; j < 8; ++j) { xx[j] = xr[64 * j]; a0[j] = s0[64 * j]; a1[j] = s1[64 * j]; }
        f32x4 v[16]; float s = 0.f;
#pragma unroll
        for (int j = 0; j < 8; ++j) {
            const f32x4 g0 = *(const LAS f32x4*)(g2l + b * D + 512 * j + 8 * lane), g1 = *(const LAS f32x4*)(g2l + b * D + 512 * j + 8 * lane + 4);
            const f32x4 x0 = (f32x4){bf_lo(xx[j].x), bf_hi(xx[j].x), bf_lo(xx[j].y), bf_hi(xx[j].y)}, x1 = (f32x4){bf_lo(xx[j].z), bf_hi(xx[j].z), bf_lo(xx[j].w), bf_hi(xx[j].w)};
            v[2 * j] = x0 + g0 * (fp8x4_to_f32(a0[j].x) + fp8x4_to_f32(a1[j].x)); v[2 * j + 1] = x1 + g1 * (fp8x4_to_f32(a0[j].y) + fp8x4_to_f32(a1[j].y));
            s = fmaf(v[2 * j][0], v[2 * j][0], fmaf(v[2 * j][1], v[2 * j][1], fmaf(v[2 * j][2], v[2 * j][2], fmaf(v[2 * j][3], v[2 * j][3], s))));
            s = fmaf(v[2 * j + 1][0], v[2 * j + 1][0], fmaf(v[2 * j + 1][1], v[2 * j + 1][1], fmaf(v[2 * j + 1][2], v[2 * j + 1][2], fmaf(v[2 * j + 1][3], v[2 * j + 1][3], s)))); }
        const float rstd = rsqrtf(wave_sum(s) * (1.f / D) + EPS);
        float* o = F.out + (size_t)r * D + 8 * lane;
#pragma unroll
        for (int j = 0; j < 8; ++j) { *(f32x4*)(o + 512 * j) = v[2 * j] * rstd * *(const LAS f32x4*)(fnl + 512 * j + 8 * lane); *(f32x4*)(o + 512 * j + 4) = v[2 * j + 1] * rstd * *(const LAS f32x4*)(fnl + 512 * j + 8 * lane + 4);
            if ((j & 1) == 1) asm volatile("" ::: "memory"); }
    }
}

struct SchedProj {
    int G, c;
    __device__ bool next(int i, pg8::Unit& u) const {
        const int L = i * G + c; constexpr int nM = 64, nN = 48, nwg = nM * nN;
        if (L < nwg) {
            int wgid = L; { const int q = nwg / 8, xcd = wgid % 8, off = wgid / 8; wgid = xcd * q + off; }
            const int nig = 8 * nN, gid = wgid / nig, fm = gid * 8;
            u.pm = fm + ((wgid % nig) % 8); u.pn = (wgid % nig) / 8; return true; }
        const int L2 = L - nwg;
        if (L2 < 48) { u.pm = 64 + (L2 & 3); u.pn = 36 + (L2 >> 2); return true; }
        const int L3 = L2 - 48;
        if (L3 < 68) { u.pm = L3; u.pn = 48; return true; }
        return false;
    }
    __device__ __forceinline__ void a_ready(const pg8::Unit&) const {}
    __device__ __forceinline__ void done(const pg8::Unit&) const {}
    __device__ __forceinline__ unsigned row_byteoff(const pg8::Unit&, int) const { return 0u; }
};
struct EpiProj {
    static constexpr bool PERM = true;
    bf16* P; float* Gt; const float* bg;
    __device__ __forceinline__ void operator()(const pg8::f32x4 (&acc)[2][2][4][2], const pg8::Unit& u, int wr, int wc, int fr, int fq) const {
        const int row0 = u.pm * 256 + wr * 64 + fr;
        if (u.pn < 48) {
            const int col0 = u.pn * 256 + wc * 32 + 8 * fq;
#pragma unroll
            for (int ai = 0; ai < 2; ++ai)
#pragma unroll
                for (int m = 0; m < 4; ++m) { bf16* rowp = P + (size_t)(row0 + ai * 128 + m * 16) * NPROJ + col0;
#pragma unroll
                    for (int bj = 0; bj < 2; ++bj) { const pg8::f32x4 v0 = acc[ai][bj][m][0], v1 = acc[ai][bj][m][1];
                        v4u w; w.x = pk2(v0[0], v0[1]); w.y = pk2(v0[2], v0[3]); w.z = pk2(v1[0], v1[1]); w.w = pk2(v1[2], v1[3]);
                        *(v4u*)(rowp + bj * 128) = w; } }
        } else if (wc == 0) {
            const f32x4 b0 = *(const f32x4*)(bg + 8 * fq), b1 = *(const f32x4*)(bg + 8 * fq + 4);
#pragma unroll
            for (int ai = 0; ai < 2; ++ai)
#pragma unroll
                for (int m = 0; m < 4; ++m) { float* gp = Gt + (size_t)(row0 + ai * 128 + m * 16) * 32 + 8 * fq;
                    *(f32x4*)gp = acc[ai][0][m][0] + b0; *(f32x4*)(gp + 4) = acc[ai][0][m][1] + b1; }
        }
    }
};
struct EpiProjI8 {
    static constexpr bool PERM = true;
    bf16* P; const float* sa; const float* sb; float* Gt; const float* bg;
    __device__ __forceinline__ void operator()(const pg8::f32x4 (&acc)[2][2][4][2], const pg8::Unit& u, int wr, int wc, int fr, int fq) const {
        const int row0 = u.pm * 256 + wr * 64 + fr, col0 = u.pn * 256 + wc * 32 + 8 * fq;
        if (u.pn == 48) {
            if (wc == 0) {
                const f32x4 b0 = *(const f32x4*)(bg + 8 * fq), b1 = *(const f32x4*)(bg + 8 * fq + 4), q0 = *(const f32x4*)(sb + NPROJ + 8 * fq), q1 = *(const f32x4*)(sb + NPROJ + 8 * fq + 4);
#pragma unroll
                for (int ai = 0; ai < 2; ++ai)
#pragma unroll
                    for (int m = 0; m < 4; ++m) { const int row = row0 + ai * 128 + m * 16; const float ra = sa[row]; float* gp = Gt + (size_t)row * 32 + 8 * fq;
                        const pg8::i32x4 i0 = __builtin_bit_cast(pg8::i32x4, acc[ai][0][m][0]), i1 = __builtin_bit_cast(pg8::i32x4, acc[ai][0][m][1]);
                        *(f32x4*)gp = (f32x4){(float)i0[0], (float)i0[1], (float)i0[2], (float)i0[3]} * (q0 * ra) + b0; *(f32x4*)(gp + 4) = (f32x4){(float)i1[0], (float)i1[1], (float)i1[2], (float)i1[3]} * (q1 * ra) + b1; }
            }
            return;
        }
        f32x4 sbv[2][2]; float sav[2][4];
#pragma unroll
        for (int bj = 0; bj < 2; ++bj)
#pragma unroll
            for (int n = 0; n < 2; ++n) sbv[bj][n] = *(const f32x4*)(sb + col0 + bj * 128 + 4 * n);
#pragma unroll
        for (int ai = 0; ai < 2; ++ai)
#pragma unroll
            for (int m = 0; m < 4; ++m) sav[ai][m] = sa[row0 + ai * 128 + m * 16];
#pragma unroll
        for (int ai = 0; ai < 2; ++ai)
#pragma unroll
            for (int m = 0; m < 4; ++m) { bf16* rowp = P + (size_t)(row0 + ai * 128 + m * 16) * NPROJ + col0; const float ra = sav[ai][m];
#pragma unroll
                for (int bj = 0; bj < 2; ++bj) { const pg8::i32x4 i0 = __builtin_bit_cast(pg8::i32x4, acc[ai][bj][m][0]), i1 = __builtin_bit_cast(pg8::i32x4, acc[ai][bj][m][1]);
                    const f32x4 s0 = sbv[bj][0] * ra, s1 = sbv[bj][1] * ra;
                    v4u w; w.x = pk2((float)i0[0] * s0[0], (float)i0[1] * s0[1]); w.y = pk2((float)i0[2] * s0[2], (float)i0[3] * s0[3]);
                    w.z = pk2((float)i1[0] * s1[0], (float)i1[1] * s1[1]); w.w = pk2((float)i1[2] * s1[2], (float)i1[3] * s1[3]);
                    *(v4u*)(rowp + bj * 128) = w; } }
    }
    static constexpr int NS = 8, NTAB = 2;
    __device__ __forceinline__ bool stores(const pg8::Unit& u, int wc) const { return u.pn != 48 || wc == 0; }
    __device__ __forceinline__ const void* tab_src(const pg8::Unit& u, int idx) const {
        const int i = idx & 255;
        if (idx < 256) return sa + u.pm * 256 + i;
        if (u.pn == 48) return (i >= 32 && i < 64) ? bg + (i - 32) : sb + NPROJ + (i & 31);
        return sb + u.pn * 256 + i;
    }
    __device__ __forceinline__ void half(const pg8::f32x4 (&acc)[2][2][4][2], const pg8::Unit& u, const int ai, int wr, int wc, int fr, int fq, const LAS float* tab) const {
        const int lrow0 = wr * 64 + fr + ai * 128, row0 = u.pm * 256 + lrow0, col0 = u.pn * 256 + wc * 32 + 8 * fq;
        const LAS float* tb2 = tab + 256;
        if (u.pn == 48) {
            if (wc == 0) {
                const f32x4 q0 = *(const LAS f32x4*)(tb2 + 8 * fq), q1 = *(const LAS f32x4*)(tb2 + 8 * fq + 4), b0 = *(const LAS f32x4*)(tb2 + 32 + 8 * fq), b1 = *(const LAS f32x4*)(tb2 + 36 + 8 * fq);
#pragma unroll
                for (int m = 0; m < 4; ++m) { const float ra = tab[lrow0 + m * 16]; float* gp = Gt + (size_t)(row0 + m * 16) * 32 + 8 * fq;
                    const pg8::i32x4 i0 = __builtin_bit_cast(pg8::i32x4, acc[ai][0][m][0]), i1 = __builtin_bit_cast(pg8::i32x4, acc[ai][0][m][1]);
                    *(f32x4*)gp = (f32x4){(float)i0[0], (float)i0[1], (float)i0[2], (float)i0[3]} * (q0 * ra) + b0; *(f32x4*)(gp + 4) = (f32x4){(float)i1[0], (float)i1[1], (float)i1[2], (float)i1[3]} * (q1 * ra) + b1; }
            }
            return;
        }
        f32x4 sbv[2][2];
#pragma unroll
        for (int bj = 0; bj < 2; ++bj)
#pragma unroll
            for (int n = 0; n < 2; ++n) sbv[bj][n] = *(const LAS f32x4*)(tb2 + wc * 32 + 8 * fq + bj * 128 + 4 * n);
        if (u.pn >= COL_CC / 256 && u.pn < COL_K / 256) {
            const int ch0 = COL_CC + (u.pn - COL_CC / 256) * 128 + wc * 32 + 8 * fq;
#pragma unroll
            for (int m = 0; m < 4; ++m) { bf16* rowp = P + (size_t)(row0 + m * 16) * NPROJ + ch0; const float ra = tab[lrow0 + m * 16];
#pragma unroll
                for (int n = 0; n < 2; ++n) { const pg8::i32x4 ic = __builtin_bit_cast(pg8::i32x4, acc[ai][0][m][n]), ix = __builtin_bit_cast(pg8::i32x4, acc[ai][1][m][n]);
                    const f32x4 sc = sbv[0][n] * ra, sx = sbv[1][n] * ra;
                    *(v2u*)(rowp + 4 * n) = (v2u){pk2(((float)ic[0] * sc[0]) * ((float)ix[0] * sx[0]), ((float)ic[1] * sc[1]) * ((float)ix[1] * sx[1])), pk2(((float)ic[2] * sc[2]) * ((float)ix[2] * sx[2]), ((float)ic[3] * sc[3]) * ((float)ix[3] * sx[3]))}; } }
            return;
        }
#pragma unroll
        for (int m = 0; m < 4; ++m) { bf16* rowp = P + (size_t)(row0 + m * 16) * NPROJ + col0; const float ra = tab[lrow0 + m * 16];
#pragma unroll
            for (int bj = 0; bj < 2; ++bj) { const pg8::i32x4 i0 = __builtin_bit_cast(pg8::i32x4, acc[ai][bj][m][0]), i1 = __builtin_bit_cast(pg8::i32x4, acc[ai][bj][m][1]);
                const f32x4 s0 = sbv[bj][0] * ra, s1 = sbv[bj][1] * ra;
                v4u w; w.x = pk2((float)i0[0] * s0[0], (float)i0[1] * s0[1]); w.y = pk2((float)i0[2] * s0[2], (float)i0[3] * s0[3]);
                w.z = pk2((float)i1[0] * s1[0], (float)i1[1] * s1[1]); w.w = pk2((float)i1[2] * s1[2], (float)i1[3] * s1[3]);
                *(v4u*)(rowp + bj * 128) = w; } }
    }
};
struct SchedStatic {
    int nM, nN, nwg, G, c;
    __device__ void init(int M, int N, int G_, int c_) { nM = M / 256; nN = N / 256; nwg = nM * nN; G = G_; c = c_; }
    __device__ bool next(int i, pg8::Unit& u) const {
        const long L = (long)i * G + c; if (L >= nwg) return false;
        int wgid = (int)L; { const int q = nwg / 8, r = nwg % 8, xcd = wgid % 8, off = wgid / 8; wgid = (xcd < r ? xcd * (q + 1) : r * (q + 1) + (xcd - r) * q) + off; }
        const int nig = 8 * nN, gid = wgid / nig, fm = gid * 8, gsz = (nM - fm) < 8 ? (nM - fm) : 8;
        u.pm = fm + ((wgid % nig) % gsz); u.pn = (wgid % nig) / gsz; return true;
    }
    __device__ __forceinline__ void a_ready(const pg8::Unit&) const {}
    __device__ __forceinline__ void done(const pg8::Unit&) const {}
    __device__ __forceinline__ unsigned row_byteoff(const pg8::Unit&, int) const { return 0u; }
};
struct EpiOut {
    static constexpr bool PERM = true;
    const float* ada; bf16* DL;
    __device__ __forceinline__ void operator()(const pg8::f32x4 (&acc)[2][2][4][2], const pg8::Unit& u, int wr, int wc, int fr, int fq) const {
        const int row0 = u.pm * 256 + wr * 64 + fr, col0 = u.pn * 256 + wc * 32 + 8 * fq;
        const float* g1 = ada + (size_t)(u.pm >> 4) * ADA_N + 2 * D + col0;
        f32x4 gv[2][2];
#pragma unroll
        for (int bj = 0; bj < 2; ++bj)
#pragma unroll
            for (int n = 0; n < 2; ++n) gv[bj][n] = *(const f32x4*)(g1 + bj * 128 + 4 * n);
#pragma unroll
        for (int ai = 0; ai < 2; ++ai)
#pragma unroll
            for (int m = 0; m < 4; ++m) { bf16* rowp = DL + (size_t)(row0 + ai * 128 + m * 16) * D + col0;
#pragma unroll
                for (int bj = 0; bj < 2; ++bj) { const pg8::f32x4 v0 = acc[ai][bj][m][0] * gv[bj][0], v1 = acc[ai][bj][m][1] * gv[bj][1];
                    v4u w; w.x = pk2(v0[0], v0[1]); w.y = pk2(v0[2], v0[3]); w.z = pk2(v1[0], v1[1]); w.w = pk2(v1[2], v1[3]);
                    *(v4u*)(rowp + bj * 128) = w; } }
    }
    static constexpr int NS = 8, NTAB = 1;
    __device__ __forceinline__ bool stores(const pg8::Unit&, int) const { return true; }
    __device__ __forceinline__ const void* tab_src(const pg8::Unit& u, int idx) const { return ada + (size_t)(u.pm >> 4) * ADA_N + 2 * D + u.pn * 256 + (idx & 255); }
    __device__ __forceinline__ void half(const pg8::f32x4 (&acc)[2][2][4][2], const pg8::Unit& u, const int ai, int wr, int wc, int fr, int fq, const LAS float* tab) const {
        const int row0 = u.pm * 256 + wr * 64 + fr + ai * 128, col0 = u.pn * 256 + wc * 32 + 8 * fq;
        f32x4 gv[2][2];
#pragma unroll
        for (int bj = 0; bj < 2; ++bj)
#pragma unroll
            for (int n = 0; n < 2; ++n) gv[bj][n] = *(const LAS f32x4*)(tab + wc * 32 + 8 * fq + bj * 128 + 4 * n);
#pragma unroll
        for (int m = 0; m < 4; ++m) { bf16* rowp = DL + (size_t)(row0 + m * 16) * D + col0;
#pragma unroll
            for (int bj = 0; bj < 2; ++bj) { const pg8::f32x4 v0 = acc[ai][bj][m][0] * gv[bj][0], v1 = acc[ai][bj][m][1] * gv[bj][1];
                v4u w; w.x = pk2(v0[0], v0[1]); w.y = pk2(v0[2], v0[3]); w.z = pk2(v1[0], v1[1]); w.w = pk2(v1[2], v1[3]);
                *(v4u*)(rowp + bj * 128) = w; } }
    }
};
struct EpiOut2 {
    static constexpr bool PERM = true;
    static constexpr int NS = 8, NTAB = 3;
    const float* ada; bf16* DL; const float* sa; const float* sb; const float* xin;
    __device__ __forceinline__ bool stores(const pg8::Unit&, int) const { return true; }
    __device__ __forceinline__ const void* tab_src(const pg8::Unit& u, int idx) const {
        const int i = idx & 255, w = idx >> 8;
        if (w == 0) return ada + (size_t)(u.pm >> 4) * ADA_N + 2 * D + u.pn * 256 + i;
        if (w == 1) return sa + u.pm * 256 + i;
        return sb + u.pn * 256 + i;
    }
    __device__ __forceinline__ void mid(pg8::f32x4 (&acc)[2][2][4][2], const pg8::Unit&, int wr, int wc, int fr, int fq, const LAS float* tab) const {
        f32x4 sbv[2][2];
#pragma unroll
        for (int bj = 0; bj < 2; ++bj)
#pragma unroll
            for (int n = 0; n < 2; ++n) sbv[bj][n] = *(const LAS f32x4*)(tab + 512 + wc * 32 + 8 * fq + bj * 128 + 4 * n);
#pragma unroll
        for (int ai = 0; ai < 2; ++ai)
#pragma unroll
            for (int m = 0; m < 4; ++m) { const float ra = tab[256 + wr * 64 + fr + ai * 128 + m * 16];
#pragma unroll
                for (int bj = 0; bj < 2; ++bj)
#pragma unroll
                    for (int n = 0; n < 2; ++n) { const pg8::i32x4 iv = __builtin_bit_cast(pg8::i32x4, acc[ai][bj][m][n]); const f32x4 s = sbv[bj][n] * ra;
                        acc[ai][bj][m][n] = (f32x4){(float)iv[0] * s[0], (float)iv[1] * s[1], (float)iv[2] * s[2], (float)iv[3] * s[3]}; } }
    }
    __device__ __forceinline__ void half(const pg8::f32x4 (&acc)[2][2][4][2], const pg8::Unit& u, const int ai, int wr, int wc, int fr, int fq, const LAS float* tab) const {
        const int row0 = u.pm * 256 + wr * 64 + fr + ai * 128, col0 = u.pn * 256 + wc * 32 + 8 * fq;
        f32x4 xv[4][2][2];
#pragma unroll
        for (int m = 0; m < 4; ++m) { const float* xr = xin + (size_t)(row0 + m * 16) * D + col0;
#pragma unroll
            for (int bj = 0; bj < 2; ++bj)
#pragma unroll
                for (int n = 0; n < 2; ++n) xv[m][bj][n] = *(const f32x4*)(xr + bj * 128 + 4 * n); }
        f32x4 gv[2][2];
#pragma unroll
        for (int bj = 0; bj < 2; ++bj)
#pragma unroll
            for (int n = 0; n < 2; ++n) gv[bj][n] = *(const LAS f32x4*)(tab + wc * 32 + 8 * fq + bj * 128 + 4 * n);
#pragma unroll
        for (int m = 0; m < 4; ++m) { bf16* rowp = DL + (size_t)(row0 + m * 16) * D + col0;
#pragma unroll
            for (int bj = 0; bj < 2; ++bj) { const pg8::f32x4 v0 = acc[ai][bj][m][0] * gv[bj][0] + xv[m][bj][0], v1 = acc[ai][bj][m][1] * gv[bj][1] + xv[m][bj][1];
                v4u w; w.x = pk2(v0[0], v0[1]); w.y = pk2(v0[2], v0[3]); w.z = pk2(v1[0], v1[1]); w.w = pk2(v1[2], v1[3]);
                *(v4u*)(rowp + bj * 128) = w; } }
    }
};
typedef GAS unsigned long long gu64;
constexpr unsigned RT_FULL = 64u, RT_SPIN_CAP = 1u << 22;
template <int NCT>
struct SchedMoe {
    int G, c; const LAS int* tb; const LAS int* cnt; const int* elist; unsigned rowbytes; gu32* rtc;
    __device__ bool next(int i, pg8::Unit& u) const {
        const int L = i * G + c, rt = L / NCT, ct = L % NCT;
        if (rt >= tb[NE]) return false;
        int e = 0;
#pragma unroll
        for (int q = 1; q < NE; ++q) e += (rt >= tb[q]) ? 1 : 0;
        u.pm = rt; u.pn = e * NCT + ct; return true;
    }
    __device__ __forceinline__ void a_ready(const pg8::Unit&) const {}
    __device__ __forceinline__ void done(const pg8::Unit& u) const {
        if (rtc == nullptr) return;
        asm volatile("s_waitcnt vmcnt(0) ; publish" ::: "memory");
        if ((threadIdx.x & 63) == 0) (void)__hip_atomic_fetch_add(rtc + 16 * u.pm, 1u, RLX_AGENT);
    }
    __device__ __forceinline__ unsigned row_byteoff(const pg8::Unit& u, int lr) const {
        const int e = u.pn / NCT; int l = (u.pm - tb[e]) * 256 + lr; const int n = cnt[e]; l = l < n ? l : n - 1;
        return (unsigned)(elist[e * T + l] >> 1) * rowbytes;
    }
    __device__ __forceinline__ const int* row_src(const pg8::Unit& u, int lr) const {
        const int e = u.pn / NCT; int l = (u.pm - tb[e]) * 256 + lr; const int n = cnt[e]; l = l < n ? l : n - 1;
        return elist + e * T + l;
    }
    __device__ __forceinline__ unsigned row_raw(const pg8::Unit& u, int lr) const { return (unsigned)*row_src(u, lr); }
    __device__ __forceinline__ unsigned row_off(unsigned raw) const { return (raw >> 1) * rowbytes; }
};
struct SchedMoe2 {
    static constexpr int NCT = 16, BON = 3;
    int G, c, n7; const LAS int* tb; const LAS int* cnt; gu32* rtc; gu32* tmo;
    __device__ bool next(int i, pg8::Unit& u) const {
        const int A = n7 % G, nl = G - A; int L;
        if (A == 0) L = i * G + c;
        else if (c >= A) L = (i < BON) ? i * nl + (c - A) : BON * nl + (i - BON) * G + c;
        else L = BON * nl + i * G + c;
        const int rt = L / NCT, ct = L % NCT;
        if (rt >= tb[NE]) return false;
        int e = 0;
#pragma unroll
        for (int q = 1; q < NE; ++q) e += (rt >= tb[q]) ? 1 : 0;
        u.pm = rt; u.pn = e * NCT + ct; return true;
    }
    __device__ __forceinline__ void a_ready(const pg8::Unit& u) const {
        unsigned sp = 0;
        while ((unsigned)__builtin_amdgcn_readfirstlane((int)__hip_atomic_load(rtc + 16 * u.pm, RLX_AGENT)) < RT_FULL) {
            __builtin_amdgcn_s_sleep(1);
            if (++sp > RT_SPIN_CAP) { if ((threadIdx.x & 63) == 0) __hip_atomic_store(tmo, 1u, RLX_AGENT); break; }
        }
    }
    __device__ __forceinline__ void done(const pg8::Unit&) const {}
    __device__ __forceinline__ unsigned row_byteoff(const pg8::Unit&, int) const { return 0u; }
};
struct EpiMoe1 {
    static constexpr bool PERM = true;
    unsigned char* H;
    __device__ __forceinline__ void operator()(const pg8::f32x4 (&acc)[2][2][4][2], const pg8::Unit& u, int wr, int wc, int fr, int fq) const {
        const int row0 = u.pm * 256 + wr * 64 + fr, col0 = (u.pn & 7) * 128 + wc * 32 + 8 * fq;
        constexpr float IS = 1.f / W1_SCALE;
#pragma unroll
        for (int ai = 0; ai < 2; ++ai)
#pragma unroll
            for (int m = 0; m < 4; ++m) { float h[8];
#pragma unroll
                for (int n = 0; n < 2; ++n)
#pragma unroll
                    for (int j = 0; j < 4; ++j) { const float a = acc[ai][0][m][n][j] * IS, uu = acc[ai][1][m][n][j] * IS; h[4 * n + j] = a * uu * __builtin_amdgcn_rcpf(1.f + __expf(-a)); }
                *(v2u*)(H + (size_t)(row0 + ai * 128 + m * 16) * FF + col0) = (v2u){pk4_fp8(h[0], h[1], h[2], h[3]), pk4_fp8(h[4], h[5], h[6], h[7])}; }
    }
    static constexpr int NS = 4, NTAB = 0;
    __device__ __forceinline__ bool stores(const pg8::Unit&, int) const { return true; }
    __device__ __forceinline__ const void* tab_src(const pg8::Unit&, int) const { return nullptr; }
    __device__ __forceinline__ void half(const pg8::f32x4 (&acc)[2][2][4][2], const pg8::Unit& u, const int ai, int wr, int wc, int fr, int fq, const LAS float*) const {
        const int row0 = u.pm * 256 + wr * 64 + fr + ai * 128, col0 = (u.pn & 7) * 128 + wc * 32 + 8 * fq;
        constexpr float IS = 1.f / W1_SCALE;
#pragma unroll
        for (int m = 0; m < 4; ++m) { float h[8];
#pragma unroll
            for (int n = 0; n < 2; ++n)
#pragma unroll
                for (int j = 0; j < 4; ++j) { const float a = acc[ai][0][m][n][j] * IS, uu = acc[ai][1][m][n][j] * IS; h[4 * n + j] = a * uu * __builtin_amdgcn_rcpf(1.f + __expf(-a)); }
            __hip_atomic_store((gu64*)(H + (size_t)(row0 + m * 16) * FF + col0), (unsigned long long)pk4_fp8(h[0], h[1], h[2], h[3]) | ((unsigned long long)pk4_fp8(h[4], h[5], h[6], h[7]) << 32), RLX_AGENT); }
    }
};
struct EpiMoe2 {
    static constexpr int PERM = 2;
    unsigned char* SL; const int* elist; const float* ew; const LAS int* tb; const LAS int* cnt;
    static constexpr int NS = 4, NTAB = 2;
    unsigned char* dump;
    __device__ __forceinline__ bool stores(const pg8::Unit&, int) const { return true; }
    __device__ __forceinline__ const void* tab_src(const pg8::Unit& u, int idx) const {
        const int e = u.pn >> 4, n_e = cnt[e]; int l = (u.pm - tb[e]) * 256 + (idx & 255); l = l < n_e ? l : n_e - 1;
        return idx < 256 ? (const void*)(elist + e * T + l) : (const void*)(ew + e * T + l);
    }
    __device__ __forceinline__ void half(const pg8::f32x4 (&acc)[2][2][4][2], const pg8::Unit& u, const int ai, int wr, int wc, int fr, int fq, const LAS float* tab) const {
        const int e = u.pn >> 4, ct = u.pn & 15, n_e = cnt[e], lrow0 = wr * 64 + fr + ai * 128, lr0 = (u.pm - tb[e]) * 256 + lrow0, col0 = ct * 256 + wc * 64 + 16 * fq;
#pragma unroll
        for (int m = 0; m < 4; ++m) { const int lr = lr0 + m * 16, ent = ((const LAS int*)tab)[lrow0 + m * 16]; const float w = tab[256 + lrow0 + m * 16] * (SLOT_SCALE / W2_SCALE);
            unsigned char* rowp = (lr < n_e) ? SL + ((size_t)(ent & 1) * T + (size_t)(ent >> 1)) * D + col0 : dump + (size_t)((u.pm & 63) * 256 + lrow0 + m * 16) * D + col0;
            const pg8::f32x4 v0 = acc[ai][0][m][0] * w, v1 = acc[ai][0][m][1] * w, v2 = acc[ai][1][m][0] * w, v3 = acc[ai][1][m][1] * w;
            *(v4u*)rowp = (v4u){pk4_fp8(v0[0], v0[1], v0[2], v0[3]), pk4_fp8(v1[0], v1[1], v1[2], v1[3]), pk4_fp8(v2[0], v2[1], v2[2], v2[3]), pk4_fp8(v3[0], v3[1], v3[2], v3[3])}; }
    }
};
__device__ __forceinline__ void moe_tables(Frame& F) {
    LAS int* tb = (LAS int*)(F.lds + MOE_OFF); LAS int* cnt = tb + 32;
    __syncthreads();
    if (F.tid == 0) { int acc = 0;
        for (int e = 0; e < NE; ++e) { const int n = (int)__hip_atomic_load((unsigned*)(F.ctl + CW_CNT + 64 * e), RLX_AGENT); cnt[e] = n; tb[e] = acc; acc += (n + 255) >> 8; }
        tb[NE] = acc; }
    __syncthreads();
}

struct Args { const float* in[20]; float* out; unsigned char* ws; int ph_lo, ph_hi, li, pad; };
__global__ void __launch_bounds__(NTHR, 2) mk_fwd(Args args) {
    extern __shared__ __attribute__((aligned(16))) unsigned char lds[];
    Frame F;
    F.lds = (LAS unsigned char*)lds;
    F.MISC = (volatile LAS unsigned*)(F.lds + MISC_OFF);
    F.tid = threadIdx.x; F.lane = F.tid & 63; F.wave = __builtin_amdgcn_readfirstlane(F.tid >> 6);
    F.G = gridDim.x; { const int bx = blockIdx.x; F.vcu = (F.G % 8 == 0) ? (bx % 8) * (F.G / 8) + bx / 8 : bx; }
    unsigned char* ws = args.ws;
    F.ctl = (gu32*)(ws + WS_CTL);
    F.x = args.in[0]; F.c = args.in[1]; F.ctx = args.in[2]; F.cctx = args.in[3]; F.w_ada = args.in[4]; F.b_ada = args.in[5]; F.norm1 = args.in[6]; F.w_in = args.in[7];
    F.b_gates = args.in[8]; F.conv_w = args.in[9]; F.head_norm = args.in[10]; F.w_out = args.in[11]; F.norm2 = args.in[12]; F.w_rg = args.in[13]; F.b_rg = args.in[14];
    F.w_re = args.in[15]; F.b_re = args.in[16]; F.w_e1 = args.in[17]; F.w_e2 = args.in[18]; F.fnorm = args.in[19]; F.out = args.out;
    F.ADA = (float*)(ws + WS_ADA); F.GATES = (float*)(ws + WS_GATES); F.EW = (float*)(ws + WS_EW); F.HF = (bf16*)(ws + WS_HF); F.HB = (bf16*)(ws + WS_HB); F.DELTA = (bf16*)(ws + WS_X1); F.X1B = (bf16*)(ws + WS_X1 + 128 * MiB); F.XM8 = ws + WS_XM8; F.WO8 = ws + WS_WO8; F.WI8 = (signed char*)(ws + WS_WI8); F.SA = (float*)(ws + WS_SA); F.SB = (float*)(ws + WS_SB); F.SB2 = F.SB + 16384; F.MIXA8 = ws + WS_XM8; F.WOA8 = ws + WS_WIN + 64 * MiB;
    F.ELIST = (int*)(ws + WS_ELIST);
    F.WIN = (bf16*)(ws + WS_WIN); F.WOUT = (bf16*)(ws + WS_WOUT); F.WE1 = (bf16*)(ws + WS_WE1); F.WE2 = (bf16*)(ws + WS_WE2);
    F.XM = (bf16*)(ws + WS_XM); F.MIX = F.XM; F.XF = F.XM; F.PROJ = (bf16*)(ws + WS_PROJ); F.SLOT = (bf16*)(ws + WS_SLOT); F.HMOE = (bf16*)(ws + WS_HMOE);
    for (int u = F.tid; u < (LDS_BYTES - LDSCTL_OFF) / 4; u += NTHR) ((LAS unsigned*)(F.lds + LDSCTL_OFF))[u] = 0u;
    __syncthreads();
    const int lo = args.ph_lo, hi = args.ph_hi;
    XcdBarrier bar; bar.bar = (unsigned*)(F.ctl + CW_BAR) + args.li * XCD_BAR_WORDS; bar.x = 0; bar.st = nullptr;
    if (hi - lo > 1) bar = xcd_barrier_post((unsigned*)(F.ctl + CW_BAR) + args.li * XCD_BAR_WORDS, F.MISC + 8);
#ifndef PHASE_MASK
#define PHASE_MASK 0xFFFF
#endif
#define IN(k) (((PHASE_MASK >> (k)) & 1) && lo <= (k) && (k) < hi)
#define BOTH(k) (IN(k) && IN((k) + 1))
#define GRID_BAR() xcd_barrier(bar)
    LAS unsigned* rowtab = (LAS unsigned*)(F.lds + ROWTAB_OFF);

#ifndef PROBE_DUP
#define PROBE_DUP -1
#endif
#define RUNPH(k, ...) if (IN(k)) { __VA_ARGS__ if (PROBE_DUP == (k)) { GRID_BAR(); __VA_ARGS__ } if (BOTH(k)) GRID_BAR(); }
    RUNPH(0, { p0_ada(F); __syncthreads(); p0_transposes(F); })
    RUNPH(1, { p1_quant_weights(F); p1_quant_wout(F); p1_norm(F); })
    RUNPH(2, {
        __syncthreads();
        { pg8::Gemm gi{(const bf16*)F.XM8, (const bf16*)F.WI8, TA, NPAD, D / 2}; SchedProj Si{F.G, (int)blockIdx.x}; EpiProjI8 Ei{F.PROJ, F.SA, F.SB, F.GATES, F.b_gates};
          pg8::gemm_phase<EpiProjI8, SchedProj, PG8_ALIGN, PG8_SP2, false, false, true, PG8_ROLL2>(F.lds, gi, Si, Ei, rowtab); }
        expert_transpose_queue(F); })
    RUNPH(3, { p3_mlstm(F); })
    RUNPH(4, { p4_mix(F); })
    RUNPH(5, {
        pg8::Gemm2 g{(const char*)F.MIXA8, (const char*)F.WOA8, (unsigned)(D / 2), (unsigned)(D / 2), D / 2 / 128, (const char*)(F.MIX + D / 2), (const char*)(F.WOUT + D / 2), (unsigned)(D * 2), (unsigned)(D * 2), D / 2 * 2 / 128};
        SchedStatic S; S.init(T, D, F.G, (int)blockIdx.x); EpiOut2 E{F.ADA, F.X1B, F.SA, F.SB2, F.x};
        __syncthreads();
        pg8::gemm_phase2<EpiOut2, SchedStatic, PG8_ALIGN>(F.lds, g, S, E); })
    RUNPH(6, { p6_norm_router(F); })
    RUNPH(7, {
        moe_tables(F);
        const LAS int* tb = (const LAS int*)(F.lds + MOE_OFF);
        gu32* rtc = F.ctl + CW_RT;
        { pg8::Gemm g{F.XF, F.WE1, T, NE * 2 * FF, D / 2}; SchedMoe<8> S{F.G, F.vcu, tb, tb + 32, F.ELIST, (unsigned)D, rtc}; EpiMoe1 E{(unsigned char*)F.HMOE};
          pg8::gemm_phase<EpiMoe1, SchedMoe<8>, PG8_ALIGN, PG8_SP2, true, true, false, PG8_ROLL7>(F.lds, g, S, E, rowtab); }
        if (F.wave == 0) __builtin_amdgcn_fence(__ATOMIC_ACQUIRE, "agent");
        __syncthreads();
        { pg8::Gemm g{F.HMOE, F.WE2, HM_ROWS, NE * D, FF / 2}; SchedMoe2 S{F.G, F.vcu, tb[NE] * 8, tb, tb + 32, rtc, F.ctl + CW_TMO}; EpiMoe2 E{(unsigned char*)F.SLOT, F.ELIST, F.EW, tb, tb + 32, (unsigned char*)F.WIN};
          pg8::gemm_phase<EpiMoe2, SchedMoe2, PG8_ALIGN, PG8_SP2, false, true, false, PG8_ROLL8>(F.lds, g, S, E, rowtab); } })
    RUNPH(9, { p9_final(F); })
#undef IN
#undef BOTH
}

__global__ void __launch_bounds__(320) mlstm_naive(const bf16* __restrict__ PROJ, const float* __restrict__ GATES, bf16* __restrict__ HF, bf16* __restrict__ HB) {
    __shared__ float kq[2][256];
    __shared__ float sc[2][4];
    __shared__ float dens[2];
    const int bid = blockIdx.x, dir = bid & 1, h = (bid >> 1) & 7, b = bid >> 4, tid = threadIdx.x;
    float C[128];
#pragma unroll
    for (int i = 0; i < 128; ++i) C[i] = 0.f;
    float m = 0.f;
    bf16* HO = dir ? HB : HF;
    const int NSTEP = CTXL + SEQ;
    for (int st = 0; st < NSTEP; ++st) {
        int row;
        if (st < CTXL) { const int j = dir ? (CTXL - 1 - st) : st; row = T + b * CTXL + j; }
        else { const int s = dir ? (SEQ - 1 - (st - CTXL)) : (st - CTXL); row = b * SEQ + s; }
        const bf16* pr = PROJ + (size_t)row * NPROJ;
        const int buf = st & 1;
        if (tid < 128) kq[buf][tid] = bf1(pr[COL_K + h * DK + tid]);
        else if (tid < 256) kq[buf][tid] = bf1(pr[COL_Q + h * DK + (tid - 128)]) * 0.08838834764831845f;
        const float ig = GATES[(size_t)row * 32 + (dir ? 16 : 0) + h], fp = GATES[(size_t)row * 32 + (dir ? 24 : 8) + h];
        const float lf = fminf(fp, 0.f) - log1pf(expf(-fabsf(fp)));
        const float mn = fmaxf(lf + m, ig);
        const float fdec = expf(lf + m - mn), iw = expf(ig - mn);
        m = mn;
        const float vv = tid < 256 ? bf1(pr[COL_V + h * DV + tid]) : 1.f;
        __syncthreads();
        const bool isq = st >= CTXL;
        float dot = 0.f;
        if (tid <= 256) {
            const float a = iw * vv;
#pragma unroll
            for (int i = 0; i < 128; ++i) { C[i] = fdec * C[i] + a * kq[buf][i]; dot += C[i] * kq[buf][128 + i]; }
        }
        if (isq) {
            if (tid == 256) dens[buf] = dot;
            __syncthreads();
            if (tid < 256) { const float dn = fmaxf(fabsf(dens[buf]), expf(-m)); HO[(size_t)row * 2048 + h * DV + tid] = (bf16)(pk2(dot / dn, 0.f) & 0xffffu); }
        }
    }
}

extern "C" void kernel_launch(void* const* d_in, const int* in_sizes, int n_in, void* d_out, int out_size, void* d_ws, size_t ws_size, hipStream_t stream) {
    static int grid = 0;
    if (grid == 0) {
        if (n_in != 20 || out_size != T * D || ws_size < WS_END) { fprintf(stderr, "kernel_launch: unexpected shapes (n_in %d, out %d, ws %zu)\n", n_in, out_size, ws_size); grid = -1; return; }
        int dev = 0, cus = 0, per_cu = 0;
        if (hipGetDevice(&dev) != hipSuccess || hipDeviceGetAttribute(&cus, hipDeviceAttributeMultiprocessorCount, dev) != hipSuccess) { grid = -1; return; }
        if (hipFuncSetAttribute((const void*)mk_fwd, hipFuncAttributeMaxDynamicSharedMemorySize, LDS_BYTES) != hipSuccess) { fprintf(stderr, "kernel_launch: hipFuncSetAttribute failed\n"); grid = -1; return; }
        if (hipOccupancyMaxActiveBlocksPerMultiprocessor(&per_cu, (const void*)mk_fwd, NTHR, LDS_BYTES) != hipSuccess || per_cu < 1) fprintf(stderr, "kernel_launch: occupancy query says %d\n", per_cu);
        (void)hipGetLastError();
        grid = cus;
    }
    if (grid < 0) return;
    (void)hipMemsetAsync((char*)d_ws + WS_CTL, 0, CTL_ZERO_BYTES, stream);
    Args a{};
    for (int i = 0; i < 20; ++i) a.in[i] = (const float*)d_in[i];
    a.out = (float*)d_out; a.ws = (unsigned char*)d_ws;
    int nl = 0;
    auto launch = [&](int lo, int hi) { a.ph_lo = lo; a.ph_hi = hi; a.li = nl++; hipLaunchKernelGGL(mk_fwd, dim3(grid), dim3(NTHR), LDS_BYTES, stream, a); };
#if MK_MODE == 0
    launch(0, 1); launch(1, 2); launch(2, 3);
    hipLaunchKernelGGL(mlstm_naive, dim3(NB * NH * 2), dim3(320), 0, stream, (const bf16*)((char*)d_ws + WS_PROJ), (const float*)((char*)d_ws + WS_GATES), (bf16*)((char*)d_ws + WS_HF), (bf16*)((char*)d_ws + WS_HB));
    launch(4, 5); launch(5, 6); launch(6, 7); launch(7, 8); launch(8, 9); launch(9, 10);
#elif MK_MODE == 2
    launch(0, 10);
#else
    launch(0, 3);
    hipLaunchKernelGGL(mlstm_naive, dim3(NB * NH * 2), dim3(320), 0, stream, (const bf16*)((char*)d_ws + WS_PROJ), (const float*)((char*)d_ws + WS_GATES), (bf16*)((char*)d_ws + WS_HF), (bf16*)((char*)d_ws + WS_HB));
    launch(4, 10);
#endif
}
```

```cpp
#include <hip/hip_runtime.h>
#include <cstdio>
#include <cstdint>

#ifndef MK_MODE
#define MK_MODE 2
#endif

namespace pg8 {
#define PG8_LAS __attribute__((address_space(3)))
typedef unsigned short bf16_t;
typedef short bf16x8 __attribute__((ext_vector_type(8)));
typedef float f32x4 __attribute__((ext_vector_type(4)));
typedef unsigned u32x4 __attribute__((ext_vector_type(4)));
constexpr int BM = 256, BK = 64, HALF = 128, HTB = HALF * BK * 2, STAGE_BYTES = 8 * HTB, NXCD = 8, WGM = 8;

__host__ __device__ __forceinline__ int lds_byte(int r, int c) { const int st = (r >> 4) * 2 + (c >> 5), rr = r & 15, cc = c & 31, ob = rr * 64 + cc * 2; return st * 1024 + (ob ^ (((ob >> 9) & 1) << 5)); }
__host__ __device__ __forceinline__ void stage_rc(int b, int& R, int& C) { const int st = b / 1024, sb = b % 1024, swz = sb ^ (((sb >> 9) & 1) << 5); R = (st >> 1) * 16 + swz / 64; C = (st & 1) * 32 + (swz % 64) / 2; }
__host__ __device__ __forceinline__ int perm32(int rho) { const int n = rho >> 4, i = rho & 15; return 8 * (i >> 2) + 4 * n + (i & 3); }

struct Unit { int pm, pn; };
struct Gemm { const bf16_t* A; const bf16_t* Bt; int M, N, K; };

typedef float f32x2_t __attribute__((ext_vector_type(2))); typedef __bf16 bf16x2_t __attribute__((ext_vector_type(2)));
__device__ __forceinline__ unsigned cvt_pk_bf16(float lo, float hi) { f32x2_t v = {lo, hi}; bf16x2_t b = __builtin_convertvector(v, bf16x2_t); return __builtin_bit_cast(unsigned, b); }

typedef int i32x8 __attribute__((ext_vector_type(8)));
typedef int i32x4 __attribute__((ext_vector_type(4)));
constexpr int TAB_OFF = STAGE_BYTES;
template <class Epi, class Sched, bool ALIGN_EPI, bool SP2, bool GATHER, bool MX, bool I8 = false, bool ROLL = false>
__device__ __forceinline__ void gemm_phase(PG8_LAS unsigned char* lds, const Gemm g, const Sched& S, const Epi& E, PG8_LAS unsigned* rowtab) {
    const int tid = threadIdx.x, wid = __builtin_amdgcn_readfirstlane(tid >> 6), lane = tid & 63, wr = wid >> 2, wc = wid & 3, fr = lane & 15, fq = lane >> 4;
    const int K = g.K, nt = K / BK;
    unsigned voffA[2], voffB[2]; int RA[2], CA[2];
#pragma unroll
    for (int i = 0; i < 2; ++i) { int R, C; stage_rc(tid * 16 + i * 8192, R, C); const int Rb = ((int)Epi::PERM == 2) ? (64 * (R >> 5) + 16 * ((R & 15) >> 2) + 4 * ((R >> 4) & 1) + (R & 3)) : (Epi::PERM ? ((R & ~31) + perm32(R & 31)) : R);
        voffA[i] = (unsigned)(R * K + C) * 2u; voffB[i] = (unsigned)(Rb * K + C) * 2u; RA[i] = R; CA[i] = C * 2; }
    const size_t kstep = (size_t)(BK * 2);
    const size_t hstep = (size_t)HALF * K * 2;
    const size_t tstep = 2 * hstep;
    const size_t hstepA = GATHER ? (size_t)0 : hstep;
    const size_t hstepB = ((int)Epi::PERM == 2) ? (size_t)8 * K * 2 : hstep;
    const unsigned ldsw = (unsigned)wid * 1024u;
    const int aoff = lds_byte(wr * 64 + fr, MX ? fq * 16 : fq * 8), boff = lds_byte(wc * 32 + fr, MX ? fq * 16 : fq * 8);
#define PG8_SA(b, h) (((b) * 2 + (h)) * HTB)
#define PG8_SB(b, h) ((4 + (b) * 2 + (h)) * HTB)
#define PG8_STAGE(bufoff, gbase, voff) do { _Pragma("unroll") for (int _i = 0; _i < 2; ++_i) \
        __builtin_amdgcn_global_load_lds((const unsigned*)((const char*)(gbase) + (voff)[_i]), (PG8_LAS unsigned*)(lds + (bufoff) + ldsw + _i * 8192), 16, 0, 0); } while (0)
#define PG8_LD32(p) ({ const u32x4 lo_ = *(const PG8_LAS u32x4*)(p), hi_ = *(const PG8_LAS u32x4*)((p) + 16); (i32x8){(int)lo_[0], (int)lo_[1], (int)lo_[2], (int)lo_[3], (int)hi_[0], (int)hi_[1], (int)hi_[2], (int)hi_[3]}; })
#define PG8_LDA(dst, b, h) do { if constexpr (MX) { _Pragma("unroll") for (int m = 0; m < 4; ++m) dst##X[m] = PG8_LD32(lds + PG8_SA(b, h) + aoff + m * 2048); } \
        else { _Pragma("unroll") for (int m = 0; m < 4; ++m) _Pragma("unroll") for (int k = 0; k < 2; ++k) dst[m][k] = *(const PG8_LAS bf16x8*)(lds + PG8_SA(b, h) + aoff + m * 2048 + k * 1024); } } while (0)
#define PG8_LDB(dst, b, h) do { if constexpr (MX) { _Pragma("unroll") for (int n = 0; n < 2; ++n) dst##X[n] = PG8_LD32(lds + PG8_SB(b, h) + boff + n * 2048); } \
        else { _Pragma("unroll") for (int n = 0; n < 2; ++n) _Pragma("unroll") for (int k = 0; k < 2; ++k) dst[n][k] = *(const PG8_LAS bf16x8*)(lds + PG8_SB(b, h) + boff + n * 2048 + k * 1024); } } while (0)
#define PG8_MMA(ai, bj, At, Bt) do { __builtin_amdgcn_s_setprio(1); if constexpr (MX) { _Pragma("unroll") for (int m = 0; m < 4; ++m) _Pragma("unroll") for (int n = 0; n < 2; ++n) \
        asm volatile("v_mfma_scale_f32_16x16x128_f8f6f4 %0, %1, %2, %0, %3, %3 op_sel_hi:[0,0,0]" : "+v"(acc[ai][bj][m][n]) : "v"(Bt##X[n]), "v"(At##X[m]), "v"(mxscale)); } \
        else if constexpr (I8) { _Pragma("unroll") for (int m = 0; m < 4; ++m) _Pragma("unroll") for (int n = 0; n < 2; ++n) _Pragma("unroll") for (int k = 0; k < 2; ++k) \
        acc[ai][bj][m][n] = __builtin_bit_cast(f32x4, __builtin_amdgcn_mfma_i32_16x16x64_i8(__builtin_bit_cast(i32x4, Bt[n][k]), __builtin_bit_cast(i32x4, At[m][k]), __builtin_bit_cast(i32x4, acc[ai][bj][m][n]), 0, 0, 0)); } \
        else { _Pragma("unroll") for (int m = 0; m < 4; ++m) _Pragma("unroll") for (int n = 0; n < 2; ++n) _Pragma("unroll") for (int k = 0; k < 2; ++k) \
        acc[ai][bj][m][n] = __builtin_amdgcn_mfma_f32_16x16x32_bf16(Bt[n][k], At[m][k], acc[ai][bj][m][n], 0, 0, 0); } __builtin_amdgcn_s_setprio(0); } while (0)
#define PG8_WAIT_V(n) asm volatile("s_waitcnt vmcnt(" #n ")" ::: "memory")
#define PG8_WAIT_VN(n) asm volatile("s_waitcnt vmcnt(%0)" :: "n"(n) : "memory")
#define PG8_ZERO(ai) do { _Pragma("unroll") for (int b_ = 0; b_ < 2; ++b_) _Pragma("unroll") for (int m_ = 0; m_ < 4; ++m_) _Pragma("unroll") for (int n_ = 0; n_ < 2; ++n_) acc[ai][b_][m_][n_] = (f32x4){0.f, 0.f, 0.f, 0.f}; } while (0)
#define PG8_TABP(u_) ((const PG8_LAS float*)(lds + TAB_OFF + ((u_) & 1) * 2048))
#define PG8_WAIT_L(n) asm volatile("s_waitcnt lgkmcnt(" #n ")" ::: "memory")
#define PG8_BAR __builtin_amdgcn_s_barrier()
#define PG8_SCHED __builtin_amdgcn_sched_barrier(0)
    static_assert(!ROLL || SP2, "rolling epilogue: eight-phase loop only");
    Unit cur, nxt; int ui = 0; bool pst = false;
    if (!S.next(0, cur)) return;
    f32x4 acc[2][2][4][2];
#pragma unroll
    for (int a = 0; a < 2; ++a)
#pragma unroll
        for (int b = 0; b < 2; ++b)
#pragma unroll
            for (int m = 0; m < 4; ++m)
#pragma unroll
                for (int n = 0; n < 2; ++n) acc[a][b][m][n] = (f32x4){0.f, 0.f, 0.f, 0.f};
    bf16x8 At[4][2], B0[2][2], B1[2][2]; i32x8 AtX[4], B0X[2], B1X[2]; const int mxscale = 0x7F7F7F7F;
    unsigned vc0[2], vc1[2], vn0[2], vn1[2];
    const char* cA = GATHER ? (const char*)g.A : (const char*)g.A + (size_t)cur.pm * tstep; const char* cB = (const char*)g.Bt + (size_t)cur.pn * tstep;
    if constexpr (GATHER) {
        if (tid < 256) rowtab[tid] = ROLL ? S.row_raw(cur, tid) : S.row_byteoff(cur, tid);
        asm volatile("s_waitcnt vmcnt(0) lgkmcnt(0)" ::: "memory"); PG8_BAR; asm volatile("" ::: "memory");
#pragma unroll
        for (int i = 0; i < 2; ++i) { vc0[i] = (ROLL ? S.row_off(rowtab[RA[i]]) : rowtab[RA[i]]) + (unsigned)CA[i]; vc1[i] = (ROLL ? S.row_off(rowtab[128 + RA[i]]) : rowtab[128 + RA[i]]) + (unsigned)CA[i]; vn0[i] = vc0[i]; vn1[i] = vc1[i]; }
    } else {
#pragma unroll
        for (int i = 0; i < 2; ++i) { vc0[i] = voffA[i]; vc1[i] = voffA[i]; vn0[i] = voffA[i]; vn1[i] = voffA[i]; }
    }
    S.a_ready(cur);
    if constexpr (SP2) {
        PG8_STAGE(PG8_SB(0, 0), cB, voffB); PG8_STAGE(PG8_SB(0, 1), cB + hstepB, voffB); PG8_STAGE(PG8_SA(0, 0), cA, vc0); PG8_STAGE(PG8_SA(0, 1), cA + hstepA, vc1);
        if (wr == 1) PG8_BAR;
        PG8_WAIT_V(2); PG8_BAR;
        PG8_STAGE(PG8_SB(1, 0), cB + kstep, voffB); PG8_STAGE(PG8_SA(1, 0), cA + kstep, vc0); PG8_STAGE(PG8_SB(1, 1), cB + hstepB + kstep, voffB);
        PG8_WAIT_V(6); PG8_BAR;
    } else {
        PG8_STAGE(PG8_SB(0, 0), cB, voffB); PG8_STAGE(PG8_SA(0, 0), cA, vc0); PG8_STAGE(PG8_SB(0, 1), cB + hstepB, voffB); PG8_STAGE(PG8_SA(0, 1), cA + hstepA, vc1);
        if (wr == 1) PG8_BAR;
        PG8_WAIT_V(4); PG8_BAR;
        PG8_STAGE(PG8_SB(1, 0), cB + kstep, voffB); PG8_STAGE(PG8_SA(1, 0), cA + kstep, vc0); PG8_STAGE(PG8_SB(1, 1), cB + hstepB + kstep, voffB);
        PG8_WAIT_V(6); PG8_BAR;
    }
    for (;;) {
        const bool has_next = S.next(ui + 1, nxt);
        const char* nA = GATHER ? (const char*)g.A : (has_next ? (const char*)g.A + (size_t)nxt.pm * tstep : cA); const char* nB = has_next ? (const char*)g.Bt + (size_t)nxt.pn * tstep : cB;
        if constexpr (GATHER && !ROLL) {
            if (has_next && tid < 256) rowtab[((ui + 1) & 1) * 256 + tid] = S.row_byteoff(nxt, tid);
        }
#pragma unroll 1
        for (int t = 0; t < nt; t += 2) {
            const bool last = (t == nt - 2);
            const char* a1 = cA + (size_t)(t + 1) * kstep;
            const char* a2 = last ? nA : cA + (size_t)(t + 2) * kstep; const char* b2 = last ? nB : cB + (size_t)(t + 2) * kstep;
            const char* a3 = a2 + kstep; const char* b3 = b2 + kstep;
            if (last && has_next) S.a_ready(nxt);
            if constexpr (GATHER) {
                if (last && has_next) {
                    PG8_LAS unsigned* rt = rowtab + ((ui + 1) & 1) * 256;
#pragma unroll
                    for (int i = 0; i < 2; ++i) { vn0[i] = (ROLL ? S.row_off(rt[RA[i]]) : rt[RA[i]]) + (unsigned)CA[i]; vn1[i] = (ROLL ? S.row_off(rt[128 + RA[i]]) : rt[128 + RA[i]]) + (unsigned)CA[i]; }
                }
            }
            unsigned w20[2], w21[2];
#pragma unroll
            for (int i = 0; i < 2; ++i) { w20[i] = last ? vn0[i] : vc0[i]; w21[i] = last ? vn1[i] : vc1[i]; }
            if constexpr (SP2 && ROLL) {
            const bool rf = (t == 0) && pst;
            PG8_LDB(B0, 0, 0); PG8_LDB(B1, 0, 1); PG8_SCHED; PG8_LDA(At, 0, 0); PG8_STAGE(PG8_SA(1, 1), a1 + hstepA, vc1);
            if (t == 2) {
                if constexpr (Epi::NTAB > 0) { if (Epi::NTAB > 1 || wid < 4) __builtin_amdgcn_global_load_lds((const unsigned*)E.tab_src(cur, tid), (PG8_LAS unsigned*)(lds + TAB_OFF + (ui & 1) * 2048 + wid * 256), 4, 0, 0); }
                if constexpr (GATHER) { if (has_next && wid < 4) __builtin_amdgcn_global_load_lds((const unsigned*)S.row_src(nxt, tid), (PG8_LAS unsigned*)(rowtab + ((ui + 1) & 1) * 256 + wid * 64), 4, 0, 0); }
            }
            if (rf) PG8_WAIT_VN(8 + 2 * Epi::NS); else PG8_WAIT_V(8);
            PG8_WAIT_L(0); PG8_BAR; PG8_MMA(0, 0, At, B0); PG8_MMA(0, 1, At, B1); PG8_BAR; PG8_SCHED;
            PG8_LDA(At, 0, 1); PG8_STAGE(PG8_SB(0, 0), b2, voffB); PG8_STAGE(PG8_SB(0, 1), b2 + hstepB, voffB); PG8_STAGE(PG8_SA(0, 0), a2, w20);
            if (rf) PG8_WAIT_VN(8 + 2 * Epi::NS); else PG8_WAIT_V(8);
            PG8_WAIT_L(0); PG8_BAR; PG8_MMA(1, 0, At, B0); PG8_MMA(1, 1, At, B1); PG8_BAR; PG8_SCHED;
            PG8_LDB(B0, 1, 0); PG8_LDB(B1, 1, 1); PG8_SCHED; PG8_LDA(At, 1, 0); PG8_STAGE(PG8_SA(0, 1), a2 + hstepA, w21);
            PG8_WAIT_V(8); PG8_WAIT_L(0); PG8_BAR; PG8_MMA(0, 0, At, B0); PG8_MMA(0, 1, At, B1); PG8_BAR; PG8_SCHED;
            PG8_LDA(At, 1, 1); PG8_STAGE(PG8_SB(1, 0), b3, voffB); PG8_STAGE(PG8_SB(1, 1), b3 + hstepB, voffB); PG8_STAGE(PG8_SA(1, 0), a3, w20);
            PG8_WAIT_V(8); PG8_WAIT_L(0); PG8_BAR; PG8_MMA(1, 0, At, B0); PG8_MMA(1, 1, At, B1); PG8_BAR; PG8_SCHED;
            } else if constexpr (SP2) {
            PG8_LDB(B0, 0, 0); PG8_LDB(B1, 0, 1); PG8_SCHED; PG8_LDA(At, 0, 0); PG8_STAGE(PG8_SA(1, 1), a1 + hstepA, vc1);
            PG8_WAIT_V(8); PG8_WAIT_L(0); PG8_BAR; PG8_MMA(0, 0, At, B0); PG8_MMA(0, 1, At, B1); PG8_BAR; PG8_SCHED;
            PG8_LDA(At, 0, 1); PG8_STAGE(PG8_SB(0, 0), b2, voffB); PG8_STAGE(PG8_SB(0, 1), b2 + hstepB, voffB); PG8_STAGE(PG8_SA(0, 0), a2, w20);
            PG8_WAIT_V(8); PG8_WAIT_L(0); PG8_BAR; PG8_MMA(1, 0, At, B0); PG8_MMA(1, 1, At, B1); PG8_BAR; PG8_SCHED;
            PG8_LDB(B0, 1, 0); PG8_LDB(B1, 1, 1); PG8_SCHED; PG8_LDA(At, 1, 0); PG8_STAGE(PG8_SA(0, 1), a2 + hstepA, w21);
            PG8_WAIT_V(8); PG8_WAIT_L(0); PG8_BAR; PG8_MMA(0, 0, At, B0); PG8_MMA(0, 1, At, B1); PG8_BAR; PG8_SCHED;
            PG8_LDA(At, 1, 1); PG8_STAGE(PG8_SB(1, 0), b3, voffB); PG8_STAGE(PG8_SB(1, 1), b3 + hstepB, voffB); PG8_STAGE(PG8_SA(1, 0), a3, w20);
            PG8_WAIT_V(8); PG8_WAIT_L(0); PG8_BAR; PG8_MMA(1, 0, At, B0); PG8_MMA(1, 1, At, B1); PG8_BAR; PG8_SCHED;
            } else {
            PG8_LDB(B0, 0, 0); PG8_SCHED; PG8_LDA(At, 0, 0); PG8_STAGE(PG8_SA(1, 1), a1 + hstepA, vc1);
            PG8_WAIT_L(8); PG8_BAR; PG8_WAIT_L(0); PG8_MMA(0, 0, At, B0); PG8_BAR; PG8_SCHED;
            PG8_LDB(B1, 0, 1); PG8_STAGE(PG8_SB(0, 0), b2, voffB);
            PG8_BAR; PG8_WAIT_L(0); PG8_MMA(0, 1, At, B1); PG8_BAR;
            PG8_LDA(At, 0, 1); PG8_STAGE(PG8_SA(0, 0), a2, w20);
            PG8_BAR; PG8_WAIT_L(0); PG8_MMA(1, 0, At, B0); PG8_BAR; PG8_SCHED;
            PG8_STAGE(PG8_SB(0, 1), b2 + hstepB, voffB);
            PG8_WAIT_V(6); PG8_BAR; PG8_MMA(1, 1, At, B1); PG8_BAR;
            PG8_LDB(B0, 1, 0); PG8_SCHED; PG8_LDA(At, 1, 0); PG8_STAGE(PG8_SA(0, 1), a2 + hstepA, w21);
            PG8_WAIT_L(8); PG8_BAR; PG8_WAIT_L(0); PG8_MMA(0, 0, At, B0); PG8_BAR; PG8_SCHED;
            PG8_LDB(B1, 1, 1); PG8_STAGE(PG8_SB(1, 0), b3, voffB);
            PG8_BAR; PG8_WAIT_L(0); PG8_MMA(0, 1, At, B1); PG8_BAR;
            PG8_LDA(At, 1, 1); PG8_STAGE(PG8_SA(1, 0), a3, w20);
            PG8_BAR; PG8_WAIT_L(0); PG8_MMA(1, 0, At, B0); PG8_BAR; PG8_SCHED;
            PG8_STAGE(PG8_SB(1, 1), b3 + hstepB, voffB);
            PG8_WAIT_V(6); PG8_BAR; PG8_MMA(1, 1, At, B1); PG8_BAR;
            }
        }
        if constexpr (ALIGN_EPI) { if (wr == 0) PG8_BAR; }
        if constexpr (ROLL) { int fr_ = fr, fq_ = fq; asm volatile("" : "+v"(fr_), "+v"(fq_)); E.half(acc, cur, 0, wr, wc, fr_, fq_, PG8_TABP(ui)); E.half(acc, cur, 1, wr, wc, fr_, fq_, PG8_TABP(ui)); pst = E.stores(cur, wc); }
        else E(acc, cur, wr, wc, fr, fq);
        S.done(cur);
        if (!has_next) break;
#pragma unroll
        for (int a = 0; a < 2; ++a)
#pragma unroll
            for (int b = 0; b < 2; ++b)
#pragma unroll
                for (int m = 0; m < 4; ++m)
#pragma unroll
                    for (int n = 0; n < 2; ++n) acc[a][b][m][n] = (f32x4){0.f, 0.f, 0.f, 0.f};
        cur = nxt; cA = nA; cB = nB; ++ui;
#pragma unroll
        for (int i = 0; i < 2; ++i) { vc0[i] = vn0[i]; vc1[i] = vn1[i]; }
        if constexpr (ALIGN_EPI) { if (wr == 1) PG8_BAR; }
    }
    PG8_WAIT_V(0);
    if constexpr (!ALIGN_EPI) { if (wr == 0) PG8_BAR; }
    PG8_BAR;
}
struct Gemm2 { const char* A0; const char* B0; unsigned rbA0, rbB0; int nt0; const char* A1; const char* B1; unsigned rbA1, rbB1; int nt1; };
constexpr int TAB2_BYTES = 4096;
template <class Epi, class Sched, bool ALIGN_EPI>
__device__ __forceinline__ void gemm_phase2(PG8_LAS unsigned char* lds, const Gemm2 g, const Sched& S, const Epi& E) {
    constexpr bool MX = false;
    const int tid = threadIdx.x, wid = __builtin_amdgcn_readfirstlane(tid >> 6), lane = tid & 63, wr = wid >> 2, wc = wid & 3, fr = lane & 15, fq = lane >> 4;
    unsigned vA0[2], vB0[2], vA1[2], vB1[2];
#pragma unroll
    for (int i = 0; i < 2; ++i) { int R, C; stage_rc(tid * 16 + i * 8192, R, C); const int Rb = Epi::PERM ? ((R & ~31) + perm32(R & 31)) : R;
        vA0[i] = (unsigned)R * g.rbA0 + (unsigned)C * 2u; vB0[i] = (unsigned)Rb * g.rbB0 + (unsigned)C * 2u; vA1[i] = (unsigned)R * g.rbA1 + (unsigned)C * 2u; vB1[i] = (unsigned)Rb * g.rbB1 + (unsigned)C * 2u; }
    const size_t kstep = (size_t)(BK * 2);
    const size_t hA0 = (size_t)HALF * g.rbA0, hB0 = (size_t)HALF * g.rbB0, hA1 = (size_t)HALF * g.rbA1, hB1 = (size_t)HALF * g.rbB1;
    const unsigned ldsw = (unsigned)wid * 1024u;
    const int aoff = lds_byte(wr * 64 + fr, fq * 8), boff = lds_byte(wc * 32 + fr, fq * 8);
#define PG8_MMA8(ai, bj, At, Bt) do { __builtin_amdgcn_s_setprio(1); _Pragma("unroll") for (int m = 0; m < 4; ++m) _Pragma("unroll") for (int n = 0; n < 2; ++n) _Pragma("unroll") for (int k = 0; k < 2; ++k) \
        acc[ai][bj][m][n] = __builtin_bit_cast(f32x4, __builtin_amdgcn_mfma_i32_16x16x64_i8(__builtin_bit_cast(i32x4, Bt[n][k]), __builtin_bit_cast(i32x4, At[m][k]), __builtin_bit_cast(i32x4, acc[ai][bj][m][n]), 0, 0, 0)); __builtin_amdgcn_s_setprio(0); } while (0)
#define PG8_MMAB(ai, bj, At, Bt) do { __builtin_amdgcn_s_setprio(1); _Pragma("unroll") for (int m = 0; m < 4; ++m) _Pragma("unroll") for (int n = 0; n < 2; ++n) _Pragma("unroll") for (int k = 0; k < 2; ++k) \
        acc[ai][bj][m][n] = __builtin_amdgcn_mfma_f32_16x16x32_bf16(Bt[n][k], At[m][k], acc[ai][bj][m][n], 0, 0, 0); __builtin_amdgcn_s_setprio(0); } while (0)
#define PG8_TAB2P(u_) ((const PG8_LAS float*)(lds + TAB_OFF + ((u_) & 1) * TAB2_BYTES))
#define PG8_SEG(NT, CA, CB, HA, HB, VA, VB, NA, NB, NHA, NHB, NVA, NVB, MMA, FIRSTSEG) \
    _Pragma("unroll 1") for (int t = 0; t < (NT); t += 2) { \
        const bool last = (t == (NT) - 2); \
        const char* a1 = (CA) + (size_t)(t + 1) * kstep; \
        const char* a2 = last ? (NA) : (CA) + (size_t)(t + 2) * kstep; const char* b2 = last ? (NB) : (CB) + (size_t)(t + 2) * kstep; \
        const char* a3 = a2 + kstep; const char* b3 = b2 + kstep; \
        const size_t hA2 = last ? (NHA) : (HA), hB2 = last ? (NHB) : (HB); \
        unsigned wa[2], wb[2]; \
        _Pragma("unroll") for (int i = 0; i < 2; ++i) { wa[i] = last ? (NVA)[i] : (VA)[i]; wb[i] = last ? (NVB)[i] : (VB)[i]; } \
        const bool rf = (FIRSTSEG) && (t == 0) && pst; \
        PG8_LDB(B0, 0, 0); PG8_LDB(B1, 0, 1); PG8_SCHED; PG8_LDA(At, 0, 0); PG8_STAGE(PG8_SA(1, 1), a1 + (HA), (VA)); \
        if ((FIRSTSEG) && t == 2) { for (int q = wid; q < 4 * Epi::NTAB; q += 8) __builtin_amdgcn_global_load_lds((const unsigned*)E.tab_src(cur, q * 64 + lane), (PG8_LAS unsigned*)(lds + TAB_OFF + (ui & 1) * TAB2_BYTES + q * 256), 4, 0, 0); } \
        if (rf) PG8_WAIT_VN(8 + 2 * Epi::NS); else PG8_WAIT_V(8); \
        PG8_WAIT_L(0); PG8_BAR; MMA(0, 0, At, B0); MMA(0, 1, At, B1); PG8_BAR; PG8_SCHED; \
        PG8_LDA(At, 0, 1); PG8_STAGE(PG8_SB(0, 0), b2, wb); PG8_STAGE(PG8_SB(0, 1), b2 + hB2, wb); PG8_STAGE(PG8_SA(0, 0), a2, wa); \
        if (rf) PG8_WAIT_VN(8 + 2 * Epi::NS); else PG8_WAIT_V(8); \
        PG8_WAIT_L(0); PG8_BAR; MMA(1, 0, At, B0); MMA(1, 1, At, B1); PG8_BAR; PG8_SCHED; \
        PG8_LDB(B0, 1, 0); PG8_LDB(B1, 1, 1); PG8_SCHED; PG8_LDA(At, 1, 0); PG8_STAGE(PG8_SA(0, 1), a2 + hA2, wa); \
        PG8_WAIT_V(8); PG8_WAIT_L(0); PG8_BAR; MMA(0, 0, At, B0); MMA(0, 1, At, B1); PG8_BAR; PG8_SCHED; \
        PG8_LDA(At, 1, 1); PG8_STAGE(PG8_SB(1, 0), b3, wb); PG8_STAGE(PG8_SB(1, 1), b3 + hB2, wb); PG8_STAGE(PG8_SA(1, 0), a3, wa); \
        PG8_WAIT_V(8); PG8_WAIT_L(0); PG8_BAR; MMA(1, 0, At, B0); MMA(1, 1, At, B1); PG8_BAR; PG8_SCHED; \
    }
    Unit cur, nxt; int ui = 0; bool pst = false;
    if (!S.next(0, cur)) return;
    f32x4 acc[2][2][4][2];
#pragma unroll
    for (int a = 0; a < 2; ++a) PG8_ZERO(a);
    bf16x8 At[4][2], B0[2][2], B1[2][2]; i32x8 AtX[4], B0X[2], B1X[2]; (void)AtX; (void)B0X; (void)B1X;
    const char* cA0 = g.A0 + (size_t)cur.pm * 2 * hA0; const char* cB0 = g.B0 + (size_t)cur.pn * 2 * hB0;
    const char* cA1 = g.A1 + (size_t)cur.pm * 2 * hA1; const char* cB1 = g.B1 + (size_t)cur.pn * 2 * hB1;
    PG8_STAGE(PG8_SB(0, 0), cB0, vB0); PG8_STAGE(PG8_SB(0, 1), cB0 + hB0, vB0); PG8_STAGE(PG8_SA(0, 0), cA0, vA0); PG8_STAGE(PG8_SA(0, 1), cA0 + hA0, vA0);
    if (wr == 1) PG8_BAR;
    PG8_WAIT_V(2); PG8_BAR;
    PG8_STAGE(PG8_SB(1, 0), cB0 + kstep, vB0); PG8_STAGE(PG8_SA(1, 0), cA0 + kstep, vA0); PG8_STAGE(PG8_SB(1, 1), cB0 + hB0 + kstep, vB0);
    PG8_WAIT_V(6); PG8_BAR;
    for (;;) {
        const bool has_next = S.next(ui + 1, nxt);
        const char* nA0 = has_next ? g.A0 + (size_t)nxt.pm * 2 * hA0 : cA0; const char* nB0 = has_next ? g.B0 + (size_t)nxt.pn * 2 * hB0 : cB0;
        PG8_SEG(g.nt0, cA0, cB0, hA0, hB0, vA0, vB0, cA1, cB1, hA1, hB1, vA1, vB1, PG8_MMA8, true)
        { int fr_ = fr, fq_ = fq; asm volatile("" : "+v"(fr_), "+v"(fq_)); E.mid(acc, cur, wr, wc, fr_, fq_, PG8_TAB2P(ui)); }
        PG8_SCHED;
        PG8_SEG(g.nt1, cA1, cB1, hA1, hB1, vA1, vB1, nA0, nB0, hA0, hB0, vA0, vB0, PG8_MMAB, false)
        if constexpr (ALIGN_EPI) { if (wr == 0) PG8_BAR; }
        { int fr_ = fr, fq_ = fq; asm volatile("" : "+v"(fr_), "+v"(fq_)); E.half(acc, cur, 0, wr, wc, fr_, fq_, PG8_TAB2P(ui)); E.half(acc, cur, 1, wr, wc, fr_, fq_, PG8_TAB2P(ui)); pst = E.stores(cur, wc); }
        if (!has_next) break;
#pragma unroll
        for (int a = 0; a < 2; ++a) PG8_ZERO(a);
        cur = nxt; cA0 = nA0; cB0 = nB0; cA1 = g.A1 + (size_t)cur.pm * 2 * hA1; cB1 = g.B1 + (size_t)cur.pn * 2 * hB1; ++ui;
        if constexpr (ALIGN_EPI) { if (wr == 1) PG8_BAR; }
    }
    PG8_WAIT_V(0);
    if constexpr (!ALIGN_EPI) { if (wr == 0) PG8_BAR; }
    PG8_BAR;
#undef PG8_SEG
#undef PG8_MMA8
#undef PG8_MMAB
#undef PG8_TAB2P
#undef PG8_SA
#undef PG8_SB
#undef PG8_STAGE
#undef PG8_LDA
#undef PG8_LD32
#undef PG8_LDB
#undef PG8_MMA
#undef PG8_WAIT_V
#undef PG8_WAIT_VN
#undef PG8_ZERO
#undef PG8_TABP
#undef PG8_WAIT_L
#undef PG8_BAR
#undef PG8_SCHED
}
}

#ifndef PG8_SP2
#define PG8_SP2 true
#endif
#ifndef PG8_ALIGN
#define PG8_ALIGN true
#endif
#ifndef PG8_ROLL
#define PG8_ROLL true
#endif
#ifndef PG8_ROLL2
#define PG8_ROLL2 PG8_ROLL
#endif
#ifndef PG8_ROLL5
#define PG8_ROLL5 PG8_ROLL
#endif
#ifndef PG8_ROLL7
#define PG8_ROLL7 PG8_ROLL
#endif
#ifndef PG8_ROLL8
#define PG8_ROLL8 PG8_ROLL
#endif

constexpr int NWAVES = 8, NTHR = 512;
constexpr int D = 4096, NB = 4, SEQ = 4096, T = NB * SEQ, CTXL = 256, TC = NB * CTXL, TA = T + TC;
constexpr int NH = 8, DK = 128, DV = 256;
constexpr int COL_Q = 0, COL_O = 1024, COL_CB = 3072, COL_CC = 5120, COL_CX = 7168, COL_K = 9216, COL_V = 10240, COL_G = 12288;
constexpr int NPROJ = 12288, IN_COLS = 12320, NPAD = 12544;
constexpr int NE = 16, FF = 1024, ADA_N = 6 * D;
constexpr int HM_ROWS = 2 * T + NE * 256;
constexpr float EPS = 1e-6f;

constexpr size_t MiB = 1u << 20;
constexpr size_t WS_CTL = 0, CTL_ZERO_BYTES = 1 * MiB;
constexpr size_t WS_ADA = 1 * MiB;
constexpr size_t WS_GATES = 2 * MiB;
constexpr size_t WS_ELIST = 5 * MiB;
constexpr size_t WS_EW = 6 * MiB;
constexpr size_t WS_WIN = 8 * MiB;
constexpr size_t WS_WOUT = 106 * MiB;
constexpr size_t WS_WE1 = 138 * MiB;
constexpr size_t WS_WE2 = 394 * MiB;
constexpr size_t WS_XM = 522 * MiB;
constexpr size_t WS_PROJ = 658 * MiB;
constexpr size_t WS_SLOT = WS_PROJ, WS_HMOE = WS_PROJ + 256 * MiB;
constexpr size_t WS_HF = 1066 * MiB, WS_HB = 1194 * MiB;
constexpr size_t WS_X1 = 1322 * MiB;
constexpr size_t WS_XM8 = 1578 * MiB;
constexpr size_t WS_WO8 = 1646 * MiB;
constexpr size_t WS_WI8 = 1646 * MiB;
constexpr size_t WS_SA = 1696 * MiB, WS_SB = WS_SA + 256 * 1024;
constexpr size_t WS_END = 1698 * MiB;
static_assert(WS_XM8 + (size_t)TA * D <= WS_WI8 && WS_WI8 + (size_t)NPAD * D <= WS_SA, "ws map int8");
static_assert(WS_GATES + (size_t)TA * 32 * 4 <= WS_ELIST && WS_WIN + (size_t)NPAD * D * 2 <= WS_WOUT && WS_XM + (size_t)TA * D * 2 <= WS_PROJ && WS_PROJ + (size_t)TA * NPROJ * 2 <= WS_HF, "ws map");
static_assert(WS_HMOE + (size_t)HM_ROWS * FF * 2 <= WS_HF, "ws map 2");
constexpr int CW_TMO = 0, CW_CODE = 1, CW_TQ = 1024, CW_CNT = 2048, CW_CMAX = 32768, CW_CMAX2 = 49152, CW_BAR = 4096, CW_RT = 16384;

constexpr int RING_BYTES = 131072;
constexpr int LDS_BYTES = 147456;
constexpr int LDSCTL_OFF = LDS_BYTES - 3072;
constexpr int MISC_OFF = LDSCTL_OFF + 320;
constexpr int MOE_OFF = LDSCTL_OFF + 512;
constexpr int ROWTAB_OFF = LDSCTL_OFF + 1024;

#define GAS __attribute__((address_space(1)))
#define LAS __attribute__((address_space(3)))
typedef unsigned short bf16;
typedef unsigned v4u __attribute__((ext_vector_type(4)));
typedef unsigned v2u __attribute__((ext_vector_type(2)));
typedef float f32x4 __attribute__((ext_vector_type(4)));
typedef GAS unsigned gu32;
#define RLX_AGENT __ATOMIC_RELAXED, __HIP_MEMORY_SCOPE_AGENT
#define LDS_WAIT() asm volatile("s_waitcnt lgkmcnt(0)" ::: "memory")
#define VM_WAIT() asm volatile("s_waitcnt vmcnt(0)" ::: "memory")
__device__ __forceinline__ unsigned pk2(float lo, float hi) { return pg8::cvt_pk_bf16(lo, hi); }
__device__ __forceinline__ float bf_lo(unsigned u) { return __uint_as_float(u << 16); }
__device__ __forceinline__ float bf_hi(unsigned u) { return __uint_as_float(u & 0xffff0000u); }
__device__ __forceinline__ float bf1(bf16 u) { return __uint_as_float(((unsigned)u) << 16); }
__device__ __forceinline__ unsigned pk4_fp8(float a, float b, float c, float d) { int p = __builtin_amdgcn_cvt_pk_fp8_f32(a, b, 0, false); p = __builtin_amdgcn_cvt_pk_fp8_f32(c, d, p, true); return (unsigned)p; }
__device__ __forceinline__ unsigned pk4_i8(float a, float b, float c, float d) { return ((unsigned)(int)rintf(a) & 255u) | (((unsigned)(int)rintf(b) & 255u) << 8) | (((unsigned)(int)rintf(c) & 255u) << 16) | ((unsigned)(int)rintf(d) << 24); }
constexpr float W1_SCALE = 64.f, W2_SCALE = 32.f, SLOT_SCALE = 16.f;
typedef float f32x2v __attribute__((ext_vector_type(2)));
__device__ __forceinline__ f32x4 fp8x4_to_f32(unsigned v) { const f32x2v lo = __builtin_amdgcn_cvt_pk_f32_fp8((int)v, false), hi = __builtin_amdgcn_cvt_pk_f32_fp8((int)v, true); return (f32x4){lo[0], lo[1], hi[0], hi[1]}; }
__device__ __forceinline__ float sigmoidf_(float x) { return 1.f / (1.f + __expf(-x)); }

#define XB_TMO      128
#define XB_XCNT(j)  (256  + 64 * (j))
#define XB_XSUB(j)  (1280 + 64 * (j))
#define XB_XGEN(j)  (2304 + 64 * (j))
#define XB_TOP      3328
#define XB_TOPGEN   3392
#define XCD_BAR_WORDS 3456
#define XB_SPIN_CAP (1u << 22)
__device__ __forceinline__ unsigned xb_ld(unsigned* p)              { return __hip_atomic_load(p, __ATOMIC_RELAXED, __HIP_MEMORY_SCOPE_AGENT); }
__device__ __forceinline__ unsigned xb_add(unsigned* p, unsigned v) { return __hip_atomic_fetch_add(p, v, __ATOMIC_RELAXED, __HIP_MEMORY_SCOPE_AGENT); }
__device__ __forceinline__ unsigned xb_xcc_id() { return (unsigned)__builtin_amdgcn_s_getreg((3 << 11) | 20) & 0xFu; }
#define XB_SPIN(cond, bar) do { unsigned _sp = 0; while (cond) { __builtin_amdgcn_s_sleep(1); \
    if ((++_sp & 255u) == 0u) { if (xb_ld(&(bar)[XB_TMO])) break; if (_sp > XB_SPIN_CAP) { atomicAdd(&(bar)[XB_TMO], 1u); break; } } } } while (0)
struct XcdBarrier { unsigned* bar; unsigned x; volatile LAS unsigned* st; };
__device__ __forceinline__ XcdBarrier xcd_barrier_post(unsigned* bar, volatile LAS unsigned* st) {
    XcdBarrier b; b.bar = bar; b.x = xb_xcc_id(); b.st = st;
    if (threadIdx.x == 0) (void)xb_add(&bar[XB_XCNT(b.x)], 1u);
    return b;
}
__device__ __forceinline__ void xcd_barrier_complete(unsigned* bar, unsigned x, unsigned& nloc, unsigned& nx) {
    const unsigned G = gridDim.x * gridDim.y * gridDim.z;
    unsigned sum, cnt, mine, sp = 0u;
    for (;;) {
        sum = 0u; cnt = 0u; mine = 0u;
#pragma unroll
        for (unsigned j = 0; j < 16; ++j) { const unsigned c = xb_ld(&bar[XB_XCNT(j)]); sum += c; cnt += (c > 0u) ? 1u : 0u; mine = (j == x) ? c : mine; }
        if (sum == G) break;
        __builtin_amdgcn_s_sleep(1);
        if ((++sp & 255u) == 0u) { if (xb_ld(&bar[XB_TMO])) break; if (sp > XB_SPIN_CAP) { atomicAdd(&bar[XB_TMO], 1u); break; } }
    }
    nloc = mine > 0u ? mine : 1u; nx = cnt > 0u ? cnt : 1u;
}
__device__ __forceinline__ void xcd_barrier(const XcdBarrier& b) {
    asm volatile("s_waitcnt vmcnt(0)" ::: "memory");
    __syncthreads();
    if (threadIdx.x == 0) {
        unsigned* bar = b.bar;
        __builtin_amdgcn_s_waitcnt(0);
        unsigned nloc = b.st[0], nx = b.st[1];
        if (nloc == 0u) { xcd_barrier_complete(bar, b.x, nloc, nx); b.st[0] = nloc; b.st[1] = nx; }
        const unsigned old = xb_add(&bar[XB_XSUB(b.x)], 1u);
        const unsigned gen = old / nloc;
        if (old + 1u == (gen + 1u) * nloc) {
            __builtin_amdgcn_fence(__ATOMIC_RELEASE, "agent");
            asm volatile("s_waitcnt vmcnt(0)" ::: "memory");
            const unsigned og = xb_add(&bar[XB_TOP], 1u);
            const unsigned tg = og / nx;
            if (og + 1u == (tg + 1u) * nx) xb_add(&bar[XB_TOPGEN], 1u);
            else XB_SPIN(xb_ld(&bar[XB_TOPGEN]) == tg, bar);
            __builtin_amdgcn_fence(__ATOMIC_ACQUIRE, "agent");
            xb_add(&bar[XB_XGEN(b.x)], 1u);
            asm volatile("s_waitcnt vmcnt(0)" ::: "memory");
        } else {
            XB_SPIN(xb_ld(&bar[XB_XGEN(b.x)]) == gen, bar);
            __builtin_amdgcn_fence(__ATOMIC_ACQUIRE, "agent");
            asm volatile("s_waitcnt vmcnt(0)" ::: "memory");
        }
    }
    __syncthreads();
}

struct Frame {
    LAS unsigned char* lds;
    volatile LAS unsigned* MISC;
    gu32* ctl;
    int tid, lane, wave;
    int vcu, G;
    const float *x, *c, *ctx, *cctx, *w_ada, *b_ada, *norm1, *w_in, *b_gates, *conv_w, *head_norm, *w_out, *norm2, *w_rg, *b_rg, *w_re, *b_re, *w_e1, *w_e2, *fnorm;
    float* out;
    float *ADA, *GATES, *EW;
    bf16 *DELTA, *X1B;
    unsigned char *XM8, *WO8, *MIXA8, *WOA8; signed char* WI8; float *SA, *SB, *SB2;
    bf16 *HF, *HB;
    int* ELIST;
    bf16 *WIN, *WOUT, *WE1, *WE2, *XM, *PROJ, *MIX, *XF, *SLOT, *HMOE;
};

template <int CTRL, int ROWMASK> __device__ __forceinline__ float dpp_f(float old, float src) {
    return __builtin_bit_cast(float, __builtin_amdgcn_update_dpp(__builtin_bit_cast(int, old), __builtin_bit_cast(int, src), CTRL, ROWMASK, 0xf, false)); }
__device__ __forceinline__ float wave_incl_sum(float v) {
    v += dpp_f<0x111, 0xf>(0.f, v); v += dpp_f<0x112, 0xf>(0.f, v); v += dpp_f<0x114, 0xf>(0.f, v); v += dpp_f<0x118, 0xf>(0.f, v);
    v += dpp_f<0x142, 0xa>(0.f, v); v += dpp_f<0x143, 0xc>(0.f, v); return v; }
__device__ __forceinline__ float wave_incl_max(float v) {
    constexpr float NI = -3.0e38f;
    v = fmaxf(v, dpp_f<0x111, 0xf>(NI, v)); v = fmaxf(v, dpp_f<0x112, 0xf>(NI, v)); v = fmaxf(v, dpp_f<0x114, 0xf>(NI, v)); v = fmaxf(v, dpp_f<0x118, 0xf>(NI, v));
    v = fmaxf(v, dpp_f<0x142, 0xa>(NI, v)); v = fmaxf(v, dpp_f<0x143, 0xc>(NI, v)); return v; }
__device__ __forceinline__ float lane_bcast(float v, int l) { return __builtin_bit_cast(float, __builtin_amdgcn_readlane(__builtin_bit_cast(int, v), l)); }
__device__ __forceinline__ float wave_sum(float v) { return lane_bcast(wave_incl_sum(v), 63); }
__device__ __forceinline__ float wave_max(float v) { return lane_bcast(wave_incl_max(v), 63); }

__device__ __forceinline__ void p0_ada(Frame& F) {
    LAS float* sil = (LAS float*)F.lds;
    LAS float* red = (LAS float*)(F.lds + 81920);
    for (int i = F.tid; i < 5 * D; i += NTHR) { const int b = i >> 12, k = i & (D - 1); const float cv = b < 4 ? F.c[b * D + k] : F.cctx[k]; sil[i] = cv / (1.f + expf(-cv)); }
    __syncthreads();
    const int cq = F.tid % 24, rg = F.tid / 24;
    for (int item = F.vcu; item < ADA_N / 96; item += F.G) {
        const int col0 = item * 96;
        float acc[5][4];
#pragma unroll
        for (int b = 0; b < 5; ++b)
#pragma unroll
            for (int j = 0; j < 4; ++j) acc[b][j] = 0.f;
        if (rg < 21) {
            const float* wp = F.w_ada + col0 + 4 * cq;
#pragma unroll 13
            for (int r = rg; r < D; r += 21) {
                const f32x4 w = *(const f32x4*)(wp + (size_t)r * ADA_N);
#pragma unroll
                for (int b = 0; b < 5; ++b) { const float s = sil[b * D + r];
#pragma unroll
                    for (int j = 0; j < 4; ++j) acc[b][j] += s * w[j]; }
            }
#pragma unroll
            for (int b = 0; b < 5; ++b)
#pragma unroll
                for (int j = 0; j < 4; ++j) red[rg * 480 + b * 96 + 4 * cq + j] = acc[b][j];
        }
        __syncthreads();
        if (F.tid < 480) { const int b = F.tid / 96, cc = F.tid % 96; float s = 0.f;
#pragma unroll
            for (int q = 0; q < 21; ++q) s += red[q * 480 + F.tid];
            F.ADA[b * ADA_N + col0 + cc] = s + F.b_ada[col0 + cc]; }
        __syncthreads();
    }
}
__device__ __forceinline__ int win_row(int n) {
    if (n < COL_CC || n >= COL_K) return n;
    const int rel = n - COL_CC, au = rel >> 11, r = rel & 2047;
    return COL_CC + 256 * (r >> 7) + 128 * au + (r & 127);
}
struct TItem { const float* W; bf16* WT; const void* cmax; unsigned* cmo; int K, N, nblk, row_off, item, map, f8; float scale; };
template <int KIND>
__device__ __forceinline__ TItem titem_decode(Frame& F, int r) {
    constexpr int I_E1 = (D / 64) * (2 * FF / 32), I_E2 = (FF / 64) * (D / 32);
    TItem t; t.cmax = (const void*)(F.ctl + CW_CMAX); t.cmo = nullptr;
    if (KIND == 8) { t.W = F.w_in; t.WT = (bf16*)F.WI8; t.K = D; t.N = IN_COLS; t.nblk = IN_COLS / 32; t.row_off = 0; t.item = (D / 64) * (IN_COLS / 32) - 1 - r; t.map = 2; t.f8 = 2; t.scale = 1.f; }
    else if (KIND == 0) { t.W = F.w_in; t.WT = F.WIN; t.K = D; t.N = IN_COLS; t.nblk = IN_COLS / 32; t.row_off = 0; t.map = 0; t.f8 = 0; t.scale = 1.f;
        { constexpr int NBP = (IN_COLS - COL_K) / 32; const int kb = r / NBP, nbp = r % NBP; t.item = kb * (IN_COLS / 32) + COL_K / 32 + nbp; } }
    else if (KIND == 1) { t.W = F.w_out; t.WT = F.WOUT; t.K = D; t.N = D; t.nblk = D / 32; t.row_off = 0; t.item = r; t.map = 0; t.f8 = 0; t.scale = 1.f; t.cmo = (unsigned*)(F.ctl + CW_CMAX2); }
    else if (KIND == 2) { const int e = r / I_E1; t.W = F.w_e1 + (size_t)e * D * 2 * FF; t.WT = F.WE1; t.K = D; t.N = 2 * FF; t.nblk = 2 * FF / 32; t.row_off = e * 2 * FF; t.item = r % I_E1; t.map = 1; t.f8 = 1; t.scale = W1_SCALE; }
    else { const int e = r / I_E2; t.W = F.w_e2 + (size_t)e * FF * D; t.WT = F.WE2; t.K = FF; t.N = D; t.nblk = D / 32; t.row_off = e * D; t.item = r % I_E2; t.map = 0; t.f8 = 1; t.scale = W2_SCALE; }
    return t;
}
__device__ __forceinline__ void titem_load(const TItem& t, int lane, f32x4 (&v)[8]) {
    const int nblk = t.nblk, kb = t.item / nblk, nb = t.item % nblk, k0 = 64 * kb, n0 = 32 * nb;
    const float* p = t.W + (size_t)(k0 + (lane >> 3)) * t.N + n0 + 4 * (lane & 7);
#pragma unroll
    for (int i = 0; i < 8; ++i) v[i] = *(const f32x4*)(p + (size_t)(8 * i) * t.N);
}
__device__ __forceinline__ void titem_finish(const TItem& cur, LAS float* scr, int lane) {
    const int nblk = cur.nblk, kb = cur.item / nblk, nb = cur.item % nblk, k0 = 64 * kb, n0 = 32 * nb, c = lane & 7;
#pragma unroll
    for (int j = 0; j < 4; ++j) { const int n = (lane >> 3) + 8 * j; const LAS float* s = scr + (8 * c) * 33 + n;
        const int nn = n0 + n; int row;
        if (cur.map == 0) row = cur.row_off + nn;
        else if (cur.map == 2) row = win_row(nn);
        else { const int au = nn >> 10, r = nn & 1023; row = cur.row_off + 256 * (r >> 7) + 128 * au + (r & 127); }
        const float sc = cur.scale;
        if (cur.f8 == 2) { const float cm = __uint_as_float(((const unsigned*)cur.cmax)[nn]), iv = cm > 0.f ? 127.f / cm : 0.f;
            *(v2u*)((unsigned char*)cur.WT + (size_t)row * cur.K + k0 + 8 * c) = (v2u){pk4_i8(s[0 * 33] * iv, s[1 * 33] * iv, s[2 * 33] * iv, s[3 * 33] * iv), pk4_i8(s[4 * 33] * iv, s[5 * 33] * iv, s[6 * 33] * iv, s[7 * 33] * iv)}; }
        else if (cur.f8) { *(v2u*)((unsigned char*)cur.WT + (size_t)row * cur.K + k0 + 8 * c) = (v2u){pk4_fp8(s[0 * 33] * sc, s[1 * 33] * sc, s[2 * 33] * sc, s[3 * 33] * sc), pk4_fp8(s[4 * 33] * sc, s[5 * 33] * sc, s[6 * 33] * sc, s[7 * 33] * sc)}; }
        else { v4u o; o.x = pk2(s[0 * 33], s[1 * 33]); o.y = pk2(s[2 * 33], s[3 * 33]); o.z = pk2(s[4 * 33], s[5 * 33]); o.w = pk2(s[6 * 33], s[7 * 33]);
               *(v4u*)(cur.WT + (size_t)row * cur.K + k0 + 8 * c) = o;
               if (cur.cmo != nullptr && k0 < D / 2) {
                   unsigned mx = max(max(max((o.x & 0x7fffu) << 16, o.x & 0x7fff0000u), max((o.y & 0x7fffu) << 16, o.y & 0x7fff0000u)), max(max((o.z & 0x7fffu) << 16, o.z & 0x7fff0000u), max((o.w & 0x7fffu) << 16, o.w & 0x7fff0000u)));
                   mx = max(mx, (unsigned)__shfl_xor((int)mx, 1)); mx = max(mx, (unsigned)__shfl_xor((int)mx, 2)); mx = max(mx, (unsigned)__shfl_xor((int)mx, 4));
                   if (c == 0) (void)__hip_atomic_fetch_max(cur.cmo + nn, mx, RLX_AGENT); } } }
}
constexpr int TI_IN = (D / 64) * (IN_COLS / 32), TI_OUT = (D / 64) * (D / 32), TI_E1 = (D / 64) * (2 * FF / 32), TI_E2 = (FF / 64) * (D / 32);
template <int KIND>
__device__ __forceinline__ void transpose_range(Frame& F, LAS float* scr, int it0, int it_end, int stride) {
    const int lane = F.lane;
    f32x4 v[8];
    int it = it0;
    TItem cur = titem_decode<KIND>(F, it < it_end ? it : 0);
    if (it < it_end) titem_load(cur, lane, v);
    while (it < it_end) {
#pragma unroll
        for (int i = 0; i < 8; ++i) { const int kk = 8 * i + (lane >> 3); LAS float* s = scr + kk * 33 + 4 * (lane & 7); s[0] = v[i][0]; s[1] = v[i][1]; s[2] = v[i][2]; s[3] = v[i][3]; }
        const int nit = it + stride;
        TItem nxt = cur;
        if (nit < it_end) { nxt = titem_decode<KIND>(F, nit); titem_load(nxt, lane, v); }
        LDS_WAIT(); asm volatile("" ::: "memory");
        titem_finish(cur, scr, lane);
        LDS_WAIT(); asm volatile("" ::: "memory");
        cur = nxt; it = nit;
    }
}
__device__ __forceinline__ void p0_transposes(Frame& F) {
    LAS float* scr = (LAS float*)(F.lds + F.wave * 8704);
    const int gw = F.vcu * NWAVES + F.wave, NGW = F.G * NWAVES;
    transpose_range<1>(F, scr, gw, TI_OUT, NGW);
    {
        constexpr int NIT = (D / 64) * (IN_COLS / 32);
        const int lane = F.lane;
        auto cm_load = [&](int it, f32x4 (&w)[8]) __attribute__((always_inline)) {
            const int itc = it < NIT ? it : NIT - 1, kb = itc / (IN_COLS / 32), nb = itc % (IN_COLS / 32);
            const float* p = F.w_in + (size_t)(64 * kb + (lane >> 3)) * IN_COLS + 32 * nb + 4 * (lane & 7);
#pragma unroll
            for (int i = 0; i < 8; ++i) w[i] = *(const f32x4*)(p + (size_t)(8 * i) * IN_COLS);
        };
        auto cm_step = [&](int it, f32x4 (&cur)[8], f32x4 (&nxt)[8]) __attribute__((always_inline)) {
            cm_load(it + NGW, nxt);
            if (it < NIT) {
                const int nb = it % (IN_COLS / 32);
                f32x4 mx = (f32x4){0.f, 0.f, 0.f, 0.f};
#pragma unroll
                for (int i = 0; i < 8; ++i) { mx[0] = fmaxf(mx[0], fabsf(cur[i][0])); mx[1] = fmaxf(mx[1], fabsf(cur[i][1])); mx[2] = fmaxf(mx[2], fabsf(cur[i][2])); mx[3] = fmaxf(mx[3], fabsf(cur[i][3])); }
#pragma unroll
                for (int o = 8; o < 64; o <<= 1) { mx[0] = fmaxf(mx[0], __shfl_xor(mx[0], o)); mx[1] = fmaxf(mx[1], __shfl_xor(mx[1], o)); mx[2] = fmaxf(mx[2], __shfl_xor(mx[2], o)); mx[3] = fmaxf(mx[3], __shfl_xor(mx[3], o)); }
                if (lane < 8) { unsigned* cm = (unsigned*)(F.ctl + CW_CMAX) + 32 * nb + 4 * lane;
#pragma unroll
                    for (int j = 0; j < 4; ++j) asm volatile("global_atomic_umax %0, %1, off" :: "v"(cm + j), "v"(__float_as_uint(mx[j])) : "memory"); }
            }
        };
        f32x4 wa[8], wb[8];
        cm_load(gw, wa);
        for (int it = gw; it < NIT; it += 2 * NGW) { cm_step(it, wa, wb); cm_step(it + NGW, wb, wa); }
        asm volatile("s_waitcnt vmcnt(0) ; hidden atomics" ::: "memory");
    }
    { const size_t n16 = (size_t)(NPAD - IN_COLS) * D / 16; v4u* p = (v4u*)(F.WI8 + (size_t)IN_COLS * D);
      for (size_t i = (size_t)F.vcu * NTHR + F.tid; i < n16; i += (size_t)F.G * NTHR) p[i] = (v4u){0u, 0u, 0u, 0u}; }
}
__device__ __forceinline__ int expert_queue_items(int G) { const int tot = NE * (TI_E1 + TI_E2), p3 = (4 + SEQ / 64) * G * NWAVES / 2; return tot > p3 ? tot - p3 : 0; }
struct HItem { const float* src; unsigned char* dst; int N, Kb, map, row0; float scale; };
__device__ __forceinline__ HItem hitem_decode(Frame& F, int hi) {
    const int fi = hi >> 1, sub = hi & 1; HItem t;
    if (fi < NE * TI_E1) { const int e = fi / TI_E1, item = fi % TI_E1, kb = item >> 6, nb = item & 63, n0 = 32 * nb + 16 * sub;
        t.N = 2 * FF; t.Kb = D; t.map = 1; t.scale = W1_SCALE; t.src = F.w_e1 + (size_t)e * D * 2 * FF + (size_t)(64 * kb) * t.N + n0;
        const int au = n0 >> 10, r = n0 & 1023; t.row0 = e * 2 * FF + 256 * (r >> 7) + 128 * au + (r & 127); t.dst = (unsigned char*)F.WE1 + 64 * kb; }
    else { const int f2 = fi - NE * TI_E1, e = f2 / TI_E2, item = f2 % TI_E2, kb = item >> 7, nb = item & 127, n0 = 32 * nb + 16 * sub;
        t.N = D; t.Kb = FF; t.map = 0; t.scale = W2_SCALE; t.src = F.w_e2 + (size_t)e * FF * D + (size_t)(64 * kb) * t.N + n0;
        t.row0 = e * D + n0; t.dst = (unsigned char*)F.WE2 + 64 * kb; }
    return t;
}
__device__ __forceinline__ void hitem_load(const HItem& t, int lane, f32x4 (&v)[4]) {
    const float* p = t.src + (size_t)(lane >> 2) * t.N + 4 * (lane & 3);
#pragma unroll
    for (int i = 0; i < 4; ++i) v[i] = *(const f32x4*)(p + (size_t)(16 * i) * t.N);
}
__device__ __forceinline__ void hitem_to_lds(int lane, const f32x4 (&v)[4], LAS float* scr) {
#pragma unroll
    for (int i = 0; i < 4; ++i) { LAS float* s = scr + (16 * i + (lane >> 2)) * 17 + 4 * (lane & 3); s[0] = v[i][0]; s[1] = v[i][1]; s[2] = v[i][2]; s[3] = v[i][3]; }
}
__device__ __forceinline__ void hitem_store(const HItem& t, int lane, LAS float* scr) {
    LDS_WAIT(); asm volatile("" ::: "memory");
    const int n = lane & 15, kc = lane >> 4; const LAS float* s = scr + (16 * kc) * 17 + n; const float sc = t.scale;
    v4u o;
    o.x = pk4_fp8(s[0 * 17] * sc, s[1 * 17] * sc, s[2 * 17] * sc, s[3 * 17] * sc); o.y = pk4_fp8(s[4 * 17] * sc, s[5 * 17] * sc, s[6 * 17] * sc, s[7 * 17] * sc);
    o.z = pk4_fp8(s[8 * 17] * sc, s[9 * 17] * sc, s[10 * 17] * sc, s[11 * 17] * sc); o.w = pk4_fp8(s[12 * 17] * sc, s[13 * 17] * sc, s[14 * 17] * sc, s[15 * 17] * sc);
    *(v4u*)(t.dst + (size_t)(t.row0 + n) * t.Kb + 16 * kc) = o;
    LDS_WAIT(); asm volatile("" ::: "memory");
}
__device__ __forceinline__ void gstore8_hidden(void* p, v2u v) { asm volatile("global_store_dwordx2 %0, %1, off" :: "v"(p), "v"(v) : "memory"); }
__device__ __forceinline__ void gstore16_hidden(void* p, v4u v) { asm volatile("global_store_dwordx4 %0, %1, off" :: "v"(p), "v"(v) : "memory"); }
__device__ __forceinline__ void hitem_store_hidden(const HItem& t, int lane, LAS float* scr) {
    LDS_WAIT(); asm volatile("" ::: "memory");
    const int n = lane & 15, kc = lane >> 4; const LAS float* s = scr + (16 * kc) * 17 + n; const float sc = t.scale;
    v4u o;
    o.x = pk4_fp8(s[0 * 17] * sc, s[1 * 17] * sc, s[2 * 17] * sc, s[3 * 17] * sc); o.y = pk4_fp8(s[4 * 17] * sc, s[5 * 17] * sc, s[6 * 17] * sc, s[7 * 17] * sc);
    o.z = pk4_fp8(s[8 * 17] * sc, s[9 * 17] * sc, s[10 * 17] * sc, s[11 * 17] * sc); o.w = pk4_fp8(s[12 * 17] * sc, s[13 * 17] * sc, s[14 * 17] * sc, s[15 * 17] * sc);
    gstore16_hidden(t.dst + (size_t)(t.row0 + n) * t.Kb + 16 * kc, o);
    LDS_WAIT(); asm volatile("" ::: "memory");
}
__device__ __forceinline__ void hitem_read(int lane, const LAS float* scr, float (&hr)[16]) {
    const int n = lane & 15, kc = lane >> 4; const LAS float* s = scr + (16 * kc) * 17 + n;
#pragma unroll
    for (int j = 0; j < 16; ++j) hr[j] = s[j * 17];
}
__device__ __forceinline__ void hitem_pack_store(const HItem& t, int lane, const float (&hr)[16]) {
    const int n = lane & 15, kc = lane >> 4; const float sc = t.scale;
    v4u o;
    o.x = pk4_fp8(hr[0] * sc, hr[1] * sc, hr[2] * sc, hr[3] * sc); o.y = pk4_fp8(hr[4] * sc, hr[5] * sc, hr[6] * sc, hr[7] * sc);
    o.z = pk4_fp8(hr[8] * sc, hr[9] * sc, hr[10] * sc, hr[11] * sc); o.w = pk4_fp8(hr[12] * sc, hr[13] * sc, hr[14] * sc, hr[15] * sc);
    gstore16_hidden(t.dst + (size_t)(t.row0 + n) * t.Kb + 16 * kc, o);
}
constexpr int TQ_BATCH = 16;
static_assert((NE * TI_E1) % TQ_BATCH == 0 && (NE * TI_E2) % TQ_BATCH == 0, "queue batches stay inside one kind");
__device__ __forceinline__ void expert_transpose_queue(Frame& F) {
    LAS float* scr = (LAS float*)(F.lds + F.wave * 8704);
    for (;;) {
        int base = 0;
        if (F.lane == 0) base = (int)__hip_atomic_fetch_add((unsigned*)(F.ctl + CW_TQ), (unsigned)TQ_BATCH, RLX_AGENT);
        base = __builtin_amdgcn_readfirstlane(base);
        if (base >= expert_queue_items(F.G)) break;
        if (base < NE * TI_E1) transpose_range<2>(F, scr, base, base + TQ_BATCH, 1);
        else transpose_range<3>(F, scr, base - NE * TI_E1, base - NE * TI_E1 + TQ_BATCH, 1);
    }
}

__device__ __forceinline__ void p1_quant_weights(Frame& F) {
    __syncthreads();
    LAS float* scr = (LAS float*)(F.lds + F.wave * 8704);
    const int gw = F.vcu * NWAVES + F.wave, NGW = F.G * NWAVES;
    transpose_range<8>(F, scr, gw, (D / 64) * (IN_COLS / 32), NGW);
    for (int n = F.vcu * NTHR + F.tid; n < IN_COLS; n += F.G * NTHR) F.SB[win_row(n)] = __uint_as_float(((const unsigned*)(F.ctl + CW_CMAX))[n]) * (1.f / 127.f);
}
__device__ __forceinline__ void p1_quant_wout(Frame& F) {
    const int gw = F.vcu * NWAVES + F.wave, NGW = F.G * NWAVES, lane = F.lane;
    for (int n = gw; n < D; n += NGW) {
        const unsigned cmb = ((const unsigned*)(F.ctl + CW_CMAX2))[n]; const float cm = __uint_as_float(cmb), iv = cm > 0.f ? 127.f / cm : 0.f;
        const bf16* src = F.WOUT + (size_t)n * D; unsigned char* dst = F.WOA8 + (size_t)n * (D / 2);
        v4u v[4];
#pragma unroll
        for (int j = 0; j < 4; ++j) v[j] = *(const v4u*)(src + 512 * j + 8 * lane);
#pragma unroll
        for (int j = 0; j < 4; ++j) *(v2u*)(dst + 512 * j + 8 * lane) = (v2u){pk4_i8(bf_lo(v[j].x) * iv, bf_hi(v[j].x) * iv, bf_lo(v[j].y) * iv, bf_hi(v[j].y) * iv), pk4_i8(bf_lo(v[j].z) * iv, bf_hi(v[j].z) * iv, bf_lo(v[j].w) * iv, bf_hi(v[j].w) * iv)};
        if (lane == 0) F.SB2[n] = cm * (1.f / 127.f);
    }
}
__device__ __forceinline__ void p1_norm(Frame& F) {
    LAS float* fac = (LAS float*)F.lds; LAS float* sh = fac + D;
    const int gw = F.vcu * NWAVES + F.wave, NGW = F.G * NWAVES;
    for (int bb = 0; bb < 5; ++bb) {
        __syncthreads();
        for (int i = F.tid; i < D; i += NTHR) { fac[i] = F.norm1[i] * (1.f + F.ADA[bb * ADA_N + D + i]); sh[i] = F.ADA[bb * ADA_N + i]; }
        __syncthreads();
        const int nrows = bb < 4 ? SEQ : TC; const float* src = bb < 4 ? F.x + (size_t)bb * SEQ * D : F.ctx; const int drow0 = bb < 4 ? bb * SEQ : T;
        for (int r = gw; r < nrows; r += 2 * NGW) {
            int lane = F.lane; asm volatile("" : "+v"(lane));
            const int r2 = r + NGW; const bool has2 = r2 < nrows; const int r2c = has2 ? r2 : r;
            const f32x4* xa = (const f32x4*)(src + (size_t)r * D) + lane; const f32x4* xb = (const f32x4*)(src + (size_t)r2c * D) + lane;
            f32x4 va[16], vb[16]; float sa = 0.f, sb = 0.f;
#pragma unroll
            for (int j = 0; j < 16; ++j) { va[j] = xa[64 * j]; vb[j] = xb[64 * j]; }
#pragma unroll
            for (int j = 0; j < 16; ++j) { sa = fmaf(va[j][0], va[j][0], fmaf(va[j][1], va[j][1], fmaf(va[j][2], va[j][2], fmaf(va[j][3], va[j][3], sa))));
                                           sb = fmaf(vb[j][0], vb[j][0], fmaf(vb[j][1], vb[j][1], fmaf(vb[j][2], vb[j][2], fmaf(vb[j][3], vb[j][3], sb)))); }
            const float ra = rsqrtf(wave_sum(sa) * (1.f / D) + EPS), rb = rsqrtf(wave_sum(sb) * (1.f / D) + EPS);
#pragma unroll
            for (int j = 0; j < 16; ++j) { const f32x4 fa = *(const LAS f32x4*)(fac + 256 * j + 4 * lane), sv = *(const LAS f32x4*)(sh + 256 * j + 4 * lane);
                va[j] = va[j] * ra * fa + sv; vb[j] = vb[j] * rb * fa + sv; }
            {
                float ma = 0.f, mb = 0.f;
#pragma unroll
                for (int j = 0; j < 16; ++j) { ma = fmaxf(ma, fmaxf(fmaxf(fabsf(va[j][0]), fabsf(va[j][1])), fmaxf(fabsf(va[j][2]), fabsf(va[j][3])))); mb = fmaxf(mb, fmaxf(fmaxf(fabsf(vb[j][0]), fabsf(vb[j][1])), fmaxf(fabsf(vb[j][2]), fabsf(vb[j][3])))); }
                ma = wave_max(ma); mb = wave_max(mb);
                const float ia = ma > 0.f ? 127.f / ma : 0.f, ib = mb > 0.f ? 127.f / mb : 0.f;
                if (lane == 0) { F.SA[drow0 + r] = ma * (1.f / 127.f); if (has2) F.SA[drow0 + r2c] = mb * (1.f / 127.f); }
#pragma unroll
                for (int j = 0; j < 16; ++j) { ((unsigned*)(F.XM8 + (size_t)(drow0 + r) * D) + lane)[64 * j] = pk4_i8(va[j][0] * ia, va[j][1] * ia, va[j][2] * ia, va[j][3] * ia);
                    if (has2) ((unsigned*)(F.XM8 + (size_t)(drow0 + r2c) * D) + lane)[64 * j] = pk4_i8(vb[j][0] * ib, vb[j][1] * ib, vb[j][2] * ib, vb[j][3] * ib); }
            }
        }
    }
}

namespace ml {
constexpr int QP = 272, VP = 160, PP = 144, CP = 272;
constexpr int OFF_Q = 0, OFF_K = OFF_Q + 64 * QP, OFF_V = OFF_K + 64 * QP, OFF_VW = OFF_V + 64 * VP, OFF_P = OFF_VW + 64 * VP, OFF_CB = OFF_P + 64 * PP, CB_BYTES = 80 * CP, LDS_END = OFF_CB + 2 * CB_BYTES;
static_assert(LDS_END <= RING_BYTES, "mlstm LDS");
typedef short s16x4 __attribute__((ext_vector_type(4)));
typedef short bf16x8 __attribute__((ext_vector_type(8)));
__device__ __forceinline__ s16x4 tr(const LAS unsigned char* p) { return __builtin_bit_cast(s16x4, __builtin_amdgcn_ds_read_tr16_b64_v4i16((LAS s16x4*)p)); }
__device__ __forceinline__ bf16x8 trfrag(const LAS unsigned char* p, int pitch) { const s16x4 a = tr(p), b = tr(p + 4 * pitch); return (bf16x8){a[0], a[1], a[2], a[3], b[0], b[1], b[2], b[3]}; }
__device__ __forceinline__ bf16x8 ld16(const LAS unsigned char* p) { return *(const LAS bf16x8*)p; }
__device__ __forceinline__ int row_of(int c, int p, int dir, int b) {
    if (c < 4) { const int i = 64 * c + p; return T + b * CTXL + (dir ? (CTXL - 1 - i) : i); }
    const int i = 64 * (c - 4) + p; return b * SEQ + (dir ? (SEQ - 1 - i) : i);
}
}
#define ML_BAR() do { asm volatile("s_waitcnt lgkmcnt(0)" ::: "memory"); __builtin_amdgcn_s_barrier(); asm volatile("" ::: "memory"); } while (0)
__device__ __forceinline__ void p3_mlstm(Frame& F) {
    using namespace ml;
    LAS unsigned char* lds = F.lds;
    const int tid = F.tid, lane = F.lane, wave = F.wave, li = lane & 15, lg = lane >> 4, lq = (lane & 15) >> 2, lp = lane & 3;
    constexpr float QS = 0.08838834764831845f;
    constexpr int NCH = 4 + SEQ / 64;
    constexpr int SC_A = LDS_END, SC_M = SC_A + 256, SC_B = SC_M + 256;
    constexpr int HSCR_OFF = SC_B + 256;
    static_assert(HSCR_OFF + NWAVES * 4352 <= LDSCTL_OFF, "mlstm LDS");
    for (int unit = F.vcu; unit < NB * NH * 2 * 4; unit += F.G) {
        const int vq = unit & 3, dir = (unit >> 2) & 1, h = (unit >> 3) & 7, b = unit >> 6;
        bf16* HO = dir ? F.HB : F.HF;
        __syncthreads();
        unsigned z0 = 0u; asm volatile("" : "+v"(z0));
        for (int i = tid; i < CB_BYTES / 16; i += NTHR) *(LAS v4u*)(lds + OFF_CB + 16 * i) = (v4u){z0, z0, z0, z0};
        if (tid < 64) { *(LAS v4u*)(lds + OFF_V + tid * VP + 128) = (v4u){0x00003F80u | z0, z0, z0, z0}; *(LAS v4u*)(lds + OFF_V + tid * VP + 144) = (v4u){z0, z0, z0, z0};
                        *(LAS v4u*)(lds + OFF_VW + tid * VP + 128) = (v4u){z0, z0, z0, z0}; *(LAS v4u*)(lds + OFF_VW + tid * VP + 144) = (v4u){z0, z0, z0, z0}; }
        f32x4 Cacc[5];
#pragma unroll
        for (int i = 0; i < 5; ++i) Cacc[i] = (f32x4){0.f, 0.f, 0.f, 0.f};
        v4u rq[2], rk[2], rv; float ig, fp;
        rq[0] = rq[1] = (v4u){0u, 0u, 0u, 0u};
        const GAS bf16* pk_[2]; const GAS bf16* pv_; const GAS float* pg_;
#define ML_SETPTR(cc) do { const int cs_ = (cc); \
        _Pragma("unroll") for (int i = 0; i < 2; ++i) { const int id = tid + NTHR * i, p = id >> 4, ch = id & 15; pk_[i] = (const GAS bf16*)F.PROJ + (size_t)row_of(cs_, p, dir, b) * NPROJ + COL_K + h * DK + 8 * ch; } \
        { const int p = tid >> 3, ch = tid & 7; pv_ = (const GAS bf16*)F.PROJ + (size_t)row_of(cs_, p, dir, b) * NPROJ + COL_V + h * DV + vq * 64 + 8 * ch; } \
        pg_ = (const GAS float*)F.GATES + (size_t)row_of(cs_, lane, dir, b) * 32 + dir * 16 + h; } while (0)
#define ML_PREFETCH(cc) do { const int c_ = (cc); if (c_ == 0 || c_ == 4) ML_SETPTR(c_); \
        _Pragma("unroll") for (int i = 0; i < 2; ++i) { rk[i] = *(const GAS v4u*)pk_[i]; rq[i] = *(const GAS v4u*)(pk_[i] + (COL_Q - COL_K)); pk_[i] += pstep; } \
        rv = *(const GAS v4u*)pv_; pv_ += pstep; ig = pg_[0]; fp = pg_[8]; pg_ += gstep; } while (0)
        const long pstep = (dir ? -64 : 64) * (long)NPROJ, gstep = (dir ? -64 : 64) * 32;
        float bc, g, Ap, Mp, M63, wS, decay, wsv, m = 0.f;
#define ML_SCALARS(m_in) do { const float lf_ = fminf(fp, 0.f) - 0.6931471805599453f * __log2f(1.f + __expf(-fabsf(fp))); \
        bc = wave_incl_sum(lf_); g = lane_bcast(bc, 63); Ap = ig - bc; const float PA_ = wave_incl_max(Ap), Amax_ = lane_bcast(PA_, 63); \
        Mp = fmaxf((m_in), PA_); M63 = fmaxf((m_in), Amax_); wS = __expf(Ap - M63); decay = __expf((m_in) - M63); wsv = __shfl(wS, 8 * wave + (lane >> 3)); } while (0)
#define ML_STAGE() do { \
        _Pragma("unroll") for (int i = 0; i < 2; ++i) { const int id = tid + NTHR * i, p = id >> 4, ch = id & 15; \
            *(LAS v4u*)(lds + OFF_K + p * QP + 16 * ch) = rk[i]; *(LAS v4u*)(lds + OFF_Q + p * QP + 16 * ch) = rq[i]; } \
        { const int p = tid >> 3, ch = tid & 7; \
          *(LAS v4u*)(lds + OFF_V + p * VP + 16 * ch) = rv; \
          v4u o; o.x = pk2(bf_lo(rv.x) * wsv, bf_hi(rv.x) * wsv); o.y = pk2(bf_lo(rv.y) * wsv, bf_hi(rv.y) * wsv); o.z = pk2(bf_lo(rv.z) * wsv, bf_hi(rv.z) * wsv); o.w = pk2(bf_lo(rv.w) * wsv, bf_hi(rv.w) * wsv); \
          *(LAS v4u*)(lds + OFF_VW + p * VP + 16 * ch) = o; } \
        if (wave == 0) { *(LAS unsigned short*)(lds + OFF_VW + lane * VP + 128) = (unsigned short)(pk2(wS, 0.f) & 0xffffu); \
                         *(LAS float*)(lds + SC_A + 4 * lane) = Ap; *(LAS float*)(lds + SC_M + 4 * lane) = Mp; *(LAS float*)(lds + SC_B + 4 * lane) = bc; } } while (0)
        ML_PREFETCH(0);
        const int tt = wave >> 1, trow = 16 * tt + li, vt0 = (wave & 1) ? 2 : 0, dt = wave;
        const int hi0 = 2 * expert_queue_items(F.G) + (unit / F.G) * NCH * (F.G * NWAVES) + F.vcu * NWAVES + wave;
        LAS float* hscr = (LAS float*)(lds + HSCR_OFF + wave * 4352);
        ML_SCALARS(m);
        ML_BAR();
        ML_STAGE();
        constexpr int HLIM = 2 * NE * (TI_E1 + TI_E2);
        f32x4 hvA[4], hvB[4];
        { const int h0 = hi0 < HLIM ? hi0 : HLIM - 1; hitem_load(hitem_decode(F, h0), lane, hvA); }
        auto step = [&](const int c, f32x4 (&hvn)[4], f32x4 (&hvo)[4]) __attribute__((always_inline)) {
            const bool lat = c >= 4;
            ML_BAR();
            const float dec_c = decay, m_c = m, m_next = g + M63;
            ML_PREFETCH(c + 1);
            const int hi = hi0 + c * (F.G * NWAVES);
            const bool hact = hi < HLIM;
            f32x4 oacc[3];
#pragma unroll
            for (int j = 0; j < 3; ++j) oacc[j] = (f32x4){0.f, 0.f, 0.f, 0.f};
            float Mt = 0.f; v2u hout[2] = {(v2u){0u, 0u}, (v2u){0u, 0u}};
            if (lat) {
                bf16x8 Bq[4], Ak[2][4], Cf[3][4];
                const LAS unsigned char* cbo = lds + OFF_CB + (c & 1) * CB_BYTES;
#pragma unroll
                for (int ks = 0; ks < 4; ++ks) Bq[ks] = ld16(lds + OFF_Q + trow * QP + 64 * ks + 16 * lg);
#pragma unroll
                for (int sti = 0; sti < 2; ++sti)
#pragma unroll
                    for (int ks = 0; ks < 4; ++ks) Ak[sti][ks] = ld16(lds + OFF_K + (16 * (2 * (wave & 1) + sti) + li) * QP + 64 * ks + 16 * lg);
                Mt = *(const LAS float*)(lds + SC_M + 4 * trow);
                f32x4 A4[2];
#pragma unroll
                for (int sti = 0; sti < 2; ++sti) A4[sti] = *(const LAS f32x4*)(lds + SC_A + 4 * (16 * (2 * (wave & 1) + sti) + 4 * lg));
#pragma unroll
                for (int j = 0; j < 3; ++j)
#pragma unroll
                    for (int ks = 0; ks < 4; ++ks) Cf[j][ks] = ld16(cbo + (16 * (j < 2 ? vt0 + j : 4) + li) * CP + 64 * ks + 16 * lg);
                f32x4 sacc[2];
#pragma unroll
                for (int sti = 0; sti < 2; ++sti) { sacc[sti] = (f32x4){0.f, 0.f, 0.f, 0.f};
#pragma unroll
                    for (int ks = 0; ks < 4; ++ks) sacc[sti] = __builtin_amdgcn_mfma_f32_16x16x32_bf16(Ak[sti][ks], Bq[ks], sacc[sti], 0, 0, 0); }
#pragma unroll
                for (int ks = 0; ks < 4; ++ks)
#pragma unroll
                    for (int j = 0; j < 3; ++j) oacc[j] = __builtin_amdgcn_mfma_f32_16x16x32_bf16(Cf[j][ks], Bq[ks], oacc[j], 0, 0, 0);
#pragma unroll
                for (int sti = 0; sti < 2; ++sti) { const int st = 2 * (wave & 1) + sti; float v[4];
#pragma unroll
                    for (int r = 0; r < 4; ++r) { const int sp = 16 * st + 4 * lg + r; v[r] = sp <= trow ? sacc[sti][r] * QS * __expf(A4[sti][r] - Mt) : 0.f; }
                    *(LAS v2u*)(lds + OFF_P + trow * PP + 2 * (16 * st + 4 * lg)) = (v2u){pk2(v[0], v[1]), pk2(v[2], v[3])}; }
                const float e2 = __expf(m_c - Mt) * QS;
#pragma unroll
                for (int j = 0; j < 3; ++j) oacc[j] = oacc[j] * e2;
            }
            {
                bf16x8 At[2], Bt[5][2];
#pragma unroll
                for (int ks = 0; ks < 2; ++ks) At[ks] = trfrag(lds + OFF_K + (32 * ks + 8 * lg + lq) * QP + 32 * dt + 8 * lp, QP);
#pragma unroll
                for (int vt = 0; vt < 5; ++vt)
#pragma unroll
                    for (int ks = 0; ks < 2; ++ks) Bt[vt][ks] = trfrag(lds + OFF_VW + (32 * ks + 8 * lg + lq) * VP + 32 * vt + 8 * lp, VP);
#pragma unroll
                for (int vt = 0; vt < 5; ++vt) Cacc[vt] = Cacc[vt] * dec_c;
#pragma unroll
                for (int ks = 0; ks < 2; ++ks)
#pragma unroll
                    for (int vt = 0; vt < 5; ++vt) Cacc[vt] = __builtin_amdgcn_mfma_f32_16x16x32_bf16(At[ks], Bt[vt][ks], Cacc[vt], 0, 0, 0);
                LAS unsigned char* cbn = lds + OFF_CB + ((c + 1) & 1) * CB_BYTES;
#pragma unroll
                for (int vt = 0; vt < 5; ++vt) *(LAS v2u*)(cbn + (16 * vt + li) * CP + 2 * (16 * dt + 4 * lg)) = (v2u){pk2(Cacc[vt][0], Cacc[vt][1]), pk2(Cacc[vt][2], Cacc[vt][3])};
            }
            if (hact) hitem_to_lds(lane, hvo, hscr);
            { const int hn = hi + F.G * NWAVES; hitem_load(hitem_decode(F, hn < HLIM ? hn : HLIM - 1), lane, hvn); }
            ML_BAR();
            if (lat) {
                bf16x8 Pf[2], Vt[3][2];
#pragma unroll
                for (int ks = 0; ks < 2; ++ks) Pf[ks] = ld16(lds + OFF_P + trow * PP + 64 * ks + 16 * lg);
#pragma unroll
                for (int j = 0; j < 3; ++j)
#pragma unroll
                    for (int ks = 0; ks < 2; ++ks) Vt[j][ks] = trfrag(lds + OFF_V + (32 * ks + 8 * lg + lq) * VP + 32 * (j < 2 ? vt0 + j : 4) + 8 * lp, VP);
                const float bct = *(const LAS float*)(lds + SC_B + 4 * trow);
#pragma unroll
                for (int ks = 0; ks < 2; ++ks)
#pragma unroll
                    for (int j = 0; j < 3; ++j) oacc[j] = __builtin_amdgcn_mfma_f32_16x16x32_bf16(Vt[j][ks], Pf[ks], oacc[j], 0, 0, 0);
                const float den = __shfl(oacc[2][0], li);
                const float inv = 1.f / fmaxf(fabsf(den), __expf(-(bct + Mt)));
#pragma unroll
                for (int j = 0; j < 2; ++j) { const f32x4 o = oacc[j] * inv; hout[j] = (v2u){pk2(o[0], o[1]), pk2(o[2], o[3])}; }
            }
            float hr[16];
            if (hact) hitem_read(lane, hscr, hr);
            m = m_next;
            if (c + 1 < NCH) ML_SCALARS(m);
            asm volatile("; chunk c+1 pieces are used here so that the wait for them sits in front of this step's stores" : "+v"(rk[0]), "+v"(rk[1]), "+v"(rq[0]), "+v"(rq[1]), "+v"(rv) :: "memory");
            if (lat) { bf16* hp = HO + (size_t)row_of(c, trow, dir, b) * 2048 + h * DV + vq * 64 + 4 * lg;
#pragma unroll
                for (int j = 0; j < 2; ++j) gstore8_hidden(hp + 16 * (vt0 + j), hout[j]); }
            if (hact) hitem_pack_store(hitem_decode(F, hi), lane, hr);
            ML_BAR();
            if (c + 1 < NCH) ML_STAGE();
        };
        static_assert(NCH % 2 == 0, "two steps per trip");
        for (int c = 0; c < NCH; c += 2) { step(c, hvB, hvA); step(c + 1, hvA, hvB); }
        asm volatile("s_waitcnt vmcnt(0) ; the hidden stores of the loop" ::: "memory");
#undef ML_PREFETCH
#undef ML_SETPTR
#undef ML_SCALARS
#undef ML_STAGE
    }
}

__device__ __forceinline__ void p4_mix(Frame& F) {
    const int gw = F.vcu * NWAVES + F.wave, NGW = F.G * NWAVES;
    LAS float* cwl = (LAS float*)F.lds; LAS float* hnl = cwl + 3 * 2048;
    __syncthreads();
    for (int i = F.tid; i < 3 * 2048 / 4; i += NTHR) *(LAS f32x4*)(cwl + 4 * i) = *(const f32x4*)(F.conv_w + 4 * i);
    for (int i = F.tid; i < 2048 / 4; i += NTHR) *(LAS f32x4*)(hnl + 4 * i) = *(const f32x4*)(F.head_norm + 4 * i);
    __syncthreads();
    for (int r = gw; r < T; r += NGW) {
        int lane = F.lane; asm volatile("" : "+v"(lane));
        const int s = r & (SEQ - 1), gr = s >> 6, gc = s & 63;
        const bf16* pr = F.PROJ + (size_t)r * NPROJ;
        bf16* mr = F.MIX + (size_t)r * D;
        {
            v2u ha[NH], hb[NH], og[NH];
#pragma unroll
            for (int hh = 0; hh < NH; ++hh) { const int idx = hh * DV + 4 * lane;
                ha[hh] = *(const v2u*)(F.HF + (size_t)r * 2048 + idx); hb[hh] = *(const v2u*)(F.HB + (size_t)r * 2048 + idx); og[hh] = *(const v2u*)(pr + COL_O + idx); }
            f32x4 hs[NH]; float ss[NH];
#pragma unroll
            for (int hh = 0; hh < NH; ++hh) { hs[hh] = (f32x4){bf_lo(ha[hh].x) + bf_lo(hb[hh].x), bf_hi(ha[hh].x) + bf_hi(hb[hh].x), bf_lo(ha[hh].y) + bf_lo(hb[hh].y), bf_hi(ha[hh].y) + bf_hi(hb[hh].y)};
                ss[hh] = (hs[hh][0] * hs[hh][0] + hs[hh][1] * hs[hh][1]) + (hs[hh][2] * hs[hh][2] + hs[hh][3] * hs[hh][3]); }
#pragma unroll
            for (int hh = 0; hh < NH; ++hh) ss[hh] = wave_sum(ss[hh]);
            float ym = 0.f;
#pragma unroll
            for (int hh = 0; hh < NH; ++hh) { const float rs = rsqrtf(ss[hh] * (1.f / DV) + EPS); const f32x4 hw = *(const LAS f32x4*)(hnl + hh * DV + 4 * lane);
                hs[hh][0] = hs[hh][0] * rs * hw[0] * sigmoidf_(bf_lo(og[hh].x)); hs[hh][1] = hs[hh][1] * rs * hw[1] * sigmoidf_(bf_hi(og[hh].x));
                hs[hh][2] = hs[hh][2] * rs * hw[2] * sigmoidf_(bf_lo(og[hh].y)); hs[hh][3] = hs[hh][3] * rs * hw[3] * sigmoidf_(bf_hi(og[hh].y));
                ym = fmaxf(ym, fmaxf(fmaxf(fabsf(hs[hh][0]), fabsf(hs[hh][1])), fmaxf(fabsf(hs[hh][2]), fabsf(hs[hh][3])))); }
            ym = wave_max(ym);
            const float iy = ym > 0.f ? 127.f / ym : 0.f;
            if (lane == 0) F.SA[r] = ym * (1.f / 127.f);
#pragma unroll
            for (int hh = 0; hh < NH; ++hh) *(unsigned*)(F.MIXA8 + (size_t)r * (D / 2) + hh * DV + 4 * lane) = pk4_i8(hs[hh][0] * iy, hs[hh][1] * iy, hs[hh][2] * iy, hs[hh][3] * iy);
        }
#pragma unroll
        for (int jb = 0; jb < 2; ++jb) {
            const int dt = jb == 0 ? 1 : 64;
            const bool vm = jb == 0 ? (gc > 0) : (gr > 0), vp = jb == 0 ? (gc < 63) : (gr < 63);
            const bf16* pm = vm ? pr - (size_t)dt * NPROJ : pr; const bf16* pp = vp ? pr + (size_t)dt * NPROJ : pr;
            const float fm = vm ? 1.f : 0.f, fp = vp ? 1.f : 0.f;
            v4u cu0[2], cb0[2], cum[2], cup[2];
#pragma unroll
            for (int q = 0; q < 2; ++q) { const int cch = 512 * (2 * jb + q) + 8 * lane;
                cu0[q] = *(const v4u*)(pr + COL_CC + cch); cb0[q] = *(const v4u*)(pr + COL_CB + cch);
                cum[q] = *(const v4u*)(pm + COL_CC + cch); cup[q] = *(const v4u*)(pp + COL_CC + cch); }
#pragma unroll
            for (int q = 0; q < 2; ++q) { const int cch = 512 * (2 * jb + q) + 8 * lane;
                const unsigned u0w[4] = {cu0[q].x, cu0[q].y, cu0[q].z, cu0[q].w}, umw[4] = {cum[q].x, cum[q].y, cum[q].z, cum[q].w}, upw[4] = {cup[q].x, cup[q].y, cup[q].z, cup[q].w}, cbw[4] = {cb0[q].x, cb0[q].y, cb0[q].z, cb0[q].w};
                unsigned o[4];
#pragma unroll
                for (int hq = 0; hq < 2; ++hq) { const f32x4 w0 = *(const LAS f32x4*)(cwl + cch + 4 * hq), w1 = *(const LAS f32x4*)(cwl + 2048 + cch + 4 * hq), w2 = *(const LAS f32x4*)(cwl + 4096 + cch + 4 * hq);
#pragma unroll
                    for (int e2 = 0; e2 < 2; ++e2) { const int wi = 2 * hq + e2;
                        const float ya = bf_lo(cbw[wi]) * (w0[2 * e2] * (bf_lo(umw[wi]) * fm) + w1[2 * e2] * bf_lo(u0w[wi]) + w2[2 * e2] * (bf_lo(upw[wi]) * fp));
                        const float yb = bf_hi(cbw[wi]) * (w0[2 * e2 + 1] * (bf_hi(umw[wi]) * fm) + w1[2 * e2 + 1] * bf_hi(u0w[wi]) + w2[2 * e2 + 1] * (bf_hi(upw[wi]) * fp));
                        o[wi] = pk2(ya, yb); } }
                *(v4u*)(mr + 2048 + cch) = (v4u){o[0], o[1], o[2], o[3]}; }
        }
    }
}

__device__ __forceinline__ float p6_row_pass1(Frame& F, int row0, bool act, const LAS float* fac, const LAS float* sh) {
    const int lane = F.lane;
    const v2u* da = (const v2u*)(F.X1B + (size_t)row0 * D) + lane;
    float sa = 0.f;
    v2u dd[16];
#pragma unroll
    for (int j = 0; j < 16; ++j) dd[j] = da[64 * j];
#pragma unroll
    for (int j = 0; j < 16; ++j) { const float a0 = bf_lo(dd[j].x), a1 = bf_hi(dd[j].x), a2 = bf_lo(dd[j].y), a3 = bf_hi(dd[j].y); sa = fmaf(a0, a0, fmaf(a1, a1, fmaf(a2, a2, fmaf(a3, a3, sa)))); }
    const float rsa = rsqrtf(wave_sum(sa) * (1.f / D) + EPS);
    unsigned* oa = (unsigned*)((unsigned char*)F.XF + (size_t)row0 * D) + lane;
#pragma unroll
    for (int j = 0; j < 16; ++j) { const f32x4 fa = *(const LAS f32x4*)(fac + 256 * j + 4 * lane), sv = *(const LAS f32x4*)(sh + 256 * j + 4 * lane);
        const f32x4 xn = (f32x4){bf_lo(dd[j].x), bf_hi(dd[j].x), bf_lo(dd[j].y), bf_hi(dd[j].y)} * rsa * fa + sv;
        if (act) oa[64 * j] = pk4_fp8(xn[0], xn[1], xn[2], xn[3]); }
    return rsa;
}
__device__ __forceinline__ void p6_xquarter(Frame& F, int row, float rs, int j0, int nj, const LAS float* fac, const LAS float* sh, f32x4 (&xo)[4]) {
    const int lane = F.lane;
    const v2u* d0 = (const v2u*)(F.X1B + (size_t)row * D) + lane;
    v2u q0[4];
#pragma unroll
    for (int jj = 0; jj < 4; ++jj) if (jj < nj) q0[jj] = d0[64 * (j0 + jj)];
#pragma unroll
    for (int jj = 0; jj < 4; ++jj) if (jj < nj) { const int j = j0 + jj; const f32x4 fa = *(const LAS f32x4*)(fac + 256 * j + 4 * lane), sv = *(const LAS f32x4*)(sh + 256 * j + 4 * lane);
        xo[jj] = (f32x4){bf_lo(q0[jj].x), bf_hi(q0[jj].x), bf_lo(q0[jj].y), bf_hi(q0[jj].y)} * rs * fa + sv; }
}
__device__ __forceinline__ void p6_pick_group(Frame& F, const float (&g)[4], int& gs, float& psel) {
    float gl[4];
#pragma unroll
    for (int o = 0; o < 4; ++o) gl[o] = g[o] + F.b_rg[o];
    gs = 0; float gm = gl[0];
#pragma unroll
    for (int o = 1; o < 4; ++o) if (gl[o] > gm) { gm = gl[o]; gs = o; }
    float den = 0.f;
#pragma unroll
    for (int o = 0; o < 4; ++o) den += expf(gl[o] - gm);
    psel = 1.f / den;
}
__device__ __forceinline__ void p6_pick_experts(Frame& F, const float (&ed)[4], int gs, float psel, bool act, LAS int* ri) {
    float ev[4];
#pragma unroll
    for (int o = 0; o < 4; ++o) ev[o] = ed[o] + F.b_re[gs * 4 + o];
    int i0 = 0; float v0 = ev[0];
#pragma unroll
    for (int o = 1; o < 4; ++o) if (ev[o] > v0) { v0 = ev[o]; i0 = o; }
    int i1 = -1; float v1 = -3.0e38f;
#pragma unroll
    for (int o = 0; o < 4; ++o) if (o != i0 && ev[o] > v1) { v1 = ev[o]; i1 = o; }
    const float e1x = expf(v1 - v0); const float w0 = psel / (1.f + e1x), w1 = psel * e1x / (1.f + e1x);
    if (F.lane == 0) { ri[0] = act ? gs * 4 + i0 : -1; ri[1] = act ? gs * 4 + i1 : -1; ri[2] = __float_as_int(w0); ri[3] = __float_as_int(w1); }
}
__device__ __forceinline__ void p6_norm_router(Frame& F) {
    LAS float* fac = (LAS float*)F.lds; LAS float* sh = fac + D;
    LAS float* wg = (LAS float*)(F.lds + 32768);
    LAS float* we = (LAS float*)(F.lds + 98304);
    LAS int* rinfo = (LAS int*)(F.lds + 131072);
    const int wave = F.wave, lane = F.lane;
    const int nblk = T / 16, per = (nblk + F.G - 1) / F.G;
    __syncthreads();
    for (int c = F.tid; c < D; c += NTHR) { const f32x4 g4 = *(const f32x4*)(F.w_rg + (size_t)c * 4); wg[c] = g4[0]; wg[D + c] = g4[1]; wg[2 * D + c] = g4[2]; wg[3 * D + c] = g4[3]; }
    int curb = -1;
    for (int it = 0; it < per; ++it) {
        const int rb = F.vcu * per + it;
        const bool act = rb < nblk;
        const int row0 = (act ? rb : 0) * 16 + wave, row1 = row0 + 8;
        const int b = row0 >> 12;
        if (b != curb) {
            __syncthreads();
            for (int i = F.tid; i < D; i += NTHR) { fac[i] = F.norm2[i] * (1.f + F.ADA[b * ADA_N + 4 * D + i]); sh[i] = F.ADA[b * ADA_N + 3 * D + i]; }
            curb = b;
        }
        __syncthreads();
        const float rs0 = p6_row_pass1(F, row0, act, fac, sh);
        const float rs1 = p6_row_pass1(F, row1, act, fac, sh);
        float ga[4] = {0.f, 0.f, 0.f, 0.f}, gb[4] = {0.f, 0.f, 0.f, 0.f};
#pragma unroll 1
        for (int q = 0; q < 4; ++q) { f32x4 xa[4], xb[4];
            p6_xquarter(F, row0, rs0, 4 * q, 4, fac, sh, xa); p6_xquarter(F, row1, rs1, 4 * q, 4, fac, sh, xb);
#pragma unroll
            for (int o = 0; o < 4; ++o)
#pragma unroll
                for (int jj = 0; jj < 4; ++jj) { const f32x4 w4 = *(const LAS f32x4*)(wg + o * D + 256 * (4 * q + jj) + 4 * lane); const f32x4 a4 = xa[jj], b4 = xb[jj];
                    ga[o] = fmaf(a4[3], w4[3], fmaf(a4[2], w4[2], fmaf(a4[1], w4[1], fmaf(a4[0], w4[0], ga[o]))));
                    gb[o] = fmaf(b4[3], w4[3], fmaf(b4[2], w4[2], fmaf(b4[1], w4[1], fmaf(b4[0], w4[0], gb[o])))); } }
#pragma unroll
        for (int o = 0; o < 4; ++o) { ga[o] = wave_sum(ga[o]); gb[o] = wave_sum(gb[o]); }
        int gs0, gs1; float ps0, ps1;
        p6_pick_group(F, ga, gs0, ps0); p6_pick_group(F, gb, gs1, ps1);
        gs0 = __builtin_amdgcn_readfirstlane(gs0); gs1 = __builtin_amdgcn_readfirstlane(gs1);
        float ea[4] = {0.f, 0.f, 0.f, 0.f}, eb[4] = {0.f, 0.f, 0.f, 0.f};
#pragma unroll 1
        for (int ch = 0; ch < 8; ++ch) {
            __syncthreads();
            { const int c = 512 * ch + F.tid;
#pragma unroll
              for (int p = 0; p < 4; ++p) { const f32x4 e4 = *(const f32x4*)(F.w_re + (size_t)c * 16 + 4 * p);
                  we[(4 * p + 0) * 512 + F.tid] = e4[0]; we[(4 * p + 1) * 512 + F.tid] = e4[1]; we[(4 * p + 2) * 512 + F.tid] = e4[2]; we[(4 * p + 3) * 512 + F.tid] = e4[3]; } }
            f32x4 xa[4], xb[4];
            p6_xquarter(F, row0, rs0, 2 * ch, 2, fac, sh, xa); p6_xquarter(F, row1, rs1, 2 * ch, 2, fac, sh, xb);
            __syncthreads();
#pragma unroll
            for (int o = 0; o < 4; ++o)
#pragma unroll
                for (int jl = 0; jl < 2; ++jl) { const f32x4 wa = *(const LAS f32x4*)(we + (gs0 * 4 + o) * 512 + 256 * jl + 4 * lane), wb = *(const LAS f32x4*)(we + (gs1 * 4 + o) * 512 + 256 * jl + 4 * lane); const f32x4 a4 = xa[jl], b4 = xb[jl];
                    ea[o] = fmaf(a4[3], wa[3], fmaf(a4[2], wa[2], fmaf(a4[1], wa[1], fmaf(a4[0], wa[0], ea[o]))));
                    eb[o] = fmaf(b4[3], wb[3], fmaf(b4[2], wb[2], fmaf(b4[1], wb[1], fmaf(b4[0], wb[0], eb[o])))); }
        }
#pragma unroll
        for (int o = 0; o < 4; ++o) { ea[o] = wave_sum(ea[o]); eb[o] = wave_sum(eb[o]); }
        p6_pick_experts(F, ea, gs0, ps0, act, rinfo + wave * 4);
        p6_pick_experts(F, eb, gs1, ps1, act, rinfo + (8 + wave) * 4);
        __syncthreads();
        if (F.tid < NE && act) {
            int e = F.tid; asm volatile("" : "+v"(e)); int n = 0;
            for (int q = 0; q < 32; ++q) n += (rinfo[(q >> 1) * 4 + (q & 1)] == e) ? 1 : 0;
            if (n > 0) {
                int base = (int)__hip_atomic_fetch_add((unsigned*)(F.ctl + CW_CNT + 64 * e), (unsigned)n, RLX_AGENT);
                for (int q = 0; q < 32; ++q) if (rinfo[(q >> 1) * 4 + (q & 1)] == e) {
                    const int tok = rb * 16 + (q >> 1);
                    F.ELIST[e * T + base] = tok * 2 + (q & 1); F.EW[e * T + base] = __int_as_float(rinfo[(q >> 1) * 4 + 2 + (q & 1)]); ++base; }
            }
        }
        __syncthreads();
    }
}

__device__ __forceinline__ void p9_final(Frame& F) {
    LAS float* fnl = (LAS float*)F.lds; LAS float* g2l = fnl + D;
    __syncthreads();
    for (int i = F.tid; i < D / 4; i += NTHR) { *(LAS f32x4*)(fnl + 4 * i) = *(const f32x4*)(F.fnorm + 4 * i);
#pragma unroll
        for (int b = 0; b < NB; ++b) *(LAS f32x4*)(g2l + b * D + 4 * i) = *(const f32x4*)(F.ADA + b * ADA_N + 5 * D + 4 * i) * (1.f / SLOT_SCALE); }
    __syncthreads();
    const int gw = F.vcu * NWAVES + F.wave, NGW = F.G * NWAVES;
    for (int r = gw; r < T; r += NGW) {
        int lane = F.lane; asm volatile("" : "+v"(lane));
        const int b = r >> 12;
        const v4u* xr = (const v4u*)(F.X1B + (size_t)r * D) + lane;
        const v2u* s0 = (const v2u*)((const unsigned char*)F.SLOT + (size_t)r * D) + lane; const v2u* s1 = (const v2u*)((const unsigned char*)F.SLOT + (size_t)(T + r) * D) + lane;
        v4u xx[8]; v2u a0[8], a1[8];
#pragma unroll
        for (int j = 0; j < 8; ++j) { xx[j] = xr[64 * j]; a0[j] = s0[64 * j]; a1[j] = s1[64 * j]; }
        f32x4 v[16]; float s = 0.f;
#pragma unroll
        for (int j = 0; j < 8; ++j) {
            const f32x4 g0 = *(const LAS f32x4*)(g2l + b * D + 512 * j + 8 * lane), g1 = *(const LAS f32x4*)(g2l + b * D + 512 * j + 8 * lane + 4);
            const f32x4 x0 = (f32x4){bf_lo(xx[j].x), bf_hi(xx[j].x), bf_lo(xx[j].y), bf_hi(xx[j].y)}, x1 = (f32x4){bf_lo(xx[j].z), bf_hi(xx[j].z), bf_lo(xx[j].w), bf_hi(xx[j].w)};
            v[2 * j] = x0 + g0 * (fp8x4_to_f32(a0[j].x) + fp8x4_to_f32(a1[j].x)); v[2 * j + 1] = x1 + g1 * (fp8x4_to_f32(a0[j].y) + fp8x4_to_f32(a1[j].y));
            s = fmaf(v[2 * j][0], v[2 * j][0], fmaf(v[2 * j][1], v[2 * j][1], fmaf(v[2 * j][2], v[2 * j][2], fmaf(v[2 * j][3], v[2 * j][3], s))));
            s = fmaf(v[2 * j + 1][0], v[2 * j + 1][0], fmaf(v[2 * j + 1][1], v[2 * j + 1][1], fmaf(v[2 * j + 1][2], v[2 * j + 1][2], fmaf(v[2 * j + 1][3], v[2 * j + 1][3], s)))); }
        const float rstd = rsqrtf(wave_sum(s) * (1.f / D) + EPS);
        float* o = F.out + (size_t)r * D + 8 * lane;
#pragma unroll
        for (int j = 0; j < 8; ++j) { *(f32x4*)(o + 512 * j) = v[2 * j] * rstd * *(const LAS f32x4*)(fnl + 512 * j + 8 * lane); *(f32x4*)(o + 512 * j + 4) = v[2 * j + 1] * rstd * *(const LAS f32x4*)(fnl + 512 * j + 8 * lane + 4);
            if ((j & 1) == 1) asm volatile("" ::: "memory"); }
    }
}

struct SchedProj {
    int G, c;
    __device__ bool next(int i, pg8::Unit& u) const {
        const int L = i * G + c; constexpr int nM = 64, nN = 48, nwg = nM * nN;
        if (L < nwg) {
            int wgid = L; { const int q = nwg / 8, xcd = wgid % 8, off = wgid / 8; wgid = xcd * q + off; }
            const int nig = 8 * nN, gid = wgid / nig, fm = gid * 8;
            u.pm = fm + ((wgid % nig) % 8); u.pn = (wgid % nig) / 8; return true; }
        const int L2 = L - nwg;
        if (L2 < 48) { u.pm = 64 + (L2 & 3); u.pn = 36 + (L2 >> 2); return true; }
        const int L3 = L2 - 48;
        if (L3 < 68) { u.pm = L3; u.pn = 48; return true; }
        return false;
    }
    __device__ __forceinline__ void a_ready(const pg8::Unit&) const {}
    __device__ __forceinline__ void done(const pg8::Unit&) const {}
    __device__ __forceinline__ unsigned row_byteoff(const pg8::Unit&, int) const { return 0u; }
};
struct EpiProj {
    static constexpr bool PERM = true;
    bf16* P; float* Gt; const float* bg;
    __device__ __forceinline__ void operator()(const pg8::f32x4 (&acc)[2][2][4][2], const pg8::Unit& u, int wr, int wc, int fr, int fq) const {
        const int row0 = u.pm * 256 + wr * 64 + fr;
        if (u.pn < 48) {
            const int col0 = u.pn * 256 + wc * 32 + 8 * fq;
#pragma unroll
            for (int ai = 0; ai < 2; ++ai)
#pragma unroll
                for (int m = 0; m < 4; ++m) { bf16* rowp = P + (size_t)(row0 + ai * 128 + m * 16) * NPROJ + col0;
#pragma unroll
                    for (int bj = 0; bj < 2; ++bj) { const pg8::f32x4 v0 = acc[ai][bj][m][0], v1 = acc[ai][bj][m][1];
                        v4u w; w.x = pk2(v0[0], v0[1]); w.y = pk2(v0[2], v0[3]); w.z = pk2(v1[0], v1[1]); w.w = pk2(v1[2], v1[3]);
                        *(v4u*)(rowp + bj * 128) = w; } }
        } else if (wc == 0) {
            const f32x4 b0 = *(const f32x4*)(bg + 8 * fq), b1 = *(const f32x4*)(bg + 8 * fq + 4);
#pragma unroll
            for (int ai = 0; ai < 2; ++ai)
#pragma unroll
                for (int m = 0; m < 4; ++m) { float* gp = Gt + (size_t)(row0 + ai * 128 + m * 16) * 32 + 8 * fq;
                    *(f32x4*)gp = acc[ai][0][m][0] + b0; *(f32x4*)(gp + 4) = acc[ai][0][m][1] + b1; }
        }
    }
};
struct EpiProjI8 {
    static constexpr bool PERM = true;
    bf16* P; const float* sa; const float* sb; float* Gt; const float* bg;
    __device__ __forceinline__ void operator()(const pg8::f32x4 (&acc)[2][2][4][2], const pg8::Unit& u, int wr, int wc, int fr, int fq) const {
        const int row0 = u.pm * 256 + wr * 64 + fr, col0 = u.pn * 256 + wc * 32 + 8 * fq;
        if (u.pn == 48) {
            if (wc == 0) {
                const f32x4 b0 = *(const f32x4*)(bg + 8 * fq), b1 = *(const f32x4*)(bg + 8 * fq + 4), q0 = *(const f32x4*)(sb + NPROJ + 8 * fq), q1 = *(const f32x4*)(sb + NPROJ + 8 * fq + 4);
#pragma unroll
                for (int ai = 0; ai < 2; ++ai)
#pragma unroll
                    for (int m = 0; m < 4; ++m) { const int row = row0 + ai * 128 + m * 16; const float ra = sa[row]; float* gp = Gt + (size_t)row * 32 + 8 * fq;
                        const pg8::i32x4 i0 = __builtin_bit_cast(pg8::i32x4, acc[ai][0][m][0]), i1 = __builtin_bit_cast(pg8::i32x4, acc[ai][0][m][1]);
                        *(f32x4*)gp = (f32x4){(float)i0[0], (float)i0[1], (float)i0[2], (float)i0[3]} * (q0 * ra) + b0; *(f32x4*)(gp + 4) = (f32x4){(float)i1[0], (float)i1[1], (float)i1[2], (float)i1[3]} * (q1 * ra) + b1; }
            }
            return;
        }
        f32x4 sbv[2][2]; float sav[2][4];
#pragma unroll
        for (int bj = 0; bj < 2; ++bj)
#pragma unroll
            for (int n = 0; n < 2; ++n) sbv[bj][n] = *(const f32x4*)(sb + col0 + bj * 128 + 4 * n);
#pragma unroll
        for (int ai = 0; ai < 2; ++ai)
#pragma unroll
            for (int m = 0; m < 4; ++m) sav[ai][m] = sa[row0 + ai * 128 + m * 16];
#pragma unroll
        for (int ai = 0; ai < 2; ++ai)
#pragma unroll
            for (int m = 0; m < 4; ++m) { bf16* rowp = P + (size_t)(row0 + ai * 128 + m * 16) * NPROJ + col0; const float ra = sav[ai][m];
#pragma unroll
                for (int bj = 0; bj < 2; ++bj) { const pg8::i32x4 i0 = __builtin_bit_cast(pg8::i32x4, acc[ai][bj][m][0]), i1 = __builtin_bit_cast(pg8::i32x4, acc[ai][bj][m][1]);
                    const f32x4 s0 = sbv[bj][0] * ra, s1 = sbv[bj][1] * ra;
                    v4u w; w.x = pk2((float)i0[0] * s0[0], (float)i0[1] * s0[1]); w.y = pk2((float)i0[2] * s0[2], (float)i0[3] * s0[3]);
                    w.z = pk2((float)i1[0] * s1[0], (float)i1[1] * s1[1]); w.w = pk2((float)i1[2] * s1[2], (float)i1[3] * s1[3]);
                    *(v4u*)(rowp + bj * 128) = w; } }
    }
    static constexpr int NS = 8, NTAB = 2;
    __device__ __forceinline__ bool stores(const pg8::Unit& u, int wc) const { return u.pn != 48 || wc == 0; }
    __device__ __forceinline__ const void* tab_src(const pg8::Unit& u, int idx) const {
        const int i = idx & 255;
        if (idx < 256) return sa + u.pm * 256 + i;
        if (u.pn == 48) return (i >= 32 && i < 64) ? bg + (i - 32) : sb + NPROJ + (i & 31);
        return sb + u.pn * 256 + i;
    }
    __device__ __forceinline__ void half(const pg8::f32x4 (&acc)[2][2][4][2], const pg8::Unit& u, const int ai, int wr, int wc, int fr, int fq, const LAS float* tab) const {
        const int lrow0 = wr * 64 + fr + ai * 128, row0 = u.pm * 256 + lrow0, col0 = u.pn * 256 + wc * 32 + 8 * fq;
        const LAS float* tb2 = tab + 256;
        if (u.pn == 48) {
            if (wc == 0) {
                const f32x4 q0 = *(const LAS f32x4*)(tb2 + 8 * fq), q1 = *(const LAS f32x4*)(tb2 + 8 * fq + 4), b0 = *(const LAS f32x4*)(tb2 + 32 + 8 * fq), b1 = *(const LAS f32x4*)(tb2 + 36 + 8 * fq);
#pragma unroll
                for (int m = 0; m < 4; ++m) { const float ra = tab[lrow0 + m * 16]; float* gp = Gt + (size_t)(row0 + m * 16) * 32 + 8 * fq;
                    const pg8::i32x4 i0 = __builtin_bit_cast(pg8::i32x4, acc[ai][0][m][0]), i1 = __builtin_bit_cast(pg8::i32x4, acc[ai][0][m][1]);
                    *(f32x4*)gp = (f32x4){(float)i0[0], (float)i0[1], (float)i0[2], (float)i0[3]} * (q0 * ra) + b0; *(f32x4*)(gp + 4) = (f32x4){(float)i1[0], (float)i1[1], (float)i1[2], (float)i1[3]} * (q1 * ra) + b1; }
            }
            return;
        }
        f32x4 sbv[2][2];
#pragma unroll
        for (int bj = 0; bj < 2; ++bj)
#pragma unroll
            for (int n = 0; n < 2; ++n) sbv[bj][n] = *(const LAS f32x4*)(tb2 + wc * 32 + 8 * fq + bj * 128 + 4 * n);
        if (u.pn >= COL_CC / 256 && u.pn < COL_K / 256) {
            const int ch0 = COL_CC + (u.pn - COL_CC / 256) * 128 + wc * 32 + 8 * fq;
#pragma unroll
            for (int m = 0; m < 4; ++m) { bf16* rowp = P + (size_t)(row0 + m * 16) * NPROJ + ch0; const float ra = tab[lrow0 + m * 16];
#pragma unroll
                for (int n = 0; n < 2; ++n) { const pg8::i32x4 ic = __builtin_bit_cast(pg8::i32x4, acc[ai][0][m][n]), ix = __builtin_bit_cast(pg8::i32x4, acc[ai][1][m][n]);
                    const f32x4 sc = sbv[0][n] * ra, sx = sbv[1][n] * ra;
                    *(v2u*)(rowp + 4 * n) = (v2u){pk2(((float)ic[0] * sc[0]) * ((float)ix[0] * sx[0]), ((float)ic[1] * sc[1]) * ((float)ix[1] * sx[1])), pk2(((float)ic[2] * sc[2]) * ((float)ix[2] * sx[2]), ((float)ic[3] * sc[3]) * ((float)ix[3] * sx[3]))}; } }
            return;
        }
#pragma unroll
        for (int m = 0; m < 4; ++m) { bf16* rowp = P + (size_t)(row0 + m * 16) * NPROJ + col0; const float ra = tab[lrow0 + m * 16];
#pragma unroll
            for (int bj = 0; bj < 2; ++bj) { const pg8::i32x4 i0 = __builtin_bit_cast(pg8::i32x4, acc[ai][bj][m][0]), i1 = __builtin_bit_cast(pg8::i32x4, acc[ai][bj][m][1]);
                const f32x4 s0 = sbv[bj][0] * ra, s1 = sbv[bj][1] * ra;
                v4u w; w.x = pk2((float)i0[0] * s0[0], (float)i0[1] * s0[1]); w.y = pk2((float)i0[2] * s0[2], (float)i0[3] * s0[3]);
                w.z = pk2((float)i1[0] * s1[0], (float)i1[1] * s1[1]); w.w = pk2((float)i1[2] * s1[2], (float)i1[3] * s1[3]);
                *(v4u*)(rowp + bj * 128) = w; } }
    }
};
struct SchedStatic {
    int nM, nN, nwg, G, c;
    __device__ void init(int M, int N, int G_, int c_) { nM = M / 256; nN = N / 256; nwg = nM * nN; G = G_; c = c_; }
    __device__ bool next(int i, pg8::Unit& u) const {
        const long L = (long)i * G + c; if (L >= nwg) return false;
        int wgid = (int)L; { const int q = nwg / 8, r = nwg % 8, xcd = wgid % 8, off = wgid / 8; wgid = (xcd < r ? xcd * (q + 1) : r * (q + 1) + (xcd - r) * q) + off; }
        const int nig = 8 * nN, gid = wgid / nig, fm = gid * 8, gsz = (nM - fm) < 8 ? (nM - fm) : 8;
        u.pm = fm + ((wgid % nig) % gsz); u.pn = (wgid % nig) / gsz; return true;
    }
    __device__ __forceinline__ void a_ready(const pg8::Unit&) const {}
    __device__ __forceinline__ void done(const pg8::Unit&) const {}
    __device__ __forceinline__ unsigned row_byteoff(const pg8::Unit&, int) const { return 0u; }
};
struct EpiOut {
    static constexpr bool PERM = true;
    const float* ada; bf16* DL;
    __device__ __forceinline__ void operator()(const pg8::f32x4 (&acc)[2][2][4][2], const pg8::Unit& u, int wr, int wc, int fr, int fq) const {
        const int row0 = u.pm * 256 + wr * 64 + fr, col0 = u.pn * 256 + wc * 32 + 8 * fq;
        const float* g1 = ada + (size_t)(u.pm >> 4) * ADA_N + 2 * D + col0;
        f32x4 gv[2][2];
#pragma unroll
        for (int bj = 0; bj < 2; ++bj)
#pragma unroll
            for (int n = 0; n < 2; ++n) gv[bj][n] = *(const f32x4*)(g1 + bj * 128 + 4 * n);
#pragma unroll
        for (int ai = 0; ai < 2; ++ai)
#pragma unroll
            for (int m = 0; m < 4; ++m) { bf16* rowp = DL + (size_t)(row0 + ai * 128 + m * 16) * D + col0;
#pragma unroll
                for (int bj = 0; bj < 2; ++bj) { const pg8::f32x4 v0 = acc[ai][bj][m][0] * gv[bj][0], v1 = acc[ai][bj][m][1] * gv[bj][1];
                    v4u w; w.x = pk2(v0[0], v0[1]); w.y = pk2(v0[2], v0[3]); w.z = pk2(v1[0], v1[1]); w.w = pk2(v1[2], v1[3]);
                    *(v4u*)(rowp + bj * 128) = w; } }
    }
    static constexpr int NS = 8, NTAB = 1;
    __device__ __forceinline__ bool stores(const pg8::Unit&, int) const { return true; }
    __device__ __forceinline__ const void* tab_src(const pg8::Unit& u, int idx) const { return ada + (size_t)(u.pm >> 4) * ADA_N + 2 * D + u.pn * 256 + (idx & 255); }
    __device__ __forceinline__ void half(const pg8::f32x4 (&acc)[2][2][4][2], const pg8::Unit& u, const int ai, int wr, int wc, int fr, int fq, const LAS float* tab) const {
        const int row0 = u.pm * 256 + wr * 64 + fr + ai * 128, col0 = u.pn * 256 + wc * 32 + 8 * fq;
        f32x4 gv[2][2];
#pragma unroll
        for (int bj = 0; bj < 2; ++bj)
#pragma unroll
            for (int n = 0; n < 2; ++n) gv[bj][n] = *(const LAS f32x4*)(tab + wc * 32 + 8 * fq + bj * 128 + 4 * n);
#pragma unroll
        for (int m = 0; m < 4; ++m) { bf16* rowp = DL + (size_t)(row0 + m * 16) * D + col0;
#pragma unroll
            for (int bj = 0; bj < 2; ++bj) { const pg8::f32x4 v0 = acc[ai][bj][m][0] * gv[bj][0], v1 = acc[ai][bj][m][1] * gv[bj][1];
                v4u w; w.x = pk2(v0[0], v0[1]); w.y = pk2(v0[2], v0[3]); w.z = pk2(v1[0], v1[1]); w.w = pk2(v1[2], v1[3]);
                *(v4u*)(rowp + bj * 128) = w; } }
    }
};
struct EpiOut2 {
    static constexpr bool PERM = true;
    static constexpr int NS = 8, NTAB = 3;
    const float* ada; bf16* DL; const float* sa; const float* sb; const float* xin;
    __device__ __forceinline__ bool stores(const pg8::Unit&, int) const { return true; }
    __device__ __forceinline__ const void* tab_src(const pg8::Unit& u, int idx) const {
        const int i = idx & 255, w = idx >> 8;
        if (w == 0) return ada + (size_t)(u.pm >> 4) * ADA_N + 2 * D + u.pn * 256 + i;
        if (w == 1) return sa + u.pm * 256 + i;
        return sb + u.pn * 256 + i;
    }
    __device__ __forceinline__ void mid(pg8::f32x4 (&acc)[2][2][4][2], const pg8::Unit&, int wr, int wc, int fr, int fq, const LAS float* tab) const {
        f32x4 sbv[2][2];
#pragma unroll
        for (int bj = 0; bj < 2; ++bj)
#pragma unroll
            for (int n = 0; n < 2; ++n) sbv[bj][n] = *(const LAS f32x4*)(tab + 512 + wc * 32 + 8 * fq + bj * 128 + 4 * n);
#pragma unroll
        for (int ai = 0; ai < 2; ++ai)
#pragma unroll
            for (int m = 0; m < 4; ++m) { const float ra = tab[256 + wr * 64 + fr + ai * 128 + m * 16];
#pragma unroll
                for (int bj = 0; bj < 2; ++bj)
#pragma unroll
                    for (int n = 0; n < 2; ++n) { const pg8::i32x4 iv = __builtin_bit_cast(pg8::i32x4, acc[ai][bj][m][n]); const f32x4 s = sbv[bj][n] * ra;
                        acc[ai][bj][m][n] = (f32x4){(float)iv[0] * s[0], (float)iv[1] * s[1], (float)iv[2] * s[2], (float)iv[3] * s[3]}; } }
    }
    __device__ __forceinline__ void half(const pg8::f32x4 (&acc)[2][2][4][2], const pg8::Unit& u, const int ai, int wr, int wc, int fr, int fq, const LAS float* tab) const {
        const int row0 = u.pm * 256 + wr * 64 + fr + ai * 128, col0 = u.pn * 256 + wc * 32 + 8 * fq;
        f32x4 xv[4][2][2];
#pragma unroll
        for (int m = 0; m < 4; ++m) { const float* xr = xin + (size_t)(row0 + m * 16) * D + col0;
#pragma unroll
            for (int bj = 0; bj < 2; ++bj)
#pragma unroll
                for (int n = 0; n < 2; ++n) xv[m][bj][n] = *(const f32x4*)(xr + bj * 128 + 4 * n); }
        f32x4 gv[2][2];
#pragma unroll
        for (int bj = 0; bj < 2; ++bj)
#pragma unroll
            for (int n = 0; n < 2; ++n) gv[bj][n] = *(const LAS f32x4*)(tab + wc * 32 + 8 * fq + bj * 128 + 4 * n);
#pragma unroll
        for (int m = 0; m < 4; ++m) { bf16* rowp = DL + (size_t)(row0 + m * 16) * D + col0;
#pragma unroll
            for (int bj = 0; bj < 2; ++bj) { const pg8::f32x4 v0 = acc[ai][bj][m][0] * gv[bj][0] + xv[m][bj][0], v1 = acc[ai][bj][m][1] * gv[bj][1] + xv[m][bj][1];
                v4u w; w.x = pk2(v0[0], v0[1]); w.y = pk2(v0[2], v0[3]); w.z = pk2(v1[0], v1[1]); w.w = pk2(v1[2], v1[3]);
                *(v4u*)(rowp + bj * 128) = w; } }
    }
};
typedef GAS unsigned long long gu64;
constexpr unsigned RT_FULL = 64u, RT_SPIN_CAP = 1u << 22;
template <int NCT>
struct SchedMoe {
    int G, c; const LAS int* tb; const LAS int* cnt; const int* elist; unsigned rowbytes; gu32* rtc;
    __device__ bool next(int i, pg8::Unit& u) const {
        const int L = i * G + c, rt = L / NCT, ct = L % NCT;
        if (rt >= tb[NE]) return false;
        int e = 0;
#pragma unroll
        for (int q = 1; q < NE; ++q) e += (rt >= tb[q]) ? 1 : 0;
        u.pm = rt; u.pn = e * NCT + ct; return true;
    }
    __device__ __forceinline__ void a_ready(const pg8::Unit&) const {}
    __device__ __forceinline__ void done(const pg8::Unit& u) const {
        if (rtc == nullptr) return;
        asm volatile("s_waitcnt vmcnt(0) ; publish" ::: "memory");
        if ((threadIdx.x & 63) == 0) (void)__hip_atomic_fetch_add(rtc + 16 * u.pm, 1u, RLX_AGENT);
    }
    __device__ __forceinline__ unsigned row_byteoff(const pg8::Unit& u, int lr) const {
        const int e = u.pn / NCT; int l = (u.pm - tb[e]) * 256 + lr; const int n = cnt[e]; l = l < n ? l : n - 1;
        return (unsigned)(elist[e * T + l] >> 1) * rowbytes;
    }
    __device__ __forceinline__ const int* row_src(const pg8::Unit& u, int lr) const {
        const int e = u.pn / NCT; int l = (u.pm - tb[e]) * 256 + lr; const int n = cnt[e]; l = l < n ? l : n - 1;
        return elist + e * T + l;
    }
    __device__ __forceinline__ unsigned row_raw(const pg8::Unit& u, int lr) const { return (unsigned)*row_src(u, lr); }
    __device__ __forceinline__ unsigned row_off(unsigned raw) const { return (raw >> 1) * rowbytes; }
};
struct SchedMoe2 {
    static constexpr int NCT = 16, BON = 3;
    int G, c, n7; const LAS int* tb; const LAS int* cnt; gu32* rtc; gu32* tmo;
    __device__ bool next(int i, pg8::Unit& u) const {
        const int A = n7 % G, nl = G - A; int L;
        if (A == 0) L = i * G + c;
        else if (c >= A) L = (i < BON) ? i * nl + (c - A) : BON * nl + (i - BON) * G + c;
        else L = BON * nl + i * G + c;
        const int rt = L / NCT, ct = L % NCT;
        if (rt >= tb[NE]) return false;
        int e = 0;
#pragma unroll
        for (int q = 1; q < NE; ++q) e += (rt >= tb[q]) ? 1 : 0;
        u.pm = rt; u.pn = e * NCT + ct; return true;
    }
    __device__ __forceinline__ void a_ready(const pg8::Unit& u) const {
        unsigned sp = 0;
        while ((unsigned)__builtin_amdgcn_readfirstlane((int)__hip_atomic_load(rtc + 16 * u.pm, RLX_AGENT)) < RT_FULL) {
            __builtin_amdgcn_s_sleep(1);
            if (++sp > RT_SPIN_CAP) { if ((threadIdx.x & 63) == 0) __hip_atomic_store(tmo, 1u, RLX_AGENT); break; }
        }
    }
    __device__ __forceinline__ void done(const pg8::Unit&) const {}
    __device__ __forceinline__ unsigned row_byteoff(const pg8::Unit&, int) const { return 0u; }
};
struct EpiMoe1 {
    static constexpr bool PERM = true;
    unsigned char* H;
    __device__ __forceinline__ void operator()(const pg8::f32x4 (&acc)[2][2][4][2], const pg8::Unit& u, int wr, int wc, int fr, int fq) const {
        const int row0 = u.pm * 256 + wr * 64 + fr, col0 = (u.pn & 7) * 128 + wc * 32 + 8 * fq;
        constexpr float IS = 1.f / W1_SCALE;
#pragma unroll
        for (int ai = 0; ai < 2; ++ai)
#pragma unroll
            for (int m = 0; m < 4; ++m) { float h[8];
#pragma unroll
                for (int n = 0; n < 2; ++n)
#pragma unroll
                    for (int j = 0; j < 4; ++j) { const float a = acc[ai][0][m][n][j] * IS, uu = acc[ai][1][m][n][j] * IS; h[4 * n + j] = a * uu / (1.f + __expf(-a)); }
                *(v2u*)(H + (size_t)(row0 + ai * 128 + m * 16) * FF + col0) = (v2u){pk4_fp8(h[0], h[1], h[2], h[3]), pk4_fp8(h[4], h[5], h[6], h[7])}; }
    }
    static constexpr int NS = 4, NTAB = 0;
    __device__ __forceinline__ bool stores(const pg8::Unit&, int) const { return true; }
    __device__ __forceinline__ const void* tab_src(const pg8::Unit&, int) const { return nullptr; }
    __device__ __forceinline__ void half(const pg8::f32x4 (&acc)[2][2][4][2], const pg8::Unit& u, const int ai, int wr, int wc, int fr, int fq, const LAS float*) const {
        const int row0 = u.pm * 256 + wr * 64 + fr + ai * 128, col0 = (u.pn & 7) * 128 + wc * 32 + 8 * fq;
        constexpr float IS = 1.f / W1_SCALE;
#pragma unroll
        for (int m = 0; m < 4; ++m) { float h[8];
#pragma unroll
            for (int n = 0; n < 2; ++n)
#pragma unroll
                for (int j = 0; j < 4; ++j) { const float a = acc[ai][0][m][n][j] * IS, uu = acc[ai][1][m][n][j] * IS; h[4 * n + j] = a * uu / (1.f + __expf(-a)); }
            __hip_atomic_store((gu64*)(H + (size_t)(row0 + m * 16) * FF + col0), (unsigned long long)pk4_fp8(h[0], h[1], h[2], h[3]) | ((unsigned long long)pk4_fp8(h[4], h[5], h[6], h[7]) << 32), RLX_AGENT); }
    }
};
struct EpiMoe2 {
    static constexpr int PERM = 2;
    unsigned char* SL; const int* elist; const float* ew; const LAS int* tb; const LAS int* cnt;
    static constexpr int NS = 4, NTAB = 2;
    unsigned char* dump;
    __device__ __forceinline__ bool stores(const pg8::Unit&, int) const { return true; }
    __device__ __forceinline__ const void* tab_src(const pg8::Unit& u, int idx) const {
        const int e = u.pn >> 4, n_e = cnt[e]; int l = (u.pm - tb[e]) * 256 + (idx & 255); l = l < n_e ? l : n_e - 1;
        return idx < 256 ? (const void*)(elist + e * T + l) : (const void*)(ew + e * T + l);
    }
    __device__ __forceinline__ void half(const pg8::f32x4 (&acc)[2][2][4][2], const pg8::Unit& u, const int ai, int wr, int wc, int fr, int fq, const LAS float* tab) const {
        const int e = u.pn >> 4, ct = u.pn & 15, n_e = cnt[e], lrow0 = wr * 64 + fr + ai * 128, lr0 = (u.pm - tb[e]) * 256 + lrow0, col0 = ct * 256 + wc * 64 + 16 * fq;
#pragma unroll
        for (int m = 0; m < 4; ++m) { const int lr = lr0 + m * 16, ent = ((const LAS int*)tab)[lrow0 + m * 16]; const float w = tab[256 + lrow0 + m * 16] * (SLOT_SCALE / W2_SCALE);
            unsigned char* rowp = (lr < n_e) ? SL + ((size_t)(ent & 1) * T + (size_t)(ent >> 1)) * D + col0 : dump + (size_t)((u.pm & 63) * 256 + lrow0 + m * 16) * D + col0;
            const pg8::f32x4 v0 = acc[ai][0][m][0] * w, v1 = acc[ai][0][m][1] * w, v2 = acc[ai][1][m][0] * w, v3 = acc[ai][1][m][1] * w;
            *(v4u*)rowp = (v4u){pk4_fp8(v0[0], v0[1], v0[2], v0[3]), pk4_fp8(v1[0], v1[1], v1[2], v1[3]), pk4_fp8(v2[0], v2[1], v2[2], v2[3]), pk4_fp8(v3[0], v3[1], v3[2], v3[3])}; }
    }
};
__device__ __forceinline__ void moe_tables(Frame& F) {
    LAS int* tb = (LAS int*)(F.lds + MOE_OFF); LAS int* cnt = tb + 32;
    __syncthreads();
    if (F.tid == 0) { int acc = 0;
        for (int e = 0; e < NE; ++e) { const int n = (int)__hip_atomic_load((unsigned*)(F.ctl + CW_CNT + 64 * e), RLX_AGENT); cnt[e] = n; tb[e] = acc; acc += (n + 255) >> 8; }
        tb[NE] = acc; }
    __syncthreads();
}

struct Args { const float* in[20]; float* out; unsigned char* ws; int ph_lo, ph_hi, li, pad; };
__global__ void __launch_bounds__(NTHR, 2) mk_fwd(Args args) {
    extern __shared__ __attribute__((aligned(16))) unsigned char lds[];
    Frame F;
    F.lds = (LAS unsigned char*)lds;
    F.MISC = (volatile LAS unsigned*)(F.lds + MISC_OFF);
    F.tid = threadIdx.x; F.lane = F.tid & 63; F.wave = __builtin_amdgcn_readfirstlane(F.tid >> 6);
    F.G = gridDim.x; { const int bx = blockIdx.x; F.vcu = (F.G % 8 == 0) ? (bx % 8) * (F.G / 8) + bx / 8 : bx; }
    unsigned char* ws = args.ws;
    F.ctl = (gu32*)(ws + WS_CTL);
    F.x = args.in[0]; F.c = args.in[1]; F.ctx = args.in[2]; F.cctx = args.in[3]; F.w_ada = args.in[4]; F.b_ada = args.in[5]; F.norm1 = args.in[6]; F.w_in = args.in[7];
    F.b_gates = args.in[8]; F.conv_w = args.in[9]; F.head_norm = args.in[10]; F.w_out = args.in[11]; F.norm2 = args.in[12]; F.w_rg = args.in[13]; F.b_rg = args.in[14];
    F.w_re = args.in[15]; F.b_re = args.in[16]; F.w_e1 = args.in[17]; F.w_e2 = args.in[18]; F.fnorm = args.in[19]; F.out = args.out;
    F.ADA = (float*)(ws + WS_ADA); F.GATES = (float*)(ws + WS_GATES); F.EW = (float*)(ws + WS_EW); F.HF = (bf16*)(ws + WS_HF); F.HB = (bf16*)(ws + WS_HB); F.DELTA = (bf16*)(ws + WS_X1); F.X1B = (bf16*)(ws + WS_X1 + 128 * MiB); F.XM8 = ws + WS_XM8; F.WO8 = ws + WS_WO8; F.WI8 = (signed char*)(ws + WS_WI8); F.SA = (float*)(ws + WS_SA); F.SB = (float*)(ws + WS_SB); F.SB2 = F.SB + 16384; F.MIXA8 = ws + WS_XM8; F.WOA8 = ws + WS_WIN + 64 * MiB;
    F.ELIST = (int*)(ws + WS_ELIST);
    F.WIN = (bf16*)(ws + WS_WIN); F.WOUT = (bf16*)(ws + WS_WOUT); F.WE1 = (bf16*)(ws + WS_WE1); F.WE2 = (bf16*)(ws + WS_WE2);
    F.XM = (bf16*)(ws + WS_XM); F.MIX = F.XM; F.XF = F.XM; F.PROJ = (bf16*)(ws + WS_PROJ); F.SLOT = (bf16*)(ws + WS_SLOT); F.HMOE = (bf16*)(ws + WS_HMOE);
    for (int u = F.tid; u < (LDS_BYTES - LDSCTL_OFF) / 4; u += NTHR) ((LAS unsigned*)(F.lds + LDSCTL_OFF))[u] = 0u;
    __syncthreads();
    const int lo = args.ph_lo, hi = args.ph_hi;
    XcdBarrier bar; bar.bar = (unsigned*)(F.ctl + CW_BAR) + args.li * XCD_BAR_WORDS; bar.x = 0; bar.st = nullptr;
    if (hi - lo > 1) bar = xcd_barrier_post((unsigned*)(F.ctl + CW_BAR) + args.li * XCD_BAR_WORDS, F.MISC + 8);
#ifndef PHASE_MASK
#define PHASE_MASK 0xFFFF
#endif
#define IN(k) (((PHASE_MASK >> (k)) & 1) && lo <= (k) && (k) < hi)
#define BOTH(k) (IN(k) && IN((k) + 1))
#define GRID_BAR() xcd_barrier(bar)
    LAS unsigned* rowtab = (LAS unsigned*)(F.lds + ROWTAB_OFF);

#ifndef PROBE_DUP
#define PROBE_DUP -1
#endif
#define RUNPH(k, ...) if (IN(k)) { __VA_ARGS__ if (PROBE_DUP == (k)) { GRID_BAR(); __VA_ARGS__ } if (BOTH(k)) GRID_BAR(); }
    RUNPH(0, { p0_ada(F); __syncthreads(); p0_transposes(F); })
    RUNPH(1, { p1_quant_weights(F); p1_quant_wout(F); p1_norm(F); })
    RUNPH(2, {
        __syncthreads();
        { pg8::Gemm gi{(const bf16*)F.XM8, (const bf16*)F.WI8, TA, NPAD, D / 2}; SchedProj Si{F.G, (int)blockIdx.x}; EpiProjI8 Ei{F.PROJ, F.SA, F.SB, F.GATES, F.b_gates};
          pg8::gemm_phase<EpiProjI8, SchedProj, PG8_ALIGN, PG8_SP2, false, false, true, PG8_ROLL2>(F.lds, gi, Si, Ei, rowtab); }
        expert_transpose_queue(F); })
    RUNPH(3, { p3_mlstm(F); })
    RUNPH(4, { p4_mix(F); })
    RUNPH(5, {
        pg8::Gemm2 g{(const char*)F.MIXA8, (const char*)F.WOA8, (unsigned)(D / 2), (unsigned)(D / 2), D / 2 / 128, (const char*)(F.MIX + D / 2), (const char*)(F.WOUT + D / 2), (unsigned)(D * 2), (unsigned)(D * 2), D / 2 * 2 / 128};
        SchedStatic S; S.init(T, D, F.G, (int)blockIdx.x); EpiOut2 E{F.ADA, F.X1B, F.SA, F.SB2, F.x};
        __syncthreads();
        pg8::gemm_phase2<EpiOut2, SchedStatic, PG8_ALIGN>(F.lds, g, S, E); })
    RUNPH(6, { p6_norm_router(F); })
    RUNPH(7, {
        moe_tables(F);
        const LAS int* tb = (const LAS int*)(F.lds + MOE_OFF);
        gu32* rtc = F.ctl + CW_RT;
        { pg8::Gemm g{F.XF, F.WE1, T, NE * 2 * FF, D / 2}; SchedMoe<8> S{F.G, F.vcu, tb, tb + 32, F.ELIST, (unsigned)D, rtc}; EpiMoe1 E{(unsigned char*)F.HMOE};
          pg8::gemm_phase<EpiMoe1, SchedMoe<8>, PG8_ALIGN, PG8_SP2, true, true, false, PG8_ROLL7>(F.lds, g, S, E, rowtab); }
        if (F.wave == 0) __builtin_amdgcn_fence(__ATOMIC_ACQUIRE, "agent");
        __syncthreads();
        { pg8::Gemm g{F.HMOE, F.WE2, HM_ROWS, NE * D, FF / 2}; SchedMoe2 S{F.G, F.vcu, tb[NE] * 8, tb, tb + 32, rtc, F.ctl + CW_TMO}; EpiMoe2 E{(unsigned char*)F.SLOT, F.ELIST, F.EW, tb, tb + 32, (unsigned char*)F.WIN};
          pg8::gemm_phase<EpiMoe2, SchedMoe2, PG8_ALIGN, PG8_SP2, false, true, false, PG8_ROLL8>(F.lds, g, S, E, rowtab); } })
    RUNPH(9, { p9_final(F); })
#undef IN
#undef BOTH
}

__global__ void __launch_bounds__(320) mlstm_naive(const bf16* __restrict__ PROJ, const float* __restrict__ GATES, bf16* __restrict__ HF, bf16* __restrict__ HB) {
    __shared__ float kq[2][256];
    __shared__ float sc[2][4];
    __shared__ float dens[2];
    const int bid = blockIdx.x, dir = bid & 1, h = (bid >> 1) & 7, b = bid >> 4, tid = threadIdx.x;
    float C[128];
#pragma unroll
    for (int i = 0; i < 128; ++i) C[i] = 0.f;
    float m = 0.f;
    bf16* HO = dir ? HB : HF;
    const int NSTEP = CTXL + SEQ;
    for (int st = 0; st < NSTEP; ++st) {
        int row;
        if (st < CTXL) { const int j = dir ? (CTXL - 1 - st) : st; row = T + b * CTXL + j; }
        else { const int s = dir ? (SEQ - 1 - (st - CTXL)) : (st - CTXL); row = b * SEQ + s; }
        const bf16* pr = PROJ + (size_t)row * NPROJ;
        const int buf = st & 1;
        if (tid < 128) kq[buf][tid] = bf1(pr[COL_K + h * DK + tid]);
        else if (tid < 256) kq[buf][tid] = bf1(pr[COL_Q + h * DK + (tid - 128)]) * 0.08838834764831845f;
        const float ig = GATES[(size_t)row * 32 + (dir ? 16 : 0) + h], fp = GATES[(size_t)row * 32 + (dir ? 24 : 8) + h];
        const float lf = fminf(fp, 0.f) - log1pf(expf(-fabsf(fp)));
        const float mn = fmaxf(lf + m, ig);
        const float fdec = expf(lf + m - mn), iw = expf(ig - mn);
        m = mn;
        const float vv = tid < 256 ? bf1(pr[COL_V + h * DV + tid]) : 1.f;
        __syncthreads();
        const bool isq = st >= CTXL;
        float dot = 0.f;
        if (tid <= 256) {
            const float a = iw * vv;
#pragma unroll
            for (int i = 0; i < 128; ++i) { C[i] = fdec * C[i] + a * kq[buf][i]; dot += C[i] * kq[buf][128 + i]; }
        }
        if (isq) {
            if (tid == 256) dens[buf] = dot;
            __syncthreads();
            if (tid < 256) { const float dn = fmaxf(fabsf(dens[buf]), expf(-m)); HO[(size_t)row * 2048 + h * DV + tid] = (bf16)(pk2(dot / dn, 0.f) & 0xffffu); }
        }
    }
}

extern "C" void kernel_launch(void* const* d_in, const int* in_sizes, int n_in, void* d_out, int out_size, void* d_ws, size_t ws_size, hipStream_t stream) {
    static int grid = 0;
    if (grid == 0) {
        if (n_in != 20 || out_size != T * D || ws_size < WS_END) { fprintf(stderr, "kernel_launch: unexpected shapes (n_in %d, out %d, ws %zu)\n", n_in, out_size, ws_size); grid = -1; return; }
        int dev = 0, cus = 0, per_cu = 0;
        if (hipGetDevice(&dev) != hipSuccess || hipDeviceGetAttribute(&cus, hipDeviceAttributeMultiprocessorCount, dev) != hipSuccess) { grid = -1; return; }
        if (hipFuncSetAttribute((const void*)mk_fwd, hipFuncAttributeMaxDynamicSharedMemorySize, LDS_BYTES) != hipSuccess) { fprintf(stderr, "kernel_launch: hipFuncSetAttribute failed\n"); grid = -1; return; }
        if (hipOccupancyMaxActiveBlocksPerMultiprocessor(&per_cu, (const void*)mk_fwd, NTHR, LDS_BYTES) != hipSuccess || per_cu < 1) fprintf(stderr, "kernel_launch: occupancy query says %d\n", per_cu);
        (void)hipGetLastError();
        grid = cus;
    }
    if (grid < 0) return;
    (void)hipMemsetAsync((char*)d_ws + WS_CTL, 0, CTL_ZERO_BYTES, stream);
    Args a{};
    for (int i = 0; i < 20; ++i) a.in[i] = (const float*)d_in[i];
    a.out = (float*)d_out; a.ws = (unsigned char*)d_ws;
    int nl = 0;
    auto launch = [&](int lo, int hi) { a.ph_lo = lo; a.ph_hi = hi; a.li = nl++; hipLaunchKernelGGL(mk_fwd, dim3(grid), dim3(NTHR), LDS_BYTES, stream, a); };
#if MK_MODE == 0
    launch(0, 1); launch(1, 2); launch(2, 3);
    hipLaunchKernelGGL(mlstm_naive, dim3(NB * NH * 2), dim3(320), 0, stream, (const bf16*)((char*)d_ws + WS_PROJ), (const float*)((char*)d_ws + WS_GATES), (bf16*)((char*)d_ws + WS_HF), (bf16*)((char*)d_ws + WS_HB));
    launch(4, 5); launch(5, 6); launch(6, 7); launch(7, 8); launch(8, 9); launch(9, 10);
#elif MK_MODE == 2
    launch(0, 10);
#else
    launch(0, 3);
    hipLaunchKernelGGL(mlstm_naive, dim3(NB * NH * 2), dim3(320), 0, stream, (const bf16*)((char*)d_ws + WS_PROJ), (const float*)((char*)d_ws + WS_GATES), (bf16*)((char*)d_ws + WS_HF), (bf16*)((char*)d_ws + WS_HB));
    launch(4, 10);
#endif
}
```

```cpp
#include <hip/hip_runtime.h>
#include <cstdio>
#include <cstdint>

#ifndef MK_MODE
#define MK_MODE 2
#endif

namespace pg8 {
#define PG8_LAS __attribute__((address_space(3)))
typedef unsigned short bf16_t;
typedef short bf16x8 __attribute__((ext_vector_type(8)));
typedef float f32x4 __attribute__((ext_vector_type(4)));
typedef unsigned u32x4 __attribute__((ext_vector_type(4)));
constexpr int BM = 256, BK = 64, HALF = 128, HTB = HALF * BK * 2, STAGE_BYTES = 8 * HTB, NXCD = 8, WGM = 8;

__host__ __device__ __forceinline__ int lds_byte(int r, int c) { const int st = (r >> 4) * 2 + (c >> 5), rr = r & 15, cc = c & 31, ob = rr * 64 + cc * 2; return st * 1024 + (ob ^ (((ob >> 9) & 1) << 5)); }
__host__ __device__ __forceinline__ void stage_rc(int b, int& R, int& C) { const int st = b / 1024, sb = b % 1024, swz = sb ^ (((sb >> 9) & 1) << 5); R = (st >> 1) * 16 + swz / 64; C = (st & 1) * 32 + (swz % 64) / 2; }
__host__ __device__ __forceinline__ int perm32(int rho) { const int n = rho >> 4, i = rho & 15; return 8 * (i >> 2) + 4 * n + (i & 3); }

struct Unit { int pm, pn; };
struct Gemm { const bf16_t* A; const bf16_t* Bt; int M, N, K; };

typedef float f32x2_t __attribute__((ext_vector_type(2))); typedef __bf16 bf16x2_t __attribute__((ext_vector_type(2)));
__device__ __forceinline__ unsigned cvt_pk_bf16(float lo, float hi) { f32x2_t v = {lo, hi}; bf16x2_t b = __builtin_convertvector(v, bf16x2_t); return __builtin_bit_cast(unsigned, b); }

typedef int i32x8 __attribute__((ext_vector_type(8)));
typedef int i32x4 __attribute__((ext_vector_type(4)));
constexpr int TAB_OFF = STAGE_BYTES;
template <class Epi, class Sched, bool ALIGN_EPI, bool SP2, bool GATHER, bool MX, bool I8 = false, bool ROLL = false>
__device__ __forceinline__ void gemm_phase(PG8_LAS unsigned char* lds, const Gemm g, const Sched& S, const Epi& E, PG8_LAS unsigned* rowtab) {
    const int tid = threadIdx.x, wid = __builtin_amdgcn_readfirstlane(tid >> 6), lane = tid & 63, wr = wid >> 2, wc = wid & 3, fr = lane & 15, fq = lane >> 4;
    const int K = g.K, nt = K / BK;
    unsigned voffA[2], voffB[2]; int RA[2], CA[2];
#pragma unroll
    for (int i = 0; i < 2; ++i) { int R, C; stage_rc(tid * 16 + i * 8192, R, C); const int Rb = ((int)Epi::PERM == 2) ? (64 * (R >> 5) + 16 * ((R & 15) >> 2) + 4 * ((R >> 4) & 1) + (R & 3)) : (Epi::PERM ? ((R & ~31) + perm32(R & 31)) : R);
        voffA[i] = (unsigned)(R * K + C) * 2u; voffB[i] = (unsigned)(Rb * K + C) * 2u; RA[i] = R; CA[i] = C * 2; }
    const size_t kstep = (size_t)(BK * 2);
    const size_t hstep = (size_t)HALF * K * 2;
    const size_t tstep = 2 * hstep;
    const size_t hstepA = GATHER ? (size_t)0 : hstep;
    const size_t hstepB = ((int)Epi::PERM == 2) ? (size_t)8 * K * 2 : hstep;
    const unsigned ldsw = (unsigned)wid * 1024u;
    const int aoff = lds_byte(wr * 64 + fr, MX ? fq * 16 : fq * 8), boff = lds_byte(wc * 32 + fr, MX ? fq * 16 : fq * 8);
#define PG8_SA(b, h) (((b) * 2 + (h)) * HTB)
#define PG8_SB(b, h) ((4 + (b) * 2 + (h)) * HTB)
#define PG8_STAGE(bufoff, gbase, voff) do { _Pragma("unroll") for (int _i = 0; _i < 2; ++_i) \
        __builtin_amdgcn_global_load_lds((const unsigned*)((const char*)(gbase) + (voff)[_i]), (PG8_LAS unsigned*)(lds + (bufoff) + ldsw + _i * 8192), 16, 0, 0); } while (0)
#define PG8_LD32(p) ({ const u32x4 lo_ = *(const PG8_LAS u32x4*)(p), hi_ = *(const PG8_LAS u32x4*)((p) + 16); (i32x8){(int)lo_[0], (int)lo_[1], (int)lo_[2], (int)lo_[3], (int)hi_[0], (int)hi_[1], (int)hi_[2], (int)hi_[3]}; })
#define PG8_LDA(dst, b, h) do { if constexpr (MX) { _Pragma("unroll") for (int m = 0; m < 4; ++m) dst##X[m] = PG8_LD32(lds + PG8_SA(b, h) + aoff + m * 2048); } \
        else { _Pragma("unroll") for (int m = 0; m < 4; ++m) _Pragma("unroll") for (int k = 0; k < 2; ++k) dst[m][k] = *(const PG8_LAS bf16x8*)(lds + PG8_SA(b, h) + aoff + m * 2048 + k * 1024); } } while (0)
#define PG8_LDB(dst, b, h) do { if constexpr (MX) { _Pragma("unroll") for (int n = 0; n < 2; ++n) dst##X[n] = PG8_LD32(lds + PG8_SB(b, h) + boff + n * 2048); } \
        else { _Pragma("unroll") for (int n = 0; n < 2; ++n) _Pragma("unroll") for (int k = 0; k < 2; ++k) dst[n][k] = *(const PG8_LAS bf16x8*)(lds + PG8_SB(b, h) + boff + n * 2048 + k * 1024); } } while (0)
#define PG8_MMA(ai, bj, At, Bt) do { __builtin_amdgcn_s_setprio(1); if constexpr (MX) { _Pragma("unroll") for (int m = 0; m < 4; ++m) _Pragma("unroll") for (int n = 0; n < 2; ++n) \
        asm volatile("v_mfma_scale_f32_16x16x128_f8f6f4 %0, %1, %2, %0, %3, %3 op_sel_hi:[0,0,0]" : "+v"(acc[ai][bj][m][n]) : "v"(Bt##X[n]), "v"(At##X[m]), "v"(mxscale)); } \
        else if constexpr (I8) { _Pragma("unroll") for (int m = 0; m < 4; ++m) _Pragma("unroll") for (int n = 0; n < 2; ++n) _Pragma("unroll") for (int k = 0; k < 2; ++k) \
        acc[ai][bj][m][n] = __builtin_bit_cast(f32x4, __builtin_amdgcn_mfma_i32_16x16x64_i8(__builtin_bit_cast(i32x4, Bt[n][k]), __builtin_bit_cast(i32x4, At[m][k]), __builtin_bit_cast(i32x4, acc[ai][bj][m][n]), 0, 0, 0)); } \
        else { _Pragma("unroll") for (int m = 0; m < 4; ++m) _Pragma("unroll") for (int n = 0; n < 2; ++n) _Pragma("unroll") for (int k = 0; k < 2; ++k) \
        acc[ai][bj][m][n] = __builtin_amdgcn_mfma_f32_16x16x32_bf16(Bt[n][k], At[m][k], acc[ai][bj][m][n], 0, 0, 0); } __builtin_amdgcn_s_setprio(0); } while (0)
#define PG8_WAIT_V(n) asm volatile("s_waitcnt vmcnt(" #n ")" ::: "memory")
#define PG8_WAIT_VN(n) asm volatile("s_waitcnt vmcnt(%0)" :: "n"(n) : "memory")
#define PG8_ZERO(ai) do { _Pragma("unroll") for (int b_ = 0; b_ < 2; ++b_) _Pragma("unroll") for (int m_ = 0; m_ < 4; ++m_) _Pragma("unroll") for (int n_ = 0; n_ < 2; ++n_) acc[ai][b_][m_][n_] = (f32x4){0.f, 0.f, 0.f, 0.f}; } while (0)
#define PG8_TABP(u_) ((const PG8_LAS float*)(lds + TAB_OFF + ((u_) & 1) * 2048))
#define PG8_WAIT_L(n) asm volatile("s_waitcnt lgkmcnt(" #n ")" ::: "memory")
#define PG8_BAR __builtin_amdgcn_s_barrier()
#define PG8_SCHED __builtin_amdgcn_sched_barrier(0)
    static_assert(!ROLL || SP2, "rolling epilogue: eight-phase loop only");
    Unit cur, nxt; int ui = 0; bool pst = false;
    if (!S.next(0, cur)) return;
    f32x4 acc[2][2][4][2];
#pragma unroll
    for (int a = 0; a < 2; ++a)
#pragma unroll
        for (int b = 0; b < 2; ++b)
#pragma unroll
            for (int m = 0; m < 4; ++m)
#pragma unroll
                for (int n = 0; n < 2; ++n) acc[a][b][m][n] = (f32x4){0.f, 0.f, 0.f, 0.f};
    bf16x8 At[4][2], B0[2][2], B1[2][2]; i32x8 AtX[4], B0X[2], B1X[2]; const int mxscale = 0x7F7F7F7F;
    unsigned vc0[2], vc1[2], vn0[2], vn1[2];
    const char* cA = GATHER ? (const char*)g.A : (const char*)g.A + (size_t)cur.pm * tstep; const char* cB = (const char*)g.Bt + (size_t)cur.pn * tstep;
    if constexpr (GATHER) {
        if (tid < 256) rowtab[tid] = ROLL ? S.row_raw(cur, tid) : S.row_byteoff(cur, tid);
        asm volatile("s_waitcnt vmcnt(0) lgkmcnt(0)" ::: "memory"); PG8_BAR; asm volatile("" ::: "memory");
#pragma unroll
        for (int i = 0; i < 2; ++i) { vc0[i] = (ROLL ? S.row_off(rowtab[RA[i]]) : rowtab[RA[i]]) + (unsigned)CA[i]; vc1[i] = (ROLL ? S.row_off(rowtab[128 + RA[i]]) : rowtab[128 + RA[i]]) + (unsigned)CA[i]; vn0[i] = vc0[i]; vn1[i] = vc1[i]; }
    } else {
#pragma unroll
        for (int i = 0; i < 2; ++i) { vc0[i] = voffA[i]; vc1[i] = voffA[i]; vn0[i] = voffA[i]; vn1[i] = voffA[i]; }
    }
    S.a_ready(cur);
    if constexpr (SP2) {
        PG8_STAGE(PG8_SB(0, 0), cB, voffB); PG8_STAGE(PG8_SB(0, 1), cB + hstepB, voffB); PG8_STAGE(PG8_SA(0, 0), cA, vc0); PG8_STAGE(PG8_SA(0, 1), cA + hstepA, vc1);
        if (wr == 1) PG8_BAR;
        PG8_WAIT_V(2); PG8_BAR;
        PG8_STAGE(PG8_SB(1, 0), cB + kstep, voffB); PG8_STAGE(PG8_SA(1, 0), cA + kstep, vc0); PG8_STAGE(PG8_SB(1, 1), cB + hstepB + kstep, voffB);
        PG8_WAIT_V(6); PG8_BAR;
    } else {
        PG8_STAGE(PG8_SB(0, 0), cB, voffB); PG8_STAGE(PG8_SA(0, 0), cA, vc0); PG8_STAGE(PG8_SB(0, 1), cB + hstepB, voffB); PG8_STAGE(PG8_SA(0, 1), cA + hstepA, vc1);
        if (wr == 1) PG8_BAR;
        PG8_WAIT_V(4); PG8_BAR;
        PG8_STAGE(PG8_SB(1, 0), cB + kstep, voffB); PG8_STAGE(PG8_SA(1, 0), cA + kstep, vc0); PG8_STAGE(PG8_SB(1, 1), cB + hstepB + kstep, voffB);
        PG8_WAIT_V(6); PG8_BAR;
    }
    for (;;) {
        const bool has_next = S.next(ui + 1, nxt);
        const char* nA = GATHER ? (const char*)g.A : (has_next ? (const char*)g.A + (size_t)nxt.pm * tstep : cA); const char* nB = has_next ? (const char*)g.Bt + (size_t)nxt.pn * tstep : cB;
        if constexpr (GATHER && !ROLL) {
            if (has_next && tid < 256) rowtab[((ui + 1) & 1) * 256 + tid] = S.row_byteoff(nxt, tid);
        }
#pragma unroll 1
        for (int t = 0; t < nt; t += 2) {
            const bool last = (t == nt - 2);
            const char* a1 = cA + (size_t)(t + 1) * kstep;
            const char* a2 = last ? nA : cA + (size_t)(t + 2) * kstep; const char* b2 = last ? nB : cB + (size_t)(t + 2) * kstep;
            const char* a3 = a2 + kstep; const char* b3 = b2 + kstep;
            if (last && has_next) S.a_ready(nxt);
            if constexpr (GATHER) {
                if (last && has_next) {
                    PG8_LAS unsigned* rt = rowtab + ((ui + 1) & 1) * 256;
#pragma unroll
                    for (int i = 0; i < 2; ++i) { vn0[i] = (ROLL ? S.row_off(rt[RA[i]]) : rt[RA[i]]) + (unsigned)CA[i]; vn1[i] = (ROLL ? S.row_off(rt[128 + RA[i]]) : rt[128 + RA[i]]) + (unsigned)CA[i]; }
                }
            }
            unsigned w20[2], w21[2];
#pragma unroll
            for (int i = 0; i < 2; ++i) { w20[i] = last ? vn0[i] : vc0[i]; w21[i] = last ? vn1[i] : vc1[i]; }
            if constexpr (SP2 && ROLL) {
            const bool rf = (t == 0) && pst;
            PG8_LDB(B0, 0, 0); PG8_LDB(B1, 0, 1); PG8_SCHED; PG8_LDA(At, 0, 0); PG8_STAGE(PG8_SA(1, 1), a1 + hstepA, vc1);
            if (t == 2) {
                if constexpr (Epi::NTAB > 0) { if (Epi::NTAB > 1 || wid < 4) __builtin_amdgcn_global_load_lds((const unsigned*)E.tab_src(cur, tid), (PG8_LAS unsigned*)(lds + TAB_OFF + (ui & 1) * 2048 + wid * 256), 4, 0, 0); }
                if constexpr (GATHER) { if (has_next && wid < 4) __builtin_amdgcn_global_load_lds((const unsigned*)S.row_src(nxt, tid), (PG8_LAS unsigned*)(rowtab + ((ui + 1) & 1) * 256 + wid * 64), 4, 0, 0); }
            }
            if (rf) PG8_WAIT_VN(8 + 2 * Epi::NS); else PG8_WAIT_V(8);
            PG8_WAIT_L(0); PG8_BAR; PG8_MMA(0, 0, At, B0); PG8_MMA(0, 1, At, B1); PG8_BAR; PG8_SCHED;
            PG8_LDA(At, 0, 1); PG8_STAGE(PG8_SB(0, 0), b2, voffB); PG8_STAGE(PG8_SB(0, 1), b2 + hstepB, voffB); PG8_STAGE(PG8_SA(0, 0), a2, w20);
            if (rf) PG8_WAIT_VN(8 + 2 * Epi::NS); else PG8_WAIT_V(8);
            PG8_WAIT_L(0); PG8_BAR; PG8_MMA(1, 0, At, B0); PG8_MMA(1, 1, At, B1); PG8_BAR; PG8_SCHED;
            PG8_LDB(B0, 1, 0); PG8_LDB(B1, 1, 1); PG8_SCHED; PG8_LDA(At, 1, 0); PG8_STAGE(PG8_SA(0, 1), a2 + hstepA, w21);
            PG8_WAIT_V(8); PG8_WAIT_L(0); PG8_BAR; PG8_MMA(0, 0, At, B0); PG8_MMA(0, 1, At, B1); PG8_BAR; PG8_SCHED;
            PG8_LDA(At, 1, 1); PG8_STAGE(PG8_SB(1, 0), b3, voffB); PG8_STAGE(PG8_SB(1, 1), b3 + hstepB, voffB); PG8_STAGE(PG8_SA(1, 0), a3, w20);
            PG8_WAIT_V(8); PG8_WAIT_L(0); PG8_BAR; PG8_MMA(1, 0, At, B0); PG8_MMA(1, 1, At, B1); PG8_BAR; PG8_SCHED;
            } else if constexpr (SP2) {
            PG8_LDB(B0, 0, 0); PG8_LDB(B1, 0, 1); PG8_SCHED; PG8_LDA(At, 0, 0); PG8_STAGE(PG8_SA(1, 1), a1 + hstepA, vc1);
            PG8_WAIT_V(8); PG8_WAIT_L(0); PG8_BAR; PG8_MMA(0, 0, At, B0); PG8_MMA(0, 1, At, B1); PG8_BAR; PG8_SCHED;
            PG8_LDA(At, 0, 1); PG8_STAGE(PG8_SB(0, 0), b2, voffB); PG8_STAGE(PG8_SB(0, 1), b2 + hstepB, voffB); PG8_STAGE(PG8_SA(0, 0), a2, w20);
            PG8_WAIT_V(8); PG8_WAIT_L(0); PG8_BAR; PG8_MMA(1, 0, At, B0); PG8_MMA(1, 1, At, B1); PG8_BAR; PG8_SCHED;
            PG8_LDB(B0, 1, 0); PG8_LDB(B1, 1, 1); PG8_SCHED; PG8_LDA(At, 1, 0); PG8_STAGE(PG8_SA(0, 1), a2 + hstepA, w21);
            PG8_WAIT_V(8); PG8_WAIT_L(0); PG8_BAR; PG8_MMA(0, 0, At, B0); PG8_MMA(0, 1, At, B1); PG8_BAR; PG8_SCHED;
            PG8_LDA(At, 1, 1); PG8_STAGE(PG8_SB(1, 0), b3, voffB); PG8_STAGE(PG8_SB(1, 1), b3 + hstepB, voffB); PG8_STAGE(PG8_SA(1, 0), a3, w20);
            PG8_WAIT_V(8); PG8_WAIT_L(0); PG8_BAR; PG8_MMA(1, 0, At, B0); PG8_MMA(1, 1, At, B1); PG8_BAR; PG8_SCHED;
            } else {
            PG8_LDB(B0, 0, 0); PG8_SCHED; PG8_LDA(At, 0, 0); PG8_STAGE(PG8_SA(1, 1), a1 + hstepA, vc1);
            PG8_WAIT_L(8); PG8_BAR; PG8_WAIT_L(0); PG8_MMA(0, 0, At, B0); PG8_BAR; PG8_SCHED;
            PG8_LDB(B1, 0, 1); PG8_STAGE(PG8_SB(0, 0), b2, voffB);
            PG8_BAR; PG8_WAIT_L(0); PG8_MMA(0, 1, At, B1); PG8_BAR;
            PG8_LDA(At, 0, 1); PG8_STAGE(PG8_SA(0, 0), a2, w20);
            PG8_BAR; PG8_WAIT_L(0); PG8_MMA(1, 0, At, B0); PG8_BAR; PG8_SCHED;
            PG8_STAGE(PG8_SB(0, 1), b2 + hstepB, voffB);
            PG8_WAIT_V(6); PG8_BAR; PG8_MMA(1, 1, At, B1); PG8_BAR;
            PG8_LDB(B0, 1, 0); PG8_SCHED; PG8_LDA(At, 1, 0); PG8_STAGE(PG8_SA(0, 1), a2 + hstepA, w21);
            PG8_WAIT_L(8); PG8_BAR; PG8_WAIT_L(0); PG8_MMA(0, 0, At, B0); PG8_BAR; PG8_SCHED;
            PG8_LDB(B1, 1, 1); PG8_STAGE(PG8_SB(1, 0), b3, voffB);
            PG8_BAR; PG8_WAIT_L(0); PG8_MMA(0, 1, At, B1); PG8_BAR;
            PG8_LDA(At, 1, 1); PG8_STAGE(PG8_SA(1, 0), a3, w20);
            PG8_BAR; PG8_WAIT_L(0); PG8_MMA(1, 0, At, B0); PG8_BAR; PG8_SCHED;
            PG8_STAGE(PG8_SB(1, 1), b3 + hstepB, voffB);
            PG8_WAIT_V(6); PG8_BAR; PG8_MMA(1, 1, At, B1); PG8_BAR;
            }
        }
        if constexpr (ALIGN_EPI) { if (wr == 0) PG8_BAR; }
        if constexpr (ROLL) { int fr_ = fr, fq_ = fq; asm volatile("" : "+v"(fr_), "+v"(fq_)); E.half(acc, cur, 0, wr, wc, fr_, fq_, PG8_TABP(ui)); E.half(acc, cur, 1, wr, wc, fr_, fq_, PG8_TABP(ui)); pst = E.stores(cur, wc); }
        else E(acc, cur, wr, wc, fr, fq);
        S.done(cur);
        if (!has_next) break;
#pragma unroll
        for (int a = 0; a < 2; ++a)
#pragma unroll
            for (int b = 0; b < 2; ++b)
#pragma unroll
                for (int m = 0; m < 4; ++m)
#pragma unroll
                    for (int n = 0; n < 2; ++n) acc[a][b][m][n] = (f32x4){0.f, 0.f, 0.f, 0.f};
        cur = nxt; cA = nA; cB = nB; ++ui;
#pragma unroll
        for (int i = 0; i < 2; ++i) { vc0[i] = vn0[i]; vc1[i] = vn1[i]; }
        if constexpr (ALIGN_EPI) { if (wr == 1) PG8_BAR; }
    }
    PG8_WAIT_V(0);
    if constexpr (!ALIGN_EPI) { if (wr == 0) PG8_BAR; }
    PG8_BAR;
}
struct Gemm2 { const char* A0; const char* B0; unsigned rbA0, rbB0; int nt0; const char* A1; const char* B1; unsigned rbA1, rbB1; int nt1; };
constexpr int TAB2_BYTES = 4096;
template <class Epi, class Sched, bool ALIGN_EPI>
__device__ __forceinline__ void gemm_phase2(PG8_LAS unsigned char* lds, const Gemm2 g, const Sched& S, const Epi& E) {
    constexpr bool MX = false;
    const int tid = threadIdx.x, wid = __builtin_amdgcn_readfirstlane(tid >> 6), lane = tid & 63, wr = wid >> 2, wc = wid & 3, fr = lane & 15, fq = lane >> 4;
    unsigned vA0[2], vB0[2], vA1[2], vB1[2];
#pragma unroll
    for (int i = 0; i < 2; ++i) { int R, C; stage_rc(tid * 16 + i * 8192, R, C); const int Rb = Epi::PERM ? ((R & ~31) + perm32(R & 31)) : R;
        vA0[i] = (unsigned)R * g.rbA0 + (unsigned)C * 2u; vB0[i] = (unsigned)Rb * g.rbB0 + (unsigned)C * 2u; vA1[i] = (unsigned)R * g.rbA1 + (unsigned)C * 2u; vB1[i] = (unsigned)Rb * g.rbB1 + (unsigned)C * 2u; }
    const size_t kstep = (size_t)(BK * 2);
    const size_t hA0 = (size_t)HALF * g.rbA0, hB0 = (size_t)HALF * g.rbB0, hA1 = (size_t)HALF * g.rbA1, hB1 = (size_t)HALF * g.rbB1;
    const unsigned ldsw = (unsigned)wid * 1024u;
    const int aoff = lds_byte(wr * 64 + fr, fq * 8), boff = lds_byte(wc * 32 + fr, fq * 8);
#define PG8_MMA8(ai, bj, At, Bt) do { __builtin_amdgcn_s_setprio(1); _Pragma("unroll") for (int m = 0; m < 4; ++m) _Pragma("unroll") for (int n = 0; n < 2; ++n) _Pragma("unroll") for (int k = 0; k < 2; ++k) \
        acc[ai][bj][m][n] = __builtin_bit_cast(f32x4, __builtin_amdgcn_mfma_i32_16x16x64_i8(__builtin_bit_cast(i32x4, Bt[n][k]), __builtin_bit_cast(i32x4, At[m][k]), __builtin_bit_cast(i32x4, acc[ai][bj][m][n]), 0, 0, 0)); __builtin_amdgcn_s_setprio(0); } while (0)
#define PG8_MMAB(ai, bj, At, Bt) do { __builtin_amdgcn_s_setprio(1); _Pragma("unroll") for (int m = 0; m < 4; ++m) _Pragma("unroll") for (int n = 0; n < 2; ++n) _Pragma("unroll") for (int k = 0; k < 2; ++k) \
        acc[ai][bj][m][n] = __builtin_amdgcn_mfma_f32_16x16x32_bf16(Bt[n][k], At[m][k], acc[ai][bj][m][n], 0, 0, 0); __builtin_amdgcn_s_setprio(0); } while (0)
#define PG8_TAB2P(u_) ((const PG8_LAS float*)(lds + TAB_OFF + ((u_) & 1) * TAB2_BYTES))
#define PG8_SEG(NT, CA, CB, HA, HB, VA, VB, NA, NB, NHA, NHB, NVA, NVB, MMA, FIRSTSEG) \
    _Pragma("unroll 1") for (int t = 0; t < (NT); t += 2) { \
        const bool last = (t == (NT) - 2); \
        const char* a1 = (CA) + (size_t)(t + 1) * kstep; \
        const char* a2 = last ? (NA) : (CA) + (size_t)(t + 2) * kstep; const char* b2 = last ? (NB) : (CB) + (size_t)(t + 2) * kstep; \
        const char* a3 = a2 + kstep; const char* b3 = b2 + kstep; \
        const size_t hA2 = last ? (NHA) : (HA), hB2 = last ? (NHB) : (HB); \
        unsigned wa[2], wb[2]; \
        _Pragma("unroll") for (int i = 0; i < 2; ++i) { wa[i] = last ? (NVA)[i] : (VA)[i]; wb[i] = last ? (NVB)[i] : (VB)[i]; } \
        const bool rf = (FIRSTSEG) && (t == 0) && pst; \
        PG8_LDB(B0, 0, 0); PG8_LDB(B1, 0, 1); PG8_SCHED; PG8_LDA(At, 0, 0); PG8_STAGE(PG8_SA(1, 1), a1 + (HA), (VA)); \
        if ((FIRSTSEG) && t == 2) { for (int q = wid; q < 4 * Epi::NTAB; q += 8) __builtin_amdgcn_global_load_lds((const unsigned*)E.tab_src(cur, q * 64 + lane), (PG8_LAS unsigned*)(lds + TAB_OFF + (ui & 1) * TAB2_BYTES + q * 256), 4, 0, 0); } \
        if (rf) PG8_WAIT_VN(8 + 2 * Epi::NS); else PG8_WAIT_V(8); \
        PG8_WAIT_L(0); PG8_BAR; MMA(0, 0, At, B0); MMA(0, 1, At, B1); PG8_BAR; PG8_SCHED; \
        PG8_LDA(At, 0, 1); PG8_STAGE(PG8_SB(0, 0), b2, wb); PG8_STAGE(PG8_SB(0, 1), b2 + hB2, wb); PG8_STAGE(PG8_SA(0, 0), a2, wa); \
        if (rf) PG8_WAIT_VN(8 + 2 * Epi::NS); else PG8_WAIT_V(8); \
        PG8_WAIT_L(0); PG8_BAR; MMA(1, 0, At, B0); MMA(1, 1, At, B1); PG8_BAR; PG8_SCHED; \
        PG8_LDB(B0, 1, 0); PG8_LDB(B1, 1, 1); PG8_SCHED; PG8_LDA(At, 1, 0); PG8_STAGE(PG8_SA(0, 1), a2 + hA2, wa); \
        PG8_WAIT_V(8); PG8_WAIT_L(0); PG8_BAR; MMA(0, 0, At, B0); MMA(0, 1, At, B1); PG8_BAR; PG8_SCHED; \
        PG8_LDA(At, 1, 1); PG8_STAGE(PG8_SB(1, 0), b3, wb); PG8_STAGE(PG8_SB(1, 1), b3 + hB2, wb); PG8_STAGE(PG8_SA(1, 0), a3, wa); \
        PG8_WAIT_V(8); PG8_WAIT_L(0); PG8_BAR; MMA(1, 0, At, B0); MMA(1, 1, At, B1); PG8_BAR; PG8_SCHED; \
    }
    Unit cur, nxt; int ui = 0; bool pst = false;
    if (!S.next(0, cur)) return;
    f32x4 acc[2][2][4][2];
#pragma unroll
    for (int a = 0; a < 2; ++a) PG8_ZERO(a);
    bf16x8 At[4][2], B0[2][2], B1[2][2]; i32x8 AtX[4], B0X[2], B1X[2]; (void)AtX; (void)B0X; (void)B1X;
    const char* cA0 = g.A0 + (size_t)cur.pm * 2 * hA0; const char* cB0 = g.B0 + (size_t)cur.pn * 2 * hB0;
    const char* cA1 = g.A1 + (size_t)cur.pm * 2 * hA1; const char* cB1 = g.B1 + (size_t)cur.pn * 2 * hB1;
    PG8_STAGE(PG8_SB(0, 0), cB0, vB0); PG8_STAGE(PG8_SB(0, 1), cB0 + hB0, vB0); PG8_STAGE(PG8_SA(0, 0), cA0, vA0); PG8_STAGE(PG8_SA(0, 1), cA0 + hA0, vA0);
    if (wr == 1) PG8_BAR;
    PG8_WAIT_V(2); PG8_BAR;
    PG8_STAGE(PG8_SB(1, 0), cB0 + kstep, vB0); PG8_STAGE(PG8_SA(1, 0), cA0 + kstep, vA0); PG8_STAGE(PG8_SB(1, 1), cB0 + hB0 + kstep, vB0);
    PG8_WAIT_V(6); PG8_BAR;
    for (;;) {
        const bool has_next = S.next(ui + 1, nxt);
        const char* nA0 = has_next ? g.A0 + (size_t)nxt.pm * 2 * hA0 : cA0; const char* nB0 = has_next ? g.B0 + (size_t)nxt.pn * 2 * hB0 : cB0;
        PG8_SEG(g.nt0, cA0, cB0, hA0, hB0, vA0, vB0, cA1, cB1, hA1, hB1, vA1, vB1, PG8_MMA8, true)
        { int fr_ = fr, fq_ = fq; asm volatile("" : "+v"(fr_), "+v"(fq_)); E.mid(acc, cur, wr, wc, fr_, fq_, PG8_TAB2P(ui)); }
        PG8_SCHED;
        PG8_SEG(g.nt1, cA1, cB1, hA1, hB1, vA1, vB1, nA0, nB0, hA0, hB0, vA0, vB0, PG8_MMAB, false)
        if constexpr (ALIGN_EPI) { if (wr == 0) PG8_BAR; }
        { int fr_ = fr, fq_ = fq; asm volatile("" : "+v"(fr_), "+v"(fq_)); E.half(acc, cur, 0, wr, wc, fr_, fq_, PG8_TAB2P(ui)); E.half(acc, cur, 1, wr, wc, fr_, fq_, PG8_TAB2P(ui)); pst = E.stores(cur, wc); }
        if (!has_next) break;
#pragma unroll
        for (int a = 0; a < 2; ++a) PG8_ZERO(a);
        cur = nxt; cA0 = nA0; cB0 = nB0; cA1 = g.A1 + (size_t)cur.pm * 2 * hA1; cB1 = g.B1 + (size_t)cur.pn * 2 * hB1; ++ui;
        if constexpr (ALIGN_EPI) { if (wr == 1) PG8_BAR; }
    }
    PG8_WAIT_V(0);
    if constexpr (!ALIGN_EPI) { if (wr == 0) PG8_BAR; }
    PG8_BAR;
#undef PG8_SEG
#undef PG8_MMA8
#undef PG8_MMAB
#undef PG8_TAB2P
#undef PG8_SA
#undef PG8_SB
#undef PG8_STAGE
#undef PG8_LDA
#undef PG8_LD32
#undef PG8_LDB
#undef PG8_MMA
#undef PG8_WAIT_V
#undef PG8_WAIT_VN
#undef PG8_ZERO
#undef PG8_TABP
#undef PG8_WAIT_L
#undef PG8_BAR
#undef PG8_SCHED
}
}

#ifndef PG8_SP2
#define PG8_SP2 true
#endif
#ifndef PG8_ALIGN
#define PG8_ALIGN true
#endif
#ifndef PG8_ROLL
#define PG8_ROLL true
#endif
#ifndef PG8_ROLL2
#define PG8_ROLL2 PG8_ROLL
#endif
#ifndef PG8_ROLL5
#define PG8_ROLL5 PG8_ROLL
#endif
#ifndef PG8_ROLL7
#define PG8_ROLL7 PG8_ROLL
#endif
#ifndef PG8_ROLL8
#define PG8_ROLL8 PG8_ROLL
#endif

constexpr int NWAVES = 8, NTHR = 512;
constexpr int D = 4096, NB = 4, SEQ = 4096, T = NB * SEQ, CTXL = 256, TC = NB * CTXL, TA = T + TC;
constexpr int NH = 8, DK = 128, DV = 256;
constexpr int COL_Q = 0, COL_O = 1024, COL_CB = 3072, COL_CC = 5120, COL_CX = 7168, COL_K = 9216, COL_V = 10240, COL_G = 12288;
constexpr int NPROJ = 12288, IN_COLS = 12320, NPAD = 12544;
constexpr int NE = 16, FF = 1024, ADA_N = 6 * D;
constexpr int HM_ROWS = 2 * T + NE * 256;
constexpr float EPS = 1e-6f;

constexpr size_t MiB = 1u << 20;
constexpr size_t WS_CTL = 0, CTL_ZERO_BYTES = 1 * MiB;
constexpr size_t WS_ADA = 1 * MiB;
constexpr size_t WS_GATES = 2 * MiB;
constexpr size_t WS_ELIST = 5 * MiB;
constexpr size_t WS_EW = 6 * MiB;
constexpr size_t WS_WIN = 8 * MiB;
constexpr size_t WS_WOUT = 106 * MiB;
constexpr size_t WS_WE1 = 138 * MiB;
constexpr size_t WS_WE2 = 394 * MiB;
constexpr size_t WS_XM = 522 * MiB;
constexpr size_t WS_PROJ = 658 * MiB;
constexpr size_t WS_SLOT = WS_PROJ, WS_HMOE = WS_PROJ + 256 * MiB;
constexpr size_t WS_HF = 1066 * MiB, WS_HB = 1194 * MiB;
constexpr size_t WS_X1 = 1322 * MiB;
constexpr size_t WS_XM8 = 1578 * MiB;
constexpr size_t WS_WO8 = 1646 * MiB;
constexpr size_t WS_WI8 = 1646 * MiB;
constexpr size_t WS_SA = 1696 * MiB, WS_SB = WS_SA + 256 * 1024;
constexpr size_t WS_END = 1698 * MiB;
static_assert(WS_XM8 + (size_t)TA * D <= WS_WI8 && WS_WI8 + (size_t)NPAD * D <= WS_SA, "ws map int8");
static_assert(WS_GATES + (size_t)TA * 32 * 4 <= WS_ELIST && WS_WIN + (size_t)NPAD * D * 2 <= WS_WOUT && WS_XM + (size_t)TA * D * 2 <= WS_PROJ && WS_PROJ + (size_t)TA * NPROJ * 2 <= WS_HF, "ws map");
static_assert(WS_HMOE + (size_t)HM_ROWS * FF * 2 <= WS_HF, "ws map 2");
constexpr int CW_TMO = 0, CW_CODE = 1, CW_TQ = 1024, CW_CNT = 2048, CW_CMAX = 32768, CW_CMAX2 = 49152, CW_BAR = 4096, CW_RT = 16384;

constexpr int RING_BYTES = 131072;
constexpr int LDS_BYTES = 147456;
constexpr int LDSCTL_OFF = LDS_BYTES - 3072;
constexpr int MISC_OFF = LDSCTL_OFF + 320;
constexpr int MOE_OFF = LDSCTL_OFF + 512;
constexpr int ROWTAB_OFF = LDSCTL_OFF + 1024;

#define GAS __attribute__((address_space(1)))
#define LAS __attribute__((address_space(3)))
typedef unsigned short bf16;
typedef unsigned v4u __attribute__((ext_vector_type(4)));
typedef unsigned v2u __attribute__((ext_vector_type(2)));
typedef float f32x4 __attribute__((ext_vector_type(4)));
typedef GAS unsigned gu32;
#define RLX_AGENT __ATOMIC_RELAXED, __HIP_MEMORY_SCOPE_AGENT
#define LDS_WAIT() asm volatile("s_waitcnt lgkmcnt(0)" ::: "memory")
#define VM_WAIT() asm volatile("s_waitcnt vmcnt(0)" ::: "memory")
__device__ __forceinline__ unsigned pk2(float lo, float hi) { return pg8::cvt_pk_bf16(lo, hi); }
__device__ __forceinline__ float bf_lo(unsigned u) { return __uint_as_float(u << 16); }
__device__ __forceinline__ float bf_hi(unsigned u) { return __uint_as_float(u & 0xffff0000u); }
__device__ __forceinline__ float bf1(bf16 u) { return __uint_as_float(((unsigned)u) << 16); }
__device__ __forceinline__ unsigned pk4_fp8(float a, float b, float c, float d) { int p = __builtin_amdgcn_cvt_pk_fp8_f32(a, b, 0, false); p = __builtin_amdgcn_cvt_pk_fp8_f32(c, d, p, true); return (unsigned)p; }
__device__ __forceinline__ unsigned pk4_i8(float a, float b, float c, float d) { return ((unsigned)(int)rintf(a) & 255u) | (((unsigned)(int)rintf(b) & 255u) << 8) | (((unsigned)(int)rintf(c) & 255u) << 16) | ((unsigned)(int)rintf(d) << 24); }
constexpr float W1_SCALE = 64.f, W2_SCALE = 32.f, SLOT_SCALE = 16.f;
typedef float f32x2v __attribute__((ext_vector_type(2)));
__device__ __forceinline__ f32x4 fp8x4_to_f32(unsigned v) { const f32x2v lo = __builtin_amdgcn_cvt_pk_f32_fp8((int)v, false), hi = __builtin_amdgcn_cvt_pk_f32_fp8((int)v, true); return (f32x4){lo[0], lo[1], hi[0], hi[1]}; }
__device__ __forceinline__ float sigmoidf_(float x) { return 1.f / (1.f + __expf(-x)); }

#define XB_TMO      128
#define XB_XCNT(j)  (256  + 64 * (j))
#define XB_XSUB(j)  (1280 + 64 * (j))
#define XB_XGEN(j)  (2304 + 64 * (j))
#define XB_TOP      3328
#define XB_TOPGEN   3392
#define XCD_BAR_WORDS 3456
#define XB_SPIN_CAP (1u << 22)
__device__ __forceinline__ unsigned xb_ld(unsigned* p)              { return __hip_atomic_load(p, __ATOMIC_RELAXED, __HIP_MEMORY_SCOPE_AGENT); }
__device__ __forceinline__ unsigned xb_add(unsigned* p, unsigned v) { return __hip_atomic_fetch_add(p, v, __ATOMIC_RELAXED, __HIP_MEMORY_SCOPE_AGENT); }
__device__ __forceinline__ unsigned xb_xcc_id() { return (unsigned)__builtin_amdgcn_s_getreg((3 << 11) | 20) & 0xFu; }
#define XB_SPIN(cond, bar) do { unsigned _sp = 0; while (cond) { __builtin_amdgcn_s_sleep(1); \
    if ((++_sp & 255u) == 0u) { if (xb_ld(&(bar)[XB_TMO])) break; if (_sp > XB_SPIN_CAP) { atomicAdd(&(bar)[XB_TMO], 1u); break; } } } } while (0)
struct XcdBarrier { unsigned* bar; unsigned x; volatile LAS unsigned* st; };
__device__ __forceinline__ XcdBarrier xcd_barrier_post(unsigned* bar, volatile LAS unsigned* st) {
    XcdBarrier b; b.bar = bar; b.x = xb_xcc_id(); b.st = st;
    if (threadIdx.x == 0) (void)xb_add(&bar[XB_XCNT(b.x)], 1u);
    return b;
}
__device__ __forceinline__ void xcd_barrier_complete(unsigned* bar, unsigned x, unsigned& nloc, unsigned& nx) {
    const unsigned G = gridDim.x * gridDim.y * gridDim.z;
    unsigned sum, cnt, mine, sp = 0u;
    for (;;) {
        sum = 0u; cnt = 0u; mine = 0u;
#pragma unroll
        for (unsigned j = 0; j < 16; ++j) { const unsigned c = xb_ld(&bar[XB_XCNT(j)]); sum += c; cnt += (c > 0u) ? 1u : 0u; mine = (j == x) ? c : mine; }
        if (sum == G) break;
        __builtin_amdgcn_s_sleep(1);
        if ((++sp & 255u) == 0u) { if (xb_ld(&bar[XB_TMO])) break; if (sp > XB_SPIN_CAP) { atomicAdd(&bar[XB_TMO], 1u); break; } }
    }
    nloc = mine > 0u ? mine : 1u; nx = cnt > 0u ? cnt : 1u;
}
__device__ __forceinline__ void xcd_barrier(const XcdBarrier& b) {
    asm volatile("s_waitcnt vmcnt(0)" ::: "memory");
    __syncthreads();
    if (threadIdx.x == 0) {
        unsigned* bar = b.bar;
        __builtin_amdgcn_s_waitcnt(0);
        unsigned nloc = b.st[0], nx = b.st[1];
        if (nloc == 0u) { xcd_barrier_complete(bar, b.x, nloc, nx); b.st[0] = nloc; b.st[1] = nx; }
        const unsigned old = xb_add(&bar[XB_XSUB(b.x)], 1u);
        const unsigned gen = old / nloc;
        if (old + 1u == (gen + 1u) * nloc) {
            __builtin_amdgcn_fence(__ATOMIC_RELEASE, "agent");
            asm volatile("s_waitcnt vmcnt(0)" ::: "memory");
            const unsigned og = xb_add(&bar[XB_TOP], 1u);
            const unsigned tg = og / nx;
            if (og + 1u == (tg + 1u) * nx) xb_add(&bar[XB_TOPGEN], 1u);
            else XB_SPIN(xb_ld(&bar[XB_TOPGEN]) == tg, bar);
            __builtin_amdgcn_fence(__ATOMIC_ACQUIRE, "agent");
            xb_add(&bar[XB_XGEN(b.x)], 1u);
            asm volatile("s_waitcnt vmcnt(0)" ::: "memory");
        } else {
            XB_SPIN(xb_ld(&bar[XB_XGEN(b.x)]) == gen, bar);
            __builtin_amdgcn_fence(__ATOMIC_ACQUIRE, "agent");
            asm volatile("s_waitcnt vmcnt(0)" ::: "memory");
        }
    }
    __syncthreads();
}

struct Frame {
    LAS unsigned char* lds;
    volatile LAS unsigned* MISC;
    gu32* ctl;
    int tid, lane, wave;
    int vcu, G;
    const float *x, *c, *ctx, *cctx, *w_ada, *b_ada, *norm1, *w_in, *b_gates, *conv_w, *head_norm, *w_out, *norm2, *w_rg, *b_rg, *w_re, *b_re, *w_e1, *w_e2, *fnorm;
    float* out;
    float *ADA, *GATES, *EW;
    bf16 *DELTA, *X1B;
    unsigned char *XM8, *WO8, *MIXA8, *WOA8; signed char* WI8; float *SA, *SB, *SB2;
    bf16 *HF, *HB;
    int* ELIST;
    bf16 *WIN, *WOUT, *WE1, *WE2, *XM, *PROJ, *MIX, *XF, *SLOT, *HMOE;
};

template <int CTRL, int ROWMASK> __device__ __forceinline__ float dpp_f(float old, float src) {
    return __builtin_bit_cast(float, __builtin_amdgcn_update_dpp(__builtin_bit_cast(int, old), __builtin_bit_cast(int, src), CTRL, ROWMASK, 0xf, false)); }
__device__ __forceinline__ float wave_incl_sum(float v) {
    v += dpp_f<0x111, 0xf>(0.f, v); v += dpp_f<0x112, 0xf>(0.f, v); v += dpp_f<0x114, 0xf>(0.f, v); v += dpp_f<0x118, 0xf>(0.f, v);
    v += dpp_f<0x142, 0xa>(0.f, v); v += dpp_f<0x143, 0xc>(0.f, v); return v; }
__device__ __forceinline__ float wave_incl_max(float v) {
    constexpr float NI = -3.0e38f;
    v = fmaxf(v, dpp_f<0x111, 0xf>(NI, v)); v = fmaxf(v, dpp_f<0x112, 0xf>(NI, v)); v = fmaxf(v, dpp_f<0x114, 0xf>(NI, v)); v = fmaxf(v, dpp_f<0x118, 0xf>(NI, v));
    v = fmaxf(v, dpp_f<0x142, 0xa>(NI, v)); v = fmaxf(v, dpp_f<0x143, 0xc>(NI, v)); return v; }
__device__ __forceinline__ float lane_bcast(float v, int l) { return __builtin_bit_cast(float, __builtin_amdgcn_readlane(__builtin_bit_cast(int, v), l)); }
__device__ __forceinline__ float wave_sum(float v) { return lane_bcast(wave_incl_sum(v), 63); }
__device__ __forceinline__ float wave_max(float v) { return lane_bcast(wave_incl_max(v), 63); }

__device__ __forceinline__ void p0_ada(Frame& F) {
    LAS float* sil = (LAS float*)F.lds;
    LAS float* red = (LAS float*)(F.lds + 81920);
    for (int i = F.tid; i < 5 * D; i += NTHR) { const int b = i >> 12, k = i & (D - 1); const float cv = b < 4 ? F.c[b * D + k] : F.cctx[k]; sil[i] = cv / (1.f + expf(-cv)); }
    __syncthreads();
    const int cq = F.tid % 24, rg = F.tid / 24;
    for (int item = F.vcu; item < ADA_N / 96; item += F.G) {
        const int col0 = item * 96;
        float acc[5][4];
#pragma unroll
        for (int b = 0; b < 5; ++b)
#pragma unroll
            for (int j = 0; j < 4; ++j) acc[b][j] = 0.f;
        if (rg < 21) {
            const float* wp = F.w_ada + col0 + 4 * cq;
#pragma unroll 13
            for (int r = rg; r < D; r += 21) {
                const f32x4 w = *(const f32x4*)(wp + (size_t)r * ADA_N);
#pragma unroll
                for (int b = 0; b < 5; ++b) { const float s = sil[b * D + r];
#pragma unroll
                    for (int j = 0; j < 4; ++j) acc[b][j] += s * w[j]; }
            }
#pragma unroll
            for (int b = 0; b < 5; ++b)
#pragma unroll
                for (int j = 0; j < 4; ++j) red[rg * 480 + b * 96 + 4 * cq + j] = acc[b][j];
        }
        __syncthreads();
        if (F.tid < 480) { const int b = F.tid / 96, cc = F.tid % 96; float s = 0.f;
#pragma unroll
            for (int q = 0; q < 21; ++q) s += red[q * 480 + F.tid];
            F.ADA[b * ADA_N + col0 + cc] = s + F.b_ada[col0 + cc]; }
        __syncthreads();
    }
}
__device__ __forceinline__ int win_row(int n) {
    if (n < COL_CC || n >= COL_K) return n;
    const int rel = n - COL_CC, au = rel >> 11, r = rel & 2047;
    return COL_CC + 256 * (r >> 7) + 128 * au + (r & 127);
}
struct TItem { const float* W; bf16* WT; const void* cmax; unsigned* cmo; int K, N, nblk, row_off, item, map, f8; float scale; };
template <int KIND>
__device__ __forceinline__ TItem titem_decode(Frame& F, int r) {
    constexpr int I_E1 = (D / 64) * (2 * FF / 32), I_E2 = (FF / 64) * (D / 32);
    TItem t; t.cmax = (const void*)(F.ctl + CW_CMAX); t.cmo = nullptr;
    if (KIND == 8) { t.W = F.w_in; t.WT = (bf16*)F.WI8; t.K = D; t.N = IN_COLS; t.nblk = IN_COLS / 32; t.row_off = 0; t.item = (D / 64) * (IN_COLS / 32) - 1 - r; t.map = 2; t.f8 = 2; t.scale = 1.f; }
    else if (KIND == 0) { t.W = F.w_in; t.WT = F.WIN; t.K = D; t.N = IN_COLS; t.nblk = IN_COLS / 32; t.row_off = 0; t.map = 0; t.f8 = 0; t.scale = 1.f;
        { constexpr int NBP = (IN_COLS - COL_K) / 32; const int kb = r / NBP, nbp = r % NBP; t.item = kb * (IN_COLS / 32) + COL_K / 32 + nbp; } }
    else if (KIND == 1) { t.W = F.w_out; t.WT = F.WOUT; t.K = D; t.N = D; t.nblk = D / 32; t.row_off = 0; t.item = r; t.map = 0; t.f8 = 0; t.scale = 1.f; t.cmo = (unsigned*)(F.ctl + CW_CMAX2); }
    else if (KIND == 2) { const int e = r / I_E1; t.W = F.w_e1 + (size_t)e * D * 2 * FF; t.WT = F.WE1; t.K = D; t.N = 2 * FF; t.nblk = 2 * FF / 32; t.row_off = e * 2 * FF; t.item = r % I_E1; t.map = 1; t.f8 = 1; t.scale = W1_SCALE; }
    else { const int e = r / I_E2; t.W = F.w_e2 + (size_t)e * FF * D; t.WT = F.WE2; t.K = FF; t.N = D; t.nblk = D / 32; t.row_off = e * D; t.item = r % I_E2; t.map = 0; t.f8 = 1; t.scale = W2_SCALE; }
    return t;
}
__device__ __forceinline__ void titem_load(const TItem& t, int lane, f32x4 (&v)[8]) {
    const int nblk = t.nblk, kb = t.item / nblk, nb = t.item % nblk, k0 = 64 * kb, n0 = 32 * nb;
    const float* p = t.W + (size_t)(k0 + (lane >> 3)) * t.N + n0 + 4 * (lane & 7);
#pragma unroll
    for (int i = 0; i < 8; ++i) v[i] = *(const f32x4*)(p + (size_t)(8 * i) * t.N);
}
__device__ __forceinline__ void titem_finish(const TItem& cur, LAS float* scr, int lane) {
    const int nblk = cur.nblk, kb = cur.item / nblk, nb = cur.item % nblk, k0 = 64 * kb, n0 = 32 * nb, c = lane & 7;
#pragma unroll
    for (int j = 0; j < 4; ++j) { const int n = (lane >> 3) + 8 * j; const LAS float* s = scr + (8 * c) * 33 + n;
        const int nn = n0 + n; int row;
        if (cur.map == 0) row = cur.row_off + nn;
        else if (cur.map == 2) row = win_row(nn);
        else { const int au = nn >> 10, r = nn & 1023; row = cur.row_off + 256 * (r >> 7) + 128 * au + (r & 127); }
        const float sc = cur.scale;
        if (cur.f8 == 2) { const float cm = __uint_as_float(((const unsigned*)cur.cmax)[nn]), iv = cm > 0.f ? 127.f / cm : 0.f;
            *(v2u*)((unsigned char*)cur.WT + (size_t)row * cur.K + k0 + 8 * c) = (v2u){pk4_i8(s[0 * 33] * iv, s[1 * 33] * iv, s[2 * 33] * iv, s[3 * 33] * iv), pk4_i8(s[4 * 33] * iv, s[5 * 33] * iv, s[6 * 33] * iv, s[7 * 33] * iv)}; }
        else if (cur.f8) { *(v2u*)((unsigned char*)cur.WT + (size_t)row * cur.K + k0 + 8 * c) = (v2u){pk4_fp8(s[0 * 33] * sc, s[1 * 33] * sc, s[2 * 33] * sc, s[3 * 33] * sc), pk4_fp8(s[4 * 33] * sc, s[5 * 33] * sc, s[6 * 33] * sc, s[7 * 33] * sc)}; }
        else { v4u o; o.x = pk2(s[0 * 33], s[1 * 33]); o.y = pk2(s[2 * 33], s[3 * 33]); o.z = pk2(s[4 * 33], s[5 * 33]); o.w = pk2(s[6 * 33], s[7 * 33]);
               *(v4u*)(cur.WT + (size_t)row * cur.K + k0 + 8 * c) = o;
               if (cur.cmo != nullptr && k0 < D / 2) {
                   unsigned mx = max(max(max((o.x & 0x7fffu) << 16, o.x & 0x7fff0000u), max((o.y & 0x7fffu) << 16, o.y & 0x7fff0000u)), max(max((o.z & 0x7fffu) << 16, o.z & 0x7fff0000u), max((o.w & 0x7fffu) << 16, o.w & 0x7fff0000u)));
                   mx = max(mx, (unsigned)__shfl_xor((int)mx, 1)); mx = max(mx, (unsigned)__shfl_xor((int)mx, 2)); mx = max(mx, (unsigned)__shfl_xor((int)mx, 4));
                   if (c == 0) (void)__hip_atomic_fetch_max(cur.cmo + nn, mx, RLX_AGENT); } } }
}
constexpr int TI_IN = (D / 64) * (IN_COLS / 32), TI_OUT = (D / 64) * (D / 32), TI_E1 = (D / 64) * (2 * FF / 32), TI_E2 = (FF / 64) * (D / 32);
template <int KIND>
__device__ __forceinline__ void transpose_range(Frame& F, LAS float* scr, int it0, int it_end, int stride) {
    const int lane = F.lane;
    f32x4 v[8];
    int it = it0;
    TItem cur = titem_decode<KIND>(F, it < it_end ? it : 0);
    if (it < it_end) titem_load(cur, lane, v);
    while (it < it_end) {
#pragma unroll
        for (int i = 0; i < 8; ++i) { const int kk = 8 * i + (lane >> 3); LAS float* s = scr + kk * 33 + 4 * (lane & 7); s[0] = v[i][0]; s[1] = v[i][1]; s[2] = v[i][2]; s[3] = v[i][3]; }
        const int nit = it + stride;
        TItem nxt = cur;
        if (nit < it_end) { nxt = titem_decode<KIND>(F, nit); titem_load(nxt, lane, v); }
        LDS_WAIT(); asm volatile("" ::: "memory");
        titem_finish(cur, scr, lane);
        LDS_WAIT(); asm volatile("" ::: "memory");
        cur = nxt; it = nit;
    }
}
__device__ __forceinline__ void p0_transposes(Frame& F) {
    LAS float* scr = (LAS float*)(F.lds + F.wave * 8704);
    const int gw = F.vcu * NWAVES + F.wave, NGW = F.G * NWAVES;
    transpose_range<1>(F, scr, gw, TI_OUT, NGW);
    {
        constexpr int NIT = (D / 64) * (IN_COLS / 32);
        const int lane = F.lane;
        auto cm_load = [&](int it, f32x4 (&w)[8]) __attribute__((always_inline)) {
            const int itc = it < NIT ? it : NIT - 1, kb = itc / (IN_COLS / 32), nb = itc % (IN_COLS / 32);
            const float* p = F.w_in + (size_t)(64 * kb + (lane >> 3)) * IN_COLS + 32 * nb + 4 * (lane & 7);
#pragma unroll
            for (int i = 0; i < 8; ++i) w[i] = *(const f32x4*)(p + (size_t)(8 * i) * IN_COLS);
        };
        auto cm_step = [&](int it, f32x4 (&cur)[8], f32x4 (&nxt)[8]) __attribute__((always_inline)) {
            cm_load(it + NGW, nxt);
            if (it < NIT) {
                const int nb = it % (IN_COLS / 32);
                f32x4 mx = (f32x4){0.f, 0.f, 0.f, 0.f};
#pragma unroll
                for (int i = 0; i < 8; ++i) { mx[0] = fmaxf(mx[0], fabsf(cur[i][0])); mx[1] = fmaxf(mx[1], fabsf(cur[i][1])); mx[2] = fmaxf(mx[2], fabsf(cur[i][2])); mx[3] = fmaxf(mx[3], fabsf(cur[i][3])); }
#pragma unroll
                for (int o = 8; o < 64; o <<= 1) { mx[0] = fmaxf(mx[0], __shfl_xor(mx[0], o)); mx[1] = fmaxf(mx[1], __shfl_xor(mx[1], o)); mx[2] = fmaxf(mx[2], __shfl_xor(mx[2], o)); mx[3] = fmaxf(mx[3], __shfl_xor(mx[3], o)); }
                if (lane < 8) { unsigned* cm = (unsigned*)(F.ctl + CW_CMAX) + 32 * nb + 4 * lane;
#pragma unroll
                    for (int j = 0; j < 4; ++j) asm volatile("global_atomic_umax %0, %1, off" :: "v"(cm + j), "v"(__float_as_uint(mx[j])) : "memory"); }
            }
        };
        f32x4 wa[8], wb[8];
        cm_load(gw, wa);
        for (int it = gw; it < NIT; it += 2 * NGW) { cm_step(it, wa, wb); cm_step(it + NGW, wb, wa); }
        asm volatile("s_waitcnt vmcnt(0) ; hidden atomics" ::: "memory");
    }
    { const size_t n16 = (size_t)(NPAD - IN_COLS) * D / 16; v4u* p = (v4u*)(F.WI8 + (size_t)IN_COLS * D);
      for (size_t i = (size_t)F.vcu * NTHR + F.tid; i < n16; i += (size_t)F.G * NTHR) p[i] = (v4u){0u, 0u, 0u, 0u}; }
}
__device__ __forceinline__ int expert_queue_items(int G) { const int tot = NE * (TI_E1 + TI_E2), p3 = (4 + SEQ / 64) * G * NWAVES / 2; return tot > p3 ? tot - p3 : 0; }
struct HItem { const float* src; unsigned char* dst; int N, Kb, map, row0; float scale; };
__device__ __forceinline__ HItem hitem_decode(Frame& F, int hi) {
    const int fi = hi >> 1, sub = hi & 1; HItem t;
    if (fi < NE * TI_E1) { const int e = fi / TI_E1, item = fi % TI_E1, kb = item >> 6, nb = item & 63, n0 = 32 * nb + 16 * sub;
        t.N = 2 * FF; t.Kb = D; t.map = 1; t.scale = W1_SCALE; t.src = F.w_e1 + (size_t)e * D * 2 * FF + (size_t)(64 * kb) * t.N + n0;
        const int au = n0 >> 10, r = n0 & 1023; t.row0 = e * 2 * FF + 256 * (r >> 7) + 128 * au + (r & 127); t.dst = (unsigned char*)F.WE1 + 64 * kb; }
    else { const int f2 = fi - NE * TI_E1, e = f2 / TI_E2, item = f2 % TI_E2, kb = item >> 7, nb = item & 127, n0 = 32 * nb + 16 * sub;
        t.N = D; t.Kb = FF; t.map = 0; t.scale = W2_SCALE; t.src = F.w_e2 + (size_t)e * FF * D + (size_t)(64 * kb) * t.N + n0;
        t.row0 = e * D + n0; t.dst = (unsigned char*)F.WE2 + 64 * kb; }
    return t;
}
__device__ __forceinline__ void hitem_load(const HItem& t, int lane, f32x4 (&v)[4]) {
    const float* p = t.src + (size_t)(lane >> 2) * t.N + 4 * (lane & 3);
#pragma unroll
    for (int i = 0; i < 4; ++i) v[i] = *(const f32x4*)(p + (size_t)(16 * i) * t.N);
}
__device__ __forceinline__ void hitem_to_lds(int lane, const f32x4 (&v)[4], LAS float* scr) {
#pragma unroll
    for (int i = 0; i < 4; ++i) { LAS float* s = scr + (16 * i + (lane >> 2)) * 17 + 4 * (lane & 3); s[0] = v[i][0]; s[1] = v[i][1]; s[2] = v[i][2]; s[3] = v[i][3]; }
}
__device__ __forceinline__ void hitem_store(const HItem& t, int lane, LAS float* scr) {
    LDS_WAIT(); asm volatile("" ::: "memory");
    const int n = lane & 15, kc = lane >> 4; const LAS float* s = scr + (16 * kc) * 17 + n; const float sc = t.scale;
    v4u o;
    o.x = pk4_fp8(s[0 * 17] * sc, s[1 * 17] * sc, s[2 * 17] * sc, s[3 * 17] * sc); o.y = pk4_fp8(s[4 * 17] * sc, s[5 * 17] * sc, s[6 * 17] * sc, s[7 * 17] * sc);
    o.z = pk4_fp8(s[8 * 17] * sc, s[9 * 17] * sc, s[10 * 17] * sc, s[11 * 17] * sc); o.w = pk4_fp8(s[12 * 17] * sc, s[13 * 17] * sc, s[14 * 17] * sc, s[15 * 17] * sc);
    *(v4u*)(t.dst + (size_t)(t.row0 + n) * t.Kb + 16 * kc) = o;
    LDS_WAIT(); asm volatile("" ::: "memory");
}
__device__ __forceinline__ void gstore8_hidden(void* p, v2u v) { asm volatile("global_store_dwordx2 %0, %1, off" :: "v"(p), "v"(v) : "memory"); }
__device__ __forceinline__ void gstore16_hidden(void* p, v4u v) { asm volatile("global_store_dwordx4 %0, %1, off" :: "v"(p), "v"(v) : "memory"); }
__device__ __forceinline__ void hitem_store_hidden(const HItem& t, int lane, LAS float* scr) {
    LDS_WAIT(); asm volatile("" ::: "memory");
    const int n = lane & 15, kc = lane >> 4; const LAS float* s = scr + (16 * kc) * 17 + n; const float sc = t.scale;
    v4u o;
    o.x = pk4_fp8(s[0 * 17] * sc, s[1 * 17] * sc, s[2 * 17] * sc, s[3 * 17] * sc); o.y = pk4_fp8(s[4 * 17] * sc, s[5 * 17] * sc, s[6 * 17] * sc, s[7 * 17] * sc);
    o.z = pk4_fp8(s[8 * 17] * sc, s[9 * 17] * sc, s[10 * 17] * sc, s[11 * 17] * sc); o.w = pk4_fp8(s[12 * 17] * sc, s[13 * 17] * sc, s[14 * 17] * sc, s[15 * 17] * sc);
    gstore16_hidden(t.dst + (size_t)(t.row0 + n) * t.Kb + 16 * kc, o);
    LDS_WAIT(); asm volatile("" ::: "memory");
}
__device__ __forceinline__ void hitem_read(int lane, const LAS float* scr, float (&hr)[16]) {
    const int n = lane & 15, kc = lane >> 4; const LAS float* s = scr + (16 * kc) * 17 + n;
#pragma unroll
    for (int j = 0; j < 16; ++j) hr[j] = s[j * 17];
}
__device__ __forceinline__ void hitem_pack_store(const HItem& t, int lane, const float (&hr)[16]) {
    const int n = lane & 15, kc = lane >> 4; const float sc = t.scale;
    v4u o;
    o.x = pk4_fp8(hr[0] * sc, hr[1] * sc, hr[2] * sc, hr[3] * sc); o.y = pk4_fp8(hr[4] * sc, hr[5] * sc, hr[6] * sc, hr[7] * sc);
    o.z = pk4_fp8(hr[8] * sc, hr[9] * sc, hr[10] * sc, hr[11] * sc); o.w = pk4_fp8(hr[12] * sc, hr[13] * sc, hr[14] * sc, hr[15] * sc);
    gstore16_hidden(t.dst + (size_t)(t.row0 + n) * t.Kb + 16 * kc, o);
}
constexpr int TQ_BATCH = 16;
static_assert((NE * TI_E1) % TQ_BATCH == 0 && (NE * TI_E2) % TQ_BATCH == 0, "queue batches stay inside one kind");
__device__ __forceinline__ void expert_transpose_queue(Frame& F) {
    LAS float* scr = (LAS float*)(F.lds + F.wave * 8704);
    for (;;) {
        int base = 0;
        if (F.lane == 0) base = (int)__hip_atomic_fetch_add((unsigned*)(F.ctl + CW_TQ), (unsigned)TQ_BATCH, RLX_AGENT);
        base = __builtin_amdgcn_readfirstlane(base);
        if (base >= expert_queue_items(F.G)) break;
        if (base < NE * TI_E1) transpose_range<2>(F, scr, base, base + TQ_BATCH, 1);
        else transpose_range<3>(F, scr, base - NE * TI_E1, base - NE * TI_E1 + TQ_BATCH, 1);
    }
}

__device__ __forceinline__ void p1_quant_weights(Frame& F) {
    __syncthreads();
    LAS float* scr = (LAS float*)(F.lds + F.wave * 8704);
    const int gw = F.vcu * NWAVES + F.wave, NGW = F.G * NWAVES;
    transpose_range<8>(F, scr, gw, (D / 64) * (IN_COLS / 32), NGW);
    for (int n = F.vcu * NTHR + F.tid; n < IN_COLS; n += F.G * NTHR) F.SB[win_row(n)] = __uint_as_float(((const unsigned*)(F.ctl + CW_CMAX))[n]) * (1.f / 127.f);
}
__device__ __forceinline__ void p1_quant_wout(Frame& F) {
    const int gw = F.vcu * NWAVES + F.wave, NGW = F.G * NWAVES, lane = F.lane;
    for (int n = gw; n < D; n += NGW) {
        const unsigned cmb = ((const unsigned*)(F.ctl + CW_CMAX2))[n]; const float cm = __uint_as_float(cmb), iv = cm > 0.f ? 127.f / cm : 0.f;
        const bf16* src = F.WOUT + (size_t)n * D; unsigned char* dst = F.WOA8 + (size_t)n * (D / 2);
        v4u v[4];
#pragma unroll
        for (int j = 0; j < 4; ++j) v[j] = *(const v4u*)(src + 512 * j + 8 * lane);
#pragma unroll
        for (int j = 0; j < 4; ++j) *(v2u*)(dst + 512 * j + 8 * lane) = (v2u){pk4_i8(bf_lo(v[j].x) * iv, bf_hi(v[j].x) * iv, bf_lo(v[j].y) * iv, bf_hi(v[j].y) * iv), pk4_i8(bf_lo(v[j].z) * iv, bf_hi(v[j].z) * iv, bf_lo(v[j].w) * iv, bf_hi(v[j].w) * iv)};
        if (lane == 0) F.SB2[n] = cm * (1.f / 127.f);
    }
}
__device__ __forceinline__ void p1_norm(Frame& F) {
    LAS float* fac = (LAS float*)F.lds; LAS float* sh = fac + D;
    const int gw = F.vcu * NWAVES + F.wave, NGW = F.G * NWAVES;
    for (int bb = 0; bb < 5; ++bb) {
        __syncthreads();
        for (int i = F.tid; i < D; i += NTHR) { fac[i] = F.norm1[i] * (1.f + F.ADA[bb * ADA_N + D + i]); sh[i] = F.ADA[bb * ADA_N + i]; }
        __syncthreads();
        const int nrows = bb < 4 ? SEQ : TC; const float* src = bb < 4 ? F.x + (size_t)bb * SEQ * D : F.ctx; const int drow0 = bb < 4 ? bb * SEQ : T;
        for (int r = gw; r < nrows; r += 2 * NGW) {
            int lane = F.lane; asm volatile("" : "+v"(lane));
            const int r2 = r + NGW; const bool has2 = r2 < nrows; const int r2c = has2 ? r2 : r;
            const f32x4* xa = (const f32x4*)(src + (size_t)r * D) + lane; const f32x4* xb = (const f32x4*)(src + (size_t)r2c * D) + lane;
            f32x4 va[16], vb[16]; float sa = 0.f, sb = 0.f;
#pragma unroll
            for (int j = 0; j < 16; ++j) { va[j] = xa[64 * j]; vb[j] = xb[64 * j]; }
#pragma unroll
            for (int j = 0; j < 16; ++j) { sa = fmaf(va[j][0], va[j][0], fmaf(va[j][1], va[j][1], fmaf(va[j][2], va[j][2], fmaf(va[j][3], va[j][3], sa))));
                                           sb = fmaf(vb[j][0], vb[j][0], fmaf(vb[j][1], vb[j][1], fmaf(vb[j][2], vb[j][2], fmaf(vb[j][3], vb[j][3], sb)))); }
            const float ra = rsqrtf(wave_sum(sa) * (1.f / D) + EPS), rb = rsqrtf(wave_sum(sb) * (1.f / D) + EPS);
#pragma unroll
            for (int j = 0; j < 16; ++j) { const f32x4 fa = *(const LAS f32x4*)(fac + 256 * j + 4 * lane), sv = *(const LAS f32x4*)(sh + 256 * j + 4 * lane);
                va[j] = va[j] * ra * fa + sv; vb[j] = vb[j] * rb * fa + sv; }
            {
                float ma = 0.f, mb = 0.f;
#pragma unroll
                for (int j = 0; j < 16; ++j) { ma = fmaxf(ma, fmaxf(fmaxf(fabsf(va[j][0]), fabsf(va[j][1])), fmaxf(fabsf(va[j][2]), fabsf(va[j][3])))); mb = fmaxf(mb, fmaxf(fmaxf(fabsf(vb[j][0]), fabsf(vb[j][1])), fmaxf(fabsf(vb[j][2]), fabsf(vb[j][3])))); }
                ma = wave_max(ma); mb = wave_max(mb);
                const float ia = ma > 0.f ? 127.f / ma : 0.f, ib = mb > 0.f ? 127.f / mb : 0.f;
                if (lane == 0) { F.SA[drow0 + r] = ma * (1.f / 127.f); if (has2) F.SA[drow0 + r2c] = mb * (1.f / 127.f); }
#pragma unroll
                for (int j = 0; j < 16; ++j) { ((unsigned*)(F.XM8 + (size_t)(drow0 + r) * D) + lane)[64 * j] = pk4_i8(va[j][0] * ia, va[j][1] * ia, va[j][2] * ia, va[j][3] * ia);
                    if (has2) ((unsigned*)(F.XM8 + (size_t)(drow0 + r2c) * D) + lane)[64 * j] = pk4_i8(vb[j][0] * ib, vb[j][1] * ib, vb[j][2] * ib, vb[j][3] * ib); }
            }
        }
    }
}

namespace ml {
constexpr int QP = 272, VP = 160, PP = 144, CP = 272;
constexpr int OFF_Q = 0, OFF_K = OFF_Q + 64 * QP, OFF_V = OFF_K + 64 * QP, OFF_VW = OFF_V + 64 * VP, OFF_P = OFF_VW + 64 * VP, OFF_CB = OFF_P + 64 * PP, CB_BYTES = 80 * CP, LDS_END = OFF_CB + 2 * CB_BYTES;
static_assert(LDS_END <= RING_BYTES, "mlstm LDS");
typedef short s16x4 __attribute__((ext_vector_type(4)));
typedef short bf16x8 __attribute__((ext_vector_type(8)));
__device__ __forceinline__ s16x4 tr(const LAS unsigned char* p) { return __builtin_bit_cast(s16x4, __builtin_amdgcn_ds_read_tr16_b64_v4i16((LAS s16x4*)p)); }
__device__ __forceinline__ bf16x8 trfrag(const LAS unsigned char* p, int pitch) { const s16x4 a = tr(p), b = tr(p + 4 * pitch); return (bf16x8){a[0], a[1], a[2], a[3], b[0], b[1], b[2], b[3]}; }
__device__ __forceinline__ bf16x8 ld16(const LAS unsigned char* p) { return *(const LAS bf16x8*)p; }
__device__ __forceinline__ int row_of(int c, int p, int dir, int b) {
    if (c < 4) { const int i = 64 * c + p; return T + b * CTXL + (dir ? (CTXL - 1 - i) : i); }
    const int i = 64 * (c - 4) + p; return b * SEQ + (dir ? (SEQ - 1 - i) : i);
}
}
#define ML_BAR() do { asm volatile("s_waitcnt lgkmcnt(0)" ::: "memory"); __builtin_amdgcn_s_barrier(); asm volatile("" ::: "memory"); } while (0)
__device__ __forceinline__ void p3_mlstm(Frame& F) {
    using namespace ml;
    LAS unsigned char* lds = F.lds;
    const int tid = F.tid, lane = F.lane, wave = F.wave, li = lane & 15, lg = lane >> 4, lq = (lane & 15) >> 2, lp = lane & 3;
    constexpr float QS = 0.08838834764831845f;
    constexpr int NCH = 4 + SEQ / 64;
    constexpr int SC_A = LDS_END, SC_M = SC_A + 256, SC_B = SC_M + 256;
    constexpr int HSCR_OFF = SC_B + 256;
    static_assert(HSCR_OFF + NWAVES * 4352 <= LDSCTL_OFF, "mlstm LDS");
    for (int unit = F.vcu; unit < NB * NH * 2 * 4; unit += F.G) {
        const int vq = unit & 3, dir = (unit >> 2) & 1, h = (unit >> 3) & 7, b = unit >> 6;
        bf16* HO = dir ? F.HB : F.HF;
        __syncthreads();
        unsigned z0 = 0u; asm volatile("" : "+v"(z0));
        for (int i = tid; i < CB_BYTES / 16; i += NTHR) *(LAS v4u*)(lds + OFF_CB + 16 * i) = (v4u){z0, z0, z0, z0};
        if (tid < 64) { *(LAS v4u*)(lds + OFF_V + tid * VP + 128) = (v4u){0x00003F80u | z0, z0, z0, z0}; *(LAS v4u*)(lds + OFF_V + tid * VP + 144) = (v4u){z0, z0, z0, z0};
                        *(LAS v4u*)(lds + OFF_VW + tid * VP + 128) = (v4u){z0, z0, z0, z0}; *(LAS v4u*)(lds + OFF_VW + tid * VP + 144) = (v4u){z0, z0, z0, z0}; }
        f32x4 Cacc[5];
#pragma unroll
        for (int i = 0; i < 5; ++i) Cacc[i] = (f32x4){0.f, 0.f, 0.f, 0.f};
        v4u rq[2], rk[2], rv; float ig, fp;
        rq[0] = rq[1] = (v4u){0u, 0u, 0u, 0u};
        const GAS bf16* pk_[2]; const GAS bf16* pv_; const GAS float* pg_;
#define ML_SETPTR(cc) do { const int cs_ = (cc); \
        _Pragma("unroll") for (int i = 0; i < 2; ++i) { const int id = tid + NTHR * i, p = id >> 4, ch = id & 15; pk_[i] = (const GAS bf16*)F.PROJ + (size_t)row_of(cs_, p, dir, b) * NPROJ + COL_K + h * DK + 8 * ch; } \
        { const int p = tid >> 3, ch = tid & 7; pv_ = (const GAS bf16*)F.PROJ + (size_t)row_of(cs_, p, dir, b) * NPROJ + COL_V + h * DV + vq * 64 + 8 * ch; } \
        pg_ = (const GAS float*)F.GATES + (size_t)row_of(cs_, lane, dir, b) * 32 + dir * 16 + h; } while (0)
#define ML_PREFETCH(cc) do { const int c_ = (cc); if (c_ == 0 || c_ == 4) ML_SETPTR(c_); \
        _Pragma("unroll") for (int i = 0; i < 2; ++i) { rk[i] = *(const GAS v4u*)pk_[i]; rq[i] = *(const GAS v4u*)(pk_[i] + (COL_Q - COL_K)); pk_[i] += pstep; } \
        rv = *(const GAS v4u*)pv_; pv_ += pstep; ig = pg_[0]; fp = pg_[8]; pg_ += gstep; } while (0)
        const long pstep = (dir ? -64 : 64) * (long)NPROJ, gstep = (dir ? -64 : 64) * 32;
        float bc, g, Ap, Mp, M63, wS, decay, wsv, m = 0.f;
#define ML_SCALARS(m_in) do { const float lf_ = fminf(fp, 0.f) - 0.6931471805599453f * __log2f(1.f + __expf(-fabsf(fp))); \
        bc = wave_incl_sum(lf_); g = lane_bcast(bc, 63); Ap = ig - bc; const float PA_ = wave_incl_max(Ap), Amax_ = lane_bcast(PA_, 63); \
        Mp = fmaxf((m_in), PA_); M63 = fmaxf((m_in), Amax_); wS = __expf(Ap - M63); decay = __expf((m_in) - M63); wsv = __shfl(wS, 8 * wave + (lane >> 3)); } while (0)
#define ML_STAGE() do { \
        _Pragma("unroll") for (int i = 0; i < 2; ++i) { const int id = tid + NTHR * i, p = id >> 4, ch = id & 15; \
            *(LAS v4u*)(lds + OFF_K + p * QP + 16 * ch) = rk[i]; *(LAS v4u*)(lds + OFF_Q + p * QP + 16 * ch) = rq[i]; } \
        { const int p = tid >> 3, ch = tid & 7; \
          *(LAS v4u*)(lds + OFF_V + p * VP + 16 * ch) = rv; \
          v4u o; o.x = pk2(bf_lo(rv.x) * wsv, bf_hi(rv.x) * wsv); o.y = pk2(bf_lo(rv.y) * wsv, bf_hi(rv.y) * wsv); o.z = pk2(bf_lo(rv.z) * wsv, bf_hi(rv.z) * wsv); o.w = pk2(bf_lo(rv.w) * wsv, bf_hi(rv.w) * wsv); \
          *(LAS v4u*)(lds + OFF_VW + p * VP + 16 * ch) = o; } \
        if (wave == 0) { *(LAS unsigned short*)(lds + OFF_VW + lane * VP + 128) = (unsigned short)(pk2(wS, 0.f) & 0xffffu); \
                         *(LAS float*)(lds + SC_A + 4 * lane) = Ap; *(LAS float*)(lds + SC_M + 4 * lane) = Mp; *(LAS float*)(lds + SC_B + 4 * lane) = bc; } } while (0)
        ML_PREFETCH(0);
        const int tt = wave >> 1, trow = 16 * tt + li, vt0 = (wave & 1) ? 2 : 0, dt = wave;
        const int hi0 = 2 * expert_queue_items(F.G) + (unit / F.G) * NCH * (F.G * NWAVES) + F.vcu * NWAVES + wave;
        LAS float* hscr = (LAS float*)(lds + HSCR_OFF + wave * 4352);
        ML_SCALARS(m);
        ML_BAR();
        ML_STAGE();
        constexpr int HLIM = 2 * NE * (TI_E1 + TI_E2);
        f32x4 hvA[4], hvB[4];
        { const int h0 = hi0 < HLIM ? hi0 : HLIM - 1; hitem_load(hitem_decode(F, h0), lane, hvA); }
        auto step = [&](const int c, f32x4 (&hvn)[4], f32x4 (&hvo)[4]) __attribute__((always_inline)) {
            const bool lat = c >= 4;
            ML_BAR();
            const float dec_c = decay, m_c = m, m_next = g + M63;
            ML_PREFETCH(c + 1);
            const int hi = hi0 + c * (F.G * NWAVES);
            const bool hact = hi < HLIM;
            f32x4 oacc[3];
#pragma unroll
            for (int j = 0; j < 3; ++j) oacc[j] = (f32x4){0.f, 0.f, 0.f, 0.f};
            float Mt = 0.f; v2u hout[2] = {(v2u){0u, 0u}, (v2u){0u, 0u}};
            if (lat) {
                bf16x8 Bq[4], Ak[2][4], Cf[3][4];
                const LAS unsigned char* cbo = lds + OFF_CB + (c & 1) * CB_BYTES;
#pragma unroll
                for (int ks = 0; ks < 4; ++ks) Bq[ks] = ld16(lds + OFF_Q + trow * QP + 64 * ks + 16 * lg);
#pragma unroll
                for (int sti = 0; sti < 2; ++sti)
#pragma unroll
                    for (int ks = 0; ks < 4; ++ks) Ak[sti][ks] = ld16(lds + OFF_K + (16 * (2 * (wave & 1) + sti) + li) * QP + 64 * ks + 16 * lg);
                Mt = *(const LAS float*)(lds + SC_M + 4 * trow);
                f32x4 A4[2];
#pragma unroll
                for (int sti = 0; sti < 2; ++sti) A4[sti] = *(const LAS f32x4*)(lds + SC_A + 4 * (16 * (2 * (wave & 1) + sti) + 4 * lg));
#pragma unroll
                for (int j = 0; j < 3; ++j)
#pragma unroll
                    for (int ks = 0; ks < 4; ++ks) Cf[j][ks] = ld16(cbo + (16 * (j < 2 ? vt0 + j : 4) + li) * CP + 64 * ks + 16 * lg);
                f32x4 sacc[2];
#pragma unroll
                for (int sti = 0; sti < 2; ++sti) { sacc[sti] = (f32x4){0.f, 0.f, 0.f, 0.f};
#pragma unroll
                    for (int ks = 0; ks < 4; ++ks) sacc[sti] = __builtin_amdgcn_mfma_f32_16x16x32_bf16(Ak[sti][ks], Bq[ks], sacc[sti], 0, 0, 0); }
#pragma unroll
                for (int ks = 0; ks < 4; ++ks)
#pragma unroll
                    for (int j = 0; j < 3; ++j) oacc[j] = __builtin_amdgcn_mfma_f32_16x16x32_bf16(Cf[j][ks], Bq[ks], oacc[j], 0, 0, 0);
#pragma unroll
                for (int sti = 0; sti < 2; ++sti) { const int st = 2 * (wave & 1) + sti; float v[4];
#pragma unroll
                    for (int r = 0; r < 4; ++r) { const int sp = 16 * st + 4 * lg + r; v[r] = sp <= trow ? sacc[sti][r] * QS * __expf(A4[sti][r] - Mt) : 0.f; }
                    *(LAS v2u*)(lds + OFF_P + trow * PP + 2 * (16 * st + 4 * lg)) = (v2u){pk2(v[0], v[1]), pk2(v[2], v[3])}; }
                const float e2 = __expf(m_c - Mt) * QS;
#pragma unroll
                for (int j = 0; j < 3; ++j) oacc[j] = oacc[j] * e2;
            }
            {
                bf16x8 At[2], Bt[5][2];
#pragma unroll
                for (int ks = 0; ks < 2; ++ks) At[ks] = trfrag(lds + OFF_K + (32 * ks + 8 * lg + lq) * QP + 32 * dt + 8 * lp, QP);
#pragma unroll
                for (int vt = 0; vt < 5; ++vt)
#pragma unroll
                    for (int ks = 0; ks < 2; ++ks) Bt[vt][ks] = trfrag(lds + OFF_VW + (32 * ks + 8 * lg + lq) * VP + 32 * vt + 8 * lp, VP);
#pragma unroll
                for (int vt = 0; vt < 5; ++vt) Cacc[vt] = Cacc[vt] * dec_c;
#pragma unroll
                for (int ks = 0; ks < 2; ++ks)
#pragma unroll
                    for (int vt = 0; vt < 5; ++vt) Cacc[vt] = __builtin_amdgcn_mfma_f32_16x16x32_bf16(At[ks], Bt[vt][ks], Cacc[vt], 0, 0, 0);
                LAS unsigned char* cbn = lds + OFF_CB + ((c + 1) & 1) * CB_BYTES;
#pragma unroll
                for (int vt = 0; vt < 5; ++vt) *(LAS v2u*)(cbn + (16 * vt + li) * CP + 2 * (16 * dt + 4 * lg)) = (v2u){pk2(Cacc[vt][0], Cacc[vt][1]), pk2(Cacc[vt][2], Cacc[vt][3])};
            }
            if (hact) hitem_to_lds(lane, hvo, hscr);
            { const int hn = hi + F.G * NWAVES; hitem_load(hitem_decode(F, hn < HLIM ? hn : HLIM - 1), lane, hvn); }
            ML_BAR();
            if (lat) {
                bf16x8 Pf[2], Vt[3][2];
#pragma unroll
                for (int ks = 0; ks < 2; ++ks) Pf[ks] = ld16(lds + OFF_P + trow * PP + 64 * ks + 16 * lg);
#pragma unroll
                for (int j = 0; j < 3; ++j)
#pragma unroll
                    for (int ks = 0; ks < 2; ++ks) Vt[j][ks] = trfrag(lds + OFF_V + (32 * ks + 8 * lg + lq) * VP + 32 * (j < 2 ? vt0 + j : 4) + 8 * lp, VP);
                const float bct = *(const LAS float*)(lds + SC_B + 4 * trow);
#pragma unroll
                for (int ks = 0; ks < 2; ++ks)
#pragma unroll
                    for (int j = 0; j < 3; ++j) oacc[j] = __builtin_amdgcn_mfma_f32_16x16x32_bf16(Vt[j][ks], Pf[ks], oacc[j], 0, 0, 0);
                const float den = __shfl(oacc[2][0], li);
                const float inv = 1.f / fmaxf(fabsf(den), __expf(-(bct + Mt)));
#pragma unroll
                for (int j = 0; j < 2; ++j) { const f32x4 o = oacc[j] * inv; hout[j] = (v2u){pk2(o[0], o[1]), pk2(o[2], o[3])}; }
            }
            float hr[16];
            if (hact) hitem_read(lane, hscr, hr);
            m = m_next;
            if (c + 1 < NCH) ML_SCALARS(m);
            asm volatile("; chunk c+1 pieces are used here so that the wait for them sits in front of this step's stores" : "+v"(rk[0]), "+v"(rk[1]), "+v"(rq[0]), "+v"(rq[1]), "+v"(rv) :: "memory");
            if (lat) { bf16* hp = HO + (size_t)row_of(c, trow, dir, b) * 2048 + h * DV + vq * 64 + 4 * lg;
#pragma unroll
                for (int j = 0; j < 2; ++j) gstore8_hidden(hp + 16 * (vt0 + j), hout[j]); }
            if (hact) hitem_pack_store(hitem_decode(F, hi), lane, hr);
            ML_BAR();
            if (c + 1 < NCH) ML_STAGE();
        };
        static_assert(NCH % 2 == 0, "two steps per trip");
        for (int c = 0; c < NCH; c += 2) { step(c, hvB, hvA); step(c + 1, hvA, hvB); }
        asm volatile("s_waitcnt vmcnt(0) ; the hidden stores of the loop" ::: "memory");
#undef ML_PREFETCH
#undef ML_SETPTR
#undef ML_SCALARS
#undef ML_STAGE
    }
}

__device__ __forceinline__ void p4_mix(Frame& F) {
    const int gw = F.vcu * NWAVES + F.wave, NGW = F.G * NWAVES;
    LAS float* cwl = (LAS float*)F.lds; LAS float* hnl = cwl + 3 * 2048;
    __syncthreads();
    for (int i = F.tid; i < 3 * 2048 / 4; i += NTHR) *(LAS f32x4*)(cwl + 4 * i) = *(const f32x4*)(F.conv_w + 4 * i);
    for (int i = F.tid; i < 2048 / 4; i += NTHR) *(LAS f32x4*)(hnl + 4 * i) = *(const f32x4*)(F.head_norm + 4 * i);
    __syncthreads();
    for (int r = gw; r < T; r += NGW) {
        int lane = F.lane; asm volatile("" : "+v"(lane));
        const int s = r & (SEQ - 1), gr = s >> 6, gc = s & 63;
        const bf16* pr = F.PROJ + (size_t)r * NPROJ;
        bf16* mr = F.MIX + (size_t)r * D;
        {
            v2u ha[NH], hb[NH], og[NH];
#pragma unroll
            for (int hh = 0; hh < NH; ++hh) { const int idx = hh * DV + 4 * lane;
                ha[hh] = *(const v2u*)(F.HF + (size_t)r * 2048 + idx); hb[hh] = *(const v2u*)(F.HB + (size_t)r * 2048 + idx); og[hh] = *(const v2u*)(pr + COL_O + idx); }
            f32x4 hs[NH]; float ss[NH];
#pragma unroll
            for (int hh = 0; hh < NH; ++hh) { hs[hh] = (f32x4){bf_lo(ha[hh].x) + bf_lo(hb[hh].x), bf_hi(ha[hh].x) + bf_hi(hb[hh].x), bf_lo(ha[hh].y) + bf_lo(hb[hh].y), bf_hi(ha[hh].y) + bf_hi(hb[hh].y)};
                ss[hh] = (hs[hh][0] * hs[hh][0] + hs[hh][1] * hs[hh][1]) + (hs[hh][2] * hs[hh][2] + hs[hh][3] * hs[hh][3]); }
#pragma unroll
            for (int hh = 0; hh < NH; ++hh) ss[hh] = wave_sum(ss[hh]);
            float ym = 0.f;
#pragma unroll
            for (int hh = 0; hh < NH; ++hh) { const float rs = rsqrtf(ss[hh] * (1.f / DV) + EPS); const f32x4 hw = *(const LAS f32x4*)(hnl + hh * DV + 4 * lane);
                hs[hh][0] = hs[hh][0] * rs * hw[0] * sigmoidf_(bf_lo(og[hh].x)); hs[hh][1] = hs[hh][1] * rs * hw[1] * sigmoidf_(bf_hi(og[hh].x));
                hs[hh][2] = hs[hh][2] * rs * hw[2] * sigmoidf_(bf_lo(og[hh].y)); hs[hh][3] = hs[hh][3] * rs * hw[3] * sigmoidf_(bf_hi(og[hh].y));
                ym = fmaxf(ym, fmaxf(fmaxf(fabsf(hs[hh][0]), fabsf(hs[hh][1])), fmaxf(fabsf(hs[hh][2]), fabsf(hs[hh][3])))); }
            ym = wave_max(ym);
            const float iy = ym > 0.f ? 127.f / ym : 0.f;
            if (lane == 0) F.SA[r] = ym * (1.f / 127.f);
#pragma unroll
            for (int hh = 0; hh < NH; ++hh) *(unsigned*)(F.MIXA8 + (size_t)r * (D / 2) + hh * DV + 4 * lane) = pk4_i8(hs[hh][0] * iy, hs[hh][1] * iy, hs[hh][2] * iy, hs[hh][3] * iy);
        }
#pragma unroll
        for (int jb = 0; jb < 2; ++jb) {
            const int dt = jb == 0 ? 1 : 64;
            const bool vm = jb == 0 ? (gc > 0) : (gr > 0), vp = jb == 0 ? (gc < 63) : (gr < 63);
            const bf16* pm = vm ? pr - (size_t)dt * NPROJ : pr; const bf16* pp = vp ? pr + (size_t)dt * NPROJ : pr;
            const float fm = vm ? 1.f : 0.f, fp = vp ? 1.f : 0.f;
            v4u cu0[2], cb0[2], cum[2], cup[2];
#pragma unroll
            for (int q = 0; q < 2; ++q) { const int cch = 512 * (2 * jb + q) + 8 * lane;
                cu0[q] = *(const v4u*)(pr + COL_CC + cch); cb0[q] = *(const v4u*)(pr + COL_CB + cch);
                cum[q] = *(const v4u*)(pm + COL_CC + cch); cup[q] = *(const v4u*)(pp + COL_CC + cch); }
#pragma unroll
            for (int q = 0; q < 2; ++q) { const int cch = 512 * (2 * jb + q) + 8 * lane;
                const unsigned u0w[4] = {cu0[q].x, cu0[q].y, cu0[q].z, cu0[q].w}, umw[4] = {cum[q].x, cum[q].y, cum[q].z, cum[q].w}, upw[4] = {cup[q].x, cup[q].y, cup[q].z, cup[q].w}, cbw[4] = {cb0[q].x, cb0[q].y, cb0[q].z, cb0[q].w};
                unsigned o[4];
#pragma unroll
                for (int hq = 0; hq < 2; ++hq) { const f32x4 w0 = *(const LAS f32x4*)(cwl + cch + 4 * hq), w1 = *(const LAS f32x4*)(cwl + 2048 + cch + 4 * hq), w2 = *(const LAS f32x4*)(cwl + 4096 + cch + 4 * hq);
#pragma unroll
                    for (int e2 = 0; e2 < 2; ++e2) { const int wi = 2 * hq + e2;
                        const float ya = bf_lo(cbw[wi]) * (w0[2 * e2] * (bf_lo(umw[wi]) * fm) + w1[2 * e2] * bf_lo(u0w[wi]) + w2[2 * e2] * (bf_lo(upw[wi]) * fp));
                        const float yb = bf_hi(cbw[wi]) * (w0[2 * e2 + 1] * (bf_hi(umw[wi]) * fm) + w1[2 * e2 + 1] * bf_hi(u0w[wi]) + w2[2 * e2 + 1] * (bf_hi(upw[wi]) * fp));
                        o[wi] = pk2(ya, yb); } }
                *(v4u*)(mr + 2048 + cch) = (v4u){o[0], o[1], o[2], o[3]}; }
        }
    }
}

__device__ __forceinline__ float p6_row_pass1(Frame& F, int row0, bool act, const LAS float* fac, const LAS float* sh) {
    const int lane = F.lane;
    const v2u* da = (const v2u*)(F.X1B + (size_t)row0 * D) + lane;
    float sa = 0.f;
    v2u dd[16];
#pragma unroll
    for (int j = 0; j < 16; ++j) dd[j] = da[64 * j];
#pragma unroll
    for (int j = 0; j < 16; ++j) { const float a0 = bf_lo(dd[j].x), a1 = bf_hi(dd[j].x), a2 = bf_lo(dd[j].y), a3 = bf_hi(dd[j].y); sa = fmaf(a0, a0, fmaf(a1, a1, fmaf(a2, a2, fmaf(a3, a3, sa)))); }
    const float rsa = rsqrtf(wave_sum(sa) * (1.f / D) + EPS);
    unsigned* oa = (unsigned*)((unsigned char*)F.XF + (size_t)row0 * D) + lane;
#pragma unroll
    for (int j = 0; j < 16; ++j) { const f32x4 fa = *(const LAS f32x4*)(fac + 256 * j + 4 * lane), sv = *(const LAS f32x4*)(sh + 256 * j + 4 * lane);
        const f32x4 xn = (f32x4){bf_lo(dd[j].x), bf_hi(dd[j].x), bf_lo(dd[j].y), bf_hi(dd[j].y)} * rsa * fa + sv;
        if (act) oa[64 * j] = pk4_fp8(xn[0], xn[1], xn[2], xn[3]); }
    return rsa;
}
__device__ __forceinline__ void p6_xquarter(Frame& F, int row, float rs, int j0, int nj, const LAS float* fac, const LAS float* sh, f32x4 (&xo)[4]) {
    const int lane = F.lane;
    const v2u* d0 = (const v2u*)(F.X1B + (size_t)row * D) + lane;
    v2u q0[4];
#pragma unroll
    for (int jj = 0; jj < 4; ++jj) if (jj < nj) q0[jj] = d0[64 * (j0 + jj)];
#pragma unroll
    for (int jj = 0; jj < 4; ++jj) if (jj < nj) { const int j = j0 + jj; const f32x4 fa = *(const LAS f32x4*)(fac + 256 * j + 4 * lane), sv = *(const LAS f32x4*)(sh + 256 * j + 4 * lane);
        xo[jj] = (f32x4){bf_lo(q0[jj].x), bf_hi(q0[jj].x), bf_lo(q0[jj].y), bf_hi(q0[jj].y)} * rs * fa + sv; }
}
__device__ __forceinline__ void p6_pick_group(Frame& F, const float (&g)[4], int& gs, float& psel) {
    float gl[4];
#pragma unroll
    for (int o = 0; o < 4; ++o) gl[o] = g[o] + F.b_rg[o];
    gs = 0; float gm = gl[0];
#pragma unroll
    for (int o = 1; o < 4; ++o) if (gl[o] > gm) { gm = gl[o]; gs = o; }
    float den = 0.f;
#pragma unroll
    for (int o = 0; o < 4; ++o) den += expf(gl[o] - gm);
    psel = 1.f / den;
}
__device__ __forceinline__ void p6_pick_experts(Frame& F, const float (&ed)[4], int gs, float psel, bool act, LAS int* ri) {
    float ev[4];
#pragma unroll
    for (int o = 0; o < 4; ++o) ev[o] = ed[o] + F.b_re[gs * 4 + o];
    int i0 = 0; float v0 = ev[0];
#pragma unroll
    for (int o = 1; o < 4; ++o) if (ev[o] > v0) { v0 = ev[o]; i0 = o; }
    int i1 = -1; float v1 = -3.0e38f;
#pragma unroll
    for (int o = 0; o < 4; ++o) if (o != i0 && ev[o] > v1) { v1 = ev[o]; i1 = o; }
    const float e1x = expf(v1 - v0); const float w0 = psel / (1.f + e1x), w1 = psel * e1x / (1.f + e1x);
    if (F.lane == 0) { ri[0] = act ? gs * 4 + i0 : -1; ri[1] = act ? gs * 4 + i1 : -1; ri[2] = __float_as_int(w0); ri[3] = __float_as_int(w1); }
}
__device__ __forceinline__ void p6_norm_router(Frame& F) {
    constexpr int R = 4;
    LAS float* fac = (LAS float*)F.lds; LAS float* sh = fac + D;
    LAS float* wg = (LAS float*)(F.lds + 32768);
    LAS float* we = (LAS float*)(F.lds + 98304);
    LAS int* rinfo = (LAS int*)(F.lds + 131072);
    const int wave = F.wave, lane = F.lane;
    const int nblk = T / (8 * R), per = (nblk + F.G - 1) / F.G;
    __syncthreads();
    for (int c = F.tid; c < D; c += NTHR) { const f32x4 g4 = *(const f32x4*)(F.w_rg + (size_t)c * 4); wg[c] = g4[0]; wg[D + c] = g4[1]; wg[2 * D + c] = g4[2]; wg[3 * D + c] = g4[3]; }
    int curb = -1;
    for (int it = 0; it < per; ++it) {
        const int rb = F.vcu * per + it;
        const bool act = rb < nblk;
        const int rowb = (act ? rb : 0) * (8 * R) + wave;
        const int b = rowb >> 12;
        if (b != curb) {
            __syncthreads();
            for (int i = F.tid; i < D; i += NTHR) { fac[i] = F.norm2[i] * (1.f + F.ADA[b * ADA_N + 4 * D + i]); sh[i] = F.ADA[b * ADA_N + 3 * D + i]; }
            curb = b;
        }
        __syncthreads();
        float rs[R];
#pragma unroll
        for (int k = 0; k < R; ++k) rs[k] = p6_row_pass1(F, rowb + 8 * k, act, fac, sh);
        float gd[R][4];
#pragma unroll
        for (int k = 0; k < R; ++k)
#pragma unroll
            for (int o = 0; o < 4; ++o) gd[k][o] = 0.f;
#pragma unroll 1
        for (int q = 0; q < 4; ++q) { f32x4 xv[R][4];
#pragma unroll
            for (int k = 0; k < R; ++k) p6_xquarter(F, rowb + 8 * k, rs[k], 4 * q, 4, fac, sh, xv[k]);
#pragma unroll
            for (int o = 0; o < 4; ++o)
#pragma unroll
                for (int jj = 0; jj < 4; ++jj) { const f32x4 w4 = *(const LAS f32x4*)(wg + o * D + 256 * (4 * q + jj) + 4 * lane);
#pragma unroll
                    for (int k = 0; k < R; ++k) { const f32x4 a4 = xv[k][jj]; gd[k][o] = fmaf(a4[3], w4[3], fmaf(a4[2], w4[2], fmaf(a4[1], w4[1], fmaf(a4[0], w4[0], gd[k][o])))); } } }
        int gs[R]; float ps[R];
#pragma unroll
        for (int k = 0; k < R; ++k) {
#pragma unroll
            for (int o = 0; o < 4; ++o) gd[k][o] = wave_sum(gd[k][o]);
            p6_pick_group(F, gd[k], gs[k], ps[k]); gs[k] = __builtin_amdgcn_readfirstlane(gs[k]); }
        float ed[R][4];
#pragma unroll
        for (int k = 0; k < R; ++k)
#pragma unroll
            for (int o = 0; o < 4; ++o) ed[k][o] = 0.f;
#pragma unroll 1
        for (int ch = 0; ch < 8; ++ch) {
            __syncthreads();
            { const int c = 512 * ch + F.tid;
#pragma unroll
              for (int p = 0; p < 4; ++p) { const f32x4 e4 = *(const f32x4*)(F.w_re + (size_t)c * 16 + 4 * p);
                  we[(4 * p + 0) * 512 + F.tid] = e4[0]; we[(4 * p + 1) * 512 + F.tid] = e4[1]; we[(4 * p + 2) * 512 + F.tid] = e4[2]; we[(4 * p + 3) * 512 + F.tid] = e4[3]; } }
            f32x4 xv[R][4];
#pragma unroll
            for (int k = 0; k < R; ++k) p6_xquarter(F, rowb + 8 * k, rs[k], 2 * ch, 2, fac, sh, xv[k]);
            __syncthreads();
#pragma unroll
            for (int k = 0; k < R; ++k)
#pragma unroll
                for (int o = 0; o < 4; ++o)
#pragma unroll
                    for (int jl = 0; jl < 2; ++jl) { const f32x4 w4 = *(const LAS f32x4*)(we + (gs[k] * 4 + o) * 512 + 256 * jl + 4 * lane); const f32x4 a4 = xv[k][jl];
                        ed[k][o] = fmaf(a4[3], w4[3], fmaf(a4[2], w4[2], fmaf(a4[1], w4[1], fmaf(a4[0], w4[0], ed[k][o])))); }
        }
#pragma unroll
        for (int k = 0; k < R; ++k) {
#pragma unroll
            for (int o = 0; o < 4; ++o) ed[k][o] = wave_sum(ed[k][o]);
            p6_pick_experts(F, ed[k], gs[k], ps[k], act, rinfo + (8 * k + wave) * 4); }
        __syncthreads();
        if (F.tid < NE && act) {
            int e = F.tid; asm volatile("" : "+v"(e)); int n = 0;
            for (int q = 0; q < 16 * R; ++q) n += (rinfo[(q >> 1) * 4 + (q & 1)] == e) ? 1 : 0;
            if (n > 0) {
                int base = (int)__hip_atomic_fetch_add((unsigned*)(F.ctl + CW_CNT + 64 * e), (unsigned)n, RLX_AGENT);
                for (int q = 0; q < 16 * R; ++q) if (rinfo[(q >> 1) * 4 + (q & 1)] == e) {
                    const int tok = rb * (8 * R) + (q >> 1);
                    F.ELIST[e * T + base] = tok * 2 + (q & 1); F.EW[e * T + base] = __int_as_float(rinfo[(q >> 1) * 4 + 2 + (q & 1)]); ++base; }
            }
        }
        __syncthreads();
    }
}

__device__ __forceinline__ void p9_final(Frame& F) {
    LAS float* fnl = (LAS float*)F.lds; LAS float* g2l = fnl + D;
    __syncthreads();
    for (int i = F.tid; i < D / 4; i += NTHR) { *(LAS f32x4*)(fnl + 4 * i) = *(const f32x4*)(F.fnorm + 4 * i);
#pragma unroll
        for (int b = 0; b < NB; ++b) *(LAS f32x4*)(g2l + b * D + 4 * i) = *(const f32x4*)(F.ADA + b * ADA_N + 5 * D + 4 * i) * (1.f / SLOT_SCALE); }
    __syncthreads();
    const int gw = F.vcu * NWAVES + F.wave, NGW = F.G * NWAVES;
    for (int r = gw; r < T; r += NGW) {
        int lane = F.lane; asm volatile("" : "+v"(lane));
        const int b = r >> 12;
        const v4u* xr = (const v4u*)(F.X1B + (size_t)r * D) + lane;
        const v2u* s0 = (const v2u*)((const unsigned char*)F.SLOT + (size_t)r * D) + lane; const v2u* s1 = (const v2u*)((const unsigned char*)F.SLOT + (size_t)(T + r) * D) + lane;
        v4u xx[8]; v2u a0[8], a1[8];
#pragma unroll
        for (int j = 0; j < 8; ++j) { xx[j] = xr[64 * j]; a0[j] = s0[64 * j]; a1[j] = s1[64 * j]; }
        f32x4 v[16]; float s = 0.f;
#pragma unroll
        for (int j = 0; j < 8; ++j) {
            const f32x4 g0 = *(const LAS f32x4*)(g2l + b * D + 512 * j + 8 * lane), g1 = *(const LAS f32x4*)(g2l + b * D + 512 * j + 8 * lane + 4);
            const f32x4 x0 = (f32x4){bf_lo(xx[j].x), bf_hi(xx[j].x), bf_lo(xx[j].y), bf_hi(xx[j].y)}, x1 = (f32x4){bf_lo(xx[j].z), bf_hi(xx[j].z), bf_lo(xx[j].w), bf_hi(xx[j].w)};
            v[2 * j] = x0 + g0 * (fp8x4_to_f32(a0[j].x) + fp8x4_to_f32(a1[j].x)); v[2 * j + 1] = x1 + g1 * (fp8x4_to_f32(a0[j].y) + fp8x4_to_f32(a1[j].y));
            s = fmaf(v[2 * j][0], v[2 * j][0], fmaf(v[2 * j][1], v[2 * j][1], fmaf(v[2 * j][2], v[2 * j][2], fmaf(v[2 * j][3], v[2 * j][3], s))));
            s = fmaf(v[2 * j + 1][0], v[2 * j + 1][0], fmaf(v[2 * j + 1][1], v[2 * j + 1][1], fmaf(v[2 * j + 1][2], v[2 * j + 1][2], fmaf(v[2 * j + 1][3], v[2 * j + 1][3], s)))); }
        const float rstd = rsqrtf(wave_sum(s) * (1.f / D) + EPS);
        float* o = F.out + (size_t)r * D + 8 * lane;
#pragma unroll
        for (int j = 0; j < 8; ++j) { *(f32x4*)(o + 512 * j) = v[2 * j] * rstd * *(const LAS f32x4*)(fnl + 512 * j + 8 * lane); *(f32x4*)(o + 512 * j + 4) = v[2 * j + 1] * rstd * *(const LAS f32x4*)(fnl + 512 * j + 8 * lane + 4);
            if ((j & 1) == 1) asm volatile("" ::: "memory"); }
    }
}

struct SchedProj {
    int G, c;
    __device__ bool next(int i, pg8::Unit& u) const {
        const int L = i * G + c; constexpr int nM = 64, nN = 48, nwg = nM * nN;
        if (L < nwg) {
            int wgid = L; { const int q = nwg / 8, xcd = wgid % 8, off = wgid / 8; wgid = xcd * q + off; }
            const int nig = 8 * nN, gid = wgid / nig, fm = gid * 8;
            u.pm = fm + ((wgid % nig) % 8); u.pn = (wgid % nig) / 8; return true; }
        const int L2 = L - nwg;
        if (L2 < 48) { u.pm = 64 + (L2 & 3); u.pn = 36 + (L2 >> 2); return true; }
        const int L3 = L2 - 48;
        if (L3 < 68) { u.pm = L3; u.pn = 48; return true; }
        return false;
    }
    __device__ __forceinline__ void a_ready(const pg8::Unit&) const {}
    __device__ __forceinline__ void done(const pg8::Unit&) const {}
    __device__ __forceinline__ unsigned row_byteoff(const pg8::Unit&, int) const { return 0u; }
};
struct EpiProj {
    static constexpr bool PERM = true;
    bf16* P; float* Gt; const float* bg;
    __device__ __forceinline__ void operator()(const pg8::f32x4 (&acc)[2][2][4][2], const pg8::Unit& u, int wr, int wc, int fr, int fq) const {
        const int row0 = u.pm * 256 + wr * 64 + fr;
        if (u.pn < 48) {
            const int col0 = u.pn * 256 + wc * 32 + 8 * fq;
#pragma unroll
            for (int ai = 0; ai < 2; ++ai)
#pragma unroll
                for (int m = 0; m < 4; ++m) { bf16* rowp = P + (size_t)(row0 + ai * 128 + m * 16) * NPROJ + col0;
#pragma unroll
                    for (int bj = 0; bj < 2; ++bj) { const pg8::f32x4 v0 = acc[ai][bj][m][0], v1 = acc[ai][bj][m][1];
                        v4u w; w.x = pk2(v0[0], v0[1]); w.y = pk2(v0[2], v0[3]); w.z = pk2(v1[0], v1[1]); w.w = pk2(v1[2], v1[3]);
                        *(v4u*)(rowp + bj * 128) = w; } }
        } else if (wc == 0) {
            const f32x4 b0 = *(const f32x4*)(bg + 8 * fq), b1 = *(const f32x4*)(bg + 8 * fq + 4);
#pragma unroll
            for (int ai = 0; ai < 2; ++ai)
#pragma unroll
                for (int m = 0; m < 4; ++m) { float* gp = Gt + (size_t)(row0 + ai * 128 + m * 16) * 32 + 8 * fq;
                    *(f32x4*)gp = acc[ai][0][m][0] + b0; *(f32x4*)(gp + 4) = acc[ai][0][m][1] + b1; }
        }
    }
};
struct EpiProjI8 {
    static constexpr bool PERM = true;
    bf16* P; const float* sa; const float* sb; float* Gt; const float* bg;
    __device__ __forceinline__ void operator()(const pg8::f32x4 (&acc)[2][2][4][2], const pg8::Unit& u, int wr, int wc, int fr, int fq) const {
        const int row0 = u.pm * 256 + wr * 64 + fr, col0 = u.pn * 256 + wc * 32 + 8 * fq;
        if (u.pn == 48) {
            if (wc == 0) {
                const f32x4 b0 = *(const f32x4*)(bg + 8 * fq), b1 = *(const f32x4*)(bg + 8 * fq + 4), q0 = *(const f32x4*)(sb + NPROJ + 8 * fq), q1 = *(const f32x4*)(sb + NPROJ + 8 * fq + 4);
#pragma unroll
                for (int ai = 0; ai < 2; ++ai)
#pragma unroll
                    for (int m = 0; m < 4; ++m) { const int row = row0 + ai * 128 + m * 16; const float ra = sa[row]; float* gp = Gt + (size_t)row * 32 + 8 * fq;
                        const pg8::i32x4 i0 = __builtin_bit_cast(pg8::i32x4, acc[ai][0][m][0]), i1 = __builtin_bit_cast(pg8::i32x4, acc[ai][0][m][1]);
                        *(f32x4*)gp = (f32x4){(float)i0[0], (float)i0[1], (float)i0[2], (float)i0[3]} * (q0 * ra) + b0; *(f32x4*)(gp + 4) = (f32x4){(float)i1[0], (float)i1[1], (float)i1[2], (float)i1[3]} * (q1 * ra) + b1; }
            }
            return;
        }
        f32x4 sbv[2][2]; float sav[2][4];
#pragma unroll
        for (int bj = 0; bj < 2; ++bj)
#pragma unroll
            for (int n = 0; n < 2; ++n) sbv[bj][n] = *(const f32x4*)(sb + col0 + bj * 128 + 4 * n);
#pragma unroll
        for (int ai = 0; ai < 2; ++ai)
#pragma unroll
            for (int m = 0; m < 4; ++m) sav[ai][m] = sa[row0 + ai * 128 + m * 16];
#pragma unroll
        for (int ai = 0; ai < 2; ++ai)
#pragma unroll
            for (int m = 0; m < 4; ++m) { bf16* rowp = P + (size_t)(row0 + ai * 128 + m * 16) * NPROJ + col0; const float ra = sav[ai][m];
#pragma unroll
                for (int bj = 0; bj < 2; ++bj) { const pg8::i32x4 i0 = __builtin_bit_cast(pg8::i32x4, acc[ai][bj][m][0]), i1 = __builtin_bit_cast(pg8::i32x4, acc[ai][bj][m][1]);
                    const f32x4 s0 = sbv[bj][0] * ra, s1 = sbv[bj][1] * ra;
                    v4u w; w.x = pk2((float)i0[0] * s0[0], (float)i0[1] * s0[1]); w.y = pk2((float)i0[2] * s0[2], (float)i0[3] * s0[3]);
                    w.z = pk2((float)i1[0] * s1[0], (float)i1[1] * s1[1]); w.w = pk2((float)i1[2] * s1[2], (float)i1[3] * s1[3]);
                    *(v4u*)(rowp + bj * 128) = w; } }
    }
    static constexpr int NS = 8, NTAB = 2;
    __device__ __forceinline__ bool stores(const pg8::Unit& u, int wc) const { return u.pn != 48 || wc == 0; }
    __device__ __forceinline__ const void* tab_src(const pg8::Unit& u, int idx) const {
        const int i = idx & 255;
        if (idx < 256) return sa + u.pm * 256 + i;
        if (u.pn == 48) return (i >= 32 && i < 64) ? bg + (i - 32) : sb + NPROJ + (i & 31);
        return sb + u.pn * 256 + i;
    }
    __device__ __forceinline__ void half(const pg8::f32x4 (&acc)[2][2][4][2], const pg8::Unit& u, const int ai, int wr, int wc, int fr, int fq, const LAS float* tab) const {
        const int lrow0 = wr * 64 + fr + ai * 128, row0 = u.pm * 256 + lrow0, col0 = u.pn * 256 + wc * 32 + 8 * fq;
        const LAS float* tb2 = tab + 256;
        if (u.pn == 48) {
            if (wc == 0) {
                const f32x4 q0 = *(const LAS f32x4*)(tb2 + 8 * fq), q1 = *(const LAS f32x4*)(tb2 + 8 * fq + 4), b0 = *(const LAS f32x4*)(tb2 + 32 + 8 * fq), b1 = *(const LAS f32x4*)(tb2 + 36 + 8 * fq);
#pragma unroll
                for (int m = 0; m < 4; ++m) { const float ra = tab[lrow0 + m * 16]; float* gp = Gt + (size_t)(row0 + m * 16) * 32 + 8 * fq;
                    const pg8::i32x4 i0 = __builtin_bit_cast(pg8::i32x4, acc[ai][0][m][0]), i1 = __builtin_bit_cast(pg8::i32x4, acc[ai][0][m][1]);
                    *(f32x4*)gp = (f32x4){(float)i0[0], (float)i0[1], (float)i0[2], (float)i0[3]} * (q0 * ra) + b0; *(f32x4*)(gp + 4) = (f32x4){(float)i1[0], (float)i1[1], (float)i1[2], (float)i1[3]} * (q1 * ra) + b1; }
            }
            return;
        }
        f32x4 sbv[2][2];
#pragma unroll
        for (int bj = 0; bj < 2; ++bj)
#pragma unroll
            for (int n = 0; n < 2; ++n) sbv[bj][n] = *(const LAS f32x4*)(tb2 + wc * 32 + 8 * fq + bj * 128 + 4 * n);
        if (u.pn >= COL_CC / 256 && u.pn < COL_K / 256) {
            const int ch0 = COL_CC + (u.pn - COL_CC / 256) * 128 + wc * 32 + 8 * fq;
#pragma unroll
            for (int m = 0; m < 4; ++m) { bf16* rowp = P + (size_t)(row0 + m * 16) * NPROJ + ch0; const float ra = tab[lrow0 + m * 16];
#pragma unroll
                for (int n = 0; n < 2; ++n) { const pg8::i32x4 ic = __builtin_bit_cast(pg8::i32x4, acc[ai][0][m][n]), ix = __builtin_bit_cast(pg8::i32x4, acc[ai][1][m][n]);
                    const f32x4 sc = sbv[0][n] * ra, sx = sbv[1][n] * ra;
                    *(v2u*)(rowp + 4 * n) = (v2u){pk2(((float)ic[0] * sc[0]) * ((float)ix[0] * sx[0]), ((float)ic[1] * sc[1]) * ((float)ix[1] * sx[1])), pk2(((float)ic[2] * sc[2]) * ((float)ix[2] * sx[2]), ((float)ic[3] * sc[3]) * ((float)ix[3] * sx[3]))}; } }
            return;
        }
#pragma unroll
        for (int m = 0; m < 4; ++m) { bf16* rowp = P + (size_t)(row0 + m * 16) * NPROJ + col0; const float ra = tab[lrow0 + m * 16];
#pragma unroll
            for (int bj = 0; bj < 2; ++bj) { const pg8::i32x4 i0 = __builtin_bit_cast(pg8::i32x4, acc[ai][bj][m][0]), i1 = __builtin_bit_cast(pg8::i32x4, acc[ai][bj][m][1]);
                const f32x4 s0 = sbv[bj][0] * ra, s1 = sbv[bj][1] * ra;
                v4u w; w.x = pk2((float)i0[0] * s0[0], (float)i0[1] * s0[1]); w.y = pk2((float)i0[2] * s0[2], (float)i0[3] * s0[3]);
                w.z = pk2((float)i1[0] * s1[0], (float)i1[1] * s1[1]); w.w = pk2((float)i1[2] * s1[2], (float)i1[3] * s1[3]);
                *(v4u*)(rowp + bj * 128) = w; } }
    }
};
struct SchedStatic {
    int nM, nN, nwg, G, c;
    __device__ void init(int M, int N, int G_, int c_) { nM = M / 256; nN = N / 256; nwg = nM * nN; G = G_; c = c_; }
    __device__ bool next(int i, pg8::Unit& u) const {
        const long L = (long)i * G + c; if (L >= nwg) return false;
        int wgid = (int)L; { const int q = nwg / 8, r = nwg % 8, xcd = wgid % 8, off = wgid / 8; wgid = (xcd < r ? xcd * (q + 1) : r * (q + 1) + (xcd - r) * q) + off; }
        const int nig = 8 * nN, gid = wgid / nig, fm = gid * 8, gsz = (nM - fm) < 8 ? (nM - fm) : 8;
        u.pm = fm + ((wgid % nig) % gsz); u.pn = (wgid % nig) / gsz; return true;
    }
    __device__ __forceinline__ void a_ready(const pg8::Unit&) const {}
    __device__ __forceinline__ void done(const pg8::Unit&) const {}
    __device__ __forceinline__ unsigned row_byteoff(const pg8::Unit&, int) const { return 0u; }
};
struct EpiOut {
    static constexpr bool PERM = true;
    const float* ada; bf16* DL;
    __device__ __forceinline__ void operator()(const pg8::f32x4 (&acc)[2][2][4][2], const pg8::Unit& u, int wr, int wc, int fr, int fq) const {
        const int row0 = u.pm * 256 + wr * 64 + fr, col0 = u.pn * 256 + wc * 32 + 8 * fq;
        const float* g1 = ada + (size_t)(u.pm >> 4) * ADA_N + 2 * D + col0;
        f32x4 gv[2][2];
#pragma unroll
        for (int bj = 0; bj < 2; ++bj)
#pragma unroll
            for (int n = 0; n < 2; ++n) gv[bj][n] = *(const f32x4*)(g1 + bj * 128 + 4 * n);
#pragma unroll
        for (int ai = 0; ai < 2; ++ai)
#pragma unroll
            for (int m = 0; m < 4; ++m) { bf16* rowp = DL + (size_t)(row0 + ai * 128 + m * 16) * D + col0;
#pragma unroll
                for (int bj = 0; bj < 2; ++bj) { const pg8::f32x4 v0 = acc[ai][bj][m][0] * gv[bj][0], v1 = acc[ai][bj][m][1] * gv[bj][1];
                    v4u w; w.x = pk2(v0[0], v0[1]); w.y = pk2(v0[2], v0[3]); w.z = pk2(v1[0], v1[1]); w.w = pk2(v1[2], v1[3]);
                    *(v4u*)(rowp + bj * 128) = w; } }
    }
    static constexpr int NS = 8, NTAB = 1;
    __device__ __forceinline__ bool stores(const pg8::Unit&, int) const { return true; }
    __device__ __forceinline__ const void* tab_src(const pg8::Unit& u, int idx) const { return ada + (size_t)(u.pm >> 4) * ADA_N + 2 * D + u.pn * 256 + (idx & 255); }
    __device__ __forceinline__ void half(const pg8::f32x4 (&acc)[2][2][4][2], const pg8::Unit& u, const int ai, int wr, int wc, int fr, int fq, const LAS float* tab) const {
        const int row0 = u.pm * 256 + wr * 64 + fr + ai * 128, col0 = u.pn * 256 + wc * 32 + 8 * fq;
        f32x4 gv[2][2];
#pragma unroll
        for (int bj = 0; bj < 2; ++bj)
#pragma unroll
            for (int n = 0; n < 2; ++n) gv[bj][n] = *(const LAS f32x4*)(tab + wc * 32 + 8 * fq + bj * 128 + 4 * n);
#pragma unroll
        for (int m = 0; m < 4; ++m) { bf16* rowp = DL + (size_t)(row0 + m * 16) * D + col0;
#pragma unroll
            for (int bj = 0; bj < 2; ++bj) { const pg8::f32x4 v0 = acc[ai][bj][m][0] * gv[bj][0], v1 = acc[ai][bj][m][1] * gv[bj][1];
                v4u w; w.x = pk2(v0[0], v0[1]); w.y = pk2(v0[2], v0[3]); w.z = pk2(v1[0], v1[1]); w.w = pk2(v1[2], v1[3]);
                *(v4u*)(rowp + bj * 128) = w; } }
    }
};
struct EpiOut2 {
    static constexpr bool PERM = true;
    static constexpr int NS = 8, NTAB = 3;
    const float* ada; bf16* DL; const float* sa; const float* sb; const float* xin;
    __device__ __forceinline__ bool stores(const pg8::Unit&, int) const { return true; }
    __device__ __forceinline__ const void* tab_src(const pg8::Unit& u, int idx) const {
        const int i = idx & 255, w = idx >> 8;
        if (w == 0) return ada + (size_t)(u.pm >> 4) * ADA_N + 2 * D + u.pn * 256 + i;
        if (w == 1) return sa + u.pm * 256 + i;
        return sb + u.pn * 256 + i;
    }
    __device__ __forceinline__ void mid(pg8::f32x4 (&acc)[2][2][4][2], const pg8::Unit&, int wr, int wc, int fr, int fq, const LAS float* tab) const {
        f32x4 sbv[2][2];
#pragma unroll
        for (int bj = 0; bj < 2; ++bj)
#pragma unroll
            for (int n = 0; n < 2; ++n) sbv[bj][n] = *(const LAS f32x4*)(tab + 512 + wc * 32 + 8 * fq + bj * 128 + 4 * n);
#pragma unroll
        for (int ai = 0; ai < 2; ++ai)
#pragma unroll
            for (int m = 0; m < 4; ++m) { const float ra = tab[256 + wr * 64 + fr + ai * 128 + m * 16];
#pragma unroll
                for (int bj = 0; bj < 2; ++bj)
#pragma unroll
                    for (int n = 0; n < 2; ++n) { const pg8::i32x4 iv = __builtin_bit_cast(pg8::i32x4, acc[ai][bj][m][n]); const f32x4 s = sbv[bj][n] * ra;
                        acc[ai][bj][m][n] = (f32x4){(float)iv[0] * s[0], (float)iv[1] * s[1], (float)iv[2] * s[2], (float)iv[3] * s[3]}; } }
    }
    __device__ __forceinline__ void half(const pg8::f32x4 (&acc)[2][2][4][2], const pg8::Unit& u, const int ai, int wr, int wc, int fr, int fq, const LAS float* tab) const {
        const int row0 = u.pm * 256 + wr * 64 + fr + ai * 128, col0 = u.pn * 256 + wc * 32 + 8 * fq;
        f32x4 xv[4][2][2];
#pragma unroll
        for (int m = 0; m < 4; ++m) { const float* xr = xin + (size_t)(row0 + m * 16) * D + col0;
#pragma unroll
            for (int bj = 0; bj < 2; ++bj)
#pragma unroll
                for (int n = 0; n < 2; ++n) xv[m][bj][n] = *(const f32x4*)(xr + bj * 128 + 4 * n); }
        f32x4 gv[2][2];
#pragma unroll
        for (int bj = 0; bj < 2; ++bj)
#pragma unroll
            for (int n = 0; n < 2; ++n) gv[bj][n] = *(const LAS f32x4*)(tab + wc * 32 + 8 * fq + bj * 128 + 4 * n);
#pragma unroll
        for (int m = 0; m < 4; ++m) { bf16* rowp = DL + (size_t)(row0 + m * 16) * D + col0;
#pragma unroll
            for (int bj = 0; bj < 2; ++bj) { const pg8::f32x4 v0 = acc[ai][bj][m][0] * gv[bj][0] + xv[m][bj][0], v1 = acc[ai][bj][m][1] * gv[bj][1] + xv[m][bj][1];
                v4u w; w.x = pk2(v0[0], v0[1]); w.y = pk2(v0[2], v0[3]); w.z = pk2(v1[0], v1[1]); w.w = pk2(v1[2], v1[3]);
                *(v4u*)(rowp + bj * 128) = w; } }
    }
};
typedef GAS unsigned long long gu64;
constexpr unsigned RT_FULL = 64u, RT_SPIN_CAP = 1u << 22;
template <int NCT>
struct SchedMoe {
    int G, c; const LAS int* tb; const LAS int* cnt; const int* elist; unsigned rowbytes; gu32* rtc;
    __device__ bool next(int i, pg8::Unit& u) const {
        const int L = i * G + c, rt = L / NCT, ct = L % NCT;
        if (rt >= tb[NE]) return false;
        int e = 0;
#pragma unroll
        for (int q = 1; q < NE; ++q) e += (rt >= tb[q]) ? 1 : 0;
        u.pm = rt; u.pn = e * NCT + ct; return true;
    }
    __device__ __forceinline__ void a_ready(const pg8::Unit&) const {}
    __device__ __forceinline__ void done(const pg8::Unit& u) const {
        if (rtc == nullptr) return;
        asm volatile("s_waitcnt vmcnt(0) ; publish" ::: "memory");
        if ((threadIdx.x & 63) == 0) (void)__hip_atomic_fetch_add(rtc + 16 * u.pm, 1u, RLX_AGENT);
    }
    __device__ __forceinline__ unsigned row_byteoff(const pg8::Unit& u, int lr) const {
        const int e = u.pn / NCT; int l = (u.pm - tb[e]) * 256 + lr; const int n = cnt[e]; l = l < n ? l : n - 1;
        return (unsigned)(elist[e * T + l] >> 1) * rowbytes;
    }
    __device__ __forceinline__ const int* row_src(const pg8::Unit& u, int lr) const {
        const int e = u.pn / NCT; int l = (u.pm - tb[e]) * 256 + lr; const int n = cnt[e]; l = l < n ? l : n - 1;
        return elist + e * T + l;
    }
    __device__ __forceinline__ unsigned row_raw(const pg8::Unit& u, int lr) const { return (unsigned)*row_src(u, lr); }
    __device__ __forceinline__ unsigned row_off(unsigned raw) const { return (raw >> 1) * rowbytes; }
};
struct SchedMoe2 {
    static constexpr int NCT = 16, BON = 3;
    int G, c, n7; const LAS int* tb; const LAS int* cnt; gu32* rtc; gu32* tmo;
    __device__ bool next(int i, pg8::Unit& u) const {
        const int A = n7 % G, nl = G - A; int L;
        if (A == 0) L = i * G + c;
        else if (c >= A) L = (i < BON) ? i * nl + (c - A) : BON * nl + (i - BON) * G + c;
        else L = BON * nl + i * G + c;
        const int rt = L / NCT, ct = L % NCT;
        if (rt >= tb[NE]) return false;
        int e = 0;
#pragma unroll
        for (int q = 1; q < NE; ++q) e += (rt >= tb[q]) ? 1 : 0;
        u.pm = rt; u.pn = e * NCT + ct; return true;
    }
    __device__ __forceinline__ void a_ready(const pg8::Unit& u) const {
        unsigned sp = 0;
        while ((unsigned)__builtin_amdgcn_readfirstlane((int)__hip_atomic_load(rtc + 16 * u.pm, RLX_AGENT)) < RT_FULL) {
            __builtin_amdgcn_s_sleep(1);
            if (++sp > RT_SPIN_CAP) { if ((threadIdx.x & 63) == 0) __hip_atomic_store(tmo, 1u, RLX_AGENT); break; }
        }
    }
    __device__ __forceinline__ void done(const pg8::Unit&) const {}
    __device__ __forceinline__ unsigned row_byteoff(const pg8::Unit&, int) const { return 0u; }
};
struct EpiMoe1 {
    static constexpr bool PERM = true;
    unsigned char* H;
    __device__ __forceinline__ void operator()(const pg8::f32x4 (&acc)[2][2][4][2], const pg8::Unit& u, int wr, int wc, int fr, int fq) const {
        const int row0 = u.pm * 256 + wr * 64 + fr, col0 = (u.pn & 7) * 128 + wc * 32 + 8 * fq;
        constexpr float IS = 1.f / W1_SCALE;
#pragma unroll
        for (int ai = 0; ai < 2; ++ai)
#pragma unroll
            for (int m = 0; m < 4; ++m) { float h[8];
#pragma unroll
                for (int n = 0; n < 2; ++n)
#pragma unroll
                    for (int j = 0; j < 4; ++j) { const float a = acc[ai][0][m][n][j] * IS, uu = acc[ai][1][m][n][j] * IS; h[4 * n + j] = a * uu / (1.f + __expf(-a)); }
                *(v2u*)(H + (size_t)(row0 + ai * 128 + m * 16) * FF + col0) = (v2u){pk4_fp8(h[0], h[1], h[2], h[3]), pk4_fp8(h[4], h[5], h[6], h[7])}; }
    }
    static constexpr int NS = 4, NTAB = 0;
    __device__ __forceinline__ bool stores(const pg8::Unit&, int) const { return true; }
    __device__ __forceinline__ const void* tab_src(const pg8::Unit&, int) const { return nullptr; }
    __device__ __forceinline__ void half(const pg8::f32x4 (&acc)[2][2][4][2], const pg8::Unit& u, const int ai, int wr, int wc, int fr, int fq, const LAS float*) const {
        const int row0 = u.pm * 256 + wr * 64 + fr + ai * 128, col0 = (u.pn & 7) * 128 + wc * 32 + 8 * fq;
        constexpr float IS = 1.f / W1_SCALE;
#pragma unroll
        for (int m = 0; m < 4; ++m) { float h[8];
#pragma unroll
            for (int n = 0; n < 2; ++n)
#pragma unroll
                for (int j = 0; j < 4; ++j) { const float a = acc[ai][0][m][n][j] * IS, uu = acc[ai][1][m][n][j] * IS; h[4 * n + j] = a * uu / (1.f + __expf(-a)); }
            __hip_atomic_store((gu64*)(H + (size_t)(row0 + m * 16) * FF + col0), (unsigned long long)pk4_fp8(h[0], h[1], h[2], h[3]) | ((unsigned long long)pk4_fp8(h[4], h[5], h[6], h[7]) << 32), RLX_AGENT); }
    }
};
struct EpiMoe2 {
    static constexpr int PERM = 2;
    unsigned char* SL; const int* elist; const float* ew; const LAS int* tb; const LAS int* cnt;
    static constexpr int NS = 4, NTAB = 2;
    unsigned char* dump;
    __device__ __forceinline__ bool stores(const pg8::Unit&, int) const { return true; }
    __device__ __forceinline__ const void* tab_src(const pg8::Unit& u, int idx) const {
        const int e = u.pn >> 4, n_e = cnt[e]; int l = (u.pm - tb[e]) * 256 + (idx & 255); l = l < n_e ? l : n_e - 1;
        return idx < 256 ? (const void*)(elist + e * T + l) : (const void*)(ew + e * T + l);
    }
    __device__ __forceinline__ void half(const pg8::f32x4 (&acc)[2][2][4][2], const pg8::Unit& u, const int ai, int wr, int wc, int fr, int fq, const LAS float* tab) const {
        const int e = u.pn >> 4, ct = u.pn & 15, n_e = cnt[e], lrow0 = wr * 64 + fr + ai * 128, lr0 = (u.pm - tb[e]) * 256 + lrow0, col0 = ct * 256 + wc * 64 + 16 * fq;
#pragma unroll
        for (int m = 0; m < 4; ++m) { const int lr = lr0 + m * 16, ent = ((const LAS int*)tab)[lrow0 + m * 16]; const float w = tab[256 + lrow0 + m * 16] * (SLOT_SCALE / W2_SCALE);
            unsigned char* rowp = (lr < n_e) ? SL + ((size_t)(ent & 1) * T + (size_t)(ent >> 1)) * D + col0 : dump + (size_t)((u.pm & 63) * 256 + lrow0 + m * 16) * D + col0;
            const pg8::f32x4 v0 = acc[ai][0][m][0] * w, v1 = acc[ai][0][m][1] * w, v2 = acc[ai][1][m][0] * w, v3 = acc[ai][1][m][1] * w;
            *(v4u*)rowp = (v4u){pk4_fp8(v0[0], v0[1], v0[2], v0[3]), pk4_fp8(v1[0], v1[1], v1[2], v1[3]), pk4_fp8(v2[0], v2[1], v2[2], v2[3]), pk4_fp8(v3[0], v3[1], v3[2], v3[3])}; }
    }
};
__device__ __forceinline__ void moe_tables(Frame& F) {
    LAS int* tb = (LAS int*)(F.lds + MOE_OFF); LAS int* cnt = tb + 32;
    __syncthreads();
    if (F.tid == 0) { int acc = 0;
        for (int e = 0; e < NE; ++e) { const int n = (int)__hip_atomic_load((unsigned*)(F.ctl + CW_CNT + 64 * e), RLX_AGENT); cnt[e] = n; tb[e] = acc; acc += (n + 255) >> 8; }
        tb[NE] = acc; }
    __syncthreads();
}

struct Args { const float* in[20]; float* out; unsigned char* ws; int ph_lo, ph_hi, li, pad; };
__global__ void __launch_bounds__(NTHR, 2) mk_fwd(Args args) {
    extern __shared__ __attribute__((aligned(16))) unsigned char lds[];
    Frame F;
    F.lds = (LAS unsigned char*)lds;
    F.MISC = (volatile LAS unsigned*)(F.lds + MISC_OFF);
    F.tid = threadIdx.x; F.lane = F.tid & 63; F.wave = __builtin_amdgcn_readfirstlane(F.tid >> 6);
    F.G = gridDim.x; { const int bx = blockIdx.x; F.vcu = (F.G % 8 == 0) ? (bx % 8) * (F.G / 8) + bx / 8 : bx; }
    unsigned char* ws = args.ws;
    F.ctl = (gu32*)(ws + WS_CTL);
    F.x = args.in[0]; F.c = args.in[1]; F.ctx = args.in[2]; F.cctx = args.in[3]; F.w_ada = args.in[4]; F.b_ada = args.in[5]; F.norm1 = args.in[6]; F.w_in = args.in[7];
    F.b_gates = args.in[8]; F.conv_w = args.in[9]; F.head_norm = args.in[10]; F.w_out = args.in[11]; F.norm2 = args.in[12]; F.w_rg = args.in[13]; F.b_rg = args.in[14];
    F.w_re = args.in[15]; F.b_re = args.in[16]; F.w_e1 = args.in[17]; F.w_e2 = args.in[18]; F.fnorm = args.in[19]; F.out = args.out;
    F.ADA = (float*)(ws + WS_ADA); F.GATES = (float*)(ws + WS_GATES); F.EW = (float*)(ws + WS_EW); F.HF = (bf16*)(ws + WS_HF); F.HB = (bf16*)(ws + WS_HB); F.DELTA = (bf16*)(ws + WS_X1); F.X1B = (bf16*)(ws + WS_X1 + 128 * MiB); F.XM8 = ws + WS_XM8; F.WO8 = ws + WS_WO8; F.WI8 = (signed char*)(ws + WS_WI8); F.SA = (float*)(ws + WS_SA); F.SB = (float*)(ws + WS_SB); F.SB2 = F.SB + 16384; F.MIXA8 = ws + WS_XM8; F.WOA8 = ws + WS_WIN + 64 * MiB;
    F.ELIST = (int*)(ws + WS_ELIST);
    F.WIN = (bf16*)(ws + WS_WIN); F.WOUT = (bf16*)(ws + WS_WOUT); F.WE1 = (bf16*)(ws + WS_WE1); F.WE2 = (bf16*)(ws + WS_WE2);
    F.XM = (bf16*)(ws + WS_XM); F.MIX = F.XM; F.XF = F.XM; F.PROJ = (bf16*)(ws + WS_PROJ); F.SLOT = (bf16*)(ws + WS_SLOT); F.HMOE = (bf16*)(ws + WS_HMOE);
    for (int u = F.tid; u < (LDS_BYTES - LDSCTL_OFF) / 4; u += NTHR) ((LAS unsigned*)(F.lds + LDSCTL_OFF))[u] = 0u;
    __syncthreads();
    const int lo = args.ph_lo, hi = args.ph_hi;
    XcdBarrier bar; bar.bar = (unsigned*)(F.ctl + CW_BAR) + args.li * XCD_BAR_WORDS; bar.x = 0; bar.st = nullptr;
    if (hi - lo > 1) bar = xcd_barrier_post((unsigned*)(F.ctl + CW_BAR) + args.li * XCD_BAR_WORDS, F.MISC + 8);
#ifndef PHASE_MASK
#define PHASE_MASK 0xFFFF
#endif
#define IN(k) (((PHASE_MASK >> (k)) & 1) && lo <= (k) && (k) < hi)
#define BOTH(k) (IN(k) && IN((k) + 1))
#define GRID_BAR() xcd_barrier(bar)
    LAS unsigned* rowtab = (LAS unsigned*)(F.lds + ROWTAB_OFF);

#ifndef PROBE_DUP
#define PROBE_DUP -1
#endif
#define RUNPH(k, ...) if (IN(k)) { __VA_ARGS__ if (PROBE_DUP == (k)) { GRID_BAR(); __VA_ARGS__ } if (BOTH(k)) GRID_BAR(); }
    RUNPH(0, { p0_ada(F); __syncthreads(); p0_transposes(F); })
    RUNPH(1, { p1_quant_weights(F); p1_quant_wout(F); p1_norm(F); })
    RUNPH(2, {
        __syncthreads();
        { pg8::Gemm gi{(const bf16*)F.XM8, (const bf16*)F.WI8, TA, NPAD, D / 2}; SchedProj Si{F.G, (int)blockIdx.x}; EpiProjI8 Ei{F.PROJ, F.SA, F.SB, F.GATES, F.b_gates};
          pg8::gemm_phase<EpiProjI8, SchedProj, PG8_ALIGN, PG8_SP2, false, false, true, PG8_ROLL2>(F.lds, gi, Si, Ei, rowtab); }
        expert_transpose_queue(F); })
    RUNPH(3, { p3_mlstm(F); })
    RUNPH(4, { p4_mix(F); })
    RUNPH(5, {
        pg8::Gemm2 g{(const char*)F.MIXA8, (const char*)F.WOA8, (unsigned)(D / 2), (unsigned)(D / 2), D / 2 / 128, (const char*)(F.MIX + D / 2), (const char*)(F.WOUT + D / 2), (unsigned)(D * 2), (unsigned)(D * 2), D / 2 * 2 / 128};
        SchedStatic S; S.init(T, D, F.G, (int)blockIdx.x); EpiOut2 E{F.ADA, F.X1B, F.SA, F.SB2, F.x};
        __syncthreads();
        pg8::gemm_phase2<EpiOut2, SchedStatic, PG8_ALIGN>(F.lds, g, S, E); })
    RUNPH(6, { p6_norm_router(F); })
    RUNPH(7, {
        moe_tables(F);
        const LAS int* tb = (const LAS int*)(F.lds + MOE_OFF);
        gu32* rtc = F.ctl + CW_RT;
        { pg8::Gemm g{F.XF, F.WE1, T, NE * 2 * FF, D / 2}; SchedMoe<8> S{F.G, F.vcu, tb, tb + 32, F.ELIST, (unsigned)D, rtc}; EpiMoe1 E{(unsigned char*)F.HMOE};
          pg8::gemm_phase<EpiMoe1, SchedMoe<8>, PG8_ALIGN, PG8_SP2, true, true, false, PG8_ROLL7>(F.lds, g, S, E, rowtab); }
        if (F.wave == 0) __builtin_amdgcn_fence(__ATOMIC_ACQUIRE, "agent");
        __syncthreads();
        { pg8::Gemm g{F.HMOE, F.WE2, HM_ROWS, NE * D, FF / 2}; SchedMoe2 S{F.G, F.vcu, tb[NE] * 8, tb, tb + 32, rtc, F.ctl + CW_TMO}; EpiMoe2 E{(unsigned char*)F.SLOT, F.ELIST, F.EW, tb, tb + 32, (unsigned char*)F.WIN};
          pg8::gemm_phase<EpiMoe2, SchedMoe2, PG8_ALIGN, PG8_SP2, false, true, false, PG8_ROLL8>(F.lds, g, S, E, rowtab); } })
    RUNPH(9, { p9_final(F); })
#undef IN
#undef BOTH
}

__global__ void __launch_bounds__(320) mlstm_naive(const bf16* __restrict__ PROJ, const float* __restrict__ GATES, bf16* __restrict__ HF, bf16* __restrict__ HB) {
    __shared__ float kq[2][256];
    __shared__ float sc[2][4];
    __shared__ float dens[2];
    const int bid = blockIdx.x, dir = bid & 1, h = (bid >> 1) & 7, b = bid >> 4, tid = threadIdx.x;
    float C[128];
#pragma unroll
    for (int i = 0; i < 128; ++i) C[i] = 0.f;
    float m = 0.f;
    bf16* HO = dir ? HB : HF;
    const int NSTEP = CTXL + SEQ;
    for (int st = 0; st < NSTEP; ++st) {
        int row;
        if (st < CTXL) { const int j = dir ? (CTXL - 1 - st) : st; row = T + b * CTXL + j; }
        else { const int s = dir ? (SEQ - 1 - (st - CTXL)) : (st - CTXL); row = b * SEQ + s; }
        const bf16* pr = PROJ + (size_t)row * NPROJ;
        const int buf = st & 1;
        if (tid < 128) kq[buf][tid] = bf1(pr[COL_K + h * DK + tid]);
        else if (tid < 256) kq[buf][tid] = bf1(pr[COL_Q + h * DK + (tid - 128)]) * 0.08838834764831845f;
        const float ig = GATES[(size_t)row * 32 + (dir ? 16 : 0) + h], fp = GATES[(size_t)row * 32 + (dir ? 24 : 8) + h];
        const float lf = fminf(fp, 0.f) - log1pf(expf(-fabsf(fp)));
        const float mn = fmaxf(lf + m, ig);
        const float fdec = expf(lf + m - mn), iw = expf(ig - mn);
        m = mn;
        const float vv = tid < 256 ? bf1(pr[COL_V + h * DV + tid]) : 1.f;
        __syncthreads();
        const bool isq = st >= CTXL;
        float dot = 0.f;
        if (tid <= 256) {
            const float a = iw * vv;
#pragma unroll
            for (int i = 0; i < 128; ++i) { C[i] = fdec * C[i] + a * kq[buf][i]; dot += C[i] * kq[buf][128 + i]; }
        }
        if (isq) {
            if (tid == 256) dens[buf] = dot;
            __syncthreads();
            if (tid < 256) { const float dn = fmaxf(fabsf(dens[buf]), expf(-m)); HO[(size_t)row * 2048 + h * DV + tid] = (bf16)(pk2(dot / dn, 0.f) & 0xffffu); }
        }
    }
}

extern "C" void kernel_launch(void* const* d_in, const int* in_sizes, int n_in, void* d_out, int out_size, void* d_ws, size_t ws_size, hipStream_t stream) {
    static int grid = 0;
    if (grid == 0) {
        if (n_in != 20 || out_size != T * D || ws_size < WS_END) { fprintf(stderr, "kernel_launch: unexpected shapes (n_in %d, out %d, ws %zu)\n", n_in, out_size, ws_size); grid = -1; return; }
        int dev = 0, cus = 0, per_cu = 0;
        if (hipGetDevice(&dev) != hipSuccess || hipDeviceGetAttribute(&cus, hipDeviceAttributeMultiprocessorCount, dev) != hipSuccess) { grid = -1; return; }
        if (hipFuncSetAttribute((const void*)mk_fwd, hipFuncAttributeMaxDynamicSharedMemorySize, LDS_BYTES) != hipSuccess) { fprintf(stderr, "kernel_launch: hipFuncSetAttribute failed\n"); grid = -1; return; }
        if (hipOccupancyMaxActiveBlocksPerMultiprocessor(&per_cu, (const void*)mk_fwd, NTHR, LDS_BYTES) != hipSuccess || per_cu < 1) fprintf(stderr, "kernel_launch: occupancy query says %d\n", per_cu);
        (void)hipGetLastError();
        grid = cus;
    }
    if (grid < 0) return;
    (void)hipMemsetAsync((char*)d_ws + WS_CTL, 0, CTL_ZERO_BYTES, stream);
    Args a{};
    for (int i = 0; i < 20; ++i) a.in[i] = (const float*)d_in[i];
    a.out = (float*)d_out; a.ws = (unsigned char*)d_ws;
    int nl = 0;
    auto launch = [&](int lo, int hi) { a.ph_lo = lo; a.ph_hi = hi; a.li = nl++; hipLaunchKernelGGL(mk_fwd, dim3(grid), dim3(NTHR), LDS_BYTES, stream, a); };
#if MK_MODE == 0
    launch(0, 1); launch(1, 2); launch(2, 3);
    hipLaunchKernelGGL(mlstm_naive, dim3(NB * NH * 2), dim3(320), 0, stream, (const bf16*)((char*)d_ws + WS_PROJ), (const float*)((char*)d_ws + WS_GATES), (bf16*)((char*)d_ws + WS_HF), (bf16*)((char*)d_ws + WS_HB));
    launch(4, 5); launch(5, 6); launch(6, 7); launch(7, 8); launch(8, 9); launch(9, 10);
#elif MK_MODE == 2
    launch(0, 10);
#else
    launch(0, 3);
    hipLaunchKernelGGL(mlstm_naive, dim3(NB * NH * 2), dim3(320), 0, stream, (const bf16*)((char*)d_ws + WS_PROJ), (const float*)((char*)d_ws + WS_GATES), (bf16*)((char*)d_ws + WS_HF), (bf16*)((char*)d_ws + WS_HB));
    launch(4, 10);
#endif
}
```

```cpp
#include <hip/hip_runtime.h>
#include <cstdio>
#include <cstdint>

#ifndef MK_MODE
#define MK_MODE 2
#endif

namespace pg8 {
#define PG8_LAS __attribute__((address_space(3)))
typedef unsigned short bf16_t;
typedef short bf16x8 __attribute__((ext_vector_type(8)));
typedef float f32x4 __attribute__((ext_vector_type(4)));
typedef unsigned u32x4 __attribute__((ext_vector_type(4)));
constexpr int BM = 256, BK = 64, HALF = 128, HTB = HALF * BK * 2, STAGE_BYTES = 8 * HTB, NXCD = 8, WGM = 8;

__host__ __device__ __forceinline__ int lds_byte(int r, int c) { const int st = (r >> 4) * 2 + (c >> 5), rr = r & 15, cc = c & 31, ob = rr * 64 + cc * 2; return st * 1024 + (ob ^ (((ob >> 9) & 1) << 5)); }
__host__ __device__ __forceinline__ void stage_rc(int b, int& R, int& C) { const int st = b / 1024, sb = b % 1024, swz = sb ^ (((sb >> 9) & 1) << 5); R = (st >> 1) * 16 + swz / 64; C = (st & 1) * 32 + (swz % 64) / 2; }
__host__ __device__ __forceinline__ int perm32(int rho) { const int n = rho >> 4, i = rho & 15; return 8 * (i >> 2) + 4 * n + (i & 3); }

struct Unit { int pm, pn; };
struct Gemm { const bf16_t* A; const bf16_t* Bt; int M, N, K; };

typedef float f32x2_t __attribute__((ext_vector_type(2))); typedef __bf16 bf16x2_t __attribute__((ext_vector_type(2)));
__device__ __forceinline__ unsigned cvt_pk_bf16(float lo, float hi) { f32x2_t v = {lo, hi}; bf16x2_t b = __builtin_convertvector(v, bf16x2_t); return __builtin_bit_cast(unsigned, b); }

typedef int i32x8 __attribute__((ext_vector_type(8)));
typedef int i32x4 __attribute__((ext_vector_type(4)));
constexpr int TAB_OFF = STAGE_BYTES;
template <class Epi, class Sched, bool ALIGN_EPI, bool SP2, bool GATHER, bool MX, bool I8 = false, bool ROLL = false>
__device__ __forceinline__ void gemm_phase(PG8_LAS unsigned char* lds, const Gemm g, const Sched& S, const Epi& E, PG8_LAS unsigned* rowtab) {
    const int tid = threadIdx.x, wid = __builtin_amdgcn_readfirstlane(tid >> 6), lane = tid & 63, wr = wid >> 2, wc = wid & 3, fr = lane & 15, fq = lane >> 4;
    const int K = g.K, nt = K / BK;
    unsigned voffA[2], voffB[2]; int RA[2], CA[2];
#pragma unroll
    for (int i = 0; i < 2; ++i) { int R, C; stage_rc(tid * 16 + i * 8192, R, C); const int Rb = ((int)Epi::PERM == 2) ? (64 * (R >> 5) + 16 * ((R & 15) >> 2) + 4 * ((R >> 4) & 1) + (R & 3)) : (Epi::PERM ? ((R & ~31) + perm32(R & 31)) : R);
        voffA[i] = (unsigned)(R * K + C) * 2u; voffB[i] = (unsigned)(Rb * K + C) * 2u; RA[i] = R; CA[i] = C * 2; }
    const size_t kstep = (size_t)(BK * 2);
    const size_t hstep = (size_t)HALF * K * 2;
    const size_t tstep = 2 * hstep;
    const size_t hstepA = GATHER ? (size_t)0 : hstep;
    const size_t hstepB = ((int)Epi::PERM == 2) ? (size_t)8 * K * 2 : hstep;
    const unsigned ldsw = (unsigned)wid * 1024u;
    const int aoff = lds_byte(wr * 64 + fr, MX ? fq * 16 : fq * 8), boff = lds_byte(wc * 32 + fr, MX ? fq * 16 : fq * 8);
#define PG8_SA(b, h) (((b) * 2 + (h)) * HTB)
#define PG8_SB(b, h) ((4 + (b) * 2 + (h)) * HTB)
#define PG8_STAGE(bufoff, gbase, voff) do { _Pragma("unroll") for (int _i = 0; _i < 2; ++_i) \
        __builtin_amdgcn_global_load_lds((const unsigned*)((const char*)(gbase) + (voff)[_i]), (PG8_LAS unsigned*)(lds + (bufoff) + ldsw + _i * 8192), 16, 0, 0); } while (0)
#define PG8_LD32(p) ({ const u32x4 lo_ = *(const PG8_LAS u32x4*)(p), hi_ = *(const PG8_LAS u32x4*)((p) + 16); (i32x8){(int)lo_[0], (int)lo_[1], (int)lo_[2], (int)lo_[3], (int)hi_[0], (int)hi_[1], (int)hi_[2], (int)hi_[3]}; })
#define PG8_LDA(dst, b, h) do { if constexpr (MX) { _Pragma("unroll") for (int m = 0; m < 4; ++m) dst##X[m] = PG8_LD32(lds + PG8_SA(b, h) + aoff + m * 2048); } \
        else { _Pragma("unroll") for (int m = 0; m < 4; ++m) _Pragma("unroll") for (int k = 0; k < 2; ++k) dst[m][k] = *(const PG8_LAS bf16x8*)(lds + PG8_SA(b, h) + aoff + m * 2048 + k * 1024); } } while (0)
#define PG8_LDB(dst, b, h) do { if constexpr (MX) { _Pragma("unroll") for (int n = 0; n < 2; ++n) dst##X[n] = PG8_LD32(lds + PG8_SB(b, h) + boff + n * 2048); } \
        else { _Pragma("unroll") for (int n = 0; n < 2; ++n) _Pragma("unroll") for (int k = 0; k < 2; ++k) dst[n][k] = *(const PG8_LAS bf16x8*)(lds + PG8_SB(b, h) + boff + n * 2048 + k * 1024); } } while (0)
#define PG8_MMA(ai, bj, At, Bt) do { __builtin_amdgcn_s_setprio(1); if constexpr (MX) { _Pragma("unroll") for (int m = 0; m < 4; ++m) _Pragma("unroll") for (int n = 0; n < 2; ++n) \
        asm volatile("v_mfma_scale_f32_16x16x128_f8f6f4 %0, %1, %2, %0, %3, %3 op_sel_hi:[0,0,0]" : "+v"(acc[ai][bj][m][n]) : "v"(Bt##X[n]), "v"(At##X[m]), "v"(mxscale)); } \
        else if constexpr (I8) { _Pragma("unroll") for (int m = 0; m < 4; ++m) _Pragma("unroll") for (int n = 0; n < 2; ++n) _Pragma("unroll") for (int k = 0; k < 2; ++k) \
        acc[ai][bj][m][n] = __builtin_bit_cast(f32x4, __builtin_amdgcn_mfma_i32_16x16x64_i8(__builtin_bit_cast(i32x4, Bt[n][k]), __builtin_bit_cast(i32x4, At[m][k]), __builtin_bit_cast(i32x4, acc[ai][bj][m][n]), 0, 0, 0)); } \
        else { _Pragma("unroll") for (int m = 0; m < 4; ++m) _Pragma("unroll") for (int n = 0; n < 2; ++n) _Pragma("unroll") for (int k = 0; k < 2; ++k) \
        acc[ai][bj][m][n] = __builtin_amdgcn_mfma_f32_16x16x32_bf16(Bt[n][k], At[m][k], acc[ai][bj][m][n], 0, 0, 0); } __builtin_amdgcn_s_setprio(0); } while (0)
#define PG8_WAIT_V(n) asm volatile("s_waitcnt vmcnt(" #n ")" ::: "memory")
#define PG8_WAIT_VN(n) asm volatile("s_waitcnt vmcnt(%0)" :: "n"(n) : "memory")
#define PG8_ZERO(ai) do { _Pragma("unroll") for (int b_ = 0; b_ < 2; ++b_) _Pragma("unroll") for (int m_ = 0; m_ < 4; ++m_) _Pragma("unroll") for (int n_ = 0; n_ < 2; ++n_) acc[ai][b_][m_][n_] = (f32x4){0.f, 0.f, 0.f, 0.f}; } while (0)
#define PG8_TABP(u_) ((const PG8_LAS float*)(lds + TAB_OFF + ((u_) & 1) * 2048))
#define PG8_WAIT_L(n) asm volatile("s_waitcnt lgkmcnt(" #n ")" ::: "memory")
#define PG8_BAR __builtin_amdgcn_s_barrier()
#define PG8_SCHED __builtin_amdgcn_sched_barrier(0)
    static_assert(!ROLL || SP2, "rolling epilogue: eight-phase loop only");
    Unit cur, nxt; int ui = 0; bool pst = false;
    if (!S.next(0, cur)) return;
    f32x4 acc[2][2][4][2];
#pragma unroll
    for (int a = 0; a < 2; ++a)
#pragma unroll
        for (int b = 0; b < 2; ++b)
#pragma unroll
            for (int m = 0; m < 4; ++m)
#pragma unroll
                for (int n = 0; n < 2; ++n) acc[a][b][m][n] = (f32x4){0.f, 0.f, 0.f, 0.f};
    bf16x8 At[4][2], B0[2][2], B1[2][2]; i32x8 AtX[4], B0X[2], B1X[2]; const int mxscale = 0x7F7F7F7F;
    unsigned vc0[2], vc1[2], vn0[2], vn1[2];
    const char* cA = GATHER ? (const char*)g.A : (const char*)g.A + (size_t)cur.pm * tstep; const char* cB = (const char*)g.Bt + (size_t)cur.pn * tstep;
    if constexpr (GATHER) {
        if (tid < 256) rowtab[tid] = ROLL ? S.row_raw(cur, tid) : S.row_byteoff(cur, tid);
        asm volatile("s_waitcnt vmcnt(0) lgkmcnt(0)" ::: "memory"); PG8_BAR; asm volatile("" ::: "memory");
#pragma unroll
        for (int i = 0; i < 2; ++i) { vc0[i] = (ROLL ? S.row_off(rowtab[RA[i]]) : rowtab[RA[i]]) + (unsigned)CA[i]; vc1[i] = (ROLL ? S.row_off(rowtab[128 + RA[i]]) : rowtab[128 + RA[i]]) + (unsigned)CA[i]; vn0[i] = vc0[i]; vn1[i] = vc1[i]; }
    } else {
#pragma unroll
        for (int i = 0; i < 2; ++i) { vc0[i] = voffA[i]; vc1[i] = voffA[i]; vn0[i] = voffA[i]; vn1[i] = voffA[i]; }
    }
    S.a_ready(cur);
    if constexpr (SP2) {
        PG8_STAGE(PG8_SB(0, 0), cB, voffB); PG8_STAGE(PG8_SB(0, 1), cB + hstepB, voffB); PG8_STAGE(PG8_SA(0, 0), cA, vc0); PG8_STAGE(PG8_SA(0, 1), cA + hstepA, vc1);
        if (wr == 1) PG8_BAR;
        PG8_WAIT_V(2); PG8_BAR;
        PG8_STAGE(PG8_SB(1, 0), cB + kstep, voffB); PG8_STAGE(PG8_SA(1, 0), cA + kstep, vc0); PG8_STAGE(PG8_SB(1, 1), cB + hstepB + kstep, voffB);
        PG8_WAIT_V(6); PG8_BAR;
    } else {
        PG8_STAGE(PG8_SB(0, 0), cB, voffB); PG8_STAGE(PG8_SA(0, 0), cA, vc0); PG8_STAGE(PG8_SB(0, 1), cB + hstepB, voffB); PG8_STAGE(PG8_SA(0, 1), cA + hstepA, vc1);
        if (wr == 1) PG8_BAR;
        PG8_WAIT_V(4); PG8_BAR;
        PG8_STAGE(PG8_SB(1, 0), cB + kstep, voffB); PG8_STAGE(PG8_SA(1, 0), cA + kstep, vc0); PG8_STAGE(PG8_SB(1, 1), cB + hstepB + kstep, voffB);
        PG8_WAIT_V(6); PG8_BAR;
    }
    for (;;) {
        const bool has_next = S.next(ui + 1, nxt);
        const char* nA = GATHER ? (const char*)g.A : (has_next ? (const char*)g.A + (size_t)nxt.pm * tstep : cA); const char* nB = has_next ? (const char*)g.Bt + (size_t)nxt.pn * tstep : cB;
        if constexpr (GATHER && !ROLL) {
            if (has_next && tid < 256) rowtab[((ui + 1) & 1) * 256 + tid] = S.row_byteoff(nxt, tid);
        }
#pragma unroll 1
        for (int t = 0; t < nt; t += 2) {
            const bool last = (t == nt - 2);
            const char* a1 = cA + (size_t)(t + 1) * kstep;
            const char* a2 = last ? nA : cA + (size_t)(t + 2) * kstep; const char* b2 = last ? nB : cB + (size_t)(t + 2) * kstep;
            const char* a3 = a2 + kstep; const char* b3 = b2 + kstep;
            if (last && has_next) S.a_ready(nxt);
            if constexpr (GATHER) {
                if (last && has_next) {
                    PG8_LAS unsigned* rt = rowtab + ((ui + 1) & 1) * 256;
#pragma unroll
                    for (int i = 0; i < 2; ++i) { vn0[i] = (ROLL ? S.row_off(rt[RA[i]]) : rt[RA[i]]) + (unsigned)CA[i]; vn1[i] = (ROLL ? S.row_off(rt[128 + RA[i]]) : rt[128 + RA[i]]) + (unsigned)CA[i]; }
                }
            }
            unsigned w20[2], w21[2];
#pragma unroll
            for (int i = 0; i < 2; ++i) { w20[i] = last ? vn0[i] : vc0[i]; w21[i] = last ? vn1[i] : vc1[i]; }
            if constexpr (SP2 && ROLL) {
            const bool rf = (t == 0) && pst;
            PG8_LDB(B0, 0, 0); PG8_LDB(B1, 0, 1); PG8_SCHED; PG8_LDA(At, 0, 0); PG8_STAGE(PG8_SA(1, 1), a1 + hstepA, vc1);
            if (t == 2) {
                if constexpr (Epi::NTAB > 0) { if (Epi::NTAB > 1 || wid < 4) __builtin_amdgcn_global_load_lds((const unsigned*)E.tab_src(cur, tid), (PG8_LAS unsigned*)(lds + TAB_OFF + (ui & 1) * 2048 + wid * 256), 4, 0, 0); }
                if constexpr (GATHER) { if (has_next && wid < 4) __builtin_amdgcn_global_load_lds((const unsigned*)S.row_src(nxt, tid), (PG8_LAS unsigned*)(rowtab + ((ui + 1) & 1) * 256 + wid * 64), 4, 0, 0); }
            }
            if (rf) PG8_WAIT_VN(8 + 2 * Epi::NS); else PG8_WAIT_V(8);
            PG8_WAIT_L(0); PG8_BAR; PG8_MMA(0, 0, At, B0); PG8_MMA(0, 1, At, B1); PG8_BAR; PG8_SCHED;
            PG8_LDA(At, 0, 1); PG8_STAGE(PG8_SB(0, 0), b2, voffB); PG8_STAGE(PG8_SB(0, 1), b2 + hstepB, voffB); PG8_STAGE(PG8_SA(0, 0), a2, w20);
            if (rf) PG8_WAIT_VN(8 + 2 * Epi::NS); else PG8_WAIT_V(8);
            PG8_WAIT_L(0); PG8_BAR; PG8_MMA(1, 0, At, B0); PG8_MMA(1, 1, At, B1); PG8_BAR; PG8_SCHED;
            PG8_LDB(B0, 1, 0); PG8_LDB(B1, 1, 1); PG8_SCHED; PG8_LDA(At, 1, 0); PG8_STAGE(PG8_SA(0, 1), a2 + hstepA, w21);
            PG8_WAIT_V(8); PG8_WAIT_L(0); PG8_BAR; PG8_MMA(0, 0, At, B0); PG8_MMA(0, 1, At, B1); PG8_BAR; PG8_SCHED;
            PG8_LDA(At, 1, 1); PG8_STAGE(PG8_SB(1, 0), b3, voffB); PG8_STAGE(PG8_SB(1, 1), b3 + hstepB, voffB); PG8_STAGE(PG8_SA(1, 0), a3, w20);
            PG8_WAIT_V(8); PG8_WAIT_L(0); PG8_BAR; PG8_MMA(1, 0, At, B0); PG8_MMA(1, 1, At, B1); PG8_BAR; PG8_SCHED;
            } else if constexpr (SP2) {
            PG8_LDB(B0, 0, 0); PG8_LDB(B1, 0, 1); PG8_SCHED; PG8_LDA(At, 0, 0); PG8_STAGE(PG8_SA(1, 1), a1 + hstepA, vc1);
            PG8_WAIT_V(8); PG8_WAIT_L(0); PG8_BAR; PG8_MMA(0, 0, At, B0); PG8_MMA(0, 1, At, B1); PG8_BAR; PG8_SCHED;
            PG8_LDA(At, 0, 1); PG8_STAGE(PG8_SB(0, 0), b2, voffB); PG8_STAGE(PG8_SB(0, 1), b2 + hstepB, voffB); PG8_STAGE(PG8_SA(0, 0), a2, w20);
            PG8_WAIT_V(8); PG8_WAIT_L(0); PG8_BAR; PG8_MMA(1, 0, At, B0); PG8_MMA(1, 1, At, B1); PG8_BAR; PG8_SCHED;
            PG8_LDB(B0, 1, 0); PG8_LDB(B1, 1, 1); PG8_SCHED; PG8_LDA(At, 1, 0); PG8_STAGE(PG8_SA(0, 1), a2 + hstepA, w21);
            PG8_WAIT_V(8); PG8_WAIT_L(0); PG8_BAR; PG8_MMA(0, 0, At, B0); PG8_MMA(0, 1, At, B1); PG8_BAR; PG8_SCHED;
            PG8_LDA(At, 1, 1); PG8_STAGE(PG8_SB(1, 0), b3, voffB); PG8_STAGE(PG8_SB(1, 1), b3 + hstepB, voffB); PG8_STAGE(PG8_SA(1, 0), a3, w20);
            PG8_WAIT_V(8); PG8_WAIT_L(0); PG8_BAR; PG8_MMA(1, 0, At, B0); PG8_MMA(1, 1, At, B1); PG8_BAR; PG8_SCHED;
            } else {
            PG8_LDB(B0, 0, 0); PG8_SCHED; PG8_LDA(At, 0, 0); PG8_STAGE(PG8_SA(1, 1), a1 + hstepA, vc1);
            PG8_WAIT_L(8); PG8_BAR; PG8_WAIT_L(0); PG8_MMA(0, 0, At, B0); PG8_BAR; PG8_SCHED;
            PG8_LDB(B1, 0, 1); PG8_STAGE(PG8_SB(0, 0), b2, voffB);
            PG8_BAR; PG8_WAIT_L(0); PG8_MMA(0, 1, At, B1); PG8_BAR;
            PG8_LDA(At, 0, 1); PG8_STAGE(PG8_SA(0, 0), a2, w20);
            PG8_BAR; PG8_WAIT_L(0); PG8_MMA(1, 0, At, B0); PG8_BAR; PG8_SCHED;
            PG8_STAGE(PG8_SB(0, 1), b2 + hstepB, voffB);
            PG8_WAIT_V(6); PG8_BAR; PG8_MMA(1, 1, At, B1); PG8_BAR;
            PG8_LDB(B0, 1, 0); PG8_SCHED; PG8_LDA(At, 1, 0); PG8_STAGE(PG8_SA(0, 1), a2 + hstepA, w21);
            PG8_WAIT_L(8); PG8_BAR; PG8_WAIT_L(0); PG8_MMA(0, 0, At, B0); PG8_BAR; PG8_SCHED;
            PG8_LDB(B1, 1, 1); PG8_STAGE(PG8_SB(1, 0), b3, voffB);
            PG8_BAR; PG8_WAIT_L(0); PG8_MMA(0, 1, At, B1); PG8_BAR;
            PG8_LDA(At, 1, 1); PG8_STAGE(PG8_SA(1, 0), a3, w20);
            PG8_BAR; PG8_WAIT_L(0); PG8_MMA(1, 0, At, B0); PG8_BAR; PG8_SCHED;
            PG8_STAGE(PG8_SB(1, 1), b3 + hstepB, voffB);
            PG8_WAIT_V(6); PG8_BAR; PG8_MMA(1, 1, At, B1); PG8_BAR;
            }
        }
        if constexpr (ALIGN_EPI) { if (wr == 0) PG8_BAR; }
        if constexpr (ROLL) { int fr_ = fr, fq_ = fq; asm volatile("" : "+v"(fr_), "+v"(fq_)); E.half(acc, cur, 0, wr, wc, fr_, fq_, PG8_TABP(ui)); E.half(acc, cur, 1, wr, wc, fr_, fq_, PG8_TABP(ui)); pst = E.stores(cur, wc); }
        else E(acc, cur, wr, wc, fr, fq);
        S.done(cur);
        if (!has_next) break;
#pragma unroll
        for (int a = 0; a < 2; ++a)
#pragma unroll
            for (int b = 0; b < 2; ++b)
#pragma unroll
                for (int m = 0; m < 4; ++m)
#pragma unroll
                    for (int n = 0; n < 2; ++n) acc[a][b][m][n] = (f32x4){0.f, 0.f, 0.f, 0.f};
        cur = nxt; cA = nA; cB = nB; ++ui;
#pragma unroll
        for (int i = 0; i < 2; ++i) { vc0[i] = vn0[i]; vc1[i] = vn1[i]; }
        if constexpr (ALIGN_EPI) { if (wr == 1) PG8_BAR; }
    }
    PG8_WAIT_V(0);
    if constexpr (!ALIGN_EPI) { if (wr == 0) PG8_BAR; }
    PG8_BAR;
}
struct Gemm2 { const char* A0; const char* B0; unsigned rbA0, rbB0; int nt0; const char* A1; const char* B1; unsigned rbA1, rbB1; int nt1; };
constexpr int TAB2_BYTES = 4096;
template <class Epi, class Sched, bool ALIGN_EPI>
__device__ __forceinline__ void gemm_phase2(PG8_LAS unsigned char* lds, const Gemm2 g, const Sched& S, const Epi& E) {
    constexpr bool MX = false;
    const int tid = threadIdx.x, wid = __builtin_amdgcn_readfirstlane(tid >> 6), lane = tid & 63, wr = wid >> 2, wc = wid & 3, fr = lane & 15, fq = lane >> 4;
    unsigned vA0[2], vB0[2], vA1[2], vB1[2];
#pragma unroll
    for (int i = 0; i < 2; ++i) { int R, C; stage_rc(tid * 16 + i * 8192, R, C); const int Rb = Epi::PERM ? ((R & ~31) + perm32(R & 31)) : R;
        vA0[i] = (unsigned)R * g.rbA0 + (unsigned)C * 2u; vB0[i] = (unsigned)Rb * g.rbB0 + (unsigned)C * 2u; vA1[i] = (unsigned)R * g.rbA1 + (unsigned)C * 2u; vB1[i] = (unsigned)Rb * g.rbB1 + (unsigned)C * 2u; }
    const size_t kstep = (size_t)(BK * 2);
    const size_t hA0 = (size_t)HALF * g.rbA0, hB0 = (size_t)HALF * g.rbB0, hA1 = (size_t)HALF * g.rbA1, hB1 = (size_t)HALF * g.rbB1;
    const unsigned ldsw = (unsigned)wid * 1024u;
    const int aoff = lds_byte(wr * 64 + fr, fq * 8), boff = lds_byte(wc * 32 + fr, fq * 8);
#define PG8_MMA8(ai, bj, At, Bt) do { __builtin_amdgcn_s_setprio(1); _Pragma("unroll") for (int m = 0; m < 4; ++m) _Pragma("unroll") for (int n = 0; n < 2; ++n) _Pragma("unroll") for (int k = 0; k < 2; ++k) \
        acc[ai][bj][m][n] = __builtin_bit_cast(f32x4, __builtin_amdgcn_mfma_i32_16x16x64_i8(__builtin_bit_cast(i32x4, Bt[n][k]), __builtin_bit_cast(i32x4, At[m][k]), __builtin_bit_cast(i32x4, acc[ai][bj][m][n]), 0, 0, 0)); __builtin_amdgcn_s_setprio(0); } while (0)
#define PG8_MMAB(ai, bj, At, Bt) do { __builtin_amdgcn_s_setprio(1); _Pragma("unroll") for (int m = 0; m < 4; ++m) _Pragma("unroll") for (int n = 0; n < 2; ++n) _Pragma("unroll") for (int k = 0; k < 2; ++k) \
        acc[ai][bj][m][n] = __builtin_amdgcn_mfma_f32_16x16x32_bf16(Bt[n][k], At[m][k], acc[ai][bj][m][n], 0, 0, 0); __builtin_amdgcn_s_setprio(0); } while (0)
#define PG8_TAB2P(u_) ((const PG8_LAS float*)(lds + TAB_OFF + ((u_) & 1) * TAB2_BYTES))
#define PG8_SEG(NT, CA, CB, HA, HB, VA, VB, NA, NB, NHA, NHB, NVA, NVB, MMA, FIRSTSEG) \
    _Pragma("unroll 1") for (int t = 0; t < (NT); t += 2) { \
        const bool last = (t == (NT) - 2); \
        const char* a1 = (CA) + (size_t)(t + 1) * kstep; \
        const char* a2 = last ? (NA) : (CA) + (size_t)(t + 2) * kstep; const char* b2 = last ? (NB) : (CB) + (size_t)(t + 2) * kstep; \
        const char* a3 = a2 + kstep; const char* b3 = b2 + kstep; \
        const size_t hA2 = last ? (NHA) : (HA), hB2 = last ? (NHB) : (HB); \
        unsigned wa[2], wb[2]; \
        _Pragma("unroll") for (int i = 0; i < 2; ++i) { wa[i] = last ? (NVA)[i] : (VA)[i]; wb[i] = last ? (NVB)[i] : (VB)[i]; } \
        const bool rf = (FIRSTSEG) && (t == 0) && pst; \
        PG8_LDB(B0, 0, 0); PG8_LDB(B1, 0, 1); PG8_SCHED; PG8_LDA(At, 0, 0); PG8_STAGE(PG8_SA(1, 1), a1 + (HA), (VA)); \
        if ((FIRSTSEG) && t == 2) { for (int q = wid; q < 4 * Epi::NTAB; q += 8) __builtin_amdgcn_global_load_lds((const unsigned*)E.tab_src(cur, q * 64 + lane), (PG8_LAS unsigned*)(lds + TAB_OFF + (ui & 1) * TAB2_BYTES + q * 256), 4, 0, 0); } \
        if (rf) PG8_WAIT_VN(8 + 2 * Epi::NS); else PG8_WAIT_V(8); \
        PG8_WAIT_L(0); PG8_BAR; MMA(0, 0, At, B0); MMA(0, 1, At, B1); PG8_BAR; PG8_SCHED; \
        PG8_LDA(At, 0, 1); PG8_STAGE(PG8_SB(0, 0), b2, wb); PG8_STAGE(PG8_SB(0, 1), b2 + hB2, wb); PG8_STAGE(PG8_SA(0, 0), a2, wa); \
        if (rf) PG8_WAIT_VN(8 + 2 * Epi::NS); else PG8_WAIT_V(8); \
        PG8_WAIT_L(0); PG8_BAR; MMA(1, 0, At, B0); MMA(1, 1, At, B1); PG8_BAR; PG8_SCHED; \
        PG8_LDB(B0, 1, 0); PG8_LDB(B1, 1, 1); PG8_SCHED; PG8_LDA(At, 1, 0); PG8_STAGE(PG8_SA(0, 1), a2 + hA2, wa); \
        PG8_WAIT_V(8); PG8_WAIT_L(0); PG8_BAR; MMA(0, 0, At, B0); MMA(0, 1, At, B1); PG8_BAR; PG8_SCHED; \
        PG8_LDA(At, 1, 1); PG8_STAGE(PG8_SB(1, 0), b3, wb); PG8_STAGE(PG8_SB(1, 1), b3 + hB2, wb); PG8_STAGE(PG8_SA(1, 0), a3, wa); \
        PG8_WAIT_V(8); PG8_WAIT_L(0); PG8_BAR; MMA(1, 0, At, B0); MMA(1, 1, At, B1); PG8_BAR; PG8_SCHED; \
    }
    Unit cur, nxt; int ui = 0; bool pst = false;
    if (!S.next(0, cur)) return;
    f32x4 acc[2][2][4][2];
#pragma unroll
    for (int a = 0; a < 2; ++a) PG8_ZERO(a);
    bf16x8 At[4][2], B0[2][2], B1[2][2]; i32x8 AtX[4], B0X[2], B1X[2]; (void)AtX; (void)B0X; (void)B1X;
    const char* cA0 = g.A0 + (size_t)cur.pm * 2 * hA0; const char* cB0 = g.B0 + (size_t)cur.pn * 2 * hB0;
    const char* cA1 = g.A1 + (size_t)cur.pm * 2 * hA1; const char* cB1 = g.B1 + (size_t)cur.pn * 2 * hB1;
    PG8_STAGE(PG8_SB(0, 0), cB0, vB0); PG8_STAGE(PG8_SB(0, 1), cB0 + hB0, vB0); PG8_STAGE(PG8_SA(0, 0), cA0, vA0); PG8_STAGE(PG8_SA(0, 1), cA0 + hA0, vA0);
    if (wr == 1) PG8_BAR;
    PG8_WAIT_V(2); PG8_BAR;
    PG8_STAGE(PG8_SB(1, 0), cB0 + kstep, vB0); PG8_STAGE(PG8_SA(1, 0), cA0 + kstep, vA0); PG8_STAGE(PG8_SB(1, 1), cB0 + hB0 + kstep, vB0);
    PG8_WAIT_V(6); PG8_BAR;
    for (;;) {
        const bool has_next = S.next(ui + 1, nxt);
        const char* nA0 = has_next ? g.A0 + (size_t)nxt.pm * 2 * hA0 : cA0; const char* nB0 = has_next ? g.B0 + (size_t)nxt.pn * 2 * hB0 : cB0;
        PG8_SEG(g.nt0, cA0, cB0, hA0, hB0, vA0, vB0, cA1, cB1, hA1, hB1, vA1, vB1, PG8_MMA8, true)
        { int fr_ = fr, fq_ = fq; asm volatile("" : "+v"(fr_), "+v"(fq_)); E.mid(acc, cur, wr, wc, fr_, fq_, PG8_TAB2P(ui)); }
        PG8_SCHED;
        PG8_SEG(g.nt1, cA1, cB1, hA1, hB1, vA1, vB1, nA0, nB0, hA0, hB0, vA0, vB0, PG8_MMAB, false)
        if constexpr (ALIGN_EPI) { if (wr == 0) PG8_BAR; }
        { int fr_ = fr, fq_ = fq; asm volatile("" : "+v"(fr_), "+v"(fq_)); E.half(acc, cur, 0, wr, wc, fr_, fq_, PG8_TAB2P(ui)); E.half(acc, cur, 1, wr, wc, fr_, fq_, PG8_TAB2P(ui)); pst = E.stores(cur, wc); }
        if (!has_next) break;
#pragma unroll
        for (int a = 0; a < 2; ++a) PG8_ZERO(a);
        cur = nxt; cA0 = nA0; cB0 = nB0; cA1 = g.A1 + (size_t)cur.pm * 2 * hA1; cB1 = g.B1 + (size_t)cur.pn * 2 * hB1; ++ui;
        if constexpr (ALIGN_EPI) { if (wr == 1) PG8_BAR; }
    }
    PG8_WAIT_V(0);
    if constexpr (!ALIGN_EPI) { if (wr == 0) PG8_BAR; }
    PG8_BAR;
#undef PG8_SEG
#undef PG8_MMA8
#undef PG8_MMAB
#undef PG8_TAB2P
#undef PG8_SA
#undef PG8_SB
#undef PG8_STAGE
#undef PG8_LDA
#undef PG8_LD32
#undef PG8_LDB
#undef PG8_MMA
#undef PG8_WAIT_V
#undef PG8_WAIT_VN
#undef PG8_ZERO
#undef PG8_TABP
#undef PG8_WAIT_L
#undef PG8_BAR
#undef PG8_SCHED
}
}

#ifndef PG8_SP2
#define PG8_SP2 true
#endif
#ifndef PG8_ALIGN
#define PG8_ALIGN true
#endif
#ifndef PG8_ROLL
#define PG8_ROLL true
#endif
#ifndef PG8_ROLL2
#define PG8_ROLL2 PG8_ROLL
#endif
#ifndef PG8_ROLL5
#define PG8_ROLL5 PG8_ROLL
#endif
#ifndef PG8_ROLL7
#define PG8_ROLL7 PG8_ROLL
#endif
#ifndef PG8_ROLL8
#define PG8_ROLL8 PG8_ROLL
#endif

constexpr int NWAVES = 8, NTHR = 512;
constexpr int D = 4096, NB = 4, SEQ = 4096, T = NB * SEQ, CTXL = 256, TC = NB * CTXL, TA = T + TC;
constexpr int NH = 8, DK = 128, DV = 256;
constexpr int COL_Q = 0, COL_O = 1024, COL_CB = 3072, COL_CC = 5120, COL_CX = 7168, COL_K = 9216, COL_V = 10240, COL_G = 12288;
constexpr int NPROJ = 12288, IN_COLS = 12320, NPAD = 12544;
constexpr int NE = 16, FF = 1024, ADA_N = 6 * D;
constexpr int HM_ROWS = 2 * T + NE * 256;
constexpr float EPS = 1e-6f;

constexpr size_t MiB = 1u << 20;
constexpr size_t WS_CTL = 0, CTL_ZERO_BYTES = 1 * MiB;
constexpr size_t WS_ADA = 1 * MiB;
constexpr size_t WS_GATES = 2 * MiB;
constexpr size_t WS_ELIST = 5 * MiB;
constexpr size_t WS_EW = 6 * MiB;
constexpr size_t WS_WIN = 8 * MiB;
constexpr size_t WS_WOUT = 106 * MiB;
constexpr size_t WS_WE1 = 138 * MiB;
constexpr size_t WS_WE2 = 394 * MiB;
constexpr size_t WS_XM = 522 * MiB;
constexpr size_t WS_PROJ = 658 * MiB;
constexpr size_t WS_SLOT = WS_PROJ, WS_HMOE = WS_PROJ + 256 * MiB;
constexpr size_t WS_HF = 1066 * MiB, WS_HB = 1194 * MiB;
constexpr size_t WS_X1 = 1322 * MiB;
constexpr size_t WS_XM8 = 1578 * MiB;
constexpr size_t WS_WO8 = 1646 * MiB;
constexpr size_t WS_WI8 = 1646 * MiB;
constexpr size_t WS_SA = 1696 * MiB, WS_SB = WS_SA + 256 * 1024;
constexpr size_t WS_END = 1698 * MiB;
static_assert(WS_XM8 + (size_t)TA * D <= WS_WI8 && WS_WI8 + (size_t)NPAD * D <= WS_SA, "ws map int8");
static_assert(WS_GATES + (size_t)TA * 32 * 4 <= WS_ELIST && WS_WIN + (size_t)NPAD * D * 2 <= WS_WOUT && WS_XM + (size_t)TA * D * 2 <= WS_PROJ && WS_PROJ + (size_t)TA * NPROJ * 2 <= WS_HF, "ws map");
static_assert(WS_HMOE + (size_t)HM_ROWS * FF * 2 <= WS_HF, "ws map 2");
constexpr int CW_TMO = 0, CW_CODE = 1, CW_TQ = 1024, CW_CNT = 2048, CW_CMAX = 32768, CW_CMAX2 = 49152, CW_BAR = 4096, CW_RT = 16384;

constexpr int RING_BYTES = 131072;
constexpr int LDS_BYTES = 147456;
constexpr int LDSCTL_OFF = LDS_BYTES - 3072;
constexpr int MISC_OFF = LDSCTL_OFF + 320;
constexpr int MOE_OFF = LDSCTL_OFF + 512;
constexpr int ROWTAB_OFF = LDSCTL_OFF + 1024;

#define GAS __attribute__((address_space(1)))
#define LAS __attribute__((address_space(3)))
typedef unsigned short bf16;
typedef unsigned v4u __attribute__((ext_vector_type(4)));
typedef unsigned v2u __attribute__((ext_vector_type(2)));
typedef float f32x4 __attribute__((ext_vector_type(4)));
typedef GAS unsigned gu32;
#define RLX_AGENT __ATOMIC_RELAXED, __HIP_MEMORY_SCOPE_AGENT
#define LDS_WAIT() asm volatile("s_waitcnt lgkmcnt(0)" ::: "memory")
#define VM_WAIT() asm volatile("s_waitcnt vmcnt(0)" ::: "memory")
__device__ __forceinline__ unsigned pk2(float lo, float hi) { return pg8::cvt_pk_bf16(lo, hi); }
__device__ __forceinline__ float bf_lo(unsigned u) { return __uint_as_float(u << 16); }
__device__ __forceinline__ float bf_hi(unsigned u) { return __uint_as_float(u & 0xffff0000u); }
__device__ __forceinline__ float bf1(bf16 u) { return __uint_as_float(((unsigned)u) << 16); }
__device__ __forceinline__ unsigned pk4_fp8(float a, float b, float c, float d) { int p = __builtin_amdgcn_cvt_pk_fp8_f32(a, b, 0, false); p = __builtin_amdgcn_cvt_pk_fp8_f32(c, d, p, true); return (unsigned)p; }
__device__ __forceinline__ unsigned pk4_i8(float a, float b, float c, float d) { return ((unsigned)(int)rintf(a) & 255u) | (((unsigned)(int)rintf(b) & 255u) << 8) | (((unsigned)(int)rintf(c) & 255u) << 16) | ((unsigned)(int)rintf(d) << 24); }
constexpr float W1_SCALE = 64.f, W2_SCALE = 32.f, SLOT_SCALE = 16.f;
typedef float f32x2v __attribute__((ext_vector_type(2)));
__device__ __forceinline__ f32x4 fp8x4_to_f32(unsigned v) { const f32x2v lo = __builtin_amdgcn_cvt_pk_f32_fp8((int)v, false), hi = __builtin_amdgcn_cvt_pk_f32_fp8((int)v, true); return (f32x4){lo[0], lo[1], hi[0], hi[1]}; }
__device__ __forceinline__ float sigmoidf_(float x) { return 1.f / (1.f + __expf(-x)); }

#define XB_TMO      128
#define XB_XCNT(j)  (256  + 64 * (j))
#define XB_XSUB(j)  (1280 + 64 * (j))
#define XB_XGEN(j)  (2304 + 64 * (j))
#define XB_TOP      3328
#define XB_TOPGEN   3392
#define XCD_BAR_WORDS 3456
#define XB_SPIN_CAP (1u << 22)
__device__ __forceinline__ unsigned xb_ld(unsigned* p)              { return __hip_atomic_load(p, __ATOMIC_RELAXED, __HIP_MEMORY_SCOPE_AGENT); }
__device__ __forceinline__ unsigned xb_add(unsigned* p, unsigned v) { return __hip_atomic_fetch_add(p, v, __ATOMIC_RELAXED, __HIP_MEMORY_SCOPE_AGENT); }
__device__ __forceinline__ unsigned xb_xcc_id() { return (unsigned)__builtin_amdgcn_s_getreg((3 << 11) | 20) & 0xFu; }
#define XB_SPIN(cond, bar) do { unsigned _sp = 0; while (cond) { __builtin_amdgcn_s_sleep(1); \
    if ((++_sp & 255u) == 0u) { if (xb_ld(&(bar)[XB_TMO])) break; if (_sp > XB_SPIN_CAP) { atomicAdd(&(bar)[XB_TMO], 1u); break; } } } } while (0)
struct XcdBarrier { unsigned* bar; unsigned x; volatile LAS unsigned* st; };
__device__ __forceinline__ XcdBarrier xcd_barrier_post(unsigned* bar, volatile LAS unsigned* st) {
    XcdBarrier b; b.bar = bar; b.x = xb_xcc_id(); b.st = st;
    if (threadIdx.x == 0) (void)xb_add(&bar[XB_XCNT(b.x)], 1u);
    return b;
}
__device__ __forceinline__ void xcd_barrier_complete(unsigned* bar, unsigned x, unsigned& nloc, unsigned& nx) {
    const unsigned G = gridDim.x * gridDim.y * gridDim.z;
    unsigned sum, cnt, mine, sp = 0u;
    for (;;) {
        sum = 0u; cnt = 0u; mine = 0u;
#pragma unroll
        for (unsigned j = 0; j < 16; ++j) { const unsigned c = xb_ld(&bar[XB_XCNT(j)]); sum += c; cnt += (c > 0u) ? 1u : 0u; mine = (j == x) ? c : mine; }
        if (sum == G) break;
        __builtin_amdgcn_s_sleep(1);
        if ((++sp & 255u) == 0u) { if (xb_ld(&bar[XB_TMO])) break; if (sp > XB_SPIN_CAP) { atomicAdd(&bar[XB_TMO], 1u); break; } }
    }
    nloc = mine > 0u ? mine : 1u; nx = cnt > 0u ? cnt : 1u;
}
__device__ __forceinline__ void xcd_barrier(const XcdBarrier& b) {
    asm volatile("s_waitcnt vmcnt(0)" ::: "memory");
    __syncthreads();
    if (threadIdx.x == 0) {
        unsigned* bar = b.bar;
        __builtin_amdgcn_s_waitcnt(0);
        unsigned nloc = b.st[0], nx = b.st[1];
        if (nloc == 0u) { xcd_barrier_complete(bar, b.x, nloc, nx); b.st[0] = nloc; b.st[1] = nx; }
        const unsigned old = xb_add(&bar[XB_XSUB(b.x)], 1u);
        const unsigned gen = old / nloc;
        if (old + 1u == (gen + 1u) * nloc) {
            __builtin_amdgcn_fence(__ATOMIC_RELEASE, "agent");
            asm volatile("s_waitcnt vmcnt(0)" ::: "memory");
            const unsigned og = xb_add(&bar[XB_TOP], 1u);
            const unsigned tg = og / nx;
            if (og + 1u == (tg + 1u) * nx) xb_add(&bar[XB_TOPGEN], 1u);
            else XB_SPIN(xb_ld(&bar[XB_TOPGEN]) == tg, bar);
            __builtin_amdgcn_fence(__ATOMIC_ACQUIRE, "agent");
            xb_add(&bar[XB_XGEN(b.x)], 1u);
            asm volatile("s_waitcnt vmcnt(0)" ::: "memory");
        } else {
            XB_SPIN(xb_ld(&bar[XB_XGEN(b.x)]) == gen, bar);
            __builtin_amdgcn_fence(__ATOMIC_ACQUIRE, "agent");
            asm volatile("s_waitcnt vmcnt(0)" ::: "memory");
        }
    }
    __syncthreads();
}

struct Frame {
    LAS unsigned char* lds;
    volatile LAS unsigned* MISC;
    gu32* ctl;
    int tid, lane, wave;
    int vcu, G;
    const float *x, *c, *ctx, *cctx, *w_ada, *b_ada, *norm1, *w_in, *b_gates, *conv_w, *head_norm, *w_out, *norm2, *w_rg, *b_rg, *w_re, *b_re, *w_e1, *w_e2, *fnorm;
    float* out;
    float *ADA, *GATES, *EW;
    bf16 *DELTA, *X1B;
    unsigned char *XM8, *WO8, *MIXA8, *WOA8; signed char* WI8; float *SA, *SB, *SB2;
    bf16 *HF, *HB;
    int* ELIST;
    bf16 *WIN, *WOUT, *WE1, *WE2, *XM, *PROJ, *MIX, *XF, *SLOT, *HMOE;
};

template <int CTRL, int ROWMASK> __device__ __forceinline__ float dpp_f(float old, float src) {
    return __builtin_bit_cast(float, __builtin_amdgcn_update_dpp(__builtin_bit_cast(int, old), __builtin_bit_cast(int, src), CTRL, ROWMASK, 0xf, false)); }
__device__ __forceinline__ float wave_incl_sum(float v) {
    v += dpp_f<0x111, 0xf>(0.f, v); v += dpp_f<0x112, 0xf>(0.f, v); v += dpp_f<0x114, 0xf>(0.f, v); v += dpp_f<0x118, 0xf>(0.f, v);
    v += dpp_f<0x142, 0xa>(0.f, v); v += dpp_f<0x143, 0xc>(0.f, v); return v; }
__device__ __forceinline__ float wave_incl_max(float v) {
    constexpr float NI = -3.0e38f;
    v = fmaxf(v, dpp_f<0x111, 0xf>(NI, v)); v = fmaxf(v, dpp_f<0x112, 0xf>(NI, v)); v = fmaxf(v, dpp_f<0x114, 0xf>(NI, v)); v = fmaxf(v, dpp_f<0x118, 0xf>(NI, v));
    v = fmaxf(v, dpp_f<0x142, 0xa>(NI, v)); v = fmaxf(v, dpp_f<0x143, 0xc>(NI, v)); return v; }
__device__ __forceinline__ float lane_bcast(float v, int l) { return __builtin_bit_cast(float, __builtin_amdgcn_readlane(__builtin_bit_cast(int, v), l)); }
__device__ __forceinline__ float wave_sum(float v) { return lane_bcast(wave_incl_sum(v), 63); }
__device__ __forceinline__ float wave_max(float v) { return lane_bcast(wave_incl_max(v), 63); }

__device__ __forceinline__ void p0_ada(Frame& F) {
    LAS float* sil = (LAS float*)F.lds;
    LAS float* red = (LAS float*)(F.lds + 81920);
    for (int i = F.tid; i < 5 * D; i += NTHR) { const int b = i >> 12, k = i & (D - 1); const float cv = b < 4 ? F.c[b * D + k] : F.cctx[k]; sil[i] = cv / (1.f + expf(-cv)); }
    __syncthreads();
    const int cq = F.tid % 24, rg = F.tid / 24;
    for (int item = F.vcu; item < ADA_N / 96; item += F.G) {
        const int col0 = item * 96;
        float acc[5][4];
#pragma unroll
        for (int b = 0; b < 5; ++b)
#pragma unroll
            for (int j = 0; j < 4; ++j) acc[b][j] = 0.f;
        if (rg < 21) {
            const float* wp = F.w_ada + col0 + 4 * cq;
#pragma unroll 13
            for (int r = rg; r < D; r += 21) {
                const f32x4 w = *(const f32x4*)(wp + (size_t)r * ADA_N);
#pragma unroll
                for (int b = 0; b < 5; ++b) { const float s = sil[b * D + r];
#pragma unroll
                    for (int j = 0; j < 4; ++j) acc[b][j] += s * w[j]; }
            }
#pragma unroll
            for (int b = 0; b < 5; ++b)
#pragma unroll
                for (int j = 0; j < 4; ++j) red[rg * 480 + b * 96 + 4 * cq + j] = acc[b][j];
        }
        __syncthreads();
        if (F.tid < 480) { const int b = F.tid / 96, cc = F.tid % 96; float s = 0.f;
#pragma unroll
            for (int q = 0; q < 21; ++q) s += red[q * 480 + F.tid];
            F.ADA[b * ADA_N + col0 + cc] = s + F.b_ada[col0 + cc]; }
        __syncthreads();
    }
}
__device__ __forceinline__ int win_row(int n) {
    if (n < COL_CC || n >= COL_K) return n;
    const int rel = n - COL_CC, au = rel >> 11, r = rel & 2047;
    return COL_CC + 256 * (r >> 7) + 128 * au + (r & 127);
}
struct TItem { const float* W; bf16* WT; const void* cmax; unsigned* cmo; int K, N, nblk, row_off, item, map, f8; float scale; };
template <int KIND>
__device__ __forceinline__ TItem titem_decode(Frame& F, int r) {
    constexpr int I_E1 = (D / 64) * (2 * FF / 32), I_E2 = (FF / 64) * (D / 32);
    TItem t; t.cmax = (const void*)(F.ctl + CW_CMAX); t.cmo = nullptr;
    if (KIND == 8) { t.W = F.w_in; t.WT = (bf16*)F.WI8; t.K = D; t.N = IN_COLS; t.nblk = IN_COLS / 32; t.row_off = 0; t.item = (D / 64) * (IN_COLS / 32) - 1 - r; t.map = 2; t.f8 = 2; t.scale = 1.f; }
    else if (KIND == 0) { t.W = F.w_in; t.WT = F.WIN; t.K = D; t.N = IN_COLS; t.nblk = IN_COLS / 32; t.row_off = 0; t.map = 0; t.f8 = 0; t.scale = 1.f;
        { constexpr int NBP = (IN_COLS - COL_K) / 32; const int kb = r / NBP, nbp = r % NBP; t.item = kb * (IN_COLS / 32) + COL_K / 32 + nbp; } }
    else if (KIND == 1) { t.W = F.w_out; t.WT = F.WOUT; t.K = D; t.N = D; t.nblk = D / 32; t.row_off = 0; t.item = r; t.map = 0; t.f8 = 0; t.scale = 1.f; t.cmo = (unsigned*)(F.ctl + CW_CMAX2); }
    else if (KIND == 2) { const int e = r / I_E1; t.W = F.w_e1 + (size_t)e * D * 2 * FF; t.WT = F.WE1; t.K = D; t.N = 2 * FF; t.nblk = 2 * FF / 32; t.row_off = e * 2 * FF; t.item = r % I_E1; t.map = 1; t.f8 = 1; t.scale = W1_SCALE; }
    else { const int e = r / I_E2; t.W = F.w_e2 + (size_t)e * FF * D; t.WT = F.WE2; t.K = FF; t.N = D; t.nblk = D / 32; t.row_off = e * D; t.item = r % I_E2; t.map = 0; t.f8 = 1; t.scale = W2_SCALE; }
    return t;
}
__device__ __forceinline__ void titem_load(const TItem& t, int lane, f32x4 (&v)[8]) {
    const int nblk = t.nblk, kb = t.item / nblk, nb = t.item % nblk, k0 = 64 * kb, n0 = 32 * nb;
    const float* p = t.W + (size_t)(k0 + (lane >> 3)) * t.N + n0 + 4 * (lane & 7);
#pragma unroll
    for (int i = 0; i < 8; ++i) v[i] = *(const f32x4*)(p + (size_t)(8 * i) * t.N);
}
__device__ __forceinline__ void titem_finish(const TItem& cur, LAS float* scr, int lane) {
    const int nblk = cur.nblk, kb = cur.item / nblk, nb = cur.item % nblk, k0 = 64 * kb, n0 = 32 * nb, c = lane & 7;
#pragma unroll
    for (int j = 0; j < 4; ++j) { const int n = (lane >> 3) + 8 * j; const LAS float* s = scr + (8 * c) * 33 + n;
        const int nn = n0 + n; int row;
        if (cur.map == 0) row = cur.row_off + nn;
        else if (cur.map == 2) row = win_row(nn);
        else { const int au = nn >> 10, r = nn & 1023; row = cur.row_off + 256 * (r >> 7) + 128 * au + (r & 127); }
        const float sc = cur.scale;
        if (cur.f8 == 2) { const float cm = __uint_as_float(((const unsigned*)cur.cmax)[nn]), iv = cm > 0.f ? 127.f / cm : 0.f;
            *(v2u*)((unsigned char*)cur.WT + (size_t)row * cur.K + k0 + 8 * c) = (v2u){pk4_i8(s[0 * 33] * iv, s[1 * 33] * iv, s[2 * 33] * iv, s[3 * 33] * iv), pk4_i8(s[4 * 33] * iv, s[5 * 33] * iv, s[6 * 33] * iv, s[7 * 33] * iv)}; }
        else if (cur.f8) { *(v2u*)((unsigned char*)cur.WT + (size_t)row * cur.K + k0 + 8 * c) = (v2u){pk4_fp8(s[0 * 33] * sc, s[1 * 33] * sc, s[2 * 33] * sc, s[3 * 33] * sc), pk4_fp8(s[4 * 33] * sc, s[5 * 33] * sc, s[6 * 33] * sc, s[7 * 33] * sc)}; }
        else { v4u o; o.x = pk2(s[0 * 33], s[1 * 33]); o.y = pk2(s[2 * 33], s[3 * 33]); o.z = pk2(s[4 * 33], s[5 * 33]); o.w = pk2(s[6 * 33], s[7 * 33]);
               *(v4u*)(cur.WT + (size_t)row * cur.K + k0 + 8 * c) = o;
               if (cur.cmo != nullptr && k0 < D / 2) {
                   unsigned mx = max(max(max((o.x & 0x7fffu) << 16, o.x & 0x7fff0000u), max((o.y & 0x7fffu) << 16, o.y & 0x7fff0000u)), max(max((o.z & 0x7fffu) << 16, o.z & 0x7fff0000u), max((o.w & 0x7fffu) << 16, o.w & 0x7fff0000u)));
                   mx = max(mx, (unsigned)__shfl_xor((int)mx, 1)); mx = max(mx, (unsigned)__shfl_xor((int)mx, 2)); mx = max(mx, (unsigned)__shfl_xor((int)mx, 4));
                   if (c == 0) (void)__hip_atomic_fetch_max(cur.cmo + nn, mx, RLX_AGENT); } } }
}
constexpr int TI_IN = (D / 64) * (IN_COLS / 32), TI_OUT = (D / 64) * (D / 32), TI_E1 = (D / 64) * (2 * FF / 32), TI_E2 = (FF / 64) * (D / 32);
template <int KIND>
__device__ __forceinline__ void transpose_range(Frame& F, LAS float* scr, int it0, int it_end, int stride) {
    const int lane = F.lane;
    f32x4 v[8];
    int it = it0;
    TItem cur = titem_decode<KIND>(F, it < it_end ? it : 0);
    if (it < it_end) titem_load(cur, lane, v);
    while (it < it_end) {
#pragma unroll
        for (int i = 0; i < 8; ++i) { const int kk = 8 * i + (lane >> 3); LAS float* s = scr + kk * 33 + 4 * (lane & 7); s[0] = v[i][0]; s[1] = v[i][1]; s[2] = v[i][2]; s[3] = v[i][3]; }
        const int nit = it + stride;
        TItem nxt = cur;
        if (nit < it_end) { nxt = titem_decode<KIND>(F, nit); titem_load(nxt, lane, v); }
        LDS_WAIT(); asm volatile("" ::: "memory");
        titem_finish(cur, scr, lane);
        LDS_WAIT(); asm volatile("" ::: "memory");
        cur = nxt; it = nit;
    }
}
__device__ __forceinline__ void p0_transposes(Frame& F) {
    LAS float* scr = (LAS float*)(F.lds + F.wave * 8704);
    const int gw = F.vcu * NWAVES + F.wave, NGW = F.G * NWAVES;
    transpose_range<1>(F, scr, gw, TI_OUT, NGW);
    {
        constexpr int NIT = (D / 64) * (IN_COLS / 32);
        const int lane = F.lane;
        auto cm_load = [&](int it, f32x4 (&w)[8]) __attribute__((always_inline)) {
            const int itc = it < NIT ? it : NIT - 1, kb = itc / (IN_COLS / 32), nb = itc % (IN_COLS / 32);
            const float* p = F.w_in + (size_t)(64 * kb + (lane >> 3)) * IN_COLS + 32 * nb + 4 * (lane & 7);
#pragma unroll
            for (int i = 0; i < 8; ++i) w[i] = *(const f32x4*)(p + (size_t)(8 * i) * IN_COLS);
        };
        auto cm_step = [&](int it, f32x4 (&cur)[8], f32x4 (&nxt)[8]) __attribute__((always_inline)) {
            cm_load(it + NGW, nxt);
            if (it < NIT) {
                const int nb = it % (IN_COLS / 32);
                f32x4 mx = (f32x4){0.f, 0.f, 0.f, 0.f};
#pragma unroll
                for (int i = 0; i < 8; ++i) { mx[0] = fmaxf(mx[0], fabsf(cur[i][0])); mx[1] = fmaxf(mx[1], fabsf(cur[i][1])); mx[2] = fmaxf(mx[2], fabsf(cur[i][2])); mx[3] = fmaxf(mx[3], fabsf(cur[i][3])); }
#pragma unroll
                for (int o = 8; o < 64; o <<= 1) { mx[0] = fmaxf(mx[0], __shfl_xor(mx[0], o)); mx[1] = fmaxf(mx[1], __shfl_xor(mx[1], o)); mx[2] = fmaxf(mx[2], __shfl_xor(mx[2], o)); mx[3] = fmaxf(mx[3], __shfl_xor(mx[3], o)); }
                if (lane < 8) { unsigned* cm = (unsigned*)(F.ctl + CW_CMAX) + 32 * nb + 4 * lane;
#pragma unroll
                    for (int j = 0; j < 4; ++j) asm volatile("global_atomic_umax %0, %1, off" :: "v"(cm + j), "v"(__float_as_uint(mx[j])) : "memory"); }
            }
        };
        f32x4 wa[8], wb[8];
        cm_load(gw, wa);
        for (int it = gw; it < NIT; it += 2 * NGW) { cm_step(it, wa, wb); cm_step(it + NGW, wb, wa); }
        asm volatile("s_waitcnt vmcnt(0) ; hidden atomics" ::: "memory");
    }
    { const size_t n16 = (size_t)(NPAD - IN_COLS) * D / 16; v4u* p = (v4u*)(F.WI8 + (size_t)IN_COLS * D);
      for (size_t i = (size_t)F.vcu * NTHR + F.tid; i < n16; i += (size_t)F.G * NTHR) p[i] = (v4u){0u, 0u, 0u, 0u}; }
}
__device__ __forceinline__ int expert_queue_items(int G) { const int tot = NE * (TI_E1 + TI_E2), p3 = (4 + SEQ / 64) * G * NWAVES / 2; return tot > p3 ? tot - p3 : 0; }
struct HItem { const float* src; unsigned char* dst; int N, Kb, map, row0; float scale; };
__device__ __forceinline__ HItem hitem_decode(Frame& F, int hi) {
    const int fi = hi >> 1, sub = hi & 1; HItem t;
    if (fi < NE * TI_E1) { const int e = fi / TI_E1, item = fi % TI_E1, kb = item >> 6, nb = item & 63, n0 = 32 * nb + 16 * sub;
        t.N = 2 * FF; t.Kb = D; t.map = 1; t.scale = W1_SCALE; t.src = F.w_e1 + (size_t)e * D * 2 * FF + (size_t)(64 * kb) * t.N + n0;
        const int au = n0 >> 10, r = n0 & 1023; t.row0 = e * 2 * FF + 256 * (r >> 7) + 128 * au + (r & 127); t.dst = (unsigned char*)F.WE1 + 64 * kb; }
    else { const int f2 = fi - NE * TI_E1, e = f2 / TI_E2, item = f2 % TI_E2, kb = item >> 7, nb = item & 127, n0 = 32 * nb + 16 * sub;
        t.N = D; t.Kb = FF; t.map = 0; t.scale = W2_SCALE; t.src = F.w_e2 + (size_t)e * FF * D + (size_t)(64 * kb) * t.N + n0;
        t.row0 = e * D + n0; t.dst = (unsigned char*)F.WE2 + 64 * kb; }
    return t;
}
__device__ __forceinline__ void hitem_load(const HItem& t, int lane, f32x4 (&v)[4]) {
    const float* p = t.src + (size_t)(lane >> 2) * t.N + 4 * (lane & 3);
#pragma unroll
    for (int i = 0; i < 4; ++i) v[i] = *(const f32x4*)(p + (size_t)(16 * i) * t.N);
}
__device__ __forceinline__ void hitem_to_lds(int lane, const f32x4 (&v)[4], LAS float* scr) {
#pragma unroll
    for (int i = 0; i < 4; ++i) { LAS float* s = scr + (16 * i + (lane >> 2)) * 17 + 4 * (lane & 3); s[0] = v[i][0]; s[1] = v[i][1]; s[2] = v[i][2]; s[3] = v[i][3]; }
}
__device__ __forceinline__ void hitem_store(const HItem& t, int lane, LAS float* scr) {
    LDS_WAIT(); asm volatile("" ::: "memory");
    const int n = lane & 15, kc = lane >> 4; const LAS float* s = scr + (16 * kc) * 17 + n; const float sc = t.scale;
    v4u o;
    o.x = pk4_fp8(s[0 * 17] * sc, s[1 * 17] * sc, s[2 * 17] * sc, s[3 * 17] * sc); o.y = pk4_fp8(s[4 * 17] * sc, s[5 * 17] * sc, s[6 * 17] * sc, s[7 * 17] * sc);
    o.z = pk4_fp8(s[8 * 17] * sc, s[9 * 17] * sc, s[10 * 17] * sc, s[11 * 17] * sc); o.w = pk4_fp8(s[12 * 17] * sc, s[13 * 17] * sc, s[14 * 17] * sc, s[15 * 17] * sc);
    *(v4u*)(t.dst + (size_t)(t.row0 + n) * t.Kb + 16 * kc) = o;
    LDS_WAIT(); asm volatile("" ::: "memory");
}
__device__ __forceinline__ void gstore8_hidden(void* p, v2u v) { asm volatile("global_store_dwordx2 %0, %1, off" :: "v"(p), "v"(v) : "memory"); }
__device__ __forceinline__ void gstore16_hidden(void* p, v4u v) { asm volatile("global_store_dwordx4 %0, %1, off" :: "v"(p), "v"(v) : "memory"); }
__device__ __forceinline__ void hitem_store_hidden(const HItem& t, int lane, LAS float* scr) {
    LDS_WAIT(); asm volatile("" ::: "memory");
    const int n = lane & 15, kc = lane >> 4; const LAS float* s = scr + (16 * kc) * 17 + n; const float sc = t.scale;
    v4u o;
    o.x = pk4_fp8(s[0 * 17] * sc, s[1 * 17] * sc, s[2 * 17] * sc, s[3 * 17] * sc); o.y = pk4_fp8(s[4 * 17] * sc, s[5 * 17] * sc, s[6 * 17] * sc, s[7 * 17] * sc);
    o.z = pk4_fp8(s[8 * 17] * sc, s[9 * 17] * sc, s[10 * 17] * sc, s[11 * 17] * sc); o.w = pk4_fp8(s[12 * 17] * sc, s[13 * 17] * sc, s[14 * 17] * sc, s[15 * 17] * sc);
    gstore16_hidden(t.dst + (size_t)(t.row0 + n) * t.Kb + 16 * kc, o);
    LDS_WAIT(); asm volatile("" ::: "memory");
}
__device__ __forceinline__ void hitem_read(int lane, const LAS float* scr, float (&hr)[16]) {
    const int n = lane & 15, kc = lane >> 4; const LAS float* s = scr + (16 * kc) * 17 + n;
#pragma unroll
    for (int j = 0; j < 16; ++j) hr[j] = s[j * 17];
}
__device__ __forceinline__ void hitem_pack_store(const HItem& t, int lane, const float (&hr)[16]) {
    const int n = lane & 15, kc = lane >> 4; const float sc = t.scale;
    v4u o;
    o.x = pk4_fp8(hr[0] * sc, hr[1] * sc, hr[2] * sc, hr[3] * sc); o.y = pk4_fp8(hr[4] * sc, hr[5] * sc, hr[6] * sc, hr[7] * sc);
    o.z = pk4_fp8(hr[8] * sc, hr[9] * sc, hr[10] * sc, hr[11] * sc); o.w = pk4_fp8(hr[12] * sc, hr[13] * sc, hr[14] * sc, hr[15] * sc);
    gstore16_hidden(t.dst + (size_t)(t.row0 + n) * t.Kb + 16 * kc, o);
}
constexpr int TQ_BATCH = 16;
static_assert((NE * TI_E1) % TQ_BATCH == 0 && (NE * TI_E2) % TQ_BATCH == 0, "queue batches stay inside one kind");
__device__ __forceinline__ void expert_transpose_queue(Frame& F) {
    LAS float* scr = (LAS float*)(F.lds + F.wave * 8704);
    for (;;) {
        int base = 0;
        if (F.lane == 0) base = (int)__hip_atomic_fetch_add((unsigned*)(F.ctl + CW_TQ), (unsigned)TQ_BATCH, RLX_AGENT);
        base = __builtin_amdgcn_readfirstlane(base);
        if (base >= expert_queue_items(F.G)) break;
        if (base < NE * TI_E1) transpose_range<2>(F, scr, base, base + TQ_BATCH, 1);
        else transpose_range<3>(F, scr, base - NE * TI_E1, base - NE * TI_E1 + TQ_BATCH, 1);
    }
}

__device__ __forceinline__ void p1_quant_weights(Frame& F) {
    __syncthreads();
    LAS float* scr = (LAS float*)(F.lds + F.wave * 8704);
    const int gw = F.vcu * NWAVES + F.wave, NGW = F.G * NWAVES;
    transpose_range<8>(F, scr, gw, (D / 64) * (IN_COLS / 32), NGW);
    for (int n = F.vcu * NTHR + F.tid; n < IN_COLS; n += F.G * NTHR) F.SB[win_row(n)] = __uint_as_float(((const unsigned*)(F.ctl + CW_CMAX))[n]) * (1.f / 127.f);
}
__device__ __forceinline__ void p1_quant_wout(Frame& F) {
    const int gw = F.vcu * NWAVES + F.wave, NGW = F.G * NWAVES, lane = F.lane;
    for (int n = gw; n < D; n += NGW) {
        const unsigned cmb = ((const unsigned*)(F.ctl + CW_CMAX2))[n]; const float cm = __uint_as_float(cmb), iv = cm > 0.f ? 127.f / cm : 0.f;
        const bf16* src = F.WOUT + (size_t)n * D; unsigned char* dst = F.WOA8 + (size_t)n * (D / 2);
        v4u v[4];
#pragma unroll
        for (int j = 0; j < 4; ++j) v[j] = *(const v4u*)(src + 512 * j + 8 * lane);
#pragma unroll
        for (int j = 0; j < 4; ++j) *(v2u*)(dst + 512 * j + 8 * lane) = (v2u){pk4_i8(bf_lo(v[j].x) * iv, bf_hi(v[j].x) * iv, bf_lo(v[j].y) * iv, bf_hi(v[j].y) * iv), pk4_i8(bf_lo(v[j].z) * iv, bf_hi(v[j].z) * iv, bf_lo(v[j].w) * iv, bf_hi(v[j].w) * iv)};
        if (lane == 0) F.SB2[n] = cm * (1.f / 127.f);
    }
}
__device__ __forceinline__ void p1_norm(Frame& F) {
    LAS float* fac = (LAS float*)F.lds; LAS float* sh = fac + D;
    const int gw = F.vcu * NWAVES + F.wave, NGW = F.G * NWAVES;
    for (int bb = 0; bb < 5; ++bb) {
        __syncthreads();
        for (int i = F.tid; i < D; i += NTHR) { fac[i] = F.norm1[i] * (1.f + F.ADA[bb * ADA_N + D + i]); sh[i] = F.ADA[bb * ADA_N + i]; }
        __syncthreads();
        const int nrows = bb < 4 ? SEQ : TC; const float* src = bb < 4 ? F.x + (size_t)bb * SEQ * D : F.ctx; const int drow0 = bb < 4 ? bb * SEQ : T;
        for (int r = gw; r < nrows; r += 2 * NGW) {
            int lane = F.lane; asm volatile("" : "+v"(lane));
            const int r2 = r + NGW; const bool has2 = r2 < nrows; const int r2c = has2 ? r2 : r;
            const f32x4* xa = (const f32x4*)(src + (size_t)r * D) + lane; const f32x4* xb = (const f32x4*)(src + (size_t)r2c * D) + lane;
            f32x4 va[16], vb[16]; float sa = 0.f, sb = 0.f;
#pragma unroll
            for (int j = 0; j < 16; ++j) { va[j] = xa[64 * j]; vb[j] = xb[64 * j]; }
#pragma unroll
            for (int j = 0; j < 16; ++j) { sa = fmaf(va[j][0], va[j][0], fmaf(va[j][1], va[j][1], fmaf(va[j][2], va[j][2], fmaf(va[j][3], va[j][3], sa))));
                                           sb = fmaf(vb[j][0], vb[j][0], fmaf(vb[j][1], vb[j][1], fmaf(vb[j][2], vb[j][2], fmaf(vb[j][3], vb[j][3], sb)))); }
            const float ra = rsqrtf(wave_sum(sa) * (1.f / D) + EPS), rb = rsqrtf(wave_sum(sb) * (1.f / D) + EPS);
#pragma unroll
            for (int j = 0; j < 16; ++j) { const f32x4 fa = *(const LAS f32x4*)(fac + 256 * j + 4 * lane), sv = *(const LAS f32x4*)(sh + 256 * j + 4 * lane);
                va[j] = va[j] * ra * fa + sv; vb[j] = vb[j] * rb * fa + sv; }
            {
                float ma = 0.f, mb = 0.f;
#pragma unroll
                for (int j = 0; j < 16; ++j) { ma = fmaxf(ma, fmaxf(fmaxf(fabsf(va[j][0]), fabsf(va[j][1])), fmaxf(fabsf(va[j][2]), fabsf(va[j][3])))); mb = fmaxf(mb, fmaxf(fmaxf(fabsf(vb[j][0]), fabsf(vb[j][1])), fmaxf(fabsf(vb[j][2]), fabsf(vb[j][3])))); }
                ma = wave_max(ma); mb = wave_max(mb);
                const float ia = ma > 0.f ? 127.f / ma : 0.f, ib = mb > 0.f ? 127.f / mb : 0.f;
                if (lane == 0) { F.SA[drow0 + r] = ma * (1.f / 127.f); if (has2) F.SA[drow0 + r2c] = mb * (1.f / 127.f); }
#pragma unroll
                for (int j = 0; j < 16; ++j) { ((unsigned*)(F.XM8 + (size_t)(drow0 + r) * D) + lane)[64 * j] = pk4_i8(va[j][0] * ia, va[j][1] * ia, va[j][2] * ia, va[j][3] * ia);
                    if (has2) ((unsigned*)(F.XM8 + (size_t)(drow0 + r2c) * D) + lane)[64 * j] = pk4_i8(vb[j][0] * ib, vb[j][1] * ib, vb[j][2] * ib, vb[j][3] * ib); }
            }
        }
    }
}

namespace ml {
constexpr int QP = 272, VP = 160, PP = 144, CP = 272;
constexpr int OFF_Q = 0, OFF_K = OFF_Q + 64 * QP, OFF_V = OFF_K + 64 * QP, OFF_VW = OFF_V + 64 * VP, OFF_P = OFF_VW + 64 * VP, OFF_CB = OFF_P + 64 * PP, CB_BYTES = 80 * CP, LDS_END = OFF_CB + 2 * CB_BYTES;
static_assert(LDS_END <= RING_BYTES, "mlstm LDS");
typedef short s16x4 __attribute__((ext_vector_type(4)));
typedef short bf16x8 __attribute__((ext_vector_type(8)));
__device__ __forceinline__ s16x4 tr(const LAS unsigned char* p) { return __builtin_bit_cast(s16x4, __builtin_amdgcn_ds_read_tr16_b64_v4i16((LAS s16x4*)p)); }
__device__ __forceinline__ bf16x8 trfrag(const LAS unsigned char* p, int pitch) { const s16x4 a = tr(p), b = tr(p + 4 * pitch); return (bf16x8){a[0], a[1], a[2], a[3], b[0], b[1], b[2], b[3]}; }
__device__ __forceinline__ bf16x8 ld16(const LAS unsigned char* p) { return *(const LAS bf16x8*)p; }
__device__ __forceinline__ int row_of(int c, int p, int dir, int b) {
    if (c < 4) { const int i = 64 * c + p; return T + b * CTXL + (dir ? (CTXL - 1 - i) : i); }
    const int i = 64 * (c - 4) + p; return b * SEQ + (dir ? (SEQ - 1 - i) : i);
}
}
#define ML_BAR() do { asm volatile("s_waitcnt lgkmcnt(0)" ::: "memory"); __builtin_amdgcn_s_barrier(); asm volatile("" ::: "memory"); } while (0)
__device__ __forceinline__ void p3_mlstm(Frame& F) {
    using namespace ml;
    LAS unsigned char* lds = F.lds;
    const int tid = F.tid, lane = F.lane, wave = F.wave, li = lane & 15, lg = lane >> 4, lq = (lane & 15) >> 2, lp = lane & 3;
    constexpr float QS = 0.08838834764831845f;
    constexpr int NCH = 4 + SEQ / 64;
    constexpr int SC_A = LDS_END, SC_M = SC_A + 256, SC_B = SC_M + 256;
    constexpr int HSCR_OFF = SC_B + 256;
    static_assert(HSCR_OFF + NWAVES * 4352 <= LDSCTL_OFF, "mlstm LDS");
    for (int unit = F.vcu; unit < NB * NH * 2 * 4; unit += F.G) {
        const int vq = unit & 3, dir = (unit >> 2) & 1, h = (unit >> 3) & 7, b = unit >> 6;
        bf16* HO = dir ? F.HB : F.HF;
        __syncthreads();
        unsigned z0 = 0u; asm volatile("" : "+v"(z0));
        for (int i = tid; i < CB_BYTES / 16; i += NTHR) *(LAS v4u*)(lds + OFF_CB + 16 * i) = (v4u){z0, z0, z0, z0};
        if (tid < 64) { *(LAS v4u*)(lds + OFF_V + tid * VP + 128) = (v4u){0x00003F80u | z0, z0, z0, z0}; *(LAS v4u*)(lds + OFF_V + tid * VP + 144) = (v4u){z0, z0, z0, z0};
                        *(LAS v4u*)(lds + OFF_VW + tid * VP + 128) = (v4u){z0, z0, z0, z0}; *(LAS v4u*)(lds + OFF_VW + tid * VP + 144) = (v4u){z0, z0, z0, z0}; }
        f32x4 Cacc[5];
#pragma unroll
        for (int i = 0; i < 5; ++i) Cacc[i] = (f32x4){0.f, 0.f, 0.f, 0.f};
        v4u rq[2], rk[2], rv; float ig, fp;
        rq[0] = rq[1] = (v4u){0u, 0u, 0u, 0u};
        const GAS bf16* pk_[2]; const GAS bf16* pv_; const GAS float* pg_;
#define ML_SETPTR(cc) do { const int cs_ = (cc); \
        _Pragma("unroll") for (int i = 0; i < 2; ++i) { const int id = tid + NTHR * i, p = id >> 4, ch = id & 15; pk_[i] = (const GAS bf16*)F.PROJ + (size_t)row_of(cs_, p, dir, b) * NPROJ + COL_K + h * DK + 8 * ch; } \
        { const int p = tid >> 3, ch = tid & 7; pv_ = (const GAS bf16*)F.PROJ + (size_t)row_of(cs_, p, dir, b) * NPROJ + COL_V + h * DV + vq * 64 + 8 * ch; } \
        pg_ = (const GAS float*)F.GATES + (size_t)row_of(cs_, lane, dir, b) * 32 + dir * 16 + h; } while (0)
#define ML_PREFETCH(cc) do { const int c_ = (cc); if (c_ == 0 || c_ == 4) ML_SETPTR(c_); \
        _Pragma("unroll") for (int i = 0; i < 2; ++i) { rk[i] = *(const GAS v4u*)pk_[i]; rq[i] = *(const GAS v4u*)(pk_[i] + (COL_Q - COL_K)); pk_[i] += pstep; } \
        rv = *(const GAS v4u*)pv_; pv_ += pstep; ig = pg_[0]; fp = pg_[8]; pg_ += gstep; } while (0)
        const long pstep = (dir ? -64 : 64) * (long)NPROJ, gstep = (dir ? -64 : 64) * 32;
        float bc, g, Ap, Mp, M63, wS, decay, wsv, m = 0.f;
#define ML_SCALARS(m_in) do { const float lf_ = fminf(fp, 0.f) - 0.6931471805599453f * __log2f(1.f + __expf(-fabsf(fp))); \
        bc = wave_incl_sum(lf_); g = lane_bcast(bc, 63); Ap = ig - bc; const float PA_ = wave_incl_max(Ap), Amax_ = lane_bcast(PA_, 63); \
        Mp = fmaxf((m_in), PA_); M63 = fmaxf((m_in), Amax_); wS = __expf(Ap - M63); decay = __expf((m_in) - M63); wsv = __shfl(wS, 8 * wave + (lane >> 3)); } while (0)
#define ML_STAGE() do { \
        _Pragma("unroll") for (int i = 0; i < 2; ++i) { const int id = tid + NTHR * i, p = id >> 4, ch = id & 15; \
            *(LAS v4u*)(lds + OFF_K + p * QP + 16 * ch) = rk[i]; *(LAS v4u*)(lds + OFF_Q + p * QP + 16 * ch) = rq[i]; } \
        { const int p = tid >> 3, ch = tid & 7; \
          *(LAS v4u*)(lds + OFF_V + p * VP + 16 * ch) = rv; \
          v4u o; o.x = pk2(bf_lo(rv.x) * wsv, bf_hi(rv.x) * wsv); o.y = pk2(bf_lo(rv.y) * wsv, bf_hi(rv.y) * wsv); o.z = pk2(bf_lo(rv.z) * wsv, bf_hi(rv.z) * wsv); o.w = pk2(bf_lo(rv.w) * wsv, bf_hi(rv.w) * wsv); \
          *(LAS v4u*)(lds + OFF_VW + p * VP + 16 * ch) = o; } \
        if (wave == 0) { *(LAS unsigned short*)(lds + OFF_VW + lane * VP + 128) = (unsigned short)(pk2(wS, 0.f) & 0xffffu); \
                         *(LAS float*)(lds + SC_A + 4 * lane) = Ap; *(LAS float*)(lds + SC_M + 4 * lane) = Mp; *(LAS float*)(lds + SC_B + 4 * lane) = bc; } } while (0)
        ML_PREFETCH(0);
        const int tt = wave >> 1, trow = 16 * tt + li, vt0 = (wave & 1) ? 2 : 0, dt = wave;
        const int hi0 = 2 * expert_queue_items(F.G) + (unit / F.G) * NCH * (F.G * NWAVES) + F.vcu * NWAVES + wave;
        LAS float* hscr = (LAS float*)(lds + HSCR_OFF + wave * 4352);
        ML_SCALARS(m);
        ML_BAR();
        ML_STAGE();
        constexpr int HLIM = 2 * NE * (TI_E1 + TI_E2);
        f32x4 hvA[4], hvB[4];
        { const int h0 = hi0 < HLIM ? hi0 : HLIM - 1; hitem_load(hitem_decode(F, h0), lane, hvA); }
        auto step = [&](const int c, f32x4 (&hvn)[4], f32x4 (&hvo)[4]) __attribute__((always_inline)) {
            const bool lat = c >= 4;
            ML_BAR();
            const float dec_c = decay, m_c = m, m_next = g + M63;
            ML_PREFETCH(c + 1);
            const int hi = hi0 + c * (F.G * NWAVES);
            const bool hact = hi < HLIM;
            f32x4 oacc[3];
#pragma unroll
            for (int j = 0; j < 3; ++j) oacc[j] = (f32x4){0.f, 0.f, 0.f, 0.f};
            float Mt = 0.f; v2u hout[2] = {(v2u){0u, 0u}, (v2u){0u, 0u}};
            if (lat) {
                bf16x8 Bq[4], Ak[2][4], Cf[3][4];
                const LAS unsigned char* cbo = lds + OFF_CB + (c & 1) * CB_BYTES;
#pragma unroll
                for (int ks = 0; ks < 4; ++ks) Bq[ks] = ld16(lds + OFF_Q + trow * QP + 64 * ks + 16 * lg);
#pragma unroll
                for (int sti = 0; sti < 2; ++sti)
#pragma unroll
                    for (int ks = 0; ks < 4; ++ks) Ak[sti][ks] = ld16(lds + OFF_K + (16 * (2 * (wave & 1) + sti) + li) * QP + 64 * ks + 16 * lg);
                Mt = *(const LAS float*)(lds + SC_M + 4 * trow);
                f32x4 A4[2];
#pragma unroll
                for (int sti = 0; sti < 2; ++sti) A4[sti] = *(const LAS f32x4*)(lds + SC_A + 4 * (16 * (2 * (wave & 1) + sti) + 4 * lg));
#pragma unroll
                for (int j = 0; j < 3; ++j)
#pragma unroll
                    for (int ks = 0; ks < 4; ++ks) Cf[j][ks] = ld16(cbo + (16 * (j < 2 ? vt0 + j : 4) + li) * CP + 64 * ks + 16 * lg);
                f32x4 sacc[2];
#pragma unroll
                for (int sti = 0; sti < 2; ++sti) { sacc[sti] = (f32x4){0.f, 0.f, 0.f, 0.f};
#pragma unroll
                    for (int ks = 0; ks < 4; ++ks) sacc[sti] = __builtin_amdgcn_mfma_f32_16x16x32_bf16(Ak[sti][ks], Bq[ks], sacc[sti], 0, 0, 0); }
#pragma unroll
                for (int ks = 0; ks < 4; ++ks)
#pragma unroll
                    for (int j = 0; j < 3; ++j) oacc[j] = __builtin_amdgcn_mfma_f32_16x16x32_bf16(Cf[j][ks], Bq[ks], oacc[j], 0, 0, 0);
#pragma unroll
                for (int sti = 0; sti < 2; ++sti) { const int st = 2 * (wave & 1) + sti; float v[4];
#pragma unroll
                    for (int r = 0; r < 4; ++r) { const int sp = 16 * st + 4 * lg + r; v[r] = sp <= trow ? sacc[sti][r] * QS * __expf(A4[sti][r] - Mt) : 0.f; }
                    *(LAS v2u*)(lds + OFF_P + trow * PP + 2 * (16 * st + 4 * lg)) = (v2u){pk2(v[0], v[1]), pk2(v[2], v[3])}; }
                const float e2 = __expf(m_c - Mt) * QS;
#pragma unroll
                for (int j = 0; j < 3; ++j) oacc[j] = oacc[j] * e2;
            }
            {
                bf16x8 At[2], Bt[5][2];
#pragma unroll
                for (int ks = 0; ks < 2; ++ks) At[ks] = trfrag(lds + OFF_K + (32 * ks + 8 * lg + lq) * QP + 32 * dt + 8 * lp, QP);
#pragma unroll
                for (int vt = 0; vt < 5; ++vt)
#pragma unroll
                    for (int ks = 0; ks < 2; ++ks) Bt[vt][ks] = trfrag(lds + OFF_VW + (32 * ks + 8 * lg + lq) * VP + 32 * vt + 8 * lp, VP);
#pragma unroll
                for (int vt = 0; vt < 5; ++vt) Cacc[vt] = Cacc[vt] * dec_c;
#pragma unroll
                for (int ks = 0; ks < 2; ++ks)
#pragma unroll
                    for (int vt = 0; vt < 5; ++vt) Cacc[vt] = __builtin_amdgcn_mfma_f32_16x16x32_bf16(At[ks], Bt[vt][ks], Cacc[vt], 0, 0, 0);
                LAS unsigned char* cbn = lds + OFF_CB + ((c + 1) & 1) * CB_BYTES;
#pragma unroll
                for (int vt = 0; vt < 5; ++vt) *(LAS v2u*)(cbn + (16 * vt + li) * CP + 2 * (16 * dt + 4 * lg)) = (v2u){pk2(Cacc[vt][0], Cacc[vt][1]), pk2(Cacc[vt][2], Cacc[vt][3])};
            }
            if (hact) hitem_to_lds(lane, hvo, hscr);
            { const int hn = hi + F.G * NWAVES; hitem_load(hitem_decode(F, hn < HLIM ? hn : HLIM - 1), lane, hvn); }
            ML_BAR();
            if (lat) {
                bf16x8 Pf[2], Vt[3][2];
#pragma unroll
                for (int ks = 0; ks < 2; ++ks) Pf[ks] = ld16(lds + OFF_P + trow * PP + 64 * ks + 16 * lg);
#pragma unroll
                for (int j = 0; j < 3; ++j)
#pragma unroll
                    for (int ks = 0; ks < 2; ++ks) Vt[j][ks] = trfrag(lds + OFF_V + (32 * ks + 8 * lg + lq) * VP + 32 * (j < 2 ? vt0 + j : 4) + 8 * lp, VP);
                const float bct = *(const LAS float*)(lds + SC_B + 4 * trow);
#pragma unroll
                for (int ks = 0; ks < 2; ++ks)
#pragma unroll
                    for (int j = 0; j < 3; ++j) oacc[j] = __builtin_amdgcn_mfma_f32_16x16x32_bf16(Vt[j][ks], Pf[ks], oacc[j], 0, 0, 0);
                const float den = __shfl(oacc[2][0], li);
                const float inv = 1.f / fmaxf(fabsf(den), __expf(-(bct + Mt)));
#pragma unroll
                for (int j = 0; j < 2; ++j) { const f32x4 o = oacc[j] * inv; hout[j] = (v2u){pk2(o[0], o[1]), pk2(o[2], o[3])}; }
            }
            float hr[16];
            if (hact) hitem_read(lane, hscr, hr);
            m = m_next;
            if (c + 1 < NCH) ML_SCALARS(m);
            asm volatile("; chunk c+1 pieces are used here so that the wait for them sits in front of this step's stores" : "+v"(rk[0]), "+v"(rk[1]), "+v"(rq[0]), "+v"(rq[1]), "+v"(rv) :: "memory");
            if (lat) { bf16* hp = HO + (size_t)row_of(c, trow, dir, b) * 2048 + h * DV + vq * 64 + 4 * lg;
#pragma unroll
                for (int j = 0; j < 2; ++j) gstore8_hidden(hp + 16 * (vt0 + j), hout[j]); }
            if (hact) hitem_pack_store(hitem_decode(F, hi), lane, hr);
            ML_BAR();
            if (c + 1 < NCH) ML_STAGE();
        };
        static_assert(NCH % 2 == 0, "two steps per trip");
        for (int c = 0; c < NCH; c += 2) { step(c, hvB, hvA); step(c + 1, hvA, hvB); }
        asm volatile("s_waitcnt vmcnt(0) ; the hidden stores of the loop" ::: "memory");
#undef ML_PREFETCH
#undef ML_SETPTR
#undef ML_SCALARS
#undef ML_STAGE
    }
}

__device__ __forceinline__ void p4_mix(Frame& F) {
    const int gw = F.vcu * NWAVES + F.wave, NGW = F.G * NWAVES;
    LAS float* cwl = (LAS float*)F.lds; LAS float* hnl = cwl + 3 * 2048;
    __syncthreads();
    for (int i = F.tid; i < 3 * 2048 / 4; i += NTHR) *(LAS f32x4*)(cwl + 4 * i) = *(const f32x4*)(F.conv_w + 4 * i);
    for (int i = F.tid; i < 2048 / 4; i += NTHR) *(LAS f32x4*)(hnl + 4 * i) = *(const f32x4*)(F.head_norm + 4 * i);
    __syncthreads();
    for (int r = gw; r < T; r += NGW) {
        int lane = F.lane; asm volatile("" : "+v"(lane));
        const int s = r & (SEQ - 1), gr = s >> 6, gc = s & 63;
        const bf16* pr = F.PROJ + (size_t)r * NPROJ;
        bf16* mr = F.MIX + (size_t)r * D;
        {
            v2u ha[NH], hb[NH], og[NH];
#pragma unroll
            for (int hh = 0; hh < NH; ++hh) { const int idx = hh * DV + 4 * lane;
                ha[hh] = *(const v2u*)(F.HF + (size_t)r * 2048 + idx); hb[hh] = *(const v2u*)(F.HB + (size_t)r * 2048 + idx); og[hh] = *(const v2u*)(pr + COL_O + idx); }
            f32x4 hs[NH]; float ss[NH];
#pragma unroll
            for (int hh = 0; hh < NH; ++hh) { hs[hh] = (f32x4){bf_lo(ha[hh].x) + bf_lo(hb[hh].x), bf_hi(ha[hh].x) + bf_hi(hb[hh].x), bf_lo(ha[hh].y) + bf_lo(hb[hh].y), bf_hi(ha[hh].y) + bf_hi(hb[hh].y)};
                ss[hh] = (hs[hh][0] * hs[hh][0] + hs[hh][1] * hs[hh][1]) + (hs[hh][2] * hs[hh][2] + hs[hh][3] * hs[hh][3]); }
#pragma unroll
            for (int hh = 0; hh < NH; ++hh) ss[hh] = wave_sum(ss[hh]);
            float ym = 0.f;
#pragma unroll
            for (int hh = 0; hh < NH; ++hh) { const float rs = rsqrtf(ss[hh] * (1.f / DV) + EPS); const f32x4 hw = *(const LAS f32x4*)(hnl + hh * DV + 4 * lane);
                hs[hh][0] = hs[hh][0] * rs * hw[0] * sigmoidf_(bf_lo(og[hh].x)); hs[hh][1] = hs[hh][1] * rs * hw[1] * sigmoidf_(bf_hi(og[hh].x));
                hs[hh][2] = hs[hh][2] * rs * hw[2] * sigmoidf_(bf_lo(og[hh].y)); hs[hh][3] = hs[hh][3] * rs * hw[3] * sigmoidf_(bf_hi(og[hh].y));
                ym = fmaxf(ym, fmaxf(fmaxf(fabsf(hs[hh][0]), fabsf(hs[hh][1])), fmaxf(fabsf(hs[hh][2]), fabsf(hs[hh][3])))); }
            ym = wave_max(ym);
            const float iy = ym > 0.f ? 127.f / ym : 0.f;
            if (lane == 0) F.SA[r] = ym * (1.f / 127.f);
#pragma unroll
            for (int hh = 0; hh < NH; ++hh) *(unsigned*)(F.MIXA8 + (size_t)r * (D / 2) + hh * DV + 4 * lane) = pk4_i8(hs[hh][0] * iy, hs[hh][1] * iy, hs[hh][2] * iy, hs[hh][3] * iy);
        }
#pragma unroll
        for (int jb = 0; jb < 2; ++jb) {
            const int dt = jb == 0 ? 1 : 64;
            const bool vm = jb == 0 ? (gc > 0) : (gr > 0), vp = jb == 0 ? (gc < 63) : (gr < 63);
            const bf16* pm = vm ? pr - (size_t)dt * NPROJ : pr; const bf16* pp = vp ? pr + (size_t)dt * NPROJ : pr;
            const float fm = vm ? 1.f : 0.f, fp = vp ? 1.f : 0.f;
            v4u cu0[2], cb0[2], cum[2], cup[2];
#pragma unroll
            for (int q = 0; q < 2; ++q) { const int cch = 512 * (2 * jb + q) + 8 * lane;
                cu0[q] = *(const v4u*)(pr + COL_CC + cch); cb0[q] = *(const v4u*)(pr + COL_CB + cch);
                cum[q] = *(const v4u*)(pm + COL_CC + cch); cup[q] = *(const v4u*)(pp + COL_CC + cch); }
#pragma unroll
            for (int q = 0; q < 2; ++q) { const int cch = 512 * (2 * jb + q) + 8 * lane;
                const unsigned u0w[4] = {cu0[q].x, cu0[q].y, cu0[q].z, cu0[q].w}, umw[4] = {cum[q].x, cum[q].y, cum[q].z, cum[q].w}, upw[4] = {cup[q].x, cup[q].y, cup[q].z, cup[q].w}, cbw[4] = {cb0[q].x, cb0[q].y, cb0[q].z, cb0[q].w};
                unsigned o[4];
#pragma unroll
                for (int hq = 0; hq < 2; ++hq) { const f32x4 w0 = *(const LAS f32x4*)(cwl + cch + 4 * hq), w1 = *(const LAS f32x4*)(cwl + 2048 + cch + 4 * hq), w2 = *(const LAS f32x4*)(cwl + 4096 + cch + 4 * hq);
#pragma unroll
                    for (int e2 = 0; e2 < 2; ++e2) { const int wi = 2 * hq + e2;
                        const float ya = bf_lo(cbw[wi]) * (w0[2 * e2] * (bf_lo(umw[wi]) * fm) + w1[2 * e2] * bf_lo(u0w[wi]) + w2[2 * e2] * (bf_lo(upw[wi]) * fp));
                        const float yb = bf_hi(cbw[wi]) * (w0[2 * e2 + 1] * (bf_hi(umw[wi]) * fm) + w1[2 * e2 + 1] * bf_hi(u0w[wi]) + w2[2 * e2 + 1] * (bf_hi(upw[wi]) * fp));
                        o[wi] = pk2(ya, yb); } }
                *(v4u*)(mr + 2048 + cch) = (v4u){o[0], o[1], o[2], o[3]}; }
        }
    }
}

__device__ __forceinline__ float p6_row_pass1(Frame& F, int row0, bool act, const LAS float* fac, const LAS float* sh) {
    const int lane = F.lane;
    const v2u* da = (const v2u*)(F.X1B + (size_t)row0 * D) + lane;
    float sa = 0.f;
    v2u dd[16];
#pragma unroll
    for (int j = 0; j < 16; ++j) dd[j] = da[64 * j];
#pragma unroll
    for (int j = 0; j < 16; ++j) { const float a0 = bf_lo(dd[j].x), a1 = bf_hi(dd[j].x), a2 = bf_lo(dd[j].y), a3 = bf_hi(dd[j].y); sa = fmaf(a0, a0, fmaf(a1, a1, fmaf(a2, a2, fmaf(a3, a3, sa)))); }
    const float rsa = rsqrtf(wave_sum(sa) * (1.f / D) + EPS);
    unsigned* oa = (unsigned*)((unsigned char*)F.XF + (size_t)row0 * D) + lane;
#pragma unroll
    for (int j = 0; j < 16; ++j) { const f32x4 fa = *(const LAS f32x4*)(fac + 256 * j + 4 * lane), sv = *(const LAS f32x4*)(sh + 256 * j + 4 * lane);
        const f32x4 xn = (f32x4){bf_lo(dd[j].x), bf_hi(dd[j].x), bf_lo(dd[j].y), bf_hi(dd[j].y)} * rsa * fa + sv;
        if (act) oa[64 * j] = pk4_fp8(xn[0], xn[1], xn[2], xn[3]); }
    return rsa;
}
__device__ __forceinline__ void p6_xquarter(Frame& F, int row, float rs, int j0, int nj, const LAS float* fac, const LAS float* sh, f32x4 (&xo)[4]) {
    const int lane = F.lane;
    const v2u* d0 = (const v2u*)(F.X1B + (size_t)row * D) + lane;
    v2u q0[4];
#pragma unroll
    for (int jj = 0; jj < 4; ++jj) if (jj < nj) q0[jj] = d0[64 * (j0 + jj)];
#pragma unroll
    for (int jj = 0; jj < 4; ++jj) if (jj < nj) { const int j = j0 + jj; const f32x4 fa = *(const LAS f32x4*)(fac + 256 * j + 4 * lane), sv = *(const LAS f32x4*)(sh + 256 * j + 4 * lane);
        xo[jj] = (f32x4){bf_lo(q0[jj].x), bf_hi(q0[jj].x), bf_lo(q0[jj].y), bf_hi(q0[jj].y)} * rs * fa + sv; }
}
__device__ __forceinline__ void p6_pick_group(Frame& F, const float (&g)[4], int& gs, float& psel) {
    float gl[4];
#pragma unroll
    for (int o = 0; o < 4; ++o) gl[o] = g[o] + F.b_rg[o];
    gs = 0; float gm = gl[0];
#pragma unroll
    for (int o = 1; o < 4; ++o) if (gl[o] > gm) { gm = gl[o]; gs = o; }
    float den = 0.f;
#pragma unroll
    for (int o = 0; o < 4; ++o) den += expf(gl[o] - gm);
    psel = 1.f / den;
}
__device__ __forceinline__ void p6_pick_experts(Frame& F, const float (&ed)[4], int gs, float psel, bool act, LAS int* ri) {
    float ev[4];
#pragma unroll
    for (int o = 0; o < 4; ++o) ev[o] = ed[o] + F.b_re[gs * 4 + o];
    int i0 = 0; float v0 = ev[0];
#pragma unroll
    for (int o = 1; o < 4; ++o) if (ev[o] > v0) { v0 = ev[o]; i0 = o; }
    int i1 = -1; float v1 = -3.0e38f;
#pragma unroll
    for (int o = 0; o < 4; ++o) if (o != i0 && ev[o] > v1) { v1 = ev[o]; i1 = o; }
    const float e1x = expf(v1 - v0); const float w0 = psel / (1.f + e1x), w1 = psel * e1x / (1.f + e1x);
    if (F.lane == 0) { ri[0] = act ? gs * 4 + i0 : -1; ri[1] = act ? gs * 4 + i1 : -1; ri[2] = __float_as_int(w0); ri[3] = __float_as_int(w1); }
}
__device__ __forceinline__ void p6_norm_router(Frame& F) {
    constexpr int R = 8;
    LAS float* fac = (LAS float*)F.lds; LAS float* sh = fac + D;
    LAS float* wg = (LAS float*)(F.lds + 32768);
    LAS float* we = (LAS float*)(F.lds + 98304);
    LAS int* rinfo = (LAS int*)(F.lds + 131072);
    const int wave = F.wave, lane = F.lane;
    const int nblk = T / (8 * R), per = (nblk + F.G - 1) / F.G;
    __syncthreads();
    for (int c = F.tid; c < D; c += NTHR) { const f32x4 g4 = *(const f32x4*)(F.w_rg + (size_t)c * 4); wg[c] = g4[0]; wg[D + c] = g4[1]; wg[2 * D + c] = g4[2]; wg[3 * D + c] = g4[3]; }
    int curb = -1;
    for (int it = 0; it < per; ++it) {
        const int rb = F.vcu * per + it;
        const bool act = rb < nblk;
        const int rowb = (act ? rb : 0) * (8 * R) + wave;
        const int b = rowb >> 12;
        if (b != curb) {
            __syncthreads();
            for (int i = F.tid; i < D; i += NTHR) { fac[i] = F.norm2[i] * (1.f + F.ADA[b * ADA_N + 4 * D + i]); sh[i] = F.ADA[b * ADA_N + 3 * D + i]; }
            curb = b;
        }
        __syncthreads();
        float rs[R];
#pragma unroll
        for (int k = 0; k < R; ++k) rs[k] = p6_row_pass1(F, rowb + 8 * k, act, fac, sh);
        float gd[R][4];
#pragma unroll
        for (int k = 0; k < R; ++k)
#pragma unroll
            for (int o = 0; o < 4; ++o) gd[k][o] = 0.f;
#pragma unroll
        for (int kh = 0; kh < R; kh += 4) {
#pragma unroll 1
            for (int q = 0; q < 4; ++q) { f32x4 xv[4][4];
#pragma unroll
                for (int k = 0; k < 4; ++k) p6_xquarter(F, rowb + 8 * (kh + k), rs[kh + k], 4 * q, 4, fac, sh, xv[k]);
#pragma unroll
                for (int o = 0; o < 4; ++o)
#pragma unroll
                    for (int jj = 0; jj < 4; ++jj) { const f32x4 w4 = *(const LAS f32x4*)(wg + o * D + 256 * (4 * q + jj) + 4 * lane);
#pragma unroll
                        for (int k = 0; k < 4; ++k) { const f32x4 a4 = xv[k][jj]; gd[kh + k][o] = fmaf(a4[3], w4[3], fmaf(a4[2], w4[2], fmaf(a4[1], w4[1], fmaf(a4[0], w4[0], gd[kh + k][o])))); } } } }
        int gs[R]; float ps[R];
#pragma unroll
        for (int k = 0; k < R; ++k) {
#pragma unroll
            for (int o = 0; o < 4; ++o) gd[k][o] = wave_sum(gd[k][o]);
            p6_pick_group(F, gd[k], gs[k], ps[k]); gs[k] = __builtin_amdgcn_readfirstlane(gs[k]); }
        float ed[R][4];
#pragma unroll
        for (int k = 0; k < R; ++k)
#pragma unroll
            for (int o = 0; o < 4; ++o) ed[k][o] = 0.f;
#pragma unroll 1
        for (int ch = 0; ch < 8; ++ch) {
            __syncthreads();
            { const int c = 512 * ch + F.tid;
#pragma unroll
              for (int p = 0; p < 4; ++p) { const f32x4 e4 = *(const f32x4*)(F.w_re + (size_t)c * 16 + 4 * p);
                  we[(4 * p + 0) * 512 + F.tid] = e4[0]; we[(4 * p + 1) * 512 + F.tid] = e4[1]; we[(4 * p + 2) * 512 + F.tid] = e4[2]; we[(4 * p + 3) * 512 + F.tid] = e4[3]; } }
            f32x4 xv[4][4];
#pragma unroll
            for (int k = 0; k < 4; ++k) p6_xquarter(F, rowb + 8 * k, rs[k], 2 * ch, 2, fac, sh, xv[k]);
            __syncthreads();
#pragma unroll
            for (int kh = 0; kh < R; kh += 4) {
                if (kh > 0) {
#pragma unroll
                    for (int k = 0; k < 4; ++k) p6_xquarter(F, rowb + 8 * (kh + k), rs[kh + k], 2 * ch, 2, fac, sh, xv[k]); }
#pragma unroll
                for (int k = 0; k < 4; ++k)
#pragma unroll
                    for (int o = 0; o < 4; ++o)
#pragma unroll
                        for (int jl = 0; jl < 2; ++jl) { const f32x4 w4 = *(const LAS f32x4*)(we + (gs[kh + k] * 4 + o) * 512 + 256 * jl + 4 * lane); const f32x4 a4 = xv[k][jl];
                            ed[kh + k][o] = fmaf(a4[3], w4[3], fmaf(a4[2], w4[2], fmaf(a4[1], w4[1], fmaf(a4[0], w4[0], ed[kh + k][o])))); }
            }
        }
#pragma unroll
        for (int k = 0; k < R; ++k) {
#pragma unroll
            for (int o = 0; o < 4; ++o) ed[k][o] = wave_sum(ed[k][o]);
            p6_pick_experts(F, ed[k], gs[k], ps[k], act, rinfo + (8 * k + wave) * 4); }
        __syncthreads();
        if (F.tid < NE && act) {
            int e = F.tid; asm volatile("" : "+v"(e)); int n = 0;
            for (int q = 0; q < 16 * R; ++q) n += (rinfo[(q >> 1) * 4 + (q & 1)] == e) ? 1 : 0;
            if (n > 0) {
                int base = (int)__hip_atomic_fetch_add((unsigned*)(F.ctl + CW_CNT + 64 * e), (unsigned)n, RLX_AGENT);
                for (int q = 0; q < 16 * R; ++q) if (rinfo[(q >> 1) * 4 + (q & 1)] == e) {
                    const int tok = rb * (8 * R) + (q >> 1);
                    F.ELIST[e * T + base] = tok * 2 + (q & 1); F.EW[e * T + base] = __int_as_float(rinfo[(q >> 1) * 4 + 2 + (q & 1)]); ++base; }
            }
        }
        __syncthreads();
    }
}

__device__ __forceinline__ void p9_final(Frame& F) {
    LAS float* fnl = (LAS float*)F.lds; LAS float* g2l = fnl + D;
    __syncthreads();
    for (int i = F.tid; i < D / 4; i += NTHR) { *(LAS f32x4*)(fnl + 4 * i) = *(const f32x4*)(F.fnorm + 4 * i);
#pragma unroll
        for (int b = 0; b < NB; ++b) *(LAS f32x4*)(g2l + b * D + 4 * i) = *(const f32x4*)(F.ADA + b * ADA_N + 5 * D + 4 * i) * (1.f / SLOT_SCALE); }
    __syncthreads();
    const int gw = F.vcu * NWAVES + F.wave, NGW = F.G * NWAVES;
    for (int r = gw; r < T; r += NGW) {
        int lane = F.lane; asm volatile("" : "+v"(lane));
        const int b = r >> 12;
        const v4u* xr = (const v4u*)(F.X1B + (size_t)r * D) + lane;
        const v2u* s0 = (const v2u*)((const unsigned char*)F.SLOT + (size_t)r * D) + lane; const v2u* s1 = (const v2u*)((const unsigned char*)F.SLOT + (size_t)(T + r) * D) + lane;
        v4u xx[8]; v2u a0[8], a1[8];
#pragma unroll
        for (int j = 0; j < 8; ++j) { xx[j] = xr[64 * j]; a0[j] = s0[64 * j]; a1[j] = s1[64 * j]; }
        f32x4 v[16]; float s = 0.f;
#pragma unroll
        for (int j = 0; j < 8; ++j) {
            const f32x4 g0 = *(const LAS f32x4*)(g2l + b * D + 512 * j + 8 * lane), g1 = *(const LAS f32x4*)(g2l + b * D + 512 * j + 8 * lane + 4);
            const f32x4 x0 = (f32x4){bf_lo(xx[j].x), bf_hi(xx[j].x), bf_lo(xx[j].y), bf_hi(xx[j].y)}, x1 = (f32x4){bf_lo(xx[j].z), bf_hi(xx[j].z), bf_lo(xx[j].w), bf_hi(xx[j].w)};
            v[2 * j] = x0 + g0 * (fp8x4_to_f32(a0[j].x) + fp8x4_to_f32(a1[j].x)); v[2 * j + 1] = x1 + g1 * (fp8x4_to_f32(a0[j].y) + fp8x4_to_f32(a1[j].y));
            s = fmaf(v[2 * j][0], v[2 * j][0], fmaf(v[2 * j][1], v[2 * j][1], fmaf(v[2 * j][2], v[2 * j][2], fmaf(v[2 * j][3], v[2 * j][3], s))));
            s = fmaf(v[2 * j + 1][0], v[2 * j + 1][0], fmaf(v[2 * j + 1][1], v[2 * j + 1][1], fmaf(v[2 * j + 1][2], v[2 * j + 1][2], fmaf(v[2 * j + 1][3], v[2 * j + 1][3], s)))); }
        const float rstd = rsqrtf(wave_sum(s) * (1.f / D) + EPS);
        float* o = F.out + (size_t)r * D + 8 * lane;
#pragma unroll
        for (int j = 0; j < 8; ++j) { *(f32x4*)(o + 512 * j) = v[2 * j] * rstd * *(const LAS f32x4*)(fnl + 512 * j + 8 * lane); *(f32x4*)(o + 512 * j + 4) = v[2 * j + 1] * rstd * *(const LAS f32x4*)(fnl + 512 * j + 8 * lane + 4);
            if ((j & 1) == 1) asm volatile("" ::: "memory"); }
    }
}

struct SchedProj {
    int G, c;
    __device__ bool next(int i, pg8::Unit& u) const {
        const int L = i * G + c; constexpr int nM = 64, nN = 48, nwg = nM * nN;
        if (L < nwg) {
            int wgid = L; { const int q = nwg / 8, xcd = wgid % 8, off = wgid / 8; wgid = xcd * q + off; }
            const int nig = 8 * nN, gid = wgid / nig, fm = gid * 8;
            u.pm = fm + ((wgid % nig) % 8); u.pn = (wgid % nig) / 8; return true; }
        const int L2 = L - nwg;
        if (L2 < 48) { u.pm = 64 + (L2 & 3); u.pn = 36 + (L2 >> 2); return true; }
        const int L3 = L2 - 48;
        if (L3 < 68) { u.pm = L3; u.pn = 48; return true; }
        return false;
    }
    __device__ __forceinline__ void a_ready(const pg8::Unit&) const {}
    __device__ __forceinline__ void done(const pg8::Unit&) const {}
    __device__ __forceinline__ unsigned row_byteoff(const pg8::Unit&, int) const { return 0u; }
};
struct EpiProj {
    static constexpr bool PERM = true;
    bf16* P; float* Gt; const float* bg;
    __device__ __forceinline__ void operator()(const pg8::f32x4 (&acc)[2][2][4][2], const pg8::Unit& u, int wr, int wc, int fr, int fq) const {
        const int row0 = u.pm * 256 + wr * 64 + fr;
        if (u.pn < 48) {
            const int col0 = u.pn * 256 + wc * 32 + 8 * fq;
#pragma unroll
            for (int ai = 0; ai < 2; ++ai)
#pragma unroll
                for (int m = 0; m < 4; ++m) { bf16* rowp = P + (size_t)(row0 + ai * 128 + m * 16) * NPROJ + col0;
#pragma unroll
                    for (int bj = 0; bj < 2; ++bj) { const pg8::f32x4 v0 = acc[ai][bj][m][0], v1 = acc[ai][bj][m][1];
                        v4u w; w.x = pk2(v0[0], v0[1]); w.y = pk2(v0[2], v0[3]); w.z = pk2(v1[0], v1[1]); w.w = pk2(v1[2], v1[3]);
                        *(v4u*)(rowp + bj * 128) = w; } }
        } else if (wc == 0) {
            const f32x4 b0 = *(const f32x4*)(bg + 8 * fq), b1 = *(const f32x4*)(bg + 8 * fq + 4);
#pragma unroll
            for (int ai = 0; ai < 2; ++ai)
#pragma unroll
                for (int m = 0; m < 4; ++m) { float* gp = Gt + (size_t)(row0 + ai * 128 + m * 16) * 32 + 8 * fq;
                    *(f32x4*)gp = acc[ai][0][m][0] + b0; *(f32x4*)(gp + 4) = acc[ai][0][m][1] + b1; }
        }
    }
};
struct EpiProjI8 {
    static constexpr bool PERM = true;
    bf16* P; const float* sa; const float* sb; float* Gt; const float* bg;
    __device__ __forceinline__ void operator()(const pg8::f32x4 (&acc)[2][2][4][2], const pg8::Unit& u, int wr, int wc, int fr, int fq) const {
        const int row0 = u.pm * 256 + wr * 64 + fr, col0 = u.pn * 256 + wc * 32 + 8 * fq;
        if (u.pn == 48) {
            if (wc == 0) {
                const f32x4 b0 = *(const f32x4*)(bg + 8 * fq), b1 = *(const f32x4*)(bg + 8 * fq + 4), q0 = *(const f32x4*)(sb + NPROJ + 8 * fq), q1 = *(const f32x4*)(sb + NPROJ + 8 * fq + 4);
#pragma unroll
                for (int ai = 0; ai < 2; ++ai)
#pragma unroll
                    for (int m = 0; m < 4; ++m) { const int row = row0 + ai * 128 + m * 16; const float ra = sa[row]; float* gp = Gt + (size_t)row * 32 + 8 * fq;
                        const pg8::i32x4 i0 = __builtin_bit_cast(pg8::i32x4, acc[ai][0][m][0]), i1 = __builtin_bit_cast(pg8::i32x4, acc[ai][0][m][1]);
                        *(f32x4*)gp = (f32x4){(float)i0[0], (float)i0[1], (float)i0[2], (float)i0[3]} * (q0 * ra) + b0; *(f32x4*)(gp + 4) = (f32x4){(float)i1[0], (float)i1[1], (float)i1[2], (float)i1[3]} * (q1 * ra) + b1; }
            }
            return;
        }
        f32x4 sbv[2][2]; float sav[2][4];
#pragma unroll
        for (int bj = 0; bj < 2; ++bj)
#pragma unroll
            for (int n = 0; n < 2; ++n) sbv[bj][n] = *(const f32x4*)(sb + col0 + bj * 128 + 4 * n);
#pragma unroll
        for (int ai = 0; ai < 2; ++ai)
#pragma unroll
            for (int m = 0; m < 4; ++m) sav[ai][m] = sa[row0 + ai * 128 + m * 16];
#pragma unroll
        for (int ai = 0; ai < 2; ++ai)
#pragma unroll
            for (int m = 0; m < 4; ++m) { bf16* rowp = P + (size_t)(row0 + ai * 128 + m * 16) * NPROJ + col0; const float ra = sav[ai][m];
#pragma unroll
                for (int bj = 0; bj < 2; ++bj) { const pg8::i32x4 i0 = __builtin_bit_cast(pg8::i32x4, acc[ai][bj][m][0]), i1 = __builtin_bit_cast(pg8::i32x4, acc[ai][bj][m][1]);
                    const f32x4 s0 = sbv[bj][0] * ra, s1 = sbv[bj][1] * ra;
                    v4u w; w.x = pk2((float)i0[0] * s0[0], (float)i0[1] * s0[1]); w.y = pk2((float)i0[2] * s0[2], (float)i0[3] * s0[3]);
                    w.z = pk2((float)i1[0] * s1[0], (float)i1[1] * s1[1]); w.w = pk2((float)i1[2] * s1[2], (float)i1[3] * s1[3]);
                    *(v4u*)(rowp + bj * 128) = w; } }
    }
    static constexpr int NS = 8, NTAB = 2;
    __device__ __forceinline__ bool stores(const pg8::Unit& u, int wc) const { return u.pn != 48 || wc == 0; }
    __device__ __forceinline__ const void* tab_src(const pg8::Unit& u, int idx) const {
        const int i = idx & 255;
        if (idx < 256) return sa + u.pm * 256 + i;
        if (u.pn == 48) return (i >= 32 && i < 64) ? bg + (i - 32) : sb + NPROJ + (i & 31);
        return sb + u.pn * 256 + i;
    }
    __device__ __forceinline__ void half(const pg8::f32x4 (&acc)[2][2][4][2], const pg8::Unit& u, const int ai, int wr, int wc, int fr, int fq, const LAS float* tab) const {
        const int lrow0 = wr * 64 + fr + ai * 128, row0 = u.pm * 256 + lrow0, col0 = u.pn * 256 + wc * 32 + 8 * fq;
        const LAS float* tb2 = tab + 256;
        if (u.pn == 48) {
            if (wc == 0) {
                const f32x4 q0 = *(const LAS f32x4*)(tb2 + 8 * fq), q1 = *(const LAS f32x4*)(tb2 + 8 * fq + 4), b0 = *(const LAS f32x4*)(tb2 + 32 + 8 * fq), b1 = *(const LAS f32x4*)(tb2 + 36 + 8 * fq);
#pragma unroll
                for (int m = 0; m < 4; ++m) { const float ra = tab[lrow0 + m * 16]; float* gp = Gt + (size_t)(row0 + m * 16) * 32 + 8 * fq;
                    const pg8::i32x4 i0 = __builtin_bit_cast(pg8::i32x4, acc[ai][0][m][0]), i1 = __builtin_bit_cast(pg8::i32x4, acc[ai][0][m][1]);
                    *(f32x4*)gp = (f32x4){(float)i0[0], (float)i0[1], (float)i0[2], (float)i0[3]} * (q0 * ra) + b0; *(f32x4*)(gp + 4) = (f32x4){(float)i1[0], (float)i1[1], (float)i1[2], (float)i1[3]} * (q1 * ra) + b1; }
            }
            return;
        }
        f32x4 sbv[2][2];
#pragma unroll
        for (int bj = 0; bj < 2; ++bj)
#pragma unroll
            for (int n = 0; n < 2; ++n) sbv[bj][n] = *(const LAS f32x4*)(tb2 + wc * 32 + 8 * fq + bj * 128 + 4 * n);
        if (u.pn >= COL_CC / 256 && u.pn < COL_K / 256) {
            const int ch0 = COL_CC + (u.pn - COL_CC / 256) * 128 + wc * 32 + 8 * fq;
#pragma unroll
            for (int m = 0; m < 4; ++m) { bf16* rowp = P + (size_t)(row0 + m * 16) * NPROJ + ch0; const float ra = tab[lrow0 + m * 16];
#pragma unroll
                for (int n = 0; n < 2; ++n) { const pg8::i32x4 ic = __builtin_bit_cast(pg8::i32x4, acc[ai][0][m][n]), ix = __builtin_bit_cast(pg8::i32x4, acc[ai][1][m][n]);
                    const f32x4 sc = sbv[0][n] * ra, sx = sbv[1][n] * ra;
                    *(v2u*)(rowp + 4 * n) = (v2u){pk2(((float)ic[0] * sc[0]) * ((float)ix[0] * sx[0]), ((float)ic[1] * sc[1]) * ((float)ix[1] * sx[1])), pk2(((float)ic[2] * sc[2]) * ((float)ix[2] * sx[2]), ((float)ic[3] * sc[3]) * ((float)ix[3] * sx[3]))}; } }
            return;
        }
#pragma unroll
        for (int m = 0; m < 4; ++m) { bf16* rowp = P + (size_t)(row0 + m * 16) * NPROJ + col0; const float ra = tab[lrow0 + m * 16];
#pragma unroll
            for (int bj = 0; bj < 2; ++bj) { const pg8::i32x4 i0 = __builtin_bit_cast(pg8::i32x4, acc[ai][bj][m][0]), i1 = __builtin_bit_cast(pg8::i32x4, acc[ai][bj][m][1]);
                const f32x4 s0 = sbv[bj][0] * ra, s1 = sbv[bj][1] * ra;
                v4u w; w.x = pk2((float)i0[0] * s0[0], (float)i0[1] * s0[1]); w.y = pk2((float)i0[2] * s0[2], (float)i0[3] * s0[3]);
                w.z = pk2((float)i1[0] * s1[0], (float)i1[1] * s1[1]); w.w = pk2((float)i1[2] * s1[2], (float)i1[3] * s1[3]);
                *(v4u*)(rowp + bj * 128) = w; } }
    }
};
struct SchedStatic {
    int nM, nN, nwg, G, c;
    __device__ void init(int M, int N, int G_, int c_) { nM = M / 256; nN = N / 256; nwg = nM * nN; G = G_; c = c_; }
    __device__ bool next(int i, pg8::Unit& u) const {
        const long L = (long)i * G + c; if (L >= nwg) return false;
        int wgid = (int)L; { const int q = nwg / 8, r = nwg % 8, xcd = wgid % 8, off = wgid / 8; wgid = (xcd < r ? xcd * (q + 1) : r * (q + 1) + (xcd - r) * q) + off; }
        const int nig = 8 * nN, gid = wgid / nig, fm = gid * 8, gsz = (nM - fm) < 8 ? (nM - fm) : 8;
        u.pm = fm + ((wgid % nig) % gsz); u.pn = (wgid % nig) / gsz; return true;
    }
    __device__ __forceinline__ void a_ready(const pg8::Unit&) const {}
    __device__ __forceinline__ void done(const pg8::Unit&) const {}
    __device__ __forceinline__ unsigned row_byteoff(const pg8::Unit&, int) const { return 0u; }
};
struct EpiOut {
    static constexpr bool PERM = true;
    const float* ada; bf16* DL;
    __device__ __forceinline__ void operator()(const pg8::f32x4 (&acc)[2][2][4][2], const pg8::Unit& u, int wr, int wc, int fr, int fq) const {
        const int row0 = u.pm * 256 + wr * 64 + fr, col0 = u.pn * 256 + wc * 32 + 8 * fq;
        const float* g1 = ada + (size_t)(u.pm >> 4) * ADA_N + 2 * D + col0;
        f32x4 gv[2][2];
#pragma unroll
        for (int bj = 0; bj < 2; ++bj)
#pragma unroll
            for (int n = 0; n < 2; ++n) gv[bj][n] = *(const f32x4*)(g1 + bj * 128 + 4 * n);
#pragma unroll
        for (int ai = 0; ai < 2; ++ai)
#pragma unroll
            for (int m = 0; m < 4; ++m) { bf16* rowp = DL + (size_t)(row0 + ai * 128 + m * 16) * D + col0;
#pragma unroll
                for (int bj = 0; bj < 2; ++bj) { const pg8::f32x4 v0 = acc[ai][bj][m][0] * gv[bj][0], v1 = acc[ai][bj][m][1] * gv[bj][1];
                    v4u w; w.x = pk2(v0[0], v0[1]); w.y = pk2(v0[2], v0[3]); w.z = pk2(v1[0], v1[1]); w.w = pk2(v1[2], v1[3]);
                    *(v4u*)(rowp + bj * 128) = w; } }
    }
    static constexpr int NS = 8, NTAB = 1;
    __device__ __forceinline__ bool stores(const pg8::Unit&, int) const { return true; }
    __device__ __forceinline__ const void* tab_src(const pg8::Unit& u, int idx) const { return ada + (size_t)(u.pm >> 4) * ADA_N + 2 * D + u.pn * 256 + (idx & 255); }
    __device__ __forceinline__ void half(const pg8::f32x4 (&acc)[2][2][4][2], const pg8::Unit& u, const int ai, int wr, int wc, int fr, int fq, const LAS float* tab) const {
        const int row0 = u.pm * 256 + wr * 64 + fr + ai * 128, col0 = u.pn * 256 + wc * 32 + 8 * fq;
        f32x4 gv[2][2];
#pragma unroll
        for (int bj = 0; bj < 2; ++bj)
#pragma unroll
            for (int n = 0; n < 2; ++n) gv[bj][n] = *(const LAS f32x4*)(tab + wc * 32 + 8 * fq + bj * 128 + 4 * n);
#pragma unroll
        for (int m = 0; m < 4; ++m) { bf16* rowp = DL + (size_t)(row0 + m * 16) * D + col0;
#pragma unroll
            for (int bj = 0; bj < 2; ++bj) { const pg8::f32x4 v0 = acc[ai][bj][m][0] * gv[bj][0], v1 = acc[ai][bj][m][1] * gv[bj][1];
                v4u w; w.x = pk2(v0[0], v0[1]); w.y = pk2(v0[2], v0[3]); w.z = pk2(v1[0], v1[1]); w.w = pk2(v1[2], v1[3]);
                *(v4u*)(rowp + bj * 128) = w; } }
    }
};
struct EpiOut2 {
    static constexpr bool PERM = true;
    static constexpr int NS = 8, NTAB = 3;
    const float* ada; bf16* DL; const float* sa; const float* sb; const float* xin;
    __device__ __forceinline__ bool stores(const pg8::Unit&, int) const { return true; }
    __device__ __forceinline__ const void* tab_src(const pg8::Unit& u, int idx) const {
        const int i = idx & 255, w = idx >> 8;
        if (w == 0) return ada + (size_t)(u.pm >> 4) * ADA_N + 2 * D + u.pn * 256 + i;
        if (w == 1) return sa + u.pm * 256 + i;
        return sb + u.pn * 256 + i;
    }
    __device__ __forceinline__ void mid(pg8::f32x4 (&acc)[2][2][4][2], const pg8::Unit&, int wr, int wc, int fr, int fq, const LAS float* tab) const {
        f32x4 sbv[2][2];
#pragma unroll
        for (int bj = 0; bj < 2; ++bj)
#pragma unroll
            for (int n = 0; n < 2; ++n) sbv[bj][n] = *(const LAS f32x4*)(tab + 512 + wc * 32 + 8 * fq + bj * 128 + 4 * n);
#pragma unroll
        for (int ai = 0; ai < 2; ++ai)
#pragma unroll
            for (int m = 0; m < 4; ++m) { const float ra = tab[256 + wr * 64 + fr + ai * 128 + m * 16];
#pragma unroll
                for (int bj = 0; bj < 2; ++bj)
#pragma unroll
                    for (int n = 0; n < 2; ++n) { const pg8::i32x4 iv = __builtin_bit_cast(pg8::i32x4, acc[ai][bj][m][n]); const f32x4 s = sbv[bj][n] * ra;
                        acc[ai][bj][m][n] = (f32x4){(float)iv[0] * s[0], (float)iv[1] * s[1], (float)iv[2] * s[2], (float)iv[3] * s[3]}; } }
    }
    __device__ __forceinline__ void half(const pg8::f32x4 (&acc)[2][2][4][2], const pg8::Unit& u, const int ai, int wr, int wc, int fr, int fq, const LAS float* tab) const {
        const int row0 = u.pm * 256 + wr * 64 + fr + ai * 128, col0 = u.pn * 256 + wc * 32 + 8 * fq;
        f32x4 xv[4][2][2];
#pragma unroll
        for (int m = 0; m < 4; ++m) { const float* xr = xin + (size_t)(row0 + m * 16) * D + col0;
#pragma unroll
            for (int bj = 0; bj < 2; ++bj)
#pragma unroll
                for (int n = 0; n < 2; ++n) xv[m][bj][n] = *(const f32x4*)(xr + bj * 128 + 4 * n); }
        f32x4 gv[2][2];
#pragma unroll
        for (int bj = 0; bj < 2; ++bj)
#pragma unroll
            for (int n = 0; n < 2; ++n) gv[bj][n] = *(const LAS f32x4*)(tab + wc * 32 + 8 * fq + bj * 128 + 4 * n);
#pragma unroll
        for (int m = 0; m < 4; ++m) { bf16* rowp = DL + (size_t)(row0 + m * 16) * D + col0;
#pragma unroll
            for (int bj = 0; bj < 2; ++bj) { const pg8::f32x4 v0 = acc[ai][bj][m][0] * gv[bj][0] + xv[m][bj][0], v1 = acc[ai][bj][m][1] * gv[bj][1] + xv[m][bj][1];
                v4u w; w.x = pk2(v0[0], v0[1]); w.y = pk2(v0[2], v0[3]); w.z = pk2(v1[0], v1[1]); w.w = pk2(v1[2], v1[3]);
                *(v4u*)(rowp + bj * 128) = w; } }
    }
};
typedef GAS unsigned long long gu64;
constexpr unsigned RT_FULL = 64u, RT_SPIN_CAP = 1u << 22;
template <int NCT>
struct SchedMoe {
    int G, c; const LAS int* tb; const LAS int* cnt; const int* elist; unsigned rowbytes; gu32* rtc;
    __device__ bool next(int i, pg8::Unit& u) const {
        const int L = i * G + c, rt = L / NCT, ct = L % NCT;
        if (rt >= tb[NE]) return false;
        int e = 0;
#pragma unroll
        for (int q = 1; q < NE; ++q) e += (rt >= tb[q]) ? 1 : 0;
        u.pm = rt; u.pn = e * NCT + ct; return true;
    }
    __device__ __forceinline__ void a_ready(const pg8::Unit&) const {}
    __device__ __forceinline__ void done(const pg8::Unit& u) const {
        if (rtc == nullptr) return;
        asm volatile("s_waitcnt vmcnt(0) ; publish" ::: "memory");
        if ((threadIdx.x & 63) == 0) (void)__hip_atomic_fetch_add(rtc + 16 * u.pm, 1u, RLX_AGENT);
    }
    __device__ __forceinline__ unsigned row_byteoff(const pg8::Unit& u, int lr) const {
        const int e = u.pn / NCT; int l = (u.pm - tb[e]) * 256 + lr; const int n = cnt[e]; l = l < n ? l : n - 1;
        return (unsigned)(elist[e * T + l] >> 1) * rowbytes;
    }
    __device__ __forceinline__ const int* row_src(const pg8::Unit& u, int lr) const {
        const int e = u.pn / NCT; int l = (u.pm - tb[e]) * 256 + lr; const int n = cnt[e]; l = l < n ? l : n - 1;
        return elist + e * T + l;
    }
    __device__ __forceinline__ unsigned row_raw(const pg8::Unit& u, int lr) const { return (unsigned)*row_src(u, lr); }
    __device__ __forceinline__ unsigned row_off(unsigned raw) const { return (raw >> 1) * rowbytes; }
};
struct SchedMoe2 {
    static constexpr int NCT = 16, BON = 3;
    int G, c, n7; const LAS int* tb; const LAS int* cnt; gu32* rtc; gu32* tmo;
    __device__ bool next(int i, pg8::Unit& u) const {
        const int A = n7 % G, nl = G - A; int L;
        if (A == 0) L = i * G + c;
        else if (c >= A) L = (i < BON) ? i * nl + (c - A) : BON * nl + (i - BON) * G + c;
        else L = BON * nl + i * G + c;
        const int rt = L / NCT, ct = L % NCT;
        if (rt >= tb[NE]) return false;
        int e = 0;
#pragma unroll
        for (int q = 1; q < NE; ++q) e += (rt >= tb[q]) ? 1 : 0;
        u.pm = rt; u.pn = e * NCT + ct; return true;
    }
    __device__ __forceinline__ void a_ready(const pg8::Unit& u) const {
        unsigned sp = 0;
        while ((unsigned)__builtin_amdgcn_readfirstlane((int)__hip_atomic_load(rtc + 16 * u.pm, RLX_AGENT)) < RT_FULL) {
            __builtin_amdgcn_s_sleep(1);
            if (++sp > RT_SPIN_CAP) { if ((threadIdx.x & 63) == 0) __hip_atomic_store(tmo, 1u, RLX_AGENT); break; }
        }
    }
    __device__ __forceinline__ void done(const pg8::Unit&) const {}
    __device__ __forceinline__ unsigned row_byteoff(const pg8::Unit&, int) const { return 0u; }
};
struct EpiMoe1 {
    static constexpr bool PERM = true;
    unsigned char* H;
    __device__ __forceinline__ void operator()(const pg8::f32x4 (&acc)[2][2][4][2], const pg8::Unit& u, int wr, int wc, int fr, int fq) const {
        const int row0 = u.pm * 256 + wr * 64 + fr, col0 = (u.pn & 7) * 128 + wc * 32 + 8 * fq;
        constexpr float IS = 1.f / W1_SCALE;
#pragma unroll
        for (int ai = 0; ai < 2; ++ai)
#pragma unroll
            for (int m = 0; m < 4; ++m) { float h[8];
#pragma unroll
                for (int n = 0; n < 2; ++n)
#pragma unroll
                    for (int j = 0; j < 4; ++j) { const float a = acc[ai][0][m][n][j] * IS, uu = acc[ai][1][m][n][j] * IS; h[4 * n + j] = a * uu / (1.f + __expf(-a)); }
                *(v2u*)(H + (size_t)(row0 + ai * 128 + m * 16) * FF + col0) = (v2u){pk4_fp8(h[0], h[1], h[2], h[3]), pk4_fp8(h[4], h[5], h[6], h[7])}; }
    }
    static constexpr int NS = 4, NTAB = 0;
    __device__ __forceinline__ bool stores(const pg8::Unit&, int) const { return true; }
    __device__ __forceinline__ const void* tab_src(const pg8::Unit&, int) const { return nullptr; }
    __device__ __forceinline__ void half(const pg8::f32x4 (&acc)[2][2][4][2], const pg8::Unit& u, const int ai, int wr, int wc, int fr, int fq, const LAS float*) const {
        const int row0 = u.pm * 256 + wr * 64 + fr + ai * 128, col0 = (u.pn & 7) * 128 + wc * 32 + 8 * fq;
        constexpr float IS = 1.f / W1_SCALE;
#pragma unroll
        for (int m = 0; m < 4; ++m) { float h[8];
#pragma unroll
            for (int n = 0; n < 2; ++n)
#pragma unroll
                for (int j = 0; j < 4; ++j) { const float a = acc[ai][0][m][n][j] * IS, uu = acc[ai][1][m][n][j] * IS; h[4 * n + j] = a * uu / (1.f + __expf(-a)); }
            __hip_atomic_store((gu64*)(H + (size_t)(row0 + m * 16) * FF + col0), (unsigned long long)pk4_fp8(h[0], h[1], h[2], h[3]) | ((unsigned long long)pk4_fp8(h[4], h[5], h[6], h[7]) << 32), RLX_AGENT); }
    }
};
struct EpiMoe2 {
    static constexpr int PERM = 2;
    unsigned char* SL; const int* elist; const float* ew; const LAS int* tb; const LAS int* cnt;
    static constexpr int NS = 4, NTAB = 2;
    unsigned char* dump;
    __device__ __forceinline__ bool stores(const pg8::Unit&, int) const { return true; }
    __device__ __forceinline__ const void* tab_src(const pg8::Unit& u, int idx) const {
        const int e = u.pn >> 4, n_e = cnt[e]; int l = (u.pm - tb[e]) * 256 + (idx & 255); l = l < n_e ? l : n_e - 1;
        return idx < 256 ? (const void*)(elist + e * T + l) : (const void*)(ew + e * T + l);
    }
    __device__ __forceinline__ void half(const pg8::f32x4 (&acc)[2][2][4][2], const pg8::Unit& u, const int ai, int wr, int wc, int fr, int fq, const LAS float* tab) const {
        const int e = u.pn >> 4, ct = u.pn & 15, n_e = cnt[e], lrow0 = wr * 64 + fr + ai * 128, lr0 = (u.pm - tb[e]) * 256 + lrow0, col0 = ct * 256 + wc * 64 + 16 * fq;
#pragma unroll
        for (int m = 0; m < 4; ++m) { const int lr = lr0 + m * 16, ent = ((const LAS int*)tab)[lrow0 + m * 16]; const float w = tab[256 + lrow0 + m * 16] * (SLOT_SCALE / W2_SCALE);
            unsigned char* rowp = (lr < n_e) ? SL + ((size_t)(ent & 1) * T + (size_t)(ent >> 1)) * D + col0 : dump + (size_t)((u.pm & 63) * 256 + lrow0 + m * 16) * D + col0;
            const pg8::f32x4 v0 = acc[ai][0][m][0] * w, v1 = acc[ai][0][m][1] * w, v2 = acc[ai][1][m][0] * w, v3 = acc[ai][1][m][1] * w;
            *(v4u*)rowp = (v4u){pk4_fp8(v0[0], v0[1], v0[2], v0[3]), pk4_fp8(v1[0], v1[1], v1[2], v1[3]), pk4_fp8(v2[0], v2[1], v2[2], v2[3]), pk4_fp8(v3[0], v3[1], v3[2], v3[3])}; }
    }
};
__device__ __forceinline__ void moe_tables(Frame& F) {
    LAS int* tb = (LAS int*)(F.lds + MOE_OFF); LAS int* cnt = tb + 32;
    __syncthreads();
    if (F.tid == 0) { int acc = 0;
        for (int e = 0; e < NE; ++e) { const int n = (int)__hip_atomic_load((unsigned*)(F.ctl + CW_CNT + 64 * e), RLX_AGENT); cnt[e] = n; tb[e] = acc; acc += (n + 255) >> 8; }
        tb[NE] = acc; }
    __syncthreads();
}

struct Args { const float* in[20]; float* out; unsigned char* ws; int ph_lo, ph_hi, li, pad; };
__global__ void __launch_bounds__(NTHR, 2) mk_fwd(Args args) {
    extern __shared__ __attribute__((aligned(16))) unsigned char lds[];
    Frame F;
    F.lds = (LAS unsigned char*)lds;
    F.MISC = (volatile LAS unsigned*)(F.lds + MISC_OFF);
    F.tid = threadIdx.x; F.lane = F.tid & 63; F.wave = __builtin_amdgcn_readfirstlane(F.tid >> 6);
    F.G = gridDim.x; { const int bx = blockIdx.x; F.vcu = (F.G % 8 == 0) ? (bx % 8) * (F.G / 8) + bx / 8 : bx; }
    unsigned char* ws = args.ws;
    F.ctl = (gu32*)(ws + WS_CTL);
    F.x = args.in[0]; F.c = args.in[1]; F.ctx = args.in[2]; F.cctx = args.in[3]; F.w_ada = args.in[4]; F.b_ada = args.in[5]; F.norm1 = args.in[6]; F.w_in = args.in[7];
    F.b_gates = args.in[8]; F.conv_w = args.in[9]; F.head_norm = args.in[10]; F.w_out = args.in[11]; F.norm2 = args.in[12]; F.w_rg = args.in[13]; F.b_rg = args.in[14];
    F.w_re = args.in[15]; F.b_re = args.in[16]; F.w_e1 = args.in[17]; F.w_e2 = args.in[18]; F.fnorm = args.in[19]; F.out = args.out;
    F.ADA = (float*)(ws + WS_ADA); F.GATES = (float*)(ws + WS_GATES); F.EW = (float*)(ws + WS_EW); F.HF = (bf16*)(ws + WS_HF); F.HB = (bf16*)(ws + WS_HB); F.DELTA = (bf16*)(ws + WS_X1); F.X1B = (bf16*)(ws + WS_X1 + 128 * MiB); F.XM8 = ws + WS_XM8; F.WO8 = ws + WS_WO8; F.WI8 = (signed char*)(ws + WS_WI8); F.SA = (float*)(ws + WS_SA); F.SB = (float*)(ws + WS_SB); F.SB2 = F.SB + 16384; F.MIXA8 = ws + WS_XM8; F.WOA8 = ws + WS_WIN + 64 * MiB;
    F.ELIST = (int*)(ws + WS_ELIST);
    F.WIN = (bf16*)(ws + WS_WIN); F.WOUT = (bf16*)(ws + WS_WOUT); F.WE1 = (bf16*)(ws + WS_WE1); F.WE2 = (bf16*)(ws + WS_WE2);
    F.XM = (bf16*)(ws + WS_XM); F.MIX = F.XM; F.XF = F.XM; F.PROJ = (bf16*)(ws + WS_PROJ); F.SLOT = (bf16*)(ws + WS_SLOT); F.HMOE = (bf16*)(ws + WS_HMOE);
    for (int u = F.tid; u < (LDS_BYTES - LDSCTL_OFF) / 4; u += NTHR) ((LAS unsigned*)(F.lds + LDSCTL_OFF))[u] = 0u;
    __syncthreads();
    const int lo = args.ph_lo, hi = args.ph_hi;
    XcdBarrier bar; bar.bar = (unsigned*)(F.ctl + CW_BAR) + args.li * XCD_BAR_WORDS; bar.x = 0; bar.st = nullptr;
    if (hi - lo > 1) bar = xcd_barrier_post((unsigned*)(F.ctl + CW_BAR) + args.li * XCD_BAR_WORDS, F.MISC + 8);
#ifndef PHASE_MASK
#define PHASE_MASK 0xFFFF
#endif
#define IN(k) (((PHASE_MASK >> (k)) & 1) && lo <= (k) && (k) < hi)
#define BOTH(k) (IN(k) && IN((k) + 1))
#define GRID_BAR() xcd_barrier(bar)
    LAS unsigned* rowtab = (LAS unsigned*)(F.lds + ROWTAB_OFF);

#ifndef PROBE_DUP
#define PROBE_DUP -1
#endif
#define RUNPH(k, ...) if (IN(k)) { __VA_ARGS__ if (PROBE_DUP == (k)) { GRID_BAR(); __VA_ARGS__ } if (BOTH(k)) GRID_BAR(); }
    RUNPH(0, { p0_ada(F); __syncthreads(); p0_transposes(F); })
    RUNPH(1, { p1_quant_weights(F); p1_quant_wout(F); p1_norm(F); })
    RUNPH(2, {
        __syncthreads();
        { pg8::Gemm gi{(const bf16*)F.XM8, (const bf16*)F.WI8, TA, NPAD, D / 2}; SchedProj Si{F.G, (int)blockIdx.x}; EpiProjI8 Ei{F.PROJ, F.SA, F.SB, F.GATES, F.b_gates};
          pg8::gemm_phase<EpiProjI8, SchedProj, PG8_ALIGN, PG8_SP2, false, false, true, PG8_ROLL2>(F.lds, gi, Si, Ei, rowtab); }
        expert_transpose_queue(F); })
    RUNPH(3, { p3_mlstm(F); })
    RUNPH(4, { p4_mix(F); })
    RUNPH(5, {
        pg8::Gemm2 g{(const char*)F.MIXA8, (const char*)F.WOA8, (unsigned)(D / 2), (unsigned)(D / 2), D / 2 / 128, (const char*)(F.MIX + D / 2), (const char*)(F.WOUT + D / 2), (unsigned)(D * 2), (unsigned)(D * 2), D / 2 * 2 / 128};
        SchedStatic S; S.init(T, D, F.G, (int)blockIdx.x); EpiOut2 E{F.ADA, F.X1B, F.SA, F.SB2, F.x};
        __syncthreads();
        pg8::gemm_phase2<EpiOut2, SchedStatic, PG8_ALIGN>(F.lds, g, S, E); })
    RUNPH(6, { p6_norm_router(F); })
    RUNPH(7, {
        moe_tables(F);
        const LAS int* tb = (const LAS int*)(F.lds + MOE_OFF);
        gu32* rtc = F.ctl + CW_RT;
        { pg8::Gemm g{F.XF, F.WE1, T, NE * 2 * FF, D / 2}; SchedMoe<8> S{F.G, F.vcu, tb, tb + 32, F.ELIST, (unsigned)D, rtc}; EpiMoe1 E{(unsigned char*)F.HMOE};
          pg8::gemm_phase<EpiMoe1, SchedMoe<8>, PG8_ALIGN, PG8_SP2, true, true, false, PG8_ROLL7>(F.lds, g, S, E, rowtab); }
        if (F.wave == 0) __builtin_amdgcn_fence(__ATOMIC_ACQUIRE, "agent");
        __syncthreads();
        { pg8::Gemm g{F.HMOE, F.WE2, HM_ROWS, NE * D, FF / 2}; SchedMoe2 S{F.G, F.vcu, tb[NE] * 8, tb, tb + 32, rtc, F.ctl + CW_TMO}; EpiMoe2 E{(unsigned char*)F.SLOT, F.ELIST, F.EW, tb, tb + 32, (unsigned char*)F.WIN};
          pg8::gemm_phase<EpiMoe2, SchedMoe2, PG8_ALIGN, PG8_SP2, false, true, false, PG8_ROLL8>(F.lds, g, S, E, rowtab); } })
    RUNPH(9, { p9_final(F); })
#undef IN
#undef BOTH
}

__global__ void __launch_bounds__(320) mlstm_naive(const bf16* __restrict__ PROJ, const float* __restrict__ GATES, bf16* __restrict__ HF, bf16* __restrict__ HB) {
    __shared__ float kq[2][256];
    __shared__ float sc[2][4];
    __shared__ float dens[2];
    const int bid = blockIdx.x, dir = bid & 1, h = (bid >> 1) & 7, b = bid >> 4, tid = threadIdx.x;
    float C[128];
#pragma unroll
    for (int i = 0; i < 128; ++i) C[i] = 0.f;
    float m = 0.f;
    bf16* HO = dir ? HB : HF;
    const int NSTEP = CTXL + SEQ;
    for (int st = 0; st < NSTEP; ++st) {
        int row;
        if (st < CTXL) { const int j = dir ? (CTXL - 1 - st) : st; row = T + b * CTXL + j; }
        else { const int s = dir ? (SEQ - 1 - (st - CTXL)) : (st - CTXL); row = b * SEQ + s; }
        const bf16* pr = PROJ + (size_t)row * NPROJ;
        const int buf = st & 1;
        if (tid < 128) kq[buf][tid] = bf1(pr[COL_K + h * DK + tid]);
        else if (tid < 256) kq[buf][tid] = bf1(pr[COL_Q + h * DK + (tid - 128)]) * 0.08838834764831845f;
        const float ig = GATES[(size_t)row * 32 + (dir ? 16 : 0) + h], fp = GATES[(size_t)row * 32 + (dir ? 24 : 8) + h];
        const float lf = fminf(fp, 0.f) - log1pf(expf(-fabsf(fp)));
        const float mn = fmaxf(lf + m, ig);
        const float fdec = expf(lf + m - mn), iw = expf(ig - mn);
        m = mn;
        const float vv = tid < 256 ? bf1(pr[COL_V + h * DV + tid]) : 1.f;
        __syncthreads();
        const bool isq = st >= CTXL;
        float dot = 0.f;
        if (tid <= 256) {
            const float a = iw * vv;
#pragma unroll
            for (int i = 0; i < 128; ++i) { C[i] = fdec * C[i] + a * kq[buf][i]; dot += C[i] * kq[buf][128 + i]; }
        }
        if (isq) {
            if (tid == 256) dens[buf] = dot;
            __syncthreads();
            if (tid < 256) { const float dn = fmaxf(fabsf(dens[buf]), expf(-m)); HO[(size_t)row * 2048 + h * DV + tid] = (bf16)(pk2(dot / dn, 0.f) & 0xffffu); }
        }
    }
}

extern "C" void kernel_launch(void* const* d_in, const int* in_sizes, int n_in, void* d_out, int out_size, void* d_ws, size_t ws_size, hipStream_t stream) {
    static int grid = 0;
    if (grid == 0) {
        if (n_in != 20 || out_size != T * D || ws_size < WS_END) { fprintf(stderr, "kernel_launch: unexpected shapes (n_in %d, out %d, ws %zu)\n", n_in, out_size, ws_size); grid = -1; return; }
        int dev = 0, cus = 0, per_cu = 0;
        if (hipGetDevice(&dev) != hipSuccess || hipDeviceGetAttribute(&cus, hipDeviceAttributeMultiprocessorCount, dev) != hipSuccess) { grid = -1; return; }
        if (hipFuncSetAttribute((const void*)mk_fwd, hipFuncAttributeMaxDynamicSharedMemorySize, LDS_BYTES) != hipSuccess) { fprintf(stderr, "kernel_launch: hipFuncSetAttribute failed\n"); grid = -1; return; }
        if (hipOccupancyMaxActiveBlocksPerMultiprocessor(&per_cu, (const void*)mk_fwd, NTHR, LDS_BYTES) != hipSuccess || per_cu < 1) fprintf(stderr, "kernel_launch: occupancy query says %d\n", per_cu);
        (void)hipGetLastError();
        grid = cus;
    }
    if (grid < 0) return;
    (void)hipMemsetAsync((char*)d_ws + WS_CTL, 0, CTL_ZERO_BYTES, stream);
    Args a{};
    for (int i = 0; i < 20; ++i) a.in[i] = (const float*)d_in[i];
    a.out = (float*)d_out; a.ws = (unsigned char*)d_ws;
    int nl = 0;
    auto launch = [&](int lo, int hi) { a.ph_lo = lo; a.ph_hi = hi; a.li = nl++; hipLaunchKernelGGL(mk_fwd, dim3(grid), dim3(NTHR), LDS_BYTES, stream, a); };
#if MK_MODE == 0
    launch(0, 1); launch(1, 2); launch(2, 3);
    hipLaunchKernelGGL(mlstm_naive, dim3(NB * NH * 2), dim3(320), 0, stream, (const bf16*)((char*)d_ws + WS_PROJ), (const float*)((char*)d_ws + WS_GATES), (bf16*)((char*)d_ws + WS_HF), (bf16*)((char*)d_ws + WS_HB));
    launch(4, 5); launch(5, 6); launch(6, 7); launch(7, 8); launch(8, 9); launch(9, 10);
#elif MK_MODE == 2
    launch(0, 10);
#else
    launch(0, 3);
    hipLaunchKernelGGL(mlstm_naive, dim3(NB * NH * 2), dim3(320), 0, stream, (const bf16*)((char*)d_ws + WS_PROJ), (const float*)((char*)d_ws + WS_GATES), (bf16*)((char*)d_ws + WS_HF), (bf16*)((char*)d_ws + WS_HB));
    launch(4, 10);
#endif
}
```

```cpp
#include <hip/hip_runtime.h>
#include <cstdio>
#include <cstdint>

#ifndef MK_MODE
#define MK_MODE 2
#endif

namespace pg8 {
#define PG8_LAS __attribute__((address_space(3)))
typedef unsigned short bf16_t;
typedef short bf16x8 __attribute__((ext_vector_type(8)));
typedef float f32x4 __attribute__((ext_vector_type(4)));
typedef unsigned u32x4 __attribute__((ext_vector_type(4)));
constexpr int BM = 256, BK = 64, HALF = 128, HTB = HALF * BK * 2, STAGE_BYTES = 8 * HTB, NXCD = 8, WGM = 8;

__host__ __device__ __forceinline__ int lds_byte(int r, int c) { const int st = (r >> 4) * 2 + (c >> 5), rr = r & 15, cc = c & 31, ob = rr * 64 + cc * 2; return st * 1024 + (ob ^ (((ob >> 9) & 1) << 5)); }
__host__ __device__ __forceinline__ void stage_rc(int b, int& R, int& C) { const int st = b / 1024, sb = b % 1024, swz = sb ^ (((sb >> 9) & 1) << 5); R = (st >> 1) * 16 + swz / 64; C = (st & 1) * 32 + (swz % 64) / 2; }
__host__ __device__ __forceinline__ int perm32(int rho) { const int n = rho >> 4, i = rho & 15; return 8 * (i >> 2) + 4 * n + (i & 3); }

struct Unit { int pm, pn; };
struct Gemm { const bf16_t* A; const bf16_t* Bt; int M, N, K; };

typedef float f32x2_t __attribute__((ext_vector_type(2))); typedef __bf16 bf16x2_t __attribute__((ext_vector_type(2)));
__device__ __forceinline__ unsigned cvt_pk_bf16(float lo, float hi) { f32x2_t v = {lo, hi}; bf16x2_t b = __builtin_convertvector(v, bf16x2_t); return __builtin_bit_cast(unsigned, b); }

typedef int i32x8 __attribute__((ext_vector_type(8)));
typedef int i32x4 __attribute__((ext_vector_type(4)));
constexpr int TAB_OFF = STAGE_BYTES;
template <class Epi, class Sched, bool ALIGN_EPI, bool SP2, bool GATHER, bool MX, bool I8 = false, bool ROLL = false>
__device__ __forceinline__ void gemm_phase(PG8_LAS unsigned char* lds, const Gemm g, const Sched& S, const Epi& E, PG8_LAS unsigned* rowtab) {
    const int tid = threadIdx.x, wid = __builtin_amdgcn_readfirstlane(tid >> 6), lane = tid & 63, wr = wid >> 2, wc = wid & 3, fr = lane & 15, fq = lane >> 4;
    const int K = g.K, nt = K / BK;
    unsigned voffA[2], voffB[2]; int RA[2], CA[2];
#pragma unroll
    for (int i = 0; i < 2; ++i) { int R, C; stage_rc(tid * 16 + i * 8192, R, C); const int Rb = ((int)Epi::PERM == 2) ? (64 * (R >> 5) + 16 * ((R & 15) >> 2) + 4 * ((R >> 4) & 1) + (R & 3)) : (Epi::PERM ? ((R & ~31) + perm32(R & 31)) : R);
        voffA[i] = (unsigned)(R * K + C) * 2u; voffB[i] = (unsigned)(Rb * K + C) * 2u; RA[i] = R; CA[i] = C * 2; }
    const size_t kstep = (size_t)(BK * 2);
    const size_t hstep = (size_t)HALF * K * 2;
    const size_t tstep = 2 * hstep;
    const size_t hstepA = GATHER ? (size_t)0 : hstep;
    const size_t hstepB = ((int)Epi::PERM == 2) ? (size_t)8 * K * 2 : hstep;
    const unsigned ldsw = (unsigned)wid * 1024u;
    const int aoff = lds_byte(wr * 64 + fr, MX ? fq * 16 : fq * 8), boff = lds_byte(wc * 32 + fr, MX ? fq * 16 : fq * 8);
#define PG8_SA(b, h) (((b) * 2 + (h)) * HTB)
#define PG8_SB(b, h) ((4 + (b) * 2 + (h)) * HTB)
#define PG8_STAGE(bufoff, gbase, voff) do { _Pragma("unroll") for (int _i = 0; _i < 2; ++_i) \
        __builtin_amdgcn_global_load_lds((const unsigned*)((const char*)(gbase) + (voff)[_i]), (PG8_LAS unsigned*)(lds + (bufoff) + ldsw + _i * 8192), 16, 0, 0); } while (0)
#define PG8_LD32(p) ({ const u32x4 lo_ = *(const PG8_LAS u32x4*)(p), hi_ = *(const PG8_LAS u32x4*)((p) + 16); (i32x8){(int)lo_[0], (int)lo_[1], (int)lo_[2], (int)lo_[3], (int)hi_[0], (int)hi_[1], (int)hi_[2], (int)hi_[3]}; })
#define PG8_LDA(dst, b, h) do { if constexpr (MX) { _Pragma("unroll") for (int m = 0; m < 4; ++m) dst##X[m] = PG8_LD32(lds + PG8_SA(b, h) + aoff + m * 2048); } \
        else { _Pragma("unroll") for (int m = 0; m < 4; ++m) _Pragma("unroll") for (int k = 0; k < 2; ++k) dst[m][k] = *(const PG8_LAS bf16x8*)(lds + PG8_SA(b, h) + aoff + m * 2048 + k * 1024); } } while (0)
#define PG8_LDB(dst, b, h) do { if constexpr (MX) { _Pragma("unroll") for (int n = 0; n < 2; ++n) dst##X[n] = PG8_LD32(lds + PG8_SB(b, h) + boff + n * 2048); } \
        else { _Pragma("unroll") for (int n = 0; n < 2; ++n) _Pragma("unroll") for (int k = 0; k < 2; ++k) dst[n][k] = *(const PG8_LAS bf16x8*)(lds + PG8_SB(b, h) + boff + n * 2048 + k * 1024); } } while (0)
#define PG8_MMA(ai, bj, At, Bt) do { __builtin_amdgcn_s_setprio(1); if constexpr (MX) { _Pragma("unroll") for (int m = 0; m < 4; ++m) _Pragma("unroll") for (int n = 0; n < 2; ++n) \
        asm volatile("v_mfma_scale_f32_16x16x128_f8f6f4 %0, %1, %2, %0, %3, %3 op_sel_hi:[0,0,0]" : "+v"(acc[ai][bj][m][n]) : "v"(Bt##X[n]), "v"(At##X[m]), "v"(mxscale)); } \
        else if constexpr (I8) { _Pragma("unroll") for (int m = 0; m < 4; ++m) _Pragma("unroll") for (int n = 0; n < 2; ++n) _Pragma("unroll") for (int k = 0; k < 2; ++k) \
        acc[ai][bj][m][n] = __builtin_bit_cast(f32x4, __builtin_amdgcn_mfma_i32_16x16x64_i8(__builtin_bit_cast(i32x4, Bt[n][k]), __builtin_bit_cast(i32x4, At[m][k]), __builtin_bit_cast(i32x4, acc[ai][bj][m][n]), 0, 0, 0)); } \
        else { _Pragma("unroll") for (int m = 0; m < 4; ++m) _Pragma("unroll") for (int n = 0; n < 2; ++n) _Pragma("unroll") for (int k = 0; k < 2; ++k) \
        acc[ai][bj][m][n] = __builtin_amdgcn_mfma_f32_16x16x32_bf16(Bt[n][k], At[m][k], acc[ai][bj][m][n], 0, 0, 0); } __builtin_amdgcn_s_setprio(0); } while (0)
#define PG8_WAIT_V(n) asm volatile("s_waitcnt vmcnt(" #n ")" ::: "memory")
#define PG8_WAIT_VN(n) asm volatile("s_waitcnt vmcnt(%0)" :: "n"(n) : "memory")
#define PG8_ZERO(ai) do { _Pragma("unroll") for (int b_ = 0; b_ < 2; ++b_) _Pragma("unroll") for (int m_ = 0; m_ < 4; ++m_) _Pragma("unroll") for (int n_ = 0; n_ < 2; ++n_) acc[ai][b_][m_][n_] = (f32x4){0.f, 0.f, 0.f, 0.f}; } while (0)
#define PG8_TABP(u_) ((const PG8_LAS float*)(lds + TAB_OFF + ((u_) & 1) * 2048))
#define PG8_WAIT_L(n) asm volatile("s_waitcnt lgkmcnt(" #n ")" ::: "memory")
#define PG8_BAR __builtin_amdgcn_s_barrier()
#define PG8_SCHED __builtin_amdgcn_sched_barrier(0)
    static_assert(!ROLL || SP2, "rolling epilogue: eight-phase loop only");
    Unit cur, nxt; int ui = 0; bool pst = false;
    if (!S.next(0, cur)) return;
    f32x4 acc[2][2][4][2];
#pragma unroll
    for (int a = 0; a < 2; ++a)
#pragma unroll
        for (int b = 0; b < 2; ++b)
#pragma unroll
            for (int m = 0; m < 4; ++m)
#pragma unroll
                for (int n = 0; n < 2; ++n) acc[a][b][m][n] = (f32x4){0.f, 0.f, 0.f, 0.f};
    bf16x8 At[4][2], B0[2][2], B1[2][2]; i32x8 AtX[4], B0X[2], B1X[2]; const int mxscale = 0x7F7F7F7F;
    unsigned vc0[2], vc1[2], vn0[2], vn1[2];
    const char* cA = GATHER ? (const char*)g.A : (const char*)g.A + (size_t)cur.pm * tstep; const char* cB = (const char*)g.Bt + (size_t)cur.pn * tstep;
    if constexpr (GATHER) {
        if (tid < 256) rowtab[tid] = ROLL ? S.row_raw(cur, tid) : S.row_byteoff(cur, tid);
        asm volatile("s_waitcnt vmcnt(0) lgkmcnt(0)" ::: "memory"); PG8_BAR; asm volatile("" ::: "memory");
#pragma unroll
        for (int i = 0; i < 2; ++i) { vc0[i] = (ROLL ? S.row_off(rowtab[RA[i]]) : rowtab[RA[i]]) + (unsigned)CA[i]; vc1[i] = (ROLL ? S.row_off(rowtab[128 + RA[i]]) : rowtab[128 + RA[i]]) + (unsigned)CA[i]; vn0[i] = vc0[i]; vn1[i] = vc1[i]; }
    } else {
#pragma unroll
        for (int i = 0; i < 2; ++i) { vc0[i] = voffA[i]; vc1[i] = voffA[i]; vn0[i] = voffA[i]; vn1[i] = voffA[i]; }
    }
    S.a_ready(cur);
    if constexpr (SP2) {
        PG8_STAGE(PG8_SB(0, 0), cB, voffB); PG8_STAGE(PG8_SB(0, 1), cB + hstepB, voffB); PG8_STAGE(PG8_SA(0, 0), cA, vc0); PG8_STAGE(PG8_SA(0, 1), cA + hstepA, vc1);
        if (wr == 1) PG8_BAR;
        PG8_WAIT_V(2); PG8_BAR;
        PG8_STAGE(PG8_SB(1, 0), cB + kstep, voffB); PG8_STAGE(PG8_SA(1, 0), cA + kstep, vc0); PG8_STAGE(PG8_SB(1, 1), cB + hstepB + kstep, voffB);
        PG8_WAIT_V(6); PG8_BAR;
    } else {
        PG8_STAGE(PG8_SB(0, 0), cB, voffB); PG8_STAGE(PG8_SA(0, 0), cA, vc0); PG8_STAGE(PG8_SB(0, 1), cB + hstepB, voffB); PG8_STAGE(PG8_SA(0, 1), cA + hstepA, vc1);
        if (wr == 1) PG8_BAR;
        PG8_WAIT_V(4); PG8_BAR;
        PG8_STAGE(PG8_SB(1, 0), cB + kstep, voffB); PG8_STAGE(PG8_SA(1, 0), cA + kstep, vc0); PG8_STAGE(PG8_SB(1, 1), cB + hstepB + kstep, voffB);
        PG8_WAIT_V(6); PG8_BAR;
    }
    for (;;) {
        const bool has_next = S.next(ui + 1, nxt);
        const char* nA = GATHER ? (const char*)g.A : (has_next ? (const char*)g.A + (size_t)nxt.pm * tstep : cA); const char* nB = has_next ? (const char*)g.Bt + (size_t)nxt.pn * tstep : cB;
        if constexpr (GATHER && !ROLL) {
            if (has_next && tid < 256) rowtab[((ui + 1) & 1) * 256 + tid] = S.row_byteoff(nxt, tid);
        }
#pragma unroll 1
        for (int t = 0; t < nt; t += 2) {
            const bool last = (t == nt - 2);
            const char* a1 = cA + (size_t)(t + 1) * kstep;
            const char* a2 = last ? nA : cA + (size_t)(t + 2) * kstep; const char* b2 = last ? nB : cB + (size_t)(t + 2) * kstep;
            const char* a3 = a2 + kstep; const char* b3 = b2 + kstep;
            if (last && has_next) S.a_ready(nxt);
            if constexpr (GATHER) {
                if (last && has_next) {
                    PG8_LAS unsigned* rt = rowtab + ((ui + 1) & 1) * 256;
#pragma unroll
                    for (int i = 0; i < 2; ++i) { vn0[i] = (ROLL ? S.row_off(rt[RA[i]]) : rt[RA[i]]) + (unsigned)CA[i]; vn1[i] = (ROLL ? S.row_off(rt[128 + RA[i]]) : rt[128 + RA[i]]) + (unsigned)CA[i]; }
                }
            }
            unsigned w20[2], w21[2];
#pragma unroll
            for (int i = 0; i < 2; ++i) { w20[i] = last ? vn0[i] : vc0[i]; w21[i] = last ? vn1[i] : vc1[i]; }
            if constexpr (SP2 && ROLL) {
            const bool rf = (t == 0) && pst;
            PG8_LDB(B0, 0, 0); PG8_LDB(B1, 0, 1); PG8_SCHED; PG8_LDA(At, 0, 0); PG8_STAGE(PG8_SA(1, 1), a1 + hstepA, vc1);
            if (t == 2) {
                if constexpr (Epi::NTAB > 0) { if (Epi::NTAB > 1 || wid < 4) __builtin_amdgcn_global_load_lds((const unsigned*)E.tab_src(cur, tid), (PG8_LAS unsigned*)(lds + TAB_OFF + (ui & 1) * 2048 + wid * 256), 4, 0, 0); }
                if constexpr (GATHER) { if (has_next && wid < 4) __builtin_amdgcn_global_load_lds((const unsigned*)S.row_src(nxt, tid), (PG8_LAS unsigned*)(rowtab + ((ui + 1) & 1) * 256 + wid * 64), 4, 0, 0); }
            }
            if (rf) PG8_WAIT_VN(8 + 2 * Epi::NS); else PG8_WAIT_V(8);
            PG8_WAIT_L(0); PG8_BAR; PG8_MMA(0, 0, At, B0); PG8_MMA(0, 1, At, B1); PG8_BAR; PG8_SCHED;
            PG8_LDA(At, 0, 1); PG8_STAGE(PG8_SB(0, 0), b2, voffB); PG8_STAGE(PG8_SB(0, 1), b2 + hstepB, voffB); PG8_STAGE(PG8_SA(0, 0), a2, w20);
            if (rf) PG8_WAIT_VN(8 + 2 * Epi::NS); else PG8_WAIT_V(8);
            PG8_WAIT_L(0); PG8_BAR; PG8_MMA(1, 0, At, B0); PG8_MMA(1, 1, At, B1); PG8_BAR; PG8_SCHED;
            PG8_LDB(B0, 1, 0); PG8_LDB(B1, 1, 1); PG8_SCHED; PG8_LDA(At, 1, 0); PG8_STAGE(PG8_SA(0, 1), a2 + hstepA, w21);
            PG8_WAIT_V(8); PG8_WAIT_L(0); PG8_BAR; PG8_MMA(0, 0, At, B0); PG8_MMA(0, 1, At, B1); PG8_BAR; PG8_SCHED;
            PG8_LDA(At, 1, 1); PG8_STAGE(PG8_SB(1, 0), b3, voffB); PG8_STAGE(PG8_SB(1, 1), b3 + hstepB, voffB); PG8_STAGE(PG8_SA(1, 0), a3, w20);
            PG8_WAIT_V(8); PG8_WAIT_L(0); PG8_BAR; PG8_MMA(1, 0, At, B0); PG8_MMA(1, 1, At, B1); PG8_BAR; PG8_SCHED;
            } else if constexpr (SP2) {
            PG8_LDB(B0, 0, 0); PG8_LDB(B1, 0, 1); PG8_SCHED; PG8_LDA(At, 0, 0); PG8_STAGE(PG8_SA(1, 1), a1 + hstepA, vc1);
            PG8_WAIT_V(8); PG8_WAIT_L(0); PG8_BAR; PG8_MMA(0, 0, At, B0); PG8_MMA(0, 1, At, B1); PG8_BAR; PG8_SCHED;
            PG8_LDA(At, 0, 1); PG8_STAGE(PG8_SB(0, 0), b2, voffB); PG8_STAGE(PG8_SB(0, 1), b2 + hstepB, voffB); PG8_STAGE(PG8_SA(0, 0), a2, w20);
            PG8_WAIT_V(8); PG8_WAIT_L(0); PG8_BAR; PG8_MMA(1, 0, At, B0); PG8_MMA(1, 1, At, B1); PG8_BAR; PG8_SCHED;
            PG8_LDB(B0, 1, 0); PG8_LDB(B1, 1, 1); PG8_SCHED; PG8_LDA(At, 1, 0); PG8_STAGE(PG8_SA(0, 1), a2 + hstepA, w21);
            PG8_WAIT_V(8); PG8_WAIT_L(0); PG8_BAR; PG8_MMA(0, 0, At, B0); PG8_MMA(0, 1, At, B1); PG8_BAR; PG8_SCHED;
            PG8_LDA(At, 1, 1); PG8_STAGE(PG8_SB(1, 0), b3, voffB); PG8_STAGE(PG8_SB(1, 1), b3 + hstepB, voffB); PG8_STAGE(PG8_SA(1, 0), a3, w20);
            PG8_WAIT_V(8); PG8_WAIT_L(0); PG8_BAR; PG8_MMA(1, 0, At, B0); PG8_MMA(1, 1, At, B1); PG8_BAR; PG8_SCHED;
            } else {
            PG8_LDB(B0, 0, 0); PG8_SCHED; PG8_LDA(At, 0, 0); PG8_STAGE(PG8_SA(1, 1), a1 + hstepA, vc1);
            PG8_WAIT_L(8); PG8_BAR; PG8_WAIT_L(0); PG8_MMA(0, 0, At, B0); PG8_BAR; PG8_SCHED;
            PG8_LDB(B1, 0, 1); PG8_STAGE(PG8_SB(0, 0), b2, voffB);
            PG8_BAR; PG8_WAIT_L(0); PG8_MMA(0, 1, At, B1); PG8_BAR;
            PG8_LDA(At, 0, 1); PG8_STAGE(PG8_SA(0, 0), a2, w20);
            PG8_BAR; PG8_WAIT_L(0); PG8_MMA(1, 0, At, B0); PG8_BAR; PG8_SCHED;
            PG8_STAGE(PG8_SB(0, 1), b2 + hstepB, voffB);
            PG8_WAIT_V(6); PG8_BAR; PG8_MMA(1, 1, At, B1); PG8_BAR;
            PG8_LDB(B0, 1, 0); PG8_SCHED; PG8_LDA(At, 1, 0); PG8_STAGE(PG8_SA(0, 1), a2 + hstepA, w21);
            PG8_WAIT_L(8); PG8_BAR; PG8_WAIT_L(0); PG8_MMA(0, 0, At, B0); PG8_BAR; PG8_SCHED;
            PG8_LDB(B1, 1, 1); PG8_STAGE(PG8_SB(1, 0), b3, voffB);
            PG8_BAR; PG8_WAIT_L(0); PG8_MMA(0, 1, At, B1); PG8_BAR;
            PG8_LDA(At, 1, 1); PG8_STAGE(PG8_SA(1, 0), a3, w20);
            PG8_BAR; PG8_WAIT_L(0); PG8_MMA(1, 0, At, B0); PG8_BAR; PG8_SCHED;
            PG8_STAGE(PG8_SB(1, 1), b3 + hstepB, voffB);
            PG8_WAIT_V(6); PG8_BAR; PG8_MMA(1, 1, At, B1); PG8_BAR;
            }
        }
        if constexpr (ALIGN_EPI) { if (wr == 0) PG8_BAR; }
        if constexpr (ROLL) { int fr_ = fr, fq_ = fq; asm volatile("" : "+v"(fr_), "+v"(fq_)); E.half(acc, cur, 0, wr, wc, fr_, fq_, PG8_TABP(ui)); E.half(acc, cur, 1, wr, wc, fr_, fq_, PG8_TABP(ui)); pst = E.stores(cur, wc); }
        else E(acc, cur, wr, wc, fr, fq);
        S.done(cur);
        if (!has_next) break;
#pragma unroll
        for (int a = 0; a < 2; ++a)
#pragma unroll
            for (int b = 0; b < 2; ++b)
#pragma unroll
                for (int m = 0; m < 4; ++m)
#pragma unroll
                    for (int n = 0; n < 2; ++n) acc[a][b][m][n] = (f32x4){0.f, 0.f, 0.f, 0.f};
        cur = nxt; cA = nA; cB = nB; ++ui;
#pragma unroll
        for (int i = 0; i < 2; ++i) { vc0[i] = vn0[i]; vc1[i] = vn1[i]; }
        if constexpr (ALIGN_EPI) { if (wr == 1) PG8_BAR; }
    }
    PG8_WAIT_V(0);
    if constexpr (!ALIGN_EPI) { if (wr == 0) PG8_BAR; }
    PG8_BAR;
}
struct Gemm2 { const char* A0; const char* B0; unsigned rbA0, rbB0; int nt0; const char* A1; const char* B1; unsigned rbA1, rbB1; int nt1; };
constexpr int TAB2_BYTES = 4096;
template <class Epi, class Sched, bool ALIGN_EPI>
__device__ __forceinline__ void gemm_phase2(PG8_LAS unsigned char* lds, const Gemm2 g, const Sched& S, const Epi& E) {
    constexpr bool MX = false;
    const int tid = threadIdx.x, wid = __builtin_amdgcn_readfirstlane(tid >> 6), lane = tid & 63, wr = wid >> 2, wc = wid & 3, fr = lane & 15, fq = lane >> 4;
    unsigned vA0[2], vB0[2], vA1[2], vB1[2];
#pragma unroll
    for (int i = 0; i < 2; ++i) { int R, C; stage_rc(tid * 16 + i * 8192, R, C); const int Rb = Epi::PERM ? ((R & ~31) + perm32(R & 31)) : R;
        vA0[i] = (unsigned)R * g.rbA0 + (unsigned)C * 2u; vB0[i] = (unsigned)Rb * g.rbB0 + (unsigned)C * 2u; vA1[i] = (unsigned)R * g.rbA1 + (unsigned)C * 2u; vB1[i] = (unsigned)Rb * g.rbB1 + (unsigned)C * 2u; }
    const size_t kstep = (size_t)(BK * 2);
    const size_t hA0 = (size_t)HALF * g.rbA0, hB0 = (size_t)HALF * g.rbB0, hA1 = (size_t)HALF * g.rbA1, hB1 = (size_t)HALF * g.rbB1;
    const unsigned ldsw = (unsigned)wid * 1024u;
    const int aoff = lds_byte(wr * 64 + fr, fq * 8), boff = lds_byte(wc * 32 + fr, fq * 8);
#define PG8_MMA8(ai, bj, At, Bt) do { __builtin_amdgcn_s_setprio(1); _Pragma("unroll") for (int m = 0; m < 4; ++m) _Pragma("unroll") for (int n = 0; n < 2; ++n) _Pragma("unroll") for (int k = 0; k < 2; ++k) \
        acc[ai][bj][m][n] = __builtin_bit_cast(f32x4, __builtin_amdgcn_mfma_i32_16x16x64_i8(__builtin_bit_cast(i32x4, Bt[n][k]), __builtin_bit_cast(i32x4, At[m][k]), __builtin_bit_cast(i32x4, acc[ai][bj][m][n]), 0, 0, 0)); __builtin_amdgcn_s_setprio(0); } while (0)
#define PG8_MMAB(ai, bj, At, Bt) do { __builtin_amdgcn_s_setprio(1); _Pragma("unroll") for (int m = 0; m < 4; ++m) _Pragma("unroll") for (int n = 0; n < 2; ++n) _Pragma("unroll") for (int k = 0; k < 2; ++k) \
        acc[ai][bj][m][n] = __builtin_amdgcn_mfma_f32_16x16x32_bf16(Bt[n][k], At[m][k], acc[ai][bj][m][n], 0, 0, 0); __builtin_amdgcn_s_setprio(0); } while (0)
#define PG8_TAB2P(u_) ((const PG8_LAS float*)(lds + TAB_OFF + ((u_) & 1) * TAB2_BYTES))
#define PG8_SEG(NT, CA, CB, HA, HB, VA, VB, NA, NB, NHA, NHB, NVA, NVB, MMA, FIRSTSEG) \
    _Pragma("unroll 1") for (int t = 0; t < (NT); t += 2) { \
        const bool last = (t == (NT) - 2); \
        const char* a1 = (CA) + (size_t)(t + 1) * kstep; \
        const char* a2 = last ? (NA) : (CA) + (size_t)(t + 2) * kstep; const char* b2 = last ? (NB) : (CB) + (size_t)(t + 2) * kstep; \
        const char* a3 = a2 + kstep; const char* b3 = b2 + kstep; \
        const size_t hA2 = last ? (NHA) : (HA), hB2 = last ? (NHB) : (HB); \
        unsigned wa[2], wb[2]; \
        _Pragma("unroll") for (int i = 0; i < 2; ++i) { wa[i] = last ? (NVA)[i] : (VA)[i]; wb[i] = last ? (NVB)[i] : (VB)[i]; } \
        const bool rf = (FIRSTSEG) && (t == 0) && pst; \
        PG8_LDB(B0, 0, 0); PG8_LDB(B1, 0, 1); PG8_SCHED; PG8_LDA(At, 0, 0); PG8_STAGE(PG8_SA(1, 1), a1 + (HA), (VA)); \
        if ((FIRSTSEG) && t == 2) { for (int q = wid; q < 4 * Epi::NTAB; q += 8) __builtin_amdgcn_global_load_lds((const unsigned*)E.tab_src(cur, q * 64 + lane), (PG8_LAS unsigned*)(lds + TAB_OFF + (ui & 1) * TAB2_BYTES + q * 256), 4, 0, 0); } \
        if (rf) PG8_WAIT_VN(8 + 2 * Epi::NS); else PG8_WAIT_V(8); \
        PG8_WAIT_L(0); PG8_BAR; MMA(0, 0, At, B0); MMA(0, 1, At, B1); PG8_BAR; PG8_SCHED; \
        PG8_LDA(At, 0, 1); PG8_STAGE(PG8_SB(0, 0), b2, wb); PG8_STAGE(PG8_SB(0, 1), b2 + hB2, wb); PG8_STAGE(PG8_SA(0, 0), a2, wa); \
        if (rf) PG8_WAIT_VN(8 + 2 * Epi::NS); else PG8_WAIT_V(8); \
        PG8_WAIT_L(0); PG8_BAR; MMA(1, 0, At, B0); MMA(1, 1, At, B1); PG8_BAR; PG8_SCHED; \
        PG8_LDB(B0, 1, 0); PG8_LDB(B1, 1, 1); PG8_SCHED; PG8_LDA(At, 1, 0); PG8_STAGE(PG8_SA(0, 1), a2 + hA2, wa); \
        PG8_WAIT_V(8); PG8_WAIT_L(0); PG8_BAR; MMA(0, 0, At, B0); MMA(0, 1, At, B1); PG8_BAR; PG8_SCHED; \
        PG8_LDA(At, 1, 1); PG8_STAGE(PG8_SB(1, 0), b3, wb); PG8_STAGE(PG8_SB(1, 1), b3 + hB2, wb); PG8_STAGE(PG8_SA(1, 0), a3, wa); \
        PG8_WAIT_V(8); PG8_WAIT_L(0); PG8_BAR; MMA(1, 0, At, B0); MMA(1, 1, At, B1); PG8_BAR; PG8_SCHED; \
    }
    Unit cur, nxt; int ui = 0; bool pst = false;
    if (!S.next(0, cur)) return;
    f32x4 acc[2][2][4][2];
#pragma unroll
    for (int a = 0; a < 2; ++a) PG8_ZERO(a);
    bf16x8 At[4][2], B0[2][2], B1[2][2]; i32x8 AtX[4], B0X[2], B1X[2]; (void)AtX; (void)B0X; (void)B1X;
    const char* cA0 = g.A0 + (size_t)cur.pm * 2 * hA0; const char* cB0 = g.B0 + (size_t)cur.pn * 2 * hB0;
    const char* cA1 = g.A1 + (size_t)cur.pm * 2 * hA1; const char* cB1 = g.B1 + (size_t)cur.pn * 2 * hB1;
    PG8_STAGE(PG8_SB(0, 0), cB0, vB0); PG8_STAGE(PG8_SB(0, 1), cB0 + hB0, vB0); PG8_STAGE(PG8_SA(0, 0), cA0, vA0); PG8_STAGE(PG8_SA(0, 1), cA0 + hA0, vA0);
    if (wr == 1) PG8_BAR;
    PG8_WAIT_V(2); PG8_BAR;
    PG8_STAGE(PG8_SB(1, 0), cB0 + kstep, vB0); PG8_STAGE(PG8_SA(1, 0), cA0 + kstep, vA0); PG8_STAGE(PG8_SB(1, 1), cB0 + hB0 + kstep, vB0);
    PG8_WAIT_V(6); PG8_BAR;
    for (;;) {
        const bool has_next = S.next(ui + 1, nxt);
        const char* nA0 = has_next ? g.A0 + (size_t)nxt.pm * 2 * hA0 : cA0; const char* nB0 = has_next ? g.B0 + (size_t)nxt.pn * 2 * hB0 : cB0;
        PG8_SEG(g.nt0, cA0, cB0, hA0, hB0, vA0, vB0, cA1, cB1, hA1, hB1, vA1, vB1, PG8_MMA8, true)
        { int fr_ = fr, fq_ = fq; asm volatile("" : "+v"(fr_), "+v"(fq_)); E.mid(acc, cur, wr, wc, fr_, fq_, PG8_TAB2P(ui)); }
        PG8_SCHED;
        PG8_SEG(g.nt1, cA1, cB1, hA1, hB1, vA1, vB1, nA0, nB0, hA0, hB0, vA0, vB0, PG8_MMAB, false)
        if constexpr (ALIGN_EPI) { if (wr == 0) PG8_BAR; }
        { int fr_ = fr, fq_ = fq; asm volatile("" : "+v"(fr_), "+v"(fq_)); E.half(acc, cur, 0, wr, wc, fr_, fq_, PG8_TAB2P(ui)); E.half(acc, cur, 1, wr, wc, fr_, fq_, PG8_TAB2P(ui)); pst = E.stores(cur, wc); }
        if (!has_next) break;
#pragma unroll
        for (int a = 0; a < 2; ++a) PG8_ZERO(a);
        cur = nxt; cA0 = nA0; cB0 = nB0; cA1 = g.A1 + (size_t)cur.pm * 2 * hA1; cB1 = g.B1 + (size_t)cur.pn * 2 * hB1; ++ui;
        if constexpr (ALIGN_EPI) { if (wr == 1) PG8_BAR; }
    }
    PG8_WAIT_V(0);
    if constexpr (!ALIGN_EPI) { if (wr == 0) PG8_BAR; }
    PG8_BAR;
#undef PG8_SEG
#undef PG8_MMA8
#undef PG8_MMAB
#undef PG8_TAB2P
#undef PG8_SA
#undef PG8_SB
#undef PG8_STAGE
#undef PG8_LDA
#undef PG8_LD32
#undef PG8_LDB
#undef PG8_MMA
#undef PG8_WAIT_V
#undef PG8_WAIT_VN
#undef PG8_ZERO
#undef PG8_TABP
#undef PG8_WAIT_L
#undef PG8_BAR
#undef PG8_SCHED
}
}

#ifndef PG8_SP2
#define PG8_SP2 true
#endif
#ifndef PG8_ALIGN
#define PG8_ALIGN true
#endif
#ifndef PG8_ROLL
#define PG8_ROLL true
#endif
#ifndef PG8_ROLL2
#define PG8_ROLL2 PG8_ROLL
#endif
#ifndef PG8_ROLL5
#define PG8_ROLL5 PG8_ROLL
#endif
#ifndef PG8_ROLL7
#define PG8_ROLL7 PG8_ROLL
#endif
#ifndef PG8_ROLL8
#define PG8_ROLL8 PG8_ROLL
#endif

constexpr int NWAVES = 8, NTHR = 512;
constexpr int D = 4096, NB = 4, SEQ = 4096, T = NB * SEQ, CTXL = 256, TC = NB * CTXL, TA = T + TC;
constexpr int NH = 8, DK = 128, DV = 256;
constexpr int COL_Q = 0, COL_O = 1024, COL_CB = 3072, COL_CC = 5120, COL_CX = 7168, COL_K = 9216, COL_V = 10240, COL_G = 12288;
constexpr int NPROJ = 12288, IN_COLS = 12320, NPAD = 12544;
constexpr int NE = 16, FF = 1024, ADA_N = 6 * D;
constexpr int HM_ROWS = 2 * T + NE * 256;
constexpr float EPS = 1e-6f;

constexpr size_t MiB = 1u << 20;
constexpr size_t WS_CTL = 0, CTL_ZERO_BYTES = 1 * MiB;
constexpr size_t WS_ADA = 1 * MiB;
constexpr size_t WS_GATES = 2 * MiB;
constexpr size_t WS_ELIST = 5 * MiB;
constexpr size_t WS_EW = 6 * MiB;
constexpr size_t WS_WIN = 8 * MiB;
constexpr size_t WS_WOUT = 106 * MiB;
constexpr size_t WS_WE1 = 138 * MiB;
constexpr size_t WS_WE2 = 394 * MiB;
constexpr size_t WS_XM = 522 * MiB;
constexpr size_t WS_PROJ = 658 * MiB;
constexpr size_t WS_SLOT = WS_PROJ, WS_HMOE = WS_PROJ + 256 * MiB;
constexpr size_t WS_HF = 1066 * MiB, WS_HB = 1194 * MiB;
constexpr size_t WS_X1 = 1322 * MiB;
constexpr size_t WS_XM8 = 1578 * MiB;
constexpr size_t WS_WO8 = 1646 * MiB;
constexpr size_t WS_WI8 = 1646 * MiB;
constexpr size_t WS_SA = 1696 * MiB, WS_SB = WS_SA + 256 * 1024;
constexpr size_t WS_END = 1698 * MiB;
static_assert(WS_XM8 + (size_t)TA * D <= WS_WI8 && WS_WI8 + (size_t)NPAD * D <= WS_SA, "ws map int8");
static_assert(WS_GATES + (size_t)TA * 32 * 4 <= WS_ELIST && WS_WIN + (size_t)NPAD * D * 2 <= WS_WOUT && WS_XM + (size_t)TA * D * 2 <= WS_PROJ && WS_PROJ + (size_t)TA * NPROJ * 2 <= WS_HF, "ws map");
static_assert(WS_HMOE + (size_t)HM_ROWS * FF * 2 <= WS_HF, "ws map 2");
constexpr int CW_TMO = 0, CW_CODE = 1, CW_TQ = 1024, CW_CNT = 2048, CW_CMAX = 32768, CW_CMAX2 = 49152, CW_BAR = 4096, CW_RT = 16384;

constexpr int RING_BYTES = 131072;
constexpr int LDS_BYTES = 147456;
constexpr int LDSCTL_OFF = LDS_BYTES - 3072;
constexpr int MISC_OFF = LDSCTL_OFF + 320;
constexpr int MOE_OFF = LDSCTL_OFF + 512;
constexpr int ROWTAB_OFF = LDSCTL_OFF + 1024;

#define GAS __attribute__((address_space(1)))
#define LAS __attribute__((address_space(3)))
typedef unsigned short bf16;
typedef unsigned v4u __attribute__((ext_vector_type(4)));
typedef unsigned v2u __attribute__((ext_vector_type(2)));
typedef float f32x4 __attribute__((ext_vector_type(4)));
typedef GAS unsigned gu32;
#define RLX_AGENT __ATOMIC_RELAXED, __HIP_MEMORY_SCOPE_AGENT
#define LDS_WAIT() asm volatile("s_waitcnt lgkmcnt(0)" ::: "memory")
#define VM_WAIT() asm volatile("s_waitcnt vmcnt(0)" ::: "memory")
__device__ __forceinline__ unsigned pk2(float lo, float hi) { return pg8::cvt_pk_bf16(lo, hi); }
__device__ __forceinline__ float bf_lo(unsigned u) { return __uint_as_float(u << 16); }
__device__ __forceinline__ float bf_hi(unsigned u) { return __uint_as_float(u & 0xffff0000u); }
__device__ __forceinline__ float bf1(bf16 u) { return __uint_as_float(((unsigned)u) << 16); }
__device__ __forceinline__ unsigned pk4_fp8(float a, float b, float c, float d) { int p = __builtin_amdgcn_cvt_pk_fp8_f32(a, b, 0, false); p = __builtin_amdgcn_cvt_pk_fp8_f32(c, d, p, true); return (unsigned)p; }
__device__ __forceinline__ unsigned pk4_i8(float a, float b, float c, float d) { return ((unsigned)(int)rintf(a) & 255u) | (((unsigned)(int)rintf(b) & 255u) << 8) | (((unsigned)(int)rintf(c) & 255u) << 16) | ((unsigned)(int)rintf(d) << 24); }
constexpr float W1_SCALE = 64.f, W2_SCALE = 32.f, SLOT_SCALE = 16.f;
typedef float f32x2v __attribute__((ext_vector_type(2)));
__device__ __forceinline__ f32x4 fp8x4_to_f32(unsigned v) { const f32x2v lo = __builtin_amdgcn_cvt_pk_f32_fp8((int)v, false), hi = __builtin_amdgcn_cvt_pk_f32_fp8((int)v, true); return (f32x4){lo[0], lo[1], hi[0], hi[1]}; }
__device__ __forceinline__ float sig255(float x) { return 255.f * __builtin_amdgcn_rcpf(1.f + __expf(-x)); }
__device__ __forceinline__ float sigmoidf_(float x) { return 1.f / (1.f + __expf(-x)); }

#define XB_TMO      128
#define XB_XCNT(j)  (256  + 64 * (j))
#define XB_XSUB(j)  (1280 + 64 * (j))
#define XB_XGEN(j)  (2304 + 64 * (j))
#define XB_TOP      3328
#define XB_TOPGEN   3392
#define XCD_BAR_WORDS 3456
#define XB_SPIN_CAP (1u << 22)
__device__ __forceinline__ unsigned xb_ld(unsigned* p)              { return __hip_atomic_load(p, __ATOMIC_RELAXED, __HIP_MEMORY_SCOPE_AGENT); }
__device__ __forceinline__ unsigned xb_add(unsigned* p, unsigned v) { return __hip_atomic_fetch_add(p, v, __ATOMIC_RELAXED, __HIP_MEMORY_SCOPE_AGENT); }
__device__ __forceinline__ unsigned xb_xcc_id() { return (unsigned)__builtin_amdgcn_s_getreg((3 << 11) | 20) & 0xFu; }
#define XB_SPIN(cond, bar) do { unsigned _sp = 0; while (cond) { __builtin_amdgcn_s_sleep(1); \
    if ((++_sp & 255u) == 0u) { if (xb_ld(&(bar)[XB_TMO])) break; if (_sp > XB_SPIN_CAP) { atomicAdd(&(bar)[XB_TMO], 1u); break; } } } } while (0)
struct XcdBarrier { unsigned* bar; unsigned x; volatile LAS unsigned* st; };
__device__ __forceinline__ XcdBarrier xcd_barrier_post(unsigned* bar, volatile LAS unsigned* st) {
    XcdBarrier b; b.bar = bar; b.x = xb_xcc_id(); b.st = st;
    if (threadIdx.x == 0) (void)xb_add(&bar[XB_XCNT(b.x)], 1u);
    return b;
}
__device__ __forceinline__ void xcd_barrier_complete(unsigned* bar, unsigned x, unsigned& nloc, unsigned& nx) {
    const unsigned G = gridDim.x * gridDim.y * gridDim.z;
    unsigned sum, cnt, mine, sp = 0u;
    for (;;) {
        sum = 0u; cnt = 0u; mine = 0u;
#pragma unroll
        for (unsigned j = 0; j < 16; ++j) { const unsigned c = xb_ld(&bar[XB_XCNT(j)]); sum += c; cnt += (c > 0u) ? 1u : 0u; mine = (j == x) ? c : mine; }
        if (sum == G) break;
        __builtin_amdgcn_s_sleep(1);
        if ((++sp & 255u) == 0u) { if (xb_ld(&bar[XB_TMO])) break; if (sp > XB_SPIN_CAP) { atomicAdd(&bar[XB_TMO], 1u); break; } }
    }
    nloc = mine > 0u ? mine : 1u; nx = cnt > 0u ? cnt : 1u;
}
__device__ __forceinline__ void xcd_barrier(const XcdBarrier& b) {
    asm volatile("s_waitcnt vmcnt(0)" ::: "memory");
    __syncthreads();
    if (threadIdx.x == 0) {
        unsigned* bar = b.bar;
        __builtin_amdgcn_s_waitcnt(0);
        unsigned nloc = b.st[0], nx = b.st[1];
        if (nloc == 0u) { xcd_barrier_complete(bar, b.x, nloc, nx); b.st[0] = nloc; b.st[1] = nx; }
        const unsigned old = xb_add(&bar[XB_XSUB(b.x)], 1u);
        const unsigned gen = old / nloc;
        if (old + 1u == (gen + 1u) * nloc) {
            __builtin_amdgcn_fence(__ATOMIC_RELEASE, "agent");
            asm volatile("s_waitcnt vmcnt(0)" ::: "memory");
            const unsigned og = xb_add(&bar[XB_TOP], 1u);
            const unsigned tg = og / nx;
            if (og + 1u == (tg + 1u) * nx) xb_add(&bar[XB_TOPGEN], 1u);
            else XB_SPIN(xb_ld(&bar[XB_TOPGEN]) == tg, bar);
            __builtin_amdgcn_fence(__ATOMIC_ACQUIRE, "agent");
            xb_add(&bar[XB_XGEN(b.x)], 1u);
            asm volatile("s_waitcnt vmcnt(0)" ::: "memory");
        } else {
            XB_SPIN(xb_ld(&bar[XB_XGEN(b.x)]) == gen, bar);
            __builtin_amdgcn_fence(__ATOMIC_ACQUIRE, "agent");
            asm volatile("s_waitcnt vmcnt(0)" ::: "memory");
        }
    }
    __syncthreads();
}

struct Frame {
    LAS unsigned char* lds;
    volatile LAS unsigned* MISC;
    gu32* ctl;
    int tid, lane, wave;
    int vcu, G;
    const float *x, *c, *ctx, *cctx, *w_ada, *b_ada, *norm1, *w_in, *b_gates, *conv_w, *head_norm, *w_out, *norm2, *w_rg, *b_rg, *w_re, *b_re, *w_e1, *w_e2, *fnorm;
    float* out;
    float *ADA, *GATES, *EW;
    bf16 *DELTA, *X1B;
    unsigned char *XM8, *WO8, *MIXA8, *WOA8; signed char* WI8; float *SA, *SB, *SB2;
    bf16 *HF, *HB;
    int* ELIST;
    bf16 *WIN, *WOUT, *WE1, *WE2, *XM, *PROJ, *MIX, *XF, *SLOT, *HMOE;
};

template <int CTRL, int ROWMASK> __device__ __forceinline__ float dpp_f(float old, float src) {
    return __builtin_bit_cast(float, __builtin_amdgcn_update_dpp(__builtin_bit_cast(int, old), __builtin_bit_cast(int, src), CTRL, ROWMASK, 0xf, false)); }
__device__ __forceinline__ float wave_incl_sum(float v) {
    v += dpp_f<0x111, 0xf>(0.f, v); v += dpp_f<0x112, 0xf>(0.f, v); v += dpp_f<0x114, 0xf>(0.f, v); v += dpp_f<0x118, 0xf>(0.f, v);
    v += dpp_f<0x142, 0xa>(0.f, v); v += dpp_f<0x143, 0xc>(0.f, v); return v; }
__device__ __forceinline__ float wave_incl_max(float v) {
    constexpr float NI = -3.0e38f;
    v = fmaxf(v, dpp_f<0x111, 0xf>(NI, v)); v = fmaxf(v, dpp_f<0x112, 0xf>(NI, v)); v = fmaxf(v, dpp_f<0x114, 0xf>(NI, v)); v = fmaxf(v, dpp_f<0x118, 0xf>(NI, v));
    v = fmaxf(v, dpp_f<0x142, 0xa>(NI, v)); v = fmaxf(v, dpp_f<0x143, 0xc>(NI, v)); return v; }
__device__ __forceinline__ float lane_bcast(float v, int l) { return __builtin_bit_cast(float, __builtin_amdgcn_readlane(__builtin_bit_cast(int, v), l)); }
__device__ __forceinline__ float wave_sum(float v) { return lane_bcast(wave_incl_sum(v), 63); }
__device__ __forceinline__ float wave_max(float v) { return lane_bcast(wave_incl_max(v), 63); }

__device__ __forceinline__ void p0_ada(Frame& F) {
    LAS float* sil = (LAS float*)F.lds;
    LAS float* red = (LAS float*)(F.lds + 81920);
    for (int i = F.tid; i < 5 * D; i += NTHR) { const int b = i >> 12, k = i & (D - 1); const float cv = b < 4 ? F.c[b * D + k] : F.cctx[k]; sil[i] = cv / (1.f + expf(-cv)); }
    __syncthreads();
    const int cq = F.tid % 24, rg = F.tid / 24;
    for (int item = F.vcu; item < ADA_N / 96; item += F.G) {
        const int col0 = item * 96;
        float acc[5][4];
#pragma unroll
        for (int b = 0; b < 5; ++b)
#pragma unroll
            for (int j = 0; j < 4; ++j) acc[b][j] = 0.f;
        if (rg < 21) {
            const float* wp = F.w_ada + col0 + 4 * cq;
#pragma unroll 13
            for (int r = rg; r < D; r += 21) {
                const f32x4 w = *(const f32x4*)(wp + (size_t)r * ADA_N);
#pragma unroll
                for (int b = 0; b < 5; ++b) { const float s = sil[b * D + r];
#pragma unroll
                    for (int j = 0; j < 4; ++j) acc[b][j] += s * w[j]; }
            }
#pragma unroll
            for (int b = 0; b < 5; ++b)
#pragma unroll
                for (int j = 0; j < 4; ++j) red[rg * 480 + b * 96 + 4 * cq + j] = acc[b][j];
        }
        __syncthreads();
        if (F.tid < 480) { const int b = F.tid / 96, cc = F.tid % 96; float s = 0.f;
#pragma unroll
            for (int q = 0; q < 21; ++q) s += red[q * 480 + F.tid];
            F.ADA[b * ADA_N + col0 + cc] = s + F.b_ada[col0 + cc]; }
        __syncthreads();
    }
}
__device__ __forceinline__ int win_row(int n) {
    if (n < COL_CC || n >= COL_K) return n;
    const int rel = n - COL_CC, au = rel >> 11, r = rel & 2047;
    return COL_CC + 256 * (r >> 7) + 128 * au + (r & 127);
}
struct TItem { const float* W; bf16* WT; const void* cmax; unsigned* cmo; int K, N, nblk, row_off, item, map, f8; float scale; };
template <int KIND>
__device__ __forceinline__ TItem titem_decode(Frame& F, int r) {
    constexpr int I_E1 = (D / 64) * (2 * FF / 32), I_E2 = (FF / 64) * (D / 32);
    TItem t; t.cmax = (const void*)(F.ctl + CW_CMAX); t.cmo = nullptr;
    if (KIND == 8) { t.W = F.w_in; t.WT = (bf16*)F.WI8; t.K = D; t.N = IN_COLS; t.nblk = IN_COLS / 32; t.row_off = 0; t.item = (D / 64) * (IN_COLS / 32) - 1 - r; t.map = 2; t.f8 = 2; t.scale = 1.f; }
    else if (KIND == 0) { t.W = F.w_in; t.WT = F.WIN; t.K = D; t.N = IN_COLS; t.nblk = IN_COLS / 32; t.row_off = 0; t.map = 0; t.f8 = 0; t.scale = 1.f;
        { constexpr int NBP = (IN_COLS - COL_K) / 32; const int kb = r / NBP, nbp = r % NBP; t.item = kb * (IN_COLS / 32) + COL_K / 32 + nbp; } }
    else if (KIND == 1) { t.W = F.w_out; t.WT = F.WOUT; t.K = D; t.N = D; t.nblk = D / 32; t.row_off = 0; t.item = r; t.map = 0; t.f8 = 0; t.scale = 1.f; t.cmo = (unsigned*)(F.ctl + CW_CMAX2); }
    else if (KIND == 2) { const int e = r / I_E1; t.W = F.w_e1 + (size_t)e * D * 2 * FF; t.WT = F.WE1; t.K = D; t.N = 2 * FF; t.nblk = 2 * FF / 32; t.row_off = e * 2 * FF; t.item = r % I_E1; t.map = 1; t.f8 = 1; t.scale = W1_SCALE; }
    else { const int e = r / I_E2; t.W = F.w_e2 + (size_t)e * FF * D; t.WT = F.WE2; t.K = FF; t.N = D; t.nblk = D / 32; t.row_off = e * D; t.item = r % I_E2; t.map = 0; t.f8 = 1; t.scale = W2_SCALE; }
    return t;
}
__device__ __forceinline__ void titem_load(const TItem& t, int lane, f32x4 (&v)[8]) {
    const int nblk = t.nblk, kb = t.item / nblk, nb = t.item % nblk, k0 = 64 * kb, n0 = 32 * nb;
    const float* p = t.W + (size_t)(k0 + (lane >> 3)) * t.N + n0 + 4 * (lane & 7);
#pragma unroll
    for (int i = 0; i < 8; ++i) v[i] = *(const f32x4*)(p + (size_t)(8 * i) * t.N);
}
__device__ __forceinline__ void titem_finish(const TItem& cur, LAS float* scr, int lane) {
    const int nblk = cur.nblk, kb = cur.item / nblk, nb = cur.item % nblk, k0 = 64 * kb, n0 = 32 * nb, c = lane & 7;
#pragma unroll
    for (int j = 0; j < 4; ++j) { const int n = (lane >> 3) + 8 * j; const LAS float* s = scr + (8 * c) * 33 + n;
        const int nn = n0 + n; int row;
        if (cur.map == 0) row = cur.row_off + nn;
        else if (cur.map == 2) row = win_row(nn);
        else { const int au = nn >> 10, r = nn & 1023; row = cur.row_off + 256 * (r >> 7) + 128 * au + (r & 127); }
        const float sc = cur.scale;
        if (cur.f8 == 2) { const float cm = __uint_as_float(((const unsigned*)cur.cmax)[nn]), iv = cm > 0.f ? 127.f / cm : 0.f;
            *(v2u*)((unsigned char*)cur.WT + (size_t)row * cur.K + k0 + 8 * c) = (v2u){pk4_i8(s[0 * 33] * iv, s[1 * 33] * iv, s[2 * 33] * iv, s[3 * 33] * iv), pk4_i8(s[4 * 33] * iv, s[5 * 33] * iv, s[6 * 33] * iv, s[7 * 33] * iv)}; }
        else if (cur.f8) { *(v2u*)((unsigned char*)cur.WT + (size_t)row * cur.K + k0 + 8 * c) = (v2u){pk4_fp8(s[0 * 33] * sc, s[1 * 33] * sc, s[2 * 33] * sc, s[3 * 33] * sc), pk4_fp8(s[4 * 33] * sc, s[5 * 33] * sc, s[6 * 33] * sc, s[7 * 33] * sc)}; }
        else { v4u o; o.x = pk2(s[0 * 33], s[1 * 33]); o.y = pk2(s[2 * 33], s[3 * 33]); o.z = pk2(s[4 * 33], s[5 * 33]); o.w = pk2(s[6 * 33], s[7 * 33]);
               *(v4u*)(cur.WT + (size_t)row * cur.K + k0 + 8 * c) = o;
               if (cur.cmo != nullptr && k0 < D / 2) {
                   unsigned mx = max(max(max((o.x & 0x7fffu) << 16, o.x & 0x7fff0000u), max((o.y & 0x7fffu) << 16, o.y & 0x7fff0000u)), max(max((o.z & 0x7fffu) << 16, o.z & 0x7fff0000u), max((o.w & 0x7fffu) << 16, o.w & 0x7fff0000u)));
                   mx = max(mx, (unsigned)__shfl_xor((int)mx, 1)); mx = max(mx, (unsigned)__shfl_xor((int)mx, 2)); mx = max(mx, (unsigned)__shfl_xor((int)mx, 4));
                   if (c == 0) (void)__hip_atomic_fetch_max(cur.cmo + nn, mx, RLX_AGENT); } } }
}
constexpr int TI_IN = (D / 64) * (IN_COLS / 32), TI_OUT = (D / 64) * (D / 32), TI_E1 = (D / 64) * (2 * FF / 32), TI_E2 = (FF / 64) * (D / 32);
template <int KIND>
__device__ __forceinline__ void transpose_range(Frame& F, LAS float* scr, int it0, int it_end, int stride) {
    const int lane = F.lane;
    f32x4 v[8];
    int it = it0;
    TItem cur = titem_decode<KIND>(F, it < it_end ? it : 0);
    if (it < it_end) titem_load(cur, lane, v);
    while (it < it_end) {
#pragma unroll
        for (int i = 0; i < 8; ++i) { const int kk = 8 * i + (lane >> 3); LAS float* s = scr + kk * 33 + 4 * (lane & 7); s[0] = v[i][0]; s[1] = v[i][1]; s[2] = v[i][2]; s[3] = v[i][3]; }
        const int nit = it + stride;
        TItem nxt = cur;
        if (nit < it_end) { nxt = titem_decode<KIND>(F, nit); titem_load(nxt, lane, v); }
        LDS_WAIT(); asm volatile("" ::: "memory");
        titem_finish(cur, scr, lane);
        LDS_WAIT(); asm volatile("" ::: "memory");
        cur = nxt; it = nit;
    }
}
__device__ __forceinline__ void p0_transposes(Frame& F) {
    LAS float* scr = (LAS float*)(F.lds + F.wave * 8704);
    const int gw = F.vcu * NWAVES + F.wave, NGW = F.G * NWAVES;
    transpose_range<1>(F, scr, gw, TI_OUT, NGW);
    {
        constexpr int NIT = (D / 64) * (IN_COLS / 32);
        const int lane = F.lane;
        auto cm_load = [&](int it, f32x4 (&w)[8]) __attribute__((always_inline)) {
            const int itc = it < NIT ? it : NIT - 1, kb = itc / (IN_COLS / 32), nb = itc % (IN_COLS / 32);
            const float* p = F.w_in + (size_t)(64 * kb + (lane >> 3)) * IN_COLS + 32 * nb + 4 * (lane & 7);
#pragma unroll
            for (int i = 0; i < 8; ++i) w[i] = *(const f32x4*)(p + (size_t)(8 * i) * IN_COLS);
        };
        auto cm_step = [&](int it, f32x4 (&cur)[8], f32x4 (&nxt)[8]) __attribute__((always_inline)) {
            cm_load(it + NGW, nxt);
            if (it < NIT) {
                const int nb = it % (IN_COLS / 32);
                f32x4 mx = (f32x4){0.f, 0.f, 0.f, 0.f};
#pragma unroll
                for (int i = 0; i < 8; ++i) { mx[0] = fmaxf(mx[0], fabsf(cur[i][0])); mx[1] = fmaxf(mx[1], fabsf(cur[i][1])); mx[2] = fmaxf(mx[2], fabsf(cur[i][2])); mx[3] = fmaxf(mx[3], fabsf(cur[i][3])); }
#pragma unroll
                for (int o = 8; o < 64; o <<= 1) { mx[0] = fmaxf(mx[0], __shfl_xor(mx[0], o)); mx[1] = fmaxf(mx[1], __shfl_xor(mx[1], o)); mx[2] = fmaxf(mx[2], __shfl_xor(mx[2], o)); mx[3] = fmaxf(mx[3], __shfl_xor(mx[3], o)); }
                if (lane < 8) { unsigned* cm = (unsigned*)(F.ctl + CW_CMAX) + 32 * nb + 4 * lane;
#pragma unroll
                    for (int j = 0; j < 4; ++j) asm volatile("global_atomic_umax %0, %1, off" :: "v"(cm + j), "v"(__float_as_uint(mx[j])) : "memory"); }
            }
        };
        f32x4 wa[8], wb[8];
        cm_load(gw, wa);
        for (int it = gw; it < NIT; it += 2 * NGW) { cm_step(it, wa, wb); cm_step(it + NGW, wb, wa); }
        asm volatile("s_waitcnt vmcnt(0) ; hidden atomics" ::: "memory");
    }
    { const size_t n16 = (size_t)(NPAD - IN_COLS) * D / 16; v4u* p = (v4u*)(F.WI8 + (size_t)IN_COLS * D);
      for (size_t i = (size_t)F.vcu * NTHR + F.tid; i < n16; i += (size_t)F.G * NTHR) p[i] = (v4u){0u, 0u, 0u, 0u}; }
}
__device__ __forceinline__ int expert_queue_items(int G) { const int tot = NE * (TI_E1 + TI_E2), p3 = (4 + SEQ / 64) * G * NWAVES / 2; return tot > p3 ? tot - p3 : 0; }
struct HItem { const float* src; unsigned char* dst; int N, Kb, map, row0; float scale; };
__device__ __forceinline__ HItem hitem_decode(Frame& F, int hi) {
    const int fi = hi >> 1, sub = hi & 1; HItem t;
    if (fi < NE * TI_E1) { const int e = fi / TI_E1, item = fi % TI_E1, kb = item >> 6, nb = item & 63, n0 = 32 * nb + 16 * sub;
        t.N = 2 * FF; t.Kb = D; t.map = 1; t.scale = W1_SCALE; t.src = F.w_e1 + (size_t)e * D * 2 * FF + (size_t)(64 * kb) * t.N + n0;
        const int au = n0 >> 10, r = n0 & 1023; t.row0 = e * 2 * FF + 256 * (r >> 7) + 128 * au + (r & 127); t.dst = (unsigned char*)F.WE1 + 64 * kb; }
    else { const int f2 = fi - NE * TI_E1, e = f2 / TI_E2, item = f2 % TI_E2, kb = item >> 7, nb = item & 127, n0 = 32 * nb + 16 * sub;
        t.N = D; t.Kb = FF; t.map = 0; t.scale = W2_SCALE; t.src = F.w_e2 + (size_t)e * FF * D + (size_t)(64 * kb) * t.N + n0;
        t.row0 = e * D + n0; t.dst = (unsigned char*)F.WE2 + 64 * kb; }
    return t;
}
__device__ __forceinline__ void hitem_load(const HItem& t, int lane, f32x4 (&v)[4]) {
    const float* p = t.src + (size_t)(lane >> 2) * t.N + 4 * (lane & 3);
#pragma unroll
    for (int i = 0; i < 4; ++i) v[i] = *(const f32x4*)(p + (size_t)(16 * i) * t.N);
}
__device__ __forceinline__ void hitem_to_lds(int lane, const f32x4 (&v)[4], LAS float* scr) {
#pragma unroll
    for (int i = 0; i < 4; ++i) { LAS float* s = scr + (16 * i + (lane >> 2)) * 17 + 4 * (lane & 3); s[0] = v[i][0]; s[1] = v[i][1]; s[2] = v[i][2]; s[3] = v[i][3]; }
}
__device__ __forceinline__ void hitem_store(const HItem& t, int lane, LAS float* scr) {
    LDS_WAIT(); asm volatile("" ::: "memory");
    const int n = lane & 15, kc = lane >> 4; const LAS float* s = scr + (16 * kc) * 17 + n; const float sc = t.scale;
    v4u o;
    o.x = pk4_fp8(s[0 * 17] * sc, s[1 * 17] * sc, s[2 * 17] * sc, s[3 * 17] * sc); o.y = pk4_fp8(s[4 * 17] * sc, s[5 * 17] * sc, s[6 * 17] * sc, s[7 * 17] * sc);
    o.z = pk4_fp8(s[8 * 17] * sc, s[9 * 17] * sc, s[10 * 17] * sc, s[11 * 17] * sc); o.w = pk4_fp8(s[12 * 17] * sc, s[13 * 17] * sc, s[14 * 17] * sc, s[15 * 17] * sc);
    *(v4u*)(t.dst + (size_t)(t.row0 + n) * t.Kb + 16 * kc) = o;
    LDS_WAIT(); asm volatile("" ::: "memory");
}
__device__ __forceinline__ void gstore8_hidden(void* p, v2u v) { asm volatile("global_store_dwordx2 %0, %1, off" :: "v"(p), "v"(v) : "memory"); }
__device__ __forceinline__ void gstore16_hidden(void* p, v4u v) { asm volatile("global_store_dwordx4 %0, %1, off" :: "v"(p), "v"(v) : "memory"); }
__device__ __forceinline__ void hitem_store_hidden(const HItem& t, int lane, LAS float* scr) {
    LDS_WAIT(); asm volatile("" ::: "memory");
    const int n = lane & 15, kc = lane >> 4; const LAS float* s = scr + (16 * kc) * 17 + n; const float sc = t.scale;
    v4u o;
    o.x = pk4_fp8(s[0 * 17] * sc, s[1 * 17] * sc, s[2 * 17] * sc, s[3 * 17] * sc); o.y = pk4_fp8(s[4 * 17] * sc, s[5 * 17] * sc, s[6 * 17] * sc, s[7 * 17] * sc);
    o.z = pk4_fp8(s[8 * 17] * sc, s[9 * 17] * sc, s[10 * 17] * sc, s[11 * 17] * sc); o.w = pk4_fp8(s[12 * 17] * sc, s[13 * 17] * sc, s[14 * 17] * sc, s[15 * 17] * sc);
    gstore16_hidden(t.dst + (size_t)(t.row0 + n) * t.Kb + 16 * kc, o);
    LDS_WAIT(); asm volatile("" ::: "memory");
}
__device__ __forceinline__ void hitem_read(int lane, const LAS float* scr, float (&hr)[16]) {
    const int n = lane & 15, kc = lane >> 4; const LAS float* s = scr + (16 * kc) * 17 + n;
#pragma unroll
    for (int j = 0; j < 16; ++j) hr[j] = s[j * 17];
}
__device__ __forceinline__ void hitem_pack_store(const HItem& t, int lane, const float (&hr)[16]) {
    const int n = lane & 15, kc = lane >> 4; const float sc = t.scale;
    v4u o;
    o.x = pk4_fp8(hr[0] * sc, hr[1] * sc, hr[2] * sc, hr[3] * sc); o.y = pk4_fp8(hr[4] * sc, hr[5] * sc, hr[6] * sc, hr[7] * sc);
    o.z = pk4_fp8(hr[8] * sc, hr[9] * sc, hr[10] * sc, hr[11] * sc); o.w = pk4_fp8(hr[12] * sc, hr[13] * sc, hr[14] * sc, hr[15] * sc);
    gstore16_hidden(t.dst + (size_t)(t.row0 + n) * t.Kb + 16 * kc, o);
}
constexpr int TQ_BATCH = 16;
static_assert((NE * TI_E1) % TQ_BATCH == 0 && (NE * TI_E2) % TQ_BATCH == 0, "queue batches stay inside one kind");
__device__ __forceinline__ void expert_transpose_queue(Frame& F) {
    LAS float* scr = (LAS float*)(F.lds + F.wave * 8704);
    for (;;) {
        int base = 0;
        if (F.lane == 0) base = (int)__hip_atomic_fetch_add((unsigned*)(F.ctl + CW_TQ), (unsigned)TQ_BATCH, RLX_AGENT);
        base = __builtin_amdgcn_readfirstlane(base);
        if (base >= expert_queue_items(F.G)) break;
        if (base < NE * TI_E1) transpose_range<2>(F, scr, base, base + TQ_BATCH, 1);
        else transpose_range<3>(F, scr, base - NE * TI_E1, base - NE * TI_E1 + TQ_BATCH, 1);
    }
}

__device__ __forceinline__ void p1_quant_weights(Frame& F) {
    __syncthreads();
    LAS float* scr = (LAS float*)(F.lds + F.wave * 8704);
    const int gw = F.vcu * NWAVES + F.wave, NGW = F.G * NWAVES;
    transpose_range<8>(F, scr, gw, (D / 64) * (IN_COLS / 32), NGW);
    for (int n = F.vcu * NTHR + F.tid; n < IN_COLS; n += F.G * NTHR) F.SB[win_row(n)] = __uint_as_float(((const unsigned*)(F.ctl + CW_CMAX))[n]) * (1.f / 127.f);
}
__device__ __forceinline__ void p1_quant_wout(Frame& F) {
    const int gw = F.vcu * NWAVES + F.wave, NGW = F.G * NWAVES, lane = F.lane;
    for (int n = gw; n < D; n += NGW) {
        const unsigned cmb = ((const unsigned*)(F.ctl + CW_CMAX2))[n]; const float cm = __uint_as_float(cmb), iv = cm > 0.f ? 127.f / cm : 0.f;
        const bf16* src = F.WOUT + (size_t)n * D; unsigned char* dst = F.WOA8 + (size_t)n * (D / 2);
        v4u v[4];
#pragma unroll
        for (int j = 0; j < 4; ++j) v[j] = *(const v4u*)(src + 512 * j + 8 * lane);
#pragma unroll
        for (int j = 0; j < 4; ++j) *(v2u*)(dst + 512 * j + 8 * lane) = (v2u){pk4_i8(bf_lo(v[j].x) * iv, bf_hi(v[j].x) * iv, bf_lo(v[j].y) * iv, bf_hi(v[j].y) * iv), pk4_i8(bf_lo(v[j].z) * iv, bf_hi(v[j].z) * iv, bf_lo(v[j].w) * iv, bf_hi(v[j].w) * iv)};
        if (lane == 0) F.SB2[n] = cm * (1.f / 127.f);
    }
}
__device__ __forceinline__ void p1_norm(Frame& F) {
    LAS float* fac = (LAS float*)F.lds; LAS float* sh = fac + D;
    const int gw = F.vcu * NWAVES + F.wave, NGW = F.G * NWAVES;
    for (int bb = 0; bb < 5; ++bb) {
        __syncthreads();
        for (int i = F.tid; i < D; i += NTHR) { fac[i] = F.norm1[i] * (1.f + F.ADA[bb * ADA_N + D + i]); sh[i] = F.ADA[bb * ADA_N + i]; }
        __syncthreads();
        const int nrows = bb < 4 ? SEQ : TC; const float* src = bb < 4 ? F.x + (size_t)bb * SEQ * D : F.ctx; const int drow0 = bb < 4 ? bb * SEQ : T;
        for (int r = gw; r < nrows; r += 2 * NGW) {
            int lane = F.lane; asm volatile("" : "+v"(lane));
            const int r2 = r + NGW; const bool has2 = r2 < nrows; const int r2c = has2 ? r2 : r;
            const f32x4* xa = (const f32x4*)(src + (size_t)r * D) + lane; const f32x4* xb = (const f32x4*)(src + (size_t)r2c * D) + lane;
            f32x4 va[16], vb[16]; float sa = 0.f, sb = 0.f;
#pragma unroll
            for (int j = 0; j < 16; ++j) { va[j] = xa[64 * j]; vb[j] = xb[64 * j]; }
#pragma unroll
            for (int j = 0; j < 16; ++j) { sa = fmaf(va[j][0], va[j][0], fmaf(va[j][1], va[j][1], fmaf(va[j][2], va[j][2], fmaf(va[j][3], va[j][3], sa))));
                                           sb = fmaf(vb[j][0], vb[j][0], fmaf(vb[j][1], vb[j][1], fmaf(vb[j][2], vb[j][2], fmaf(vb[j][3], vb[j][3], sb)))); }
            const float ra = rsqrtf(wave_sum(sa) * (1.f / D) + EPS), rb = rsqrtf(wave_sum(sb) * (1.f / D) + EPS);
#pragma unroll
            for (int j = 0; j < 16; ++j) { const f32x4 fa = *(const LAS f32x4*)(fac + 256 * j + 4 * lane), sv = *(const LAS f32x4*)(sh + 256 * j + 4 * lane);
                va[j] = va[j] * ra * fa + sv; vb[j] = vb[j] * rb * fa + sv; }
            {
                float ma = 0.f, mb = 0.f;
#pragma unroll
                for (int j = 0; j < 16; ++j) { ma = fmaxf(ma, fmaxf(fmaxf(fabsf(va[j][0]), fabsf(va[j][1])), fmaxf(fabsf(va[j][2]), fabsf(va[j][3])))); mb = fmaxf(mb, fmaxf(fmaxf(fabsf(vb[j][0]), fabsf(vb[j][1])), fmaxf(fabsf(vb[j][2]), fabsf(vb[j][3])))); }
                ma = wave_max(ma); mb = wave_max(mb);
                const float ia = ma > 0.f ? 127.f / ma : 0.f, ib = mb > 0.f ? 127.f / mb : 0.f;
                if (lane == 0) { F.SA[drow0 + r] = ma * (1.f / 127.f); if (has2) F.SA[drow0 + r2c] = mb * (1.f / 127.f); }
#pragma unroll
                for (int j = 0; j < 16; ++j) { ((unsigned*)(F.XM8 + (size_t)(drow0 + r) * D) + lane)[64 * j] = pk4_i8(va[j][0] * ia, va[j][1] * ia, va[j][2] * ia, va[j][3] * ia);
                    if (has2) ((unsigned*)(F.XM8 + (size_t)(drow0 + r2c) * D) + lane)[64 * j] = pk4_i8(vb[j][0] * ib, vb[j][1] * ib, vb[j][2] * ib, vb[j][3] * ib); }
            }
        }
    }
}

namespace ml {
constexpr int QP = 272, VP = 160, PP = 144, CP = 272;
constexpr int OFF_Q = 0, OFF_K = OFF_Q + 64 * QP, OFF_V = OFF_K + 64 * QP, OFF_VW = OFF_V + 64 * VP, OFF_P = OFF_VW + 64 * VP, OFF_CB = OFF_P + 64 * PP, CB_BYTES = 80 * CP, LDS_END = OFF_CB + 2 * CB_BYTES;
static_assert(LDS_END <= RING_BYTES, "mlstm LDS");
typedef short s16x4 __attribute__((ext_vector_type(4)));
typedef short bf16x8 __attribute__((ext_vector_type(8)));
__device__ __forceinline__ s16x4 tr(const LAS unsigned char* p) { return __builtin_bit_cast(s16x4, __builtin_amdgcn_ds_read_tr16_b64_v4i16((LAS s16x4*)p)); }
__device__ __forceinline__ bf16x8 trfrag(const LAS unsigned char* p, int pitch) { const s16x4 a = tr(p), b = tr(p + 4 * pitch); return (bf16x8){a[0], a[1], a[2], a[3], b[0], b[1], b[2], b[3]}; }
__device__ __forceinline__ bf16x8 ld16(const LAS unsigned char* p) { return *(const LAS bf16x8*)p; }
__device__ __forceinline__ int row_of(int c, int p, int dir, int b) {
    if (c < 4) { const int i = 64 * c + p; return T + b * CTXL + (dir ? (CTXL - 1 - i) : i); }
    const int i = 64 * (c - 4) + p; return b * SEQ + (dir ? (SEQ - 1 - i) : i);
}
}
#define ML_BAR() do { asm volatile("s_waitcnt lgkmcnt(0)" ::: "memory"); __builtin_amdgcn_s_barrier(); asm volatile("" ::: "memory"); } while (0)
__device__ __forceinline__ void p3_mlstm(Frame& F) {
    using namespace ml;
    LAS unsigned char* lds = F.lds;
    const int tid = F.tid, lane = F.lane, wave = F.wave, li = lane & 15, lg = lane >> 4, lq = (lane & 15) >> 2, lp = lane & 3;
    constexpr float QS = 0.08838834764831845f;
    constexpr int NCH = 4 + SEQ / 64;
    constexpr int SC_A = LDS_END, SC_M = SC_A + 256, SC_B = SC_M + 256;
    constexpr int HSCR_OFF = SC_B + 256;
    static_assert(HSCR_OFF + NWAVES * 4352 <= LDSCTL_OFF, "mlstm LDS");
    for (int unit = F.vcu; unit < NB * NH * 2 * 4; unit += F.G) {
        const int vq = unit & 3, dir = (unit >> 2) & 1, h = (unit >> 3) & 7, b = unit >> 6;
        bf16* HO = dir ? F.HB : F.HF;
        __syncthreads();
        unsigned z0 = 0u; asm volatile("" : "+v"(z0));
        for (int i = tid; i < CB_BYTES / 16; i += NTHR) *(LAS v4u*)(lds + OFF_CB + 16 * i) = (v4u){z0, z0, z0, z0};
        if (tid < 64) { *(LAS v4u*)(lds + OFF_V + tid * VP + 128) = (v4u){0x00003F80u | z0, z0, z0, z0}; *(LAS v4u*)(lds + OFF_V + tid * VP + 144) = (v4u){z0, z0, z0, z0};
                        *(LAS v4u*)(lds + OFF_VW + tid * VP + 128) = (v4u){z0, z0, z0, z0}; *(LAS v4u*)(lds + OFF_VW + tid * VP + 144) = (v4u){z0, z0, z0, z0}; }
        f32x4 Cacc[5];
#pragma unroll
        for (int i = 0; i < 5; ++i) Cacc[i] = (f32x4){0.f, 0.f, 0.f, 0.f};
        v4u rq[2], rk[2], rv; float ig, fp;
        rq[0] = rq[1] = (v4u){0u, 0u, 0u, 0u};
        const GAS bf16* pk_[2]; const GAS bf16* pv_; const GAS float* pg_;
#define ML_SETPTR(cc) do { const int cs_ = (cc); \
        _Pragma("unroll") for (int i = 0; i < 2; ++i) { const int id = tid + NTHR * i, p = id >> 4, ch = id & 15; pk_[i] = (const GAS bf16*)F.PROJ + (size_t)row_of(cs_, p, dir, b) * NPROJ + COL_K + h * DK + 8 * ch; } \
        { const int p = tid >> 3, ch = tid & 7; pv_ = (const GAS bf16*)F.PROJ + (size_t)row_of(cs_, p, dir, b) * NPROJ + COL_V + h * DV + vq * 64 + 8 * ch; } \
        pg_ = (const GAS float*)F.GATES + (size_t)row_of(cs_, lane, dir, b) * 32 + dir * 16 + h; } while (0)
#define ML_PREFETCH(cc) do { const int c_ = (cc); if (c_ == 0 || c_ == 4) ML_SETPTR(c_); \
        _Pragma("unroll") for (int i = 0; i < 2; ++i) { rk[i] = *(const GAS v4u*)pk_[i]; rq[i] = *(const GAS v4u*)(pk_[i] + (COL_Q - COL_K)); pk_[i] += pstep; } \
        rv = *(const GAS v4u*)pv_; pv_ += pstep; ig = pg_[0]; fp = pg_[8]; pg_ += gstep; } while (0)
        const long pstep = (dir ? -64 : 64) * (long)NPROJ, gstep = (dir ? -64 : 64) * 32;
        float bc, g, Ap, Mp, M63, wS, decay, wsv, m = 0.f;
#define ML_SCALARS(m_in) do { const float lf_ = fminf(fp, 0.f) - 0.6931471805599453f * __log2f(1.f + __expf(-fabsf(fp))); \
        bc = wave_incl_sum(lf_); g = lane_bcast(bc, 63); Ap = ig - bc; const float PA_ = wave_incl_max(Ap), Amax_ = lane_bcast(PA_, 63); \
        Mp = fmaxf((m_in), PA_); M63 = fmaxf((m_in), Amax_); wS = __expf(Ap - M63); decay = __expf((m_in) - M63); wsv = __shfl(wS, 8 * wave + (lane >> 3)); } while (0)
#define ML_STAGE() do { \
        _Pragma("unroll") for (int i = 0; i < 2; ++i) { const int id = tid + NTHR * i, p = id >> 4, ch = id & 15; \
            *(LAS v4u*)(lds + OFF_K + p * QP + 16 * ch) = rk[i]; *(LAS v4u*)(lds + OFF_Q + p * QP + 16 * ch) = rq[i]; } \
        { const int p = tid >> 3, ch = tid & 7; \
          *(LAS v4u*)(lds + OFF_V + p * VP + 16 * ch) = rv; \
          v4u o; o.x = pk2(bf_lo(rv.x) * wsv, bf_hi(rv.x) * wsv); o.y = pk2(bf_lo(rv.y) * wsv, bf_hi(rv.y) * wsv); o.z = pk2(bf_lo(rv.z) * wsv, bf_hi(rv.z) * wsv); o.w = pk2(bf_lo(rv.w) * wsv, bf_hi(rv.w) * wsv); \
          *(LAS v4u*)(lds + OFF_VW + p * VP + 16 * ch) = o; } \
        if (wave == 0) { *(LAS unsigned short*)(lds + OFF_VW + lane * VP + 128) = (unsigned short)(pk2(wS, 0.f) & 0xffffu); \
                         *(LAS float*)(lds + SC_A + 4 * lane) = Ap; *(LAS float*)(lds + SC_M + 4 * lane) = Mp; *(LAS float*)(lds + SC_B + 4 * lane) = bc; } } while (0)
        ML_PREFETCH(0);
        const int tt = wave >> 1, trow = 16 * tt + li, vt0 = (wave & 1) ? 2 : 0, dt = wave;
        const int hi0 = 2 * expert_queue_items(F.G) + (unit / F.G) * NCH * (F.G * NWAVES) + F.vcu * NWAVES + wave;
        LAS float* hscr = (LAS float*)(lds + HSCR_OFF + wave * 4352);
        ML_SCALARS(m);
        ML_BAR();
        ML_STAGE();
        constexpr int HLIM = 2 * NE * (TI_E1 + TI_E2);
        f32x4 hvA[4], hvB[4];
        { const int h0 = hi0 < HLIM ? hi0 : HLIM - 1; hitem_load(hitem_decode(F, h0), lane, hvA); }
        auto step = [&](const int c, f32x4 (&hvn)[4], f32x4 (&hvo)[4]) __attribute__((always_inline)) {
            const bool lat = c >= 4;
            ML_BAR();
            const float dec_c = decay, m_c = m, m_next = g + M63;
            ML_PREFETCH(c + 1);
            const int hi = hi0 + c * (F.G * NWAVES);
            const bool hact = hi < HLIM;
            f32x4 oacc[3];
#pragma unroll
            for (int j = 0; j < 3; ++j) oacc[j] = (f32x4){0.f, 0.f, 0.f, 0.f};
            float Mt = 0.f; v2u hout[2] = {(v2u){0u, 0u}, (v2u){0u, 0u}};
            if (lat) {
                bf16x8 Bq[4], Ak[2][4], Cf[3][4];
                const LAS unsigned char* cbo = lds + OFF_CB + (c & 1) * CB_BYTES;
#pragma unroll
                for (int ks = 0; ks < 4; ++ks) Bq[ks] = ld16(lds + OFF_Q + trow * QP + 64 * ks + 16 * lg);
#pragma unroll
                for (int sti = 0; sti < 2; ++sti)
#pragma unroll
                    for (int ks = 0; ks < 4; ++ks) Ak[sti][ks] = ld16(lds + OFF_K + (16 * (2 * (wave & 1) + sti) + li) * QP + 64 * ks + 16 * lg);
                Mt = *(const LAS float*)(lds + SC_M + 4 * trow);
                f32x4 A4[2];
#pragma unroll
                for (int sti = 0; sti < 2; ++sti) A4[sti] = *(const LAS f32x4*)(lds + SC_A + 4 * (16 * (2 * (wave & 1) + sti) + 4 * lg));
#pragma unroll
                for (int j = 0; j < 3; ++j)
#pragma unroll
                    for (int ks = 0; ks < 4; ++ks) Cf[j][ks] = ld16(cbo + (16 * (j < 2 ? vt0 + j : 4) + li) * CP + 64 * ks + 16 * lg);
                f32x4 sacc[2];
#pragma unroll
                for (int sti = 0; sti < 2; ++sti) { sacc[sti] = (f32x4){0.f, 0.f, 0.f, 0.f};
#pragma unroll
                    for (int ks = 0; ks < 4; ++ks) sacc[sti] = __builtin_amdgcn_mfma_f32_16x16x32_bf16(Ak[sti][ks], Bq[ks], sacc[sti], 0, 0, 0); }
#pragma unroll
                for (int ks = 0; ks < 4; ++ks)
#pragma unroll
                    for (int j = 0; j < 3; ++j) oacc[j] = __builtin_amdgcn_mfma_f32_16x16x32_bf16(Cf[j][ks], Bq[ks], oacc[j], 0, 0, 0);
#pragma unroll
                for (int sti = 0; sti < 2; ++sti) { const int st = 2 * (wave & 1) + sti; float v[4];
#pragma unroll
                    for (int r = 0; r < 4; ++r) { const int sp = 16 * st + 4 * lg + r; v[r] = sp <= trow ? sacc[sti][r] * QS * __expf(A4[sti][r] - Mt) : 0.f; }
                    *(LAS v2u*)(lds + OFF_P + trow * PP + 2 * (16 * st + 4 * lg)) = (v2u){pk2(v[0], v[1]), pk2(v[2], v[3])}; }
                const float e2 = __expf(m_c - Mt) * QS;
#pragma unroll
                for (int j = 0; j < 3; ++j) oacc[j] = oacc[j] * e2;
            }
            {
                bf16x8 At[2], Bt[5][2];
#pragma unroll
                for (int ks = 0; ks < 2; ++ks) At[ks] = trfrag(lds + OFF_K + (32 * ks + 8 * lg + lq) * QP + 32 * dt + 8 * lp, QP);
#pragma unroll
                for (int vt = 0; vt < 5; ++vt)
#pragma unroll
                    for (int ks = 0; ks < 2; ++ks) Bt[vt][ks] = trfrag(lds + OFF_VW + (32 * ks + 8 * lg + lq) * VP + 32 * vt + 8 * lp, VP);
#pragma unroll
                for (int vt = 0; vt < 5; ++vt) Cacc[vt] = Cacc[vt] * dec_c;
#pragma unroll
                for (int ks = 0; ks < 2; ++ks)
#pragma unroll
                    for (int vt = 0; vt < 5; ++vt) Cacc[vt] = __builtin_amdgcn_mfma_f32_16x16x32_bf16(At[ks], Bt[vt][ks], Cacc[vt], 0, 0, 0);
                LAS unsigned char* cbn = lds + OFF_CB + ((c + 1) & 1) * CB_BYTES;
#pragma unroll
                for (int vt = 0; vt < 5; ++vt) *(LAS v2u*)(cbn + (16 * vt + li) * CP + 2 * (16 * dt + 4 * lg)) = (v2u){pk2(Cacc[vt][0], Cacc[vt][1]), pk2(Cacc[vt][2], Cacc[vt][3])};
            }
            if (hact) hitem_to_lds(lane, hvo, hscr);
            { const int hn = hi + F.G * NWAVES; hitem_load(hitem_decode(F, hn < HLIM ? hn : HLIM - 1), lane, hvn); }
            ML_BAR();
            if (lat) {
                bf16x8 Pf[2], Vt[3][2];
#pragma unroll
                for (int ks = 0; ks < 2; ++ks) Pf[ks] = ld16(lds + OFF_P + trow * PP + 64 * ks + 16 * lg);
#pragma unroll
                for (int j = 0; j < 3; ++j)
#pragma unroll
                    for (int ks = 0; ks < 2; ++ks) Vt[j][ks] = trfrag(lds + OFF_V + (32 * ks + 8 * lg + lq) * VP + 32 * (j < 2 ? vt0 + j : 4) + 8 * lp, VP);
                const float bct = *(const LAS float*)(lds + SC_B + 4 * trow);
#pragma unroll
                for (int ks = 0; ks < 2; ++ks)
#pragma unroll
                    for (int j = 0; j < 3; ++j) oacc[j] = __builtin_amdgcn_mfma_f32_16x16x32_bf16(Vt[j][ks], Pf[ks], oacc[j], 0, 0, 0);
                const float den = __shfl(oacc[2][0], li);
                const float inv = 1.f / fmaxf(fabsf(den), __expf(-(bct + Mt)));
#pragma unroll
                for (int j = 0; j < 2; ++j) { const f32x4 o = oacc[j] * inv; hout[j] = (v2u){pk2(o[0], o[1]), pk2(o[2], o[3])}; }
            }
            float hr[16];
            if (hact) hitem_read(lane, hscr, hr);
            m = m_next;
            if (c + 1 < NCH) ML_SCALARS(m);
            asm volatile("; chunk c+1 pieces are used here so that the wait for them sits in front of this step's stores" : "+v"(rk[0]), "+v"(rk[1]), "+v"(rq[0]), "+v"(rq[1]), "+v"(rv) :: "memory");
            if (lat) { bf16* hp = HO + (size_t)row_of(c, trow, dir, b) * 2048 + h * DV + vq * 64 + 4 * lg;
#pragma unroll
                for (int j = 0; j < 2; ++j) gstore8_hidden(hp + 16 * (vt0 + j), hout[j]); }
            if (hact) hitem_pack_store(hitem_decode(F, hi), lane, hr);
            ML_BAR();
            if (c + 1 < NCH) ML_STAGE();
        };
        static_assert(NCH % 2 == 0, "two steps per trip");
        for (int c = 0; c < NCH; c += 2) { step(c, hvB, hvA); step(c + 1, hvA, hvB); }
        asm volatile("s_waitcnt vmcnt(0) ; the hidden stores of the loop" ::: "memory");
#undef ML_PREFETCH
#undef ML_SETPTR
#undef ML_SCALARS
#undef ML_STAGE
    }
}

__device__ __forceinline__ void p4_mix(Frame& F) {
    const int gw = F.vcu * NWAVES + F.wave, NGW = F.G * NWAVES;
    LAS float* cwl = (LAS float*)F.lds; LAS float* hnl = cwl + 3 * 2048;
    __syncthreads();
    for (int i = F.tid; i < 3 * 2048 / 4; i += NTHR) *(LAS f32x4*)(cwl + 4 * i) = *(const f32x4*)(F.conv_w + 4 * i);
    for (int i = F.tid; i < 2048 / 4; i += NTHR) *(LAS f32x4*)(hnl + 4 * i) = *(const f32x4*)(F.head_norm + 4 * i);
    __syncthreads();
    for (int r = gw; r < T; r += NGW) {
        int lane = F.lane; asm volatile("" : "+v"(lane));
        const int s = r & (SEQ - 1), gr = s >> 6, gc = s & 63;
        const bf16* pr = F.PROJ + (size_t)r * NPROJ;
        bf16* mr = F.MIX + (size_t)r * D;
        {
            v2u ha[NH], hb[NH]; unsigned og[NH];
#pragma unroll
            for (int hh = 0; hh < NH; ++hh) { const int idx = hh * DV + 4 * lane;
                ha[hh] = *(const v2u*)(F.HF + (size_t)r * 2048 + idx); hb[hh] = *(const v2u*)(F.HB + (size_t)r * 2048 + idx); og[hh] = *(const unsigned*)((const unsigned char*)(pr + COL_O) + idx); }
            f32x4 hs[NH]; float ss[NH];
#pragma unroll
            for (int hh = 0; hh < NH; ++hh) { hs[hh] = (f32x4){bf_lo(ha[hh].x) + bf_lo(hb[hh].x), bf_hi(ha[hh].x) + bf_hi(hb[hh].x), bf_lo(ha[hh].y) + bf_lo(hb[hh].y), bf_hi(ha[hh].y) + bf_hi(hb[hh].y)};
                ss[hh] = (hs[hh][0] * hs[hh][0] + hs[hh][1] * hs[hh][1]) + (hs[hh][2] * hs[hh][2] + hs[hh][3] * hs[hh][3]); }
#pragma unroll
            for (int hh = 0; hh < NH; ++hh) ss[hh] = wave_sum(ss[hh]);
            float ym = 0.f;
#pragma unroll
            for (int hh = 0; hh < NH; ++hh) { const float rs = rsqrtf(ss[hh] * (1.f / DV) + EPS); const f32x4 hw = *(const LAS f32x4*)(hnl + hh * DV + 4 * lane);
                const float rq = rs * (1.f / 255.f);
                hs[hh][0] = hs[hh][0] * rq * hw[0] * (float)(og[hh] & 255u); hs[hh][1] = hs[hh][1] * rq * hw[1] * (float)((og[hh] >> 8) & 255u);
                hs[hh][2] = hs[hh][2] * rq * hw[2] * (float)((og[hh] >> 16) & 255u); hs[hh][3] = hs[hh][3] * rq * hw[3] * (float)(og[hh] >> 24);
                ym = fmaxf(ym, fmaxf(fmaxf(fabsf(hs[hh][0]), fabsf(hs[hh][1])), fmaxf(fabsf(hs[hh][2]), fabsf(hs[hh][3])))); }
            ym = wave_max(ym);
            const float iy = ym > 0.f ? 127.f / ym : 0.f;
            if (lane == 0) F.SA[r] = ym * (1.f / 127.f);
#pragma unroll
            for (int hh = 0; hh < NH; ++hh) *(unsigned*)(F.MIXA8 + (size_t)r * (D / 2) + hh * DV + 4 * lane) = pk4_i8(hs[hh][0] * iy, hs[hh][1] * iy, hs[hh][2] * iy, hs[hh][3] * iy);
        }
#pragma unroll
        for (int jb = 0; jb < 2; ++jb) {
            const int dt = jb == 0 ? 1 : 64;
            const bool vm = jb == 0 ? (gc > 0) : (gr > 0), vp = jb == 0 ? (gc < 63) : (gr < 63);
            const bf16* pm = vm ? pr - (size_t)dt * NPROJ : pr; const bf16* pp = vp ? pr + (size_t)dt * NPROJ : pr;
            const float fm = vm ? 1.f : 0.f, fp = vp ? 1.f : 0.f;
            v4u cu0[2], cb0[2], cum[2], cup[2];
#pragma unroll
            for (int q = 0; q < 2; ++q) { const int cch = 512 * (2 * jb + q) + 8 * lane;
                cu0[q] = *(const v4u*)(pr + COL_CC + cch); cb0[q] = *(const v4u*)(pr + COL_CB + cch);
                cum[q] = *(const v4u*)(pm + COL_CC + cch); cup[q] = *(const v4u*)(pp + COL_CC + cch); }
#pragma unroll
            for (int q = 0; q < 2; ++q) { const int cch = 512 * (2 * jb + q) + 8 * lane;
                const unsigned u0w[4] = {cu0[q].x, cu0[q].y, cu0[q].z, cu0[q].w}, umw[4] = {cum[q].x, cum[q].y, cum[q].z, cum[q].w}, upw[4] = {cup[q].x, cup[q].y, cup[q].z, cup[q].w}, cbw[4] = {cb0[q].x, cb0[q].y, cb0[q].z, cb0[q].w};
                unsigned o[4];
#pragma unroll
                for (int hq = 0; hq < 2; ++hq) { const f32x4 w0 = *(const LAS f32x4*)(cwl + cch + 4 * hq), w1 = *(const LAS f32x4*)(cwl + 2048 + cch + 4 * hq), w2 = *(const LAS f32x4*)(cwl + 4096 + cch + 4 * hq);
#pragma unroll
                    for (int e2 = 0; e2 < 2; ++e2) { const int wi = 2 * hq + e2;
                        const float ya = bf_lo(cbw[wi]) * (w0[2 * e2] * (bf_lo(umw[wi]) * fm) + w1[2 * e2] * bf_lo(u0w[wi]) + w2[2 * e2] * (bf_lo(upw[wi]) * fp));
                        const float yb = bf_hi(cbw[wi]) * (w0[2 * e2 + 1] * (bf_hi(umw[wi]) * fm) + w1[2 * e2 + 1] * bf_hi(u0w[wi]) + w2[2 * e2 + 1] * (bf_hi(upw[wi]) * fp));
                        o[wi] = pk2(ya, yb); } }
                *(v4u*)(mr + 2048 + cch) = (v4u){o[0], o[1], o[2], o[3]}; }
        }
    }
}

__device__ __forceinline__ float p6_row_pass1(Frame& F, int row0, bool act, const LAS float* fac, const LAS float* sh) {
    const int lane = F.lane;
    const v2u* da = (const v2u*)(F.X1B + (size_t)row0 * D) + lane;
    float sa = 0.f;
    v2u dd[16];
#pragma unroll
    for (int j = 0; j < 16; ++j) dd[j] = da[64 * j];
#pragma unroll
    for (int j = 0; j < 16; ++j) { const float a0 = bf_lo(dd[j].x), a1 = bf_hi(dd[j].x), a2 = bf_lo(dd[j].y), a3 = bf_hi(dd[j].y); sa = fmaf(a0, a0, fmaf(a1, a1, fmaf(a2, a2, fmaf(a3, a3, sa)))); }
    const float rsa = rsqrtf(wave_sum(sa) * (1.f / D) + EPS);
    unsigned* oa = (unsigned*)((unsigned char*)F.XF + (size_t)row0 * D) + lane;
#pragma unroll
    for (int j = 0; j < 16; ++j) { const f32x4 fa = *(const LAS f32x4*)(fac + 256 * j + 4 * lane), sv = *(const LAS f32x4*)(sh + 256 * j + 4 * lane);
        const f32x4 xn = (f32x4){bf_lo(dd[j].x), bf_hi(dd[j].x), bf_lo(dd[j].y), bf_hi(dd[j].y)} * rsa * fa + sv;
        if (act) oa[64 * j] = pk4_fp8(xn[0], xn[1], xn[2], xn[3]); }
    return rsa;
}
__device__ __forceinline__ void p6_xquarter(Frame& F, int row, float rs, int j0, int nj, const LAS float* fac, const LAS float* sh, f32x4 (&xo)[4]) {
    const int lane = F.lane;
    const v2u* d0 = (const v2u*)(F.X1B + (size_t)row * D) + lane;
    v2u q0[4];
#pragma unroll
    for (int jj = 0; jj < 4; ++jj) if (jj < nj) q0[jj] = d0[64 * (j0 + jj)];
#pragma unroll
    for (int jj = 0; jj < 4; ++jj) if (jj < nj) { const int j = j0 + jj; const f32x4 fa = *(const LAS f32x4*)(fac + 256 * j + 4 * lane), sv = *(const LAS f32x4*)(sh + 256 * j + 4 * lane);
        xo[jj] = (f32x4){bf_lo(q0[jj].x), bf_hi(q0[jj].x), bf_lo(q0[jj].y), bf_hi(q0[jj].y)} * rs * fa + sv; }
}
__device__ __forceinline__ void p6_pick_group(Frame& F, const float (&g)[4], int& gs, float& psel) {
    float gl[4];
#pragma unroll
    for (int o = 0; o < 4; ++o) gl[o] = g[o] + F.b_rg[o];
    gs = 0; float gm = gl[0];
#pragma unroll
    for (int o = 1; o < 4; ++o) if (gl[o] > gm) { gm = gl[o]; gs = o; }
    float den = 0.f;
#pragma unroll
    for (int o = 0; o < 4; ++o) den += expf(gl[o] - gm);
    psel = 1.f / den;
}
__device__ __forceinline__ void p6_pick_experts(Frame& F, const float (&ed)[4], int gs, float psel, bool act, LAS int* ri) {
    float ev[4];
#pragma unroll
    for (int o = 0; o < 4; ++o) ev[o] = ed[o] + F.b_re[gs * 4 + o];
    int i0 = 0; float v0 = ev[0];
#pragma unroll
    for (int o = 1; o < 4; ++o) if (ev[o] > v0) { v0 = ev[o]; i0 = o; }
    int i1 = -1; float v1 = -3.0e38f;
#pragma unroll
    for (int o = 0; o < 4; ++o) if (o != i0 && ev[o] > v1) { v1 = ev[o]; i1 = o; }
    const float e1x = expf(v1 - v0); const float w0 = psel / (1.f + e1x), w1 = psel * e1x / (1.f + e1x);
    if (F.lane == 0) { ri[0] = act ? gs * 4 + i0 : -1; ri[1] = act ? gs * 4 + i1 : -1; ri[2] = __float_as_int(w0); ri[3] = __float_as_int(w1); }
}
__device__ __forceinline__ void p6_norm_router(Frame& F) {
    constexpr int R = 8;
    LAS float* fac = (LAS float*)F.lds; LAS float* sh = fac + D;
    LAS float* wg = (LAS float*)(F.lds + 32768);
    LAS float* we = (LAS float*)(F.lds + 98304);
    LAS int* rinfo = (LAS int*)(F.lds + 131072);
    const int wave = F.wave, lane = F.lane;
    const int nblk = T / (8 * R), per = (nblk + F.G - 1) / F.G;
    __syncthreads();
    for (int c = F.tid; c < D; c += NTHR) { const f32x4 g4 = *(const f32x4*)(F.w_rg + (size_t)c * 4); wg[c] = g4[0]; wg[D + c] = g4[1]; wg[2 * D + c] = g4[2]; wg[3 * D + c] = g4[3]; }
    int curb = -1;
    for (int it = 0; it < per; ++it) {
        const int rb = F.vcu * per + it;
        const bool act = rb < nblk;
        const int rowb = (act ? rb : 0) * (8 * R) + wave;
        const int b = rowb >> 12;
        if (b != curb) {
            __syncthreads();
            for (int i = F.tid; i < D; i += NTHR) { fac[i] = F.norm2[i] * (1.f + F.ADA[b * ADA_N + 4 * D + i]); sh[i] = F.ADA[b * ADA_N + 3 * D + i]; }
            curb = b;
        }
        __syncthreads();
        float rs[R];
#pragma unroll
        for (int k = 0; k < R; ++k) rs[k] = p6_row_pass1(F, rowb + 8 * k, act, fac, sh);
        float gd[R][4];
#pragma unroll
        for (int k = 0; k < R; ++k)
#pragma unroll
            for (int o = 0; o < 4; ++o) gd[k][o] = 0.f;
#pragma unroll
        for (int kh = 0; kh < R; kh += 4) {
#pragma unroll 1
            for (int q = 0; q < 4; ++q) { f32x4 xv[4][4];
#pragma unroll
                for (int k = 0; k < 4; ++k) p6_xquarter(F, rowb + 8 * (kh + k), rs[kh + k], 4 * q, 4, fac, sh, xv[k]);
#pragma unroll
                for (int o = 0; o < 4; ++o)
#pragma unroll
                    for (int jj = 0; jj < 4; ++jj) { const f32x4 w4 = *(const LAS f32x4*)(wg + o * D + 256 * (4 * q + jj) + 4 * lane);
#pragma unroll
                        for (int k = 0; k < 4; ++k) { const f32x4 a4 = xv[k][jj]; gd[kh + k][o] = fmaf(a4[3], w4[3], fmaf(a4[2], w4[2], fmaf(a4[1], w4[1], fmaf(a4[0], w4[0], gd[kh + k][o])))); } } } }
        int gs[R]; float ps[R];
#pragma unroll
        for (int k = 0; k < R; ++k) {
#pragma unroll
            for (int o = 0; o < 4; ++o) gd[k][o] = wave_sum(gd[k][o]);
            p6_pick_group(F, gd[k], gs[k], ps[k]); gs[k] = __builtin_amdgcn_readfirstlane(gs[k]); }
        float ed[R][4];
#pragma unroll
        for (int k = 0; k < R; ++k)
#pragma unroll
            for (int o = 0; o < 4; ++o) ed[k][o] = 0.f;
#pragma unroll 1
        for (int ch = 0; ch < 8; ++ch) {
            __syncthreads();
            { const int c = 512 * ch + F.tid;
#pragma unroll
              for (int p = 0; p < 4; ++p) { const f32x4 e4 = *(const f32x4*)(F.w_re + (size_t)c * 16 + 4 * p);
                  we[(4 * p + 0) * 512 + F.tid] = e4[0]; we[(4 * p + 1) * 512 + F.tid] = e4[1]; we[(4 * p + 2) * 512 + F.tid] = e4[2]; we[(4 * p + 3) * 512 + F.tid] = e4[3]; } }
            f32x4 xv[4][4];
#pragma unroll
            for (int k = 0; k < 4; ++k) p6_xquarter(F, rowb + 8 * k, rs[k], 2 * ch, 2, fac, sh, xv[k]);
            __syncthreads();
#pragma unroll
            for (int kh = 0; kh < R; kh += 4) {
                if (kh > 0) {
#pragma unroll
                    for (int k = 0; k < 4; ++k) p6_xquarter(F, rowb + 8 * (kh + k), rs[kh + k], 2 * ch, 2, fac, sh, xv[k]); }
#pragma unroll
                for (int k = 0; k < 4; ++k)
#pragma unroll
                    for (int o = 0; o < 4; ++o)
#pragma unroll
                        for (int jl = 0; jl < 2; ++jl) { const f32x4 w4 = *(const LAS f32x4*)(we + (gs[kh + k] * 4 + o) * 512 + 256 * jl + 4 * lane); const f32x4 a4 = xv[k][jl];
                            ed[kh + k][o] = fmaf(a4[3], w4[3], fmaf(a4[2], w4[2], fmaf(a4[1], w4[1], fmaf(a4[0], w4[0], ed[kh + k][o])))); }
            }
        }
#pragma unroll
        for (int k = 0; k < R; ++k) {
#pragma unroll
            for (int o = 0; o < 4; ++o) ed[k][o] = wave_sum(ed[k][o]);
            p6_pick_experts(F, ed[k], gs[k], ps[k], act, rinfo + (8 * k + wave) * 4); }
        __syncthreads();
        if (F.tid < NE && act) {
            int e = F.tid; asm volatile("" : "+v"(e)); int n = 0;
            for (int q = 0; q < 16 * R; ++q) n += (rinfo[(q >> 1) * 4 + (q & 1)] == e) ? 1 : 0;
            if (n > 0) {
                int base = (int)__hip_atomic_fetch_add((unsigned*)(F.ctl + CW_CNT + 64 * e), (unsigned)n, RLX_AGENT);
                for (int q = 0; q < 16 * R; ++q) if (rinfo[(q >> 1) * 4 + (q & 1)] == e) {
                    const int tok = rb * (8 * R) + (q >> 1);
                    F.ELIST[e * T + base] = tok * 2 + (q & 1); F.EW[e * T + base] = __int_as_float(rinfo[(q >> 1) * 4 + 2 + (q & 1)]); ++base; }
            }
        }
        __syncthreads();
    }
}

__device__ __forceinline__ void p9_final(Frame& F) {
    LAS float* fnl = (LAS float*)F.lds; LAS float* g2l = fnl + D;
    __syncthreads();
    for (int i = F.tid; i < D / 4; i += NTHR) { *(LAS f32x4*)(fnl + 4 * i) = *(const f32x4*)(F.fnorm + 4 * i);
#pragma unroll
        for (int b = 0; b < NB; ++b) *(LAS f32x4*)(g2l + b * D + 4 * i) = *(const f32x4*)(F.ADA + b * ADA_N + 5 * D + 4 * i) * (1.f / SLOT_SCALE); }
    __syncthreads();
    const int gw = F.vcu * NWAVES + F.wave, NGW = F.G * NWAVES;
    for (int r = gw; r < T; r += NGW) {
        int lane = F.lane; asm volatile("" : "+v"(lane));
        const int b = r >> 12;
        const v4u* xr = (const v4u*)(F.X1B + (size_t)r * D) + lane;
        const v2u* s0 = (const v2u*)((const unsigned char*)F.SLOT + (size_t)r * D) + lane; const v2u* s1 = (const v2u*)((const unsigned char*)F.SLOT + (size_t)(T + r) * D) + lane;
        v4u xx[8]; v2u a0[8], a1[8];
#pragma unroll
        for (int j = 0; j < 8; ++j) { xx[j] = xr[64 * j]; a0[j] = s0[64 * j]; a1[j] = s1[64 * j]; }
        f32x4 v[16]; float s = 0.f;
#pragma unroll
        for (int j = 0; j < 8; ++j) {
            const f32x4 g0 = *(const LAS f32x4*)(g2l + b * D + 512 * j + 8 * lane), g1 = *(const LAS f32x4*)(g2l + b * D + 512 * j + 8 * lane + 4);
            const f32x4 x0 = (f32x4){bf_lo(xx[j].x), bf_hi(xx[j].x), bf_lo(xx[j].y), bf_hi(xx[j].y)}, x1 = (f32x4){bf_lo(xx[j].z), bf_hi(xx[j].z), bf_lo(xx[j].w), bf_hi(xx[j].w)};
            v[2 * j] = x0 + g0 * (fp8x4_to_f32(a0[j].x) + fp8x4_to_f32(a1[j].x)); v[2 * j + 1] = x1 + g1 * (fp8x4_to_f32(a0[j].y) + fp8x4_to_f32(a1[j].y));
            s = fmaf(v[2 * j][0], v[2 * j][0], fmaf(v[2 * j][1], v[2 * j][1], fmaf(v[2 * j][2], v[2 * j][2], fmaf(v[2 * j][3], v[2 * j][3], s))));
            s = fmaf(v[2 * j + 1][0], v[2 * j + 1][0], fmaf(v[2 * j + 1][1], v[2 * j + 1][1], fmaf(v[2 * j + 1][2], v[2 * j + 1][2], fmaf(v[2 * j + 1][3], v[2 * j + 1][3], s)))); }
        const float rstd = rsqrtf(wave_sum(s) * (1.f / D) + EPS);
        float* o = F.out + (size_t)r * D + 8 * lane;
#pragma unroll
        for (int j = 0; j < 8; ++j) { *(f32x4*)(o + 512 * j) = v[2 * j] * rstd * *(const LAS f32x4*)(fnl + 512 * j + 8 * lane); *(f32x4*)(o + 512 * j + 4) = v[2 * j + 1] * rstd * *(const LAS f32x4*)(fnl + 512 * j + 8 * lane + 4);
            if ((j & 1) == 1) asm volatile("" ::: "memory"); }
    }
}

struct SchedProj {
    int G, c;
    __device__ bool next(int i, pg8::Unit& u) const {
        const int L = i * G + c; constexpr int nM = 64, nN = 48, nwg = nM * nN;
        if (L < nwg) {
            int wgid = L; { const int q = nwg / 8, xcd = wgid % 8, off = wgid / 8; wgid = xcd * q + off; }
            const int nig = 8 * nN, gid = wgid / nig, fm = gid * 8;
            u.pm = fm + ((wgid % nig) % 8); u.pn = (wgid % nig) / 8; return true; }
        const int L2 = L - nwg;
        if (L2 < 48) { u.pm = 64 + (L2 & 3); u.pn = 36 + (L2 >> 2); return true; }
        const int L3 = L2 - 48;
        if (L3 < 68) { u.pm = L3; u.pn = 48; return true; }
        return false;
    }
    __device__ __forceinline__ void a_ready(const pg8::Unit&) const {}
    __device__ __forceinline__ void done(const pg8::Unit&) const {}
    __device__ __forceinline__ unsigned row_byteoff(const pg8::Unit&, int) const { return 0u; }
};
struct EpiProj {
    static constexpr bool PERM = true;
    bf16* P; float* Gt; const float* bg;
    __device__ __forceinline__ void operator()(const pg8::f32x4 (&acc)[2][2][4][2], const pg8::Unit& u, int wr, int wc, int fr, int fq) const {
        const int row0 = u.pm * 256 + wr * 64 + fr;
        if (u.pn < 48) {
            const int col0 = u.pn * 256 + wc * 32 + 8 * fq;
#pragma unroll
            for (int ai = 0; ai < 2; ++ai)
#pragma unroll
                for (int m = 0; m < 4; ++m) { bf16* rowp = P + (size_t)(row0 + ai * 128 + m * 16) * NPROJ + col0;
#pragma unroll
                    for (int bj = 0; bj < 2; ++bj) { const pg8::f32x4 v0 = acc[ai][bj][m][0], v1 = acc[ai][bj][m][1];
                        v4u w; w.x = pk2(v0[0], v0[1]); w.y = pk2(v0[2], v0[3]); w.z = pk2(v1[0], v1[1]); w.w = pk2(v1[2], v1[3]);
                        *(v4u*)(rowp + bj * 128) = w; } }
        } else if (wc == 0) {
            const f32x4 b0 = *(const f32x4*)(bg + 8 * fq), b1 = *(const f32x4*)(bg + 8 * fq + 4);
#pragma unroll
            for (int ai = 0; ai < 2; ++ai)
#pragma unroll
                for (int m = 0; m < 4; ++m) { float* gp = Gt + (size_t)(row0 + ai * 128 + m * 16) * 32 + 8 * fq;
                    *(f32x4*)gp = acc[ai][0][m][0] + b0; *(f32x4*)(gp + 4) = acc[ai][0][m][1] + b1; }
        }
    }
};
struct EpiProjI8 {
    static constexpr bool PERM = true;
    bf16* P; const float* sa; const float* sb; float* Gt; const float* bg;
    __device__ __forceinline__ void operator()(const pg8::f32x4 (&acc)[2][2][4][2], const pg8::Unit& u, int wr, int wc, int fr, int fq) const {
        const int row0 = u.pm * 256 + wr * 64 + fr, col0 = u.pn * 256 + wc * 32 + 8 * fq;
        if (u.pn == 48) {
            if (wc == 0) {
                const f32x4 b0 = *(const f32x4*)(bg + 8 * fq), b1 = *(const f32x4*)(bg + 8 * fq + 4), q0 = *(const f32x4*)(sb + NPROJ + 8 * fq), q1 = *(const f32x4*)(sb + NPROJ + 8 * fq + 4);
#pragma unroll
                for (int ai = 0; ai < 2; ++ai)
#pragma unroll
                    for (int m = 0; m < 4; ++m) { const int row = row0 + ai * 128 + m * 16; const float ra = sa[row]; float* gp = Gt + (size_t)row * 32 + 8 * fq;
                        const pg8::i32x4 i0 = __builtin_bit_cast(pg8::i32x4, acc[ai][0][m][0]), i1 = __builtin_bit_cast(pg8::i32x4, acc[ai][0][m][1]);
                        *(f32x4*)gp = (f32x4){(float)i0[0], (float)i0[1], (float)i0[2], (float)i0[3]} * (q0 * ra) + b0; *(f32x4*)(gp + 4) = (f32x4){(float)i1[0], (float)i1[1], (float)i1[2], (float)i1[3]} * (q1 * ra) + b1; }
            }
            return;
        }
        f32x4 sbv[2][2]; float sav[2][4];
#pragma unroll
        for (int bj = 0; bj < 2; ++bj)
#pragma unroll
            for (int n = 0; n < 2; ++n) sbv[bj][n] = *(const f32x4*)(sb + col0 + bj * 128 + 4 * n);
#pragma unroll
        for (int ai = 0; ai < 2; ++ai)
#pragma unroll
            for (int m = 0; m < 4; ++m) sav[ai][m] = sa[row0 + ai * 128 + m * 16];
#pragma unroll
        for (int ai = 0; ai < 2; ++ai)
#pragma unroll
            for (int m = 0; m < 4; ++m) { bf16* rowp = P + (size_t)(row0 + ai * 128 + m * 16) * NPROJ + col0; const float ra = sav[ai][m];
#pragma unroll
                for (int bj = 0; bj < 2; ++bj) { const pg8::i32x4 i0 = __builtin_bit_cast(pg8::i32x4, acc[ai][bj][m][0]), i1 = __builtin_bit_cast(pg8::i32x4, acc[ai][bj][m][1]);
                    const f32x4 s0 = sbv[bj][0] * ra, s1 = sbv[bj][1] * ra;
                    v4u w; w.x = pk2((float)i0[0] * s0[0], (float)i0[1] * s0[1]); w.y = pk2((float)i0[2] * s0[2], (float)i0[3] * s0[3]);
                    w.z = pk2((float)i1[0] * s1[0], (float)i1[1] * s1[1]); w.w = pk2((float)i1[2] * s1[2], (float)i1[3] * s1[3]);
                    *(v4u*)(rowp + bj * 128) = w; } }
    }
    static constexpr int NS = 8, NTAB = 2;
    __device__ __forceinline__ bool stores(const pg8::Unit& u, int wc) const { return u.pn != 48 || wc == 0; }
    __device__ __forceinline__ const void* tab_src(const pg8::Unit& u, int idx) const {
        const int i = idx & 255;
        if (idx < 256) return sa + u.pm * 256 + i;
        if (u.pn == 48) return (i >= 32 && i < 64) ? bg + (i - 32) : sb + NPROJ + (i & 31);
        return sb + u.pn * 256 + i;
    }
    __device__ __forceinline__ void half(const pg8::f32x4 (&acc)[2][2][4][2], const pg8::Unit& u, const int ai, int wr, int wc, int fr, int fq, const LAS float* tab) const {
        const int lrow0 = wr * 64 + fr + ai * 128, row0 = u.pm * 256 + lrow0, col0 = u.pn * 256 + wc * 32 + 8 * fq;
        const LAS float* tb2 = tab + 256;
        if (u.pn == 48) {
            if (wc == 0) {
                const f32x4 q0 = *(const LAS f32x4*)(tb2 + 8 * fq), q1 = *(const LAS f32x4*)(tb2 + 8 * fq + 4), b0 = *(const LAS f32x4*)(tb2 + 32 + 8 * fq), b1 = *(const LAS f32x4*)(tb2 + 36 + 8 * fq);
#pragma unroll
                for (int m = 0; m < 4; ++m) { const float ra = tab[lrow0 + m * 16]; float* gp = Gt + (size_t)(row0 + m * 16) * 32 + 8 * fq;
                    const pg8::i32x4 i0 = __builtin_bit_cast(pg8::i32x4, acc[ai][0][m][0]), i1 = __builtin_bit_cast(pg8::i32x4, acc[ai][0][m][1]);
                    *(f32x4*)gp = (f32x4){(float)i0[0], (float)i0[1], (float)i0[2], (float)i0[3]} * (q0 * ra) + b0; *(f32x4*)(gp + 4) = (f32x4){(float)i1[0], (float)i1[1], (float)i1[2], (float)i1[3]} * (q1 * ra) + b1; }
            }
            return;
        }
        f32x4 sbv[2][2];
#pragma unroll
        for (int bj = 0; bj < 2; ++bj)
#pragma unroll
            for (int n = 0; n < 2; ++n) sbv[bj][n] = *(const LAS f32x4*)(tb2 + wc * 32 + 8 * fq + bj * 128 + 4 * n);
        if (u.pn >= COL_O / 256 && u.pn < COL_CB / 256) {
            const int ch0 = (u.pn - COL_O / 256) * 256 + wc * 32 + 8 * fq;
#pragma unroll
            for (int m = 0; m < 4; ++m) { unsigned char* rowp = (unsigned char*)(P + (size_t)(row0 + m * 16) * NPROJ + COL_O) + ch0; const float ra = tab[lrow0 + m * 16];
#pragma unroll
                for (int bj = 0; bj < 2; ++bj) { const pg8::i32x4 i0 = __builtin_bit_cast(pg8::i32x4, acc[ai][bj][m][0]), i1 = __builtin_bit_cast(pg8::i32x4, acc[ai][bj][m][1]);
                    const f32x4 s0 = sbv[bj][0] * ra, s1 = sbv[bj][1] * ra;
                    *(v2u*)(rowp + bj * 128) = (v2u){pk4_i8(sig255((float)i0[0] * s0[0]), sig255((float)i0[1] * s0[1]), sig255((float)i0[2] * s0[2]), sig255((float)i0[3] * s0[3])),
                                                   pk4_i8(sig255((float)i1[0] * s1[0]), sig255((float)i1[1] * s1[1]), sig255((float)i1[2] * s1[2]), sig255((float)i1[3] * s1[3]))}; } }
            return;
        }
        if (u.pn >= COL_CC / 256 && u.pn < COL_K / 256) {
            const int ch0 = COL_CC + (u.pn - COL_CC / 256) * 128 + wc * 32 + 8 * fq;
#pragma unroll
            for (int m = 0; m < 4; ++m) { bf16* rowp = P + (size_t)(row0 + m * 16) * NPROJ + ch0; const float ra = tab[lrow0 + m * 16];
#pragma unroll
                for (int n = 0; n < 2; ++n) { const pg8::i32x4 ic = __builtin_bit_cast(pg8::i32x4, acc[ai][0][m][n]), ix = __builtin_bit_cast(pg8::i32x4, acc[ai][1][m][n]);
                    const f32x4 sc = sbv[0][n] * ra, sx = sbv[1][n] * ra;
                    *(v2u*)(rowp + 4 * n) = (v2u){pk2(((float)ic[0] * sc[0]) * ((float)ix[0] * sx[0]), ((float)ic[1] * sc[1]) * ((float)ix[1] * sx[1])), pk2(((float)ic[2] * sc[2]) * ((float)ix[2] * sx[2]), ((float)ic[3] * sc[3]) * ((float)ix[3] * sx[3]))}; } }
            return;
        }
#pragma unroll
        for (int m = 0; m < 4; ++m) { bf16* rowp = P + (size_t)(row0 + m * 16) * NPROJ + col0; const float ra = tab[lrow0 + m * 16];
#pragma unroll
            for (int bj = 0; bj < 2; ++bj) { const pg8::i32x4 i0 = __builtin_bit_cast(pg8::i32x4, acc[ai][bj][m][0]), i1 = __builtin_bit_cast(pg8::i32x4, acc[ai][bj][m][1]);
                const f32x4 s0 = sbv[bj][0] * ra, s1 = sbv[bj][1] * ra;
                v4u w; w.x = pk2((float)i0[0] * s0[0], (float)i0[1] * s0[1]); w.y = pk2((float)i0[2] * s0[2], (float)i0[3] * s0[3]);
                w.z = pk2((float)i1[0] * s1[0], (float)i1[1] * s1[1]); w.w = pk2((float)i1[2] * s1[2], (float)i1[3] * s1[3]);
                *(v4u*)(rowp + bj * 128) = w; } }
    }
};
struct SchedStatic {
    int nM, nN, nwg, G, c;
    __device__ void init(int M, int N, int G_, int c_) { nM = M / 256; nN = N / 256; nwg = nM * nN; G = G_; c = c_; }
    __device__ bool next(int i, pg8::Unit& u) const {
        const long L = (long)i * G + c; if (L >= nwg) return false;
        int wgid = (int)L; { const int q = nwg / 8, r = nwg % 8, xcd = wgid % 8, off = wgid / 8; wgid = (xcd < r ? xcd * (q + 1) : r * (q + 1) + (xcd - r) * q) + off; }
        const int nig = 8 * nN, gid = wgid / nig, fm = gid * 8, gsz = (nM - fm) < 8 ? (nM - fm) : 8;
        u.pm = fm + ((wgid % nig) % gsz); u.pn = (wgid % nig) / gsz; return true;
    }
    __device__ __forceinline__ void a_ready(const pg8::Unit&) const {}
    __device__ __forceinline__ void done(const pg8::Unit&) const {}
    __device__ __forceinline__ unsigned row_byteoff(const pg8::Unit&, int) const { return 0u; }
};
struct EpiOut {
    static constexpr bool PERM = true;
    const float* ada; bf16* DL;
    __device__ __forceinline__ void operator()(const pg8::f32x4 (&acc)[2][2][4][2], const pg8::Unit& u, int wr, int wc, int fr, int fq) const {
        const int row0 = u.pm * 256 + wr * 64 + fr, col0 = u.pn * 256 + wc * 32 + 8 * fq;
        const float* g1 = ada + (size_t)(u.pm >> 4) * ADA_N + 2 * D + col0;
        f32x4 gv[2][2];
#pragma unroll
        for (int bj = 0; bj < 2; ++bj)
#pragma unroll
            for (int n = 0; n < 2; ++n) gv[bj][n] = *(const f32x4*)(g1 + bj * 128 + 4 * n);
#pragma unroll
        for (int ai = 0; ai < 2; ++ai)
#pragma unroll
            for (int m = 0; m < 4; ++m) { bf16* rowp = DL + (size_t)(row0 + ai * 128 + m * 16) * D + col0;
#pragma unroll
                for (int bj = 0; bj < 2; ++bj) { const pg8::f32x4 v0 = acc[ai][bj][m][0] * gv[bj][0], v1 = acc[ai][bj][m][1] * gv[bj][1];
                    v4u w; w.x = pk2(v0[0], v0[1]); w.y = pk2(v0[2], v0[3]); w.z = pk2(v1[0], v1[1]); w.w = pk2(v1[2], v1[3]);
                    *(v4u*)(rowp + bj * 128) = w; } }
    }
    static constexpr int NS = 8, NTAB = 1;
    __device__ __forceinline__ bool stores(const pg8::Unit&, int) const { return true; }
    __device__ __forceinline__ const void* tab_src(const pg8::Unit& u, int idx) const { return ada + (size_t)(u.pm >> 4) * ADA_N + 2 * D + u.pn * 256 + (idx & 255); }
    __device__ __forceinline__ void half(const pg8::f32x4 (&acc)[2][2][4][2], const pg8::Unit& u, const int ai, int wr, int wc, int fr, int fq, const LAS float* tab) const {
        const int row0 = u.pm * 256 + wr * 64 + fr + ai * 128, col0 = u.pn * 256 + wc * 32 + 8 * fq;
        f32x4 gv[2][2];
#pragma unroll
        for (int bj = 0; bj < 2; ++bj)
#pragma unroll
            for (int n = 0; n < 2; ++n) gv[bj][n] = *(const LAS f32x4*)(tab + wc * 32 + 8 * fq + bj * 128 + 4 * n);
#pragma unroll
        for (int m = 0; m < 4; ++m) { bf16* rowp = DL + (size_t)(row0 + m * 16) * D + col0;
#pragma unroll
            for (int bj = 0; bj < 2; ++bj) { const pg8::f32x4 v0 = acc[ai][bj][m][0] * gv[bj][0], v1 = acc[ai][bj][m][1] * gv[bj][1];
                v4u w; w.x = pk2(v0[0], v0[1]); w.y = pk2(v0[2], v0[3]); w.z = pk2(v1[0], v1[1]); w.w = pk2(v1[2], v1[3]);
                *(v4u*)(rowp + bj * 128) = w; } }
    }
};
struct EpiOut2 {
    static constexpr bool PERM = true;
    static constexpr int NS = 8, NTAB = 3;
    const float* ada; bf16* DL; const float* sa; const float* sb; const float* xin;
    __device__ __forceinline__ bool stores(const pg8::Unit&, int) const { return true; }
    __device__ __forceinline__ const void* tab_src(const pg8::Unit& u, int idx) const {
        const int i = idx & 255, w = idx >> 8;
        if (w == 0) return ada + (size_t)(u.pm >> 4) * ADA_N + 2 * D + u.pn * 256 + i;
        if (w == 1) return sa + u.pm * 256 + i;
        return sb + u.pn * 256 + i;
    }
    __device__ __forceinline__ void mid(pg8::f32x4 (&acc)[2][2][4][2], const pg8::Unit&, int wr, int wc, int fr, int fq, const LAS float* tab) const {
        f32x4 sbv[2][2];
#pragma unroll
        for (int bj = 0; bj < 2; ++bj)
#pragma unroll
            for (int n = 0; n < 2; ++n) sbv[bj][n] = *(const LAS f32x4*)(tab + 512 + wc * 32 + 8 * fq + bj * 128 + 4 * n);
#pragma unroll
        for (int ai = 0; ai < 2; ++ai)
#pragma unroll
            for (int m = 0; m < 4; ++m) { const float ra = tab[256 + wr * 64 + fr + ai * 128 + m * 16];
#pragma unroll
                for (int bj = 0; bj < 2; ++bj)
#pragma unroll
                    for (int n = 0; n < 2; ++n) { const pg8::i32x4 iv = __builtin_bit_cast(pg8::i32x4, acc[ai][bj][m][n]); const f32x4 s = sbv[bj][n] * ra;
                        acc[ai][bj][m][n] = (f32x4){(float)iv[0] * s[0], (float)iv[1] * s[1], (float)iv[2] * s[2], (float)iv[3] * s[3]}; } }
    }
    __device__ __forceinline__ void half(const pg8::f32x4 (&acc)[2][2][4][2], const pg8::Unit& u, const int ai, int wr, int wc, int fr, int fq, const LAS float* tab) const {
        const int row0 = u.pm * 256 + wr * 64 + fr + ai * 128, col0 = u.pn * 256 + wc * 32 + 8 * fq;
        f32x4 xv[4][2][2];
#pragma unroll
        for (int m = 0; m < 4; ++m) { const float* xr = xin + (size_t)(row0 + m * 16) * D + col0;
#pragma unroll
            for (int bj = 0; bj < 2; ++bj)
#pragma unroll
                for (int n = 0; n < 2; ++n) xv[m][bj][n] = *(const f32x4*)(xr + bj * 128 + 4 * n); }
        f32x4 gv[2][2];
#pragma unroll
        for (int bj = 0; bj < 2; ++bj)
#pragma unroll
            for (int n = 0; n < 2; ++n) gv[bj][n] = *(const LAS f32x4*)(tab + wc * 32 + 8 * fq + bj * 128 + 4 * n);
#pragma unroll
        for (int m = 0; m < 4; ++m) { bf16* rowp = DL + (size_t)(row0 + m * 16) * D + col0;
#pragma unroll
            for (int bj = 0; bj < 2; ++bj) { const pg8::f32x4 v0 = acc[ai][bj][m][0] * gv[bj][0] + xv[m][bj][0], v1 = acc[ai][bj][m][1] * gv[bj][1] + xv[m][bj][1];
                v4u w; w.x = pk2(v0[0], v0[1]); w.y = pk2(v0[2], v0[3]); w.z = pk2(v1[0], v1[1]); w.w = pk2(v1[2], v1[3]);
                *(v4u*)(rowp + bj * 128) = w; } }
    }
};
typedef GAS unsigned long long gu64;
constexpr unsigned RT_FULL = 64u, RT_SPIN_CAP = 1u << 22;
template <int NCT>
struct SchedMoe {
    int G, c; const LAS int* tb; const LAS int* cnt; const int* elist; unsigned rowbytes; gu32* rtc;
    __device__ bool next(int i, pg8::Unit& u) const {
        const int L = i * G + c, rt = L / NCT, ct = L % NCT;
        if (rt >= tb[NE]) return false;
        int e = 0;
#pragma unroll
        for (int q = 1; q < NE; ++q) e += (rt >= tb[q]) ? 1 : 0;
        u.pm = rt; u.pn = e * NCT + ct; return true;
    }
    __device__ __forceinline__ void a_ready(const pg8::Unit&) const {}
    __device__ __forceinline__ void done(const pg8::Unit& u) const {
        if (rtc == nullptr) return;
        asm volatile("s_waitcnt vmcnt(0) ; publish" ::: "memory");
        if ((threadIdx.x & 63) == 0) (void)__hip_atomic_fetch_add(rtc + 16 * u.pm, 1u, RLX_AGENT);
    }
    __device__ __forceinline__ unsigned row_byteoff(const pg8::Unit& u, int lr) const {
        const int e = u.pn / NCT; int l = (u.pm - tb[e]) * 256 + lr; const int n = cnt[e]; l = l < n ? l : n - 1;
        return (unsigned)(elist[e * T + l] >> 1) * rowbytes;
    }
    __device__ __forceinline__ const int* row_src(const pg8::Unit& u, int lr) const {
        const int e = u.pn / NCT; int l = (u.pm - tb[e]) * 256 + lr; const int n = cnt[e]; l = l < n ? l : n - 1;
        return elist + e * T + l;
    }
    __device__ __forceinline__ unsigned row_raw(const pg8::Unit& u, int lr) const { return (unsigned)*row_src(u, lr); }
    __device__ __forceinline__ unsigned row_off(unsigned raw) const { return (raw >> 1) * rowbytes; }
};
struct SchedMoe2 {
    static constexpr int NCT = 16, BON = 3;
    int G, c, n7; const LAS int* tb; const LAS int* cnt; gu32* rtc; gu32* tmo;
    __device__ bool next(int i, pg8::Unit& u) const {
        const int A = n7 % G, nl = G - A; int L;
        if (A == 0) L = i * G + c;
        else if (c >= A) L = (i < BON) ? i * nl + (c - A) : BON * nl + (i - BON) * G + c;
        else L = BON * nl + i * G + c;
        const int rt = L / NCT, ct = L % NCT;
        if (rt >= tb[NE]) return false;
        int e = 0;
#pragma unroll
        for (int q = 1; q < NE; ++q) e += (rt >= tb[q]) ? 1 : 0;
        u.pm = rt; u.pn = e * NCT + ct; return true;
    }
    __device__ __forceinline__ void a_ready(const pg8::Unit& u) const {
        unsigned sp = 0;
        while ((unsigned)__builtin_amdgcn_readfirstlane((int)__hip_atomic_load(rtc + 16 * u.pm, RLX_AGENT)) < RT_FULL) {
            __builtin_amdgcn_s_sleep(1);
            if (++sp > RT_SPIN_CAP) { if ((threadIdx.x & 63) == 0) __hip_atomic_store(tmo, 1u, RLX_AGENT); break; }
        }
    }
    __device__ __forceinline__ void done(const pg8::Unit&) const {}
    __device__ __forceinline__ unsigned row_byteoff(const pg8::Unit&, int) const { return 0u; }
};
struct EpiMoe1 {
    static constexpr bool PERM = true;
    unsigned char* H;
    __device__ __forceinline__ void operator()(const pg8::f32x4 (&acc)[2][2][4][2], const pg8::Unit& u, int wr, int wc, int fr, int fq) const {
        const int row0 = u.pm * 256 + wr * 64 + fr, col0 = (u.pn & 7) * 128 + wc * 32 + 8 * fq;
        constexpr float IS = 1.f / W1_SCALE;
#pragma unroll
        for (int ai = 0; ai < 2; ++ai)
#pragma unroll
            for (int m = 0; m < 4; ++m) { float h[8];
#pragma unroll
                for (int n = 0; n < 2; ++n)
#pragma unroll
                    for (int j = 0; j < 4; ++j) { const float a = acc[ai][0][m][n][j] * IS, uu = acc[ai][1][m][n][j] * IS; h[4 * n + j] = a * uu / (1.f + __expf(-a)); }
                *(v2u*)(H + (size_t)(row0 + ai * 128 + m * 16) * FF + col0) = (v2u){pk4_fp8(h[0], h[1], h[2], h[3]), pk4_fp8(h[4], h[5], h[6], h[7])}; }
    }
    static constexpr int NS = 4, NTAB = 0;
    __device__ __forceinline__ bool stores(const pg8::Unit&, int) const { return true; }
    __device__ __forceinline__ const void* tab_src(const pg8::Unit&, int) const { return nullptr; }
    __device__ __forceinline__ void half(const pg8::f32x4 (&acc)[2][2][4][2], const pg8::Unit& u, const int ai, int wr, int wc, int fr, int fq, const LAS float*) const {
        const int row0 = u.pm * 256 + wr * 64 + fr + ai * 128, col0 = (u.pn & 7) * 128 + wc * 32 + 8 * fq;
        constexpr float IS = 1.f / W1_SCALE;
#pragma unroll
        for (int m = 0; m < 4; ++m) { float h[8];
#pragma unroll
            for (int n = 0; n < 2; ++n)
#pragma unroll
                for (int j = 0; j < 4; ++j) { const float a = acc[ai][0][m][n][j] * IS, uu = acc[ai][1][m][n][j] * IS; h[4 * n + j] = a * uu / (1.f + __expf(-a)); }
            __hip_atomic_store((gu64*)(H + (size_t)(row0 + m * 16) * FF + col0), (unsigned long long)pk4_fp8(h[0], h[1], h[2], h[3]) | ((unsigned long long)pk4_fp8(h[4], h[5], h[6], h[7]) << 32), RLX_AGENT); }
    }
};
struct EpiMoe2 {
    static constexpr int PERM = 2;
    unsigned char* SL; const int* elist; const float* ew; const LAS int* tb; const LAS int* cnt;
    static constexpr int NS = 4, NTAB = 2;
    unsigned char* dump;
    __device__ __forceinline__ bool stores(const pg8::Unit&, int) const { return true; }
    __device__ __forceinline__ const void* tab_src(const pg8::Unit& u, int idx) const {
        const int e = u.pn >> 4, n_e = cnt[e]; int l = (u.pm - tb[e]) * 256 + (idx & 255); l = l < n_e ? l : n_e - 1;
        return idx < 256 ? (const void*)(elist + e * T + l) : (const void*)(ew + e * T + l);
    }
    __device__ __forceinline__ void half(const pg8::f32x4 (&acc)[2][2][4][2], const pg8::Unit& u, const int ai, int wr, int wc, int fr, int fq, const LAS float* tab) const {
        const int e = u.pn >> 4, ct = u.pn & 15, n_e = cnt[e], lrow0 = wr * 64 + fr + ai * 128, lr0 = (u.pm - tb[e]) * 256 + lrow0, col0 = ct * 256 + wc * 64 + 16 * fq;
#pragma unroll
        for (int m = 0; m < 4; ++m) { const int lr = lr0 + m * 16, ent = ((const LAS int*)tab)[lrow0 + m * 16]; const float w = tab[256 + lrow0 + m * 16] * (SLOT_SCALE / W2_SCALE);
            unsigned char* rowp = (lr < n_e) ? SL + ((size_t)(ent & 1) * T + (size_t)(ent >> 1)) * D + col0 : dump + (size_t)((u.pm & 63) * 256 + lrow0 + m * 16) * D + col0;
            const pg8::f32x4 v0 = acc[ai][0][m][0] * w, v1 = acc[ai][0][m][1] * w, v2 = acc[ai][1][m][0] * w, v3 = acc[ai][1][m][1] * w;
            *(v4u*)rowp = (v4u){pk4_fp8(v0[0], v0[1], v0[2], v0[3]), pk4_fp8(v1[0], v1[1], v1[2], v1[3]), pk4_fp8(v2[0], v2[1], v2[2], v2[3]), pk4_fp8(v3[0], v3[1], v3[2], v3[3])}; }
    }
};
__device__ __forceinline__ void moe_tables(Frame& F) {
    LAS int* tb = (LAS int*)(F.lds + MOE_OFF); LAS int* cnt = tb + 32;
    __syncthreads();
    if (F.tid == 0) { int acc = 0;
        for (int e = 0; e < NE; ++e) { const int n = (int)__hip_atomic_load((unsigned*)(F.ctl + CW_CNT + 64 * e), RLX_AGENT); cnt[e] = n; tb[e] = acc; acc += (n + 255) >> 8; }
        tb[NE] = acc; }
    __syncthreads();
}

struct Args { const float* in[20]; float* out; unsigned char* ws; int ph_lo, ph_hi, li, pad; };
__global__ void __launch_bounds__(NTHR, 2) mk_fwd(Args args) {
    extern __shared__ __attribute__((aligned(16))) unsigned char lds[];
    Frame F;
    F.lds = (LAS unsigned char*)lds;
    F.MISC = (volatile LAS unsigned*)(F.lds + MISC_OFF);
    F.tid = threadIdx.x; F.lane = F.tid & 63; F.wave = __builtin_amdgcn_readfirstlane(F.tid >> 6);
    F.G = gridDim.x; { const int bx = blockIdx.x; F.vcu = (F.G % 8 == 0) ? (bx % 8) * (F.G / 8) + bx / 8 : bx; }
    unsigned char* ws = args.ws;
    F.ctl = (gu32*)(ws + WS_CTL);
    F.x = args.in[0]; F.c = args.in[1]; F.ctx = args.in[2]; F.cctx = args.in[3]; F.w_ada = args.in[4]; F.b_ada = args.in[5]; F.norm1 = args.in[6]; F.w_in = args.in[7];
    F.b_gates = args.in[8]; F.conv_w = args.in[9]; F.head_norm = args.in[10]; F.w_out = args.in[11]; F.norm2 = args.in[12]; F.w_rg = args.in[13]; F.b_rg = args.in[14];
    F.w_re = args.in[15]; F.b_re = args.in[16]; F.w_e1 = args.in[17]; F.w_e2 = args.in[18]; F.fnorm = args.in[19]; F.out = args.out;
    F.ADA = (float*)(ws + WS_ADA); F.GATES = (float*)(ws + WS_GATES); F.EW = (float*)(ws + WS_EW); F.HF = (bf16*)(ws + WS_HF); F.HB = (bf16*)(ws + WS_HB); F.DELTA = (bf16*)(ws + WS_X1); F.X1B = (bf16*)(ws + WS_X1 + 128 * MiB); F.XM8 = ws + WS_XM8; F.WO8 = ws + WS_WO8; F.WI8 = (signed char*)(ws + WS_WI8); F.SA = (float*)(ws + WS_SA); F.SB = (float*)(ws + WS_SB); F.SB2 = F.SB + 16384; F.MIXA8 = ws + WS_XM8; F.WOA8 = ws + WS_WIN + 64 * MiB;
    F.ELIST = (int*)(ws + WS_ELIST);
    F.WIN = (bf16*)(ws + WS_WIN); F.WOUT = (bf16*)(ws + WS_WOUT); F.WE1 = (bf16*)(ws + WS_WE1); F.WE2 = (bf16*)(ws + WS_WE2);
    F.XM = (bf16*)(ws + WS_XM); F.MIX = F.XM; F.XF = F.XM; F.PROJ = (bf16*)(ws + WS_PROJ); F.SLOT = (bf16*)(ws + WS_SLOT); F.HMOE = (bf16*)(ws + WS_HMOE);
    for (int u = F.tid; u < (LDS_BYTES - LDSCTL_OFF) / 4; u += NTHR) ((LAS unsigned*)(F.lds + LDSCTL_OFF))[u] = 0u;
    __syncthreads();
    const int lo = args.ph_lo, hi = args.ph_hi;
    XcdBarrier bar; bar.bar = (unsigned*)(F.ctl + CW_BAR) + args.li * XCD_BAR_WORDS; bar.x = 0; bar.st = nullptr;
    if (hi - lo > 1) bar = xcd_barrier_post((unsigned*)(F.ctl + CW_BAR) + args.li * XCD_BAR_WORDS, F.MISC + 8);
#ifndef PHASE_MASK
#define PHASE_MASK 0xFFFF
#endif
#define IN(k) (((PHASE_MASK >> (k)) & 1) && lo <= (k) && (k) < hi)
#define BOTH(k) (IN(k) && IN((k) + 1))
#define GRID_BAR() xcd_barrier(bar)
    LAS unsigned* rowtab = (LAS unsigned*)(F.lds + ROWTAB_OFF);

#ifndef PROBE_DUP
#define PROBE_DUP -1
#endif
#define RUNPH(k, ...) if (IN(k)) { __VA_ARGS__ if (PROBE_DUP == (k)) { GRID_BAR(); __VA_ARGS__ } if (BOTH(k)) GRID_BAR(); }
    RUNPH(0, { p0_ada(F); __syncthreads(); p0_transposes(F); })
    RUNPH(1, { p1_quant_weights(F); p1_quant_wout(F); p1_norm(F); })
    RUNPH(2, {
        __syncthreads();
        { pg8::Gemm gi{(const bf16*)F.XM8, (const bf16*)F.WI8, TA, NPAD, D / 2}; SchedProj Si{F.G, (int)blockIdx.x}; EpiProjI8 Ei{F.PROJ, F.SA, F.SB, F.GATES, F.b_gates};
          pg8::gemm_phase<EpiProjI8, SchedProj, PG8_ALIGN, PG8_SP2, false, false, true, PG8_ROLL2>(F.lds, gi, Si, Ei, rowtab); }
        expert_transpose_queue(F); })
    RUNPH(3, { p3_mlstm(F); })
    RUNPH(4, { p4_mix(F); })
    RUNPH(5, {
        pg8::Gemm2 g{(const char*)F.MIXA8, (const char*)F.WOA8, (unsigned)(D / 2), (unsigned)(D / 2), D / 2 / 128, (const char*)(F.MIX + D / 2), (const char*)(F.WOUT + D / 2), (unsigned)(D * 2), (unsigned)(D * 2), D / 2 * 2 / 128};
        SchedStatic S; S.init(T, D, F.G, (int)blockIdx.x); EpiOut2 E{F.ADA, F.X1B, F.SA, F.SB2, F.x};
        __syncthreads();
        pg8::gemm_phase2<EpiOut2, SchedStatic, PG8_ALIGN>(F.lds, g, S, E); })
    RUNPH(6, { p6_norm_router(F); })
    RUNPH(7, {
        moe_tables(F);
        const LAS int* tb = (const LAS int*)(F.lds + MOE_OFF);
        gu32* rtc = F.ctl + CW_RT;
        { pg8::Gemm g{F.XF, F.WE1, T, NE * 2 * FF, D / 2}; SchedMoe<8> S{F.G, F.vcu, tb, tb + 32, F.ELIST, (unsigned)D, rtc}; EpiMoe1 E{(unsigned char*)F.HMOE};
          pg8::gemm_phase<EpiMoe1, SchedMoe<8>, PG8_ALIGN, PG8_SP2, true, true, false, PG8_ROLL7>(F.lds, g, S, E, rowtab); }
        if (F.wave == 0) __builtin_amdgcn_fence(__ATOMIC_ACQUIRE, "agent");
        __syncthreads();
        { pg8::Gemm g{F.HMOE, F.WE2, HM_ROWS, NE * D, FF / 2}; SchedMoe2 S{F.G, F.vcu, tb[NE] * 8, tb, tb + 32, rtc, F.ctl + CW_TMO}; EpiMoe2 E{(unsigned char*)F.SLOT, F.ELIST, F.EW, tb, tb + 32, (unsigned char*)F.WIN};
          pg8::gemm_phase<EpiMoe2, SchedMoe2, PG8_ALIGN, PG8_SP2, false, true, false, PG8_ROLL8>(F.lds, g, S, E, rowtab); } })
    RUNPH(9, { p9_final(F); })
#undef IN
#undef BOTH
}

__global__ void __launch_bounds__(320) mlstm_naive(const bf16* __restrict__ PROJ, const float* __restrict__ GATES, bf16* __restrict__ HF, bf16* __restrict__ HB) {
    __shared__ float kq[2][256];
    __shared__ float sc[2][4];
    __shared__ float dens[2];
    const int bid = blockIdx.x, dir = bid & 1, h = (bid >> 1) & 7, b = bid >> 4, tid = threadIdx.x;
    float C[128];
#pragma unroll
    for (int i = 0; i < 128; ++i) C[i] = 0.f;
    float m = 0.f;
    bf16* HO = dir ? HB : HF;
    const int NSTEP = CTXL + SEQ;
    for (int st = 0; st < NSTEP; ++st) {
        int row;
        if (st < CTXL) { const int j = dir ? (CTXL - 1 - st) : st; row = T + b * CTXL + j; }
        else { const int s = dir ? (SEQ - 1 - (st - CTXL)) : (st - CTXL); row = b * SEQ + s; }
        const bf16* pr = PROJ + (size_t)row * NPROJ;
        const int buf = st & 1;
        if (tid < 128) kq[buf][tid] = bf1(pr[COL_K + h * DK + tid]);
        else if (tid < 256) kq[buf][tid] = bf1(pr[COL_Q + h * DK + (tid - 128)]) * 0.08838834764831845f;
        const float ig = GATES[(size_t)row * 32 + (dir ? 16 : 0) + h], fp = GATES[(size_t)row * 32 + (dir ? 24 : 8) + h];
        const float lf = fminf(fp, 0.f) - log1pf(expf(-fabsf(fp)));
        const float mn = fmaxf(lf + m, ig);
        const float fdec = expf(lf + m - mn), iw = expf(ig - mn);
        m = mn;
        const float vv = tid < 256 ? bf1(pr[COL_V + h * DV + tid]) : 1.f;
        __syncthreads();
        const bool isq = st >= CTXL;
        float dot = 0.f;
        if (tid <= 256) {
            const float a = iw * vv;
#pragma unroll
            for (int i = 0; i < 128; ++i) { C[i] = fdec * C[i] + a * kq[buf][i]; dot += C[i] * kq[buf][128 + i]; }
        }
        if (isq) {
            if (tid == 256) dens[buf] = dot;
            __syncthreads();
            if (tid < 256) { const float dn = fmaxf(fabsf(dens[buf]), expf(-m)); HO[(size_t)row * 2048 + h * DV + tid] = (bf16)(pk2(dot / dn, 0.f) & 0xffffu); }
        }
    }
}

extern "C" void kernel_launch(void* const* d_in, const int* in_sizes, int n_in, void* d_out, int out_size, void* d_ws, size_t ws_size, hipStream_t stream) {
    static int grid = 0;
    if (grid == 0) {
        if (n_in != 20 || out_size != T * D || ws_size < WS_END) { fprintf(stderr, "kernel_launch: unexpected shapes (n_in %d, out %d, ws %zu)\n", n_in, out_size, ws_size); grid = -1; return; }
        int dev = 0, cus = 0, per_cu = 0;
        if (hipGetDevice(&dev) != hipSuccess || hipDeviceGetAttribute(&cus, hipDeviceAttributeMultiprocessorCount, dev) != hipSuccess) { grid = -1; return; }
        if (hipFuncSetAttribute((const void*)mk_fwd, hipFuncAttributeMaxDynamicSharedMemorySize, LDS_BYTES) != hipSuccess) { fprintf(stderr, "kernel_launch: hipFuncSetAttribute failed\n"); grid = -1; return; }
        if (hipOccupancyMaxActiveBlocksPerMultiprocessor(&per_cu, (const void*)mk_fwd, NTHR, LDS_BYTES) != hipSuccess || per_cu < 1) fprintf(stderr, "kernel_launch: occupancy query says %d\n", per_cu);
        (void)hipGetLastError();
        grid = cus;
    }
    if (grid < 0) return;
    (void)hipMemsetAsync((char*)d_ws + WS_CTL, 0, CTL_ZERO_BYTES, stream);
    Args a{};
    for (int i = 0; i < 20; ++i) a.in[i] = (const float*)d_in[i];
    a.out = (float*)d_out; a.ws = (unsigned char*)d_ws;
    int nl = 0;
    auto launch = [&](int lo, int hi) { a.ph_lo = lo; a.ph_hi = hi; a.li = nl++; hipLaunchKernelGGL(mk_fwd, dim3(grid), dim3(NTHR), LDS_BYTES, stream, a); };
#if MK_MODE == 0
    launch(0, 1); launch(1, 2); launch(2, 3);
    hipLaunchKernelGGL(mlstm_naive, dim3(NB * NH * 2), dim3(320), 0, stream, (const bf16*)((char*)d_ws + WS_PROJ), (const float*)((char*)d_ws + WS_GATES), (bf16*)((char*)d_ws + WS_HF), (bf16*)((char*)d_ws + WS_HB));
    launch(4, 5); launch(5, 6); launch(6, 7); launch(7, 8); launch(8, 9); launch(9, 10);
#elif MK_MODE == 2
    launch(0, 10);
#else
    launch(0, 3);
    hipLaunchKernelGGL(mlstm_naive, dim3(NB * NH * 2), dim3(320), 0, stream, (const bf16*)((char*)d_ws + WS_PROJ), (const float*)((char*)d_ws + WS_GATES), (bf16*)((char*)d_ws + WS_HF), (bf16*)((char*)d_ws + WS_HB));
    launch(4, 10);
#endif
}
```

```cpp
#include <hip/hip_runtime.h>
#include <cstdio>
#include <cstdint>

#ifndef MK_MODE
#define MK_MODE 2
#endif

namespace pg8 {
#define PG8_LAS __attribute__((address_space(3)))
typedef unsigned short bf16_t;
typedef short bf16x8 __attribute__((ext_vector_type(8)));
typedef float f32x4 __attribute__((ext_vector_type(4)));
typedef unsigned u32x4 __attribute__((ext_vector_type(4)));
constexpr int BM = 256, BK = 64, HALF = 128, HTB = HALF * BK * 2, STAGE_BYTES = 8 * HTB, NXCD = 8, WGM = 8;

__host__ __device__ __forceinline__ int lds_byte(int r, int c) { const int st = (r >> 4) * 2 + (c >> 5), rr = r & 15, cc = c & 31, ob = rr * 64 + cc * 2; return st * 1024 + (ob ^ (((ob >> 9) & 1) << 5)); }
__host__ __device__ __forceinline__ void stage_rc(int b, int& R, int& C) { const int st = b / 1024, sb = b % 1024, swz = sb ^ (((sb >> 9) & 1) << 5); R = (st >> 1) * 16 + swz / 64; C = (st & 1) * 32 + (swz % 64) / 2; }
__host__ __device__ __forceinline__ int perm32(int rho) { const int n = rho >> 4, i = rho & 15; return 8 * (i >> 2) + 4 * n + (i & 3); }

struct Unit { int pm, pn; };
struct Gemm { const bf16_t* A; const bf16_t* Bt; int M, N, K; };

typedef float f32x2_t __attribute__((ext_vector_type(2))); typedef __bf16 bf16x2_t __attribute__((ext_vector_type(2)));
__device__ __forceinline__ unsigned cvt_pk_bf16(float lo, float hi) { f32x2_t v = {lo, hi}; bf16x2_t b = __builtin_convertvector(v, bf16x2_t); return __builtin_bit_cast(unsigned, b); }

typedef int i32x8 __attribute__((ext_vector_type(8)));
typedef int i32x4 __attribute__((ext_vector_type(4)));
constexpr int TAB_OFF = STAGE_BYTES;
template <class Epi, class Sched, bool ALIGN_EPI, bool SP2, bool GATHER, bool MX, bool I8 = false, bool ROLL = false>
__device__ __forceinline__ void gemm_phase(PG8_LAS unsigned char* lds, const Gemm g, const Sched& S, const Epi& E, PG8_LAS unsigned* rowtab) {
    const int tid = threadIdx.x, wid = __builtin_amdgcn_readfirstlane(tid >> 6), lane = tid & 63, wr = wid >> 2, wc = wid & 3, fr = lane & 15, fq = lane >> 4;
    const int K = g.K, nt = K / BK;
    unsigned voffA[2], voffB[2]; int RA[2], CA[2];
#pragma unroll
    for (int i = 0; i < 2; ++i) { int R, C; stage_rc(tid * 16 + i * 8192, R, C); const int Rb = ((int)Epi::PERM == 2) ? (64 * (R >> 5) + 16 * ((R & 15) >> 2) + 4 * ((R >> 4) & 1) + (R & 3)) : (Epi::PERM ? ((R & ~31) + perm32(R & 31)) : R);
        voffA[i] = (unsigned)(R * K + C) * 2u; voffB[i] = (unsigned)(Rb * K + C) * 2u; RA[i] = R; CA[i] = C * 2; }
    const size_t kstep = (size_t)(BK * 2);
    const size_t hstep = (size_t)HALF * K * 2;
    const size_t tstep = 2 * hstep;
    const size_t hstepA = GATHER ? (size_t)0 : hstep;
    const size_t hstepB = ((int)Epi::PERM == 2) ? (size_t)8 * K * 2 : hstep;
    const unsigned ldsw = (unsigned)wid * 1024u;
    const int aoff = lds_byte(wr * 64 + fr, MX ? fq * 16 : fq * 8), boff = lds_byte(wc * 32 + fr, MX ? fq * 16 : fq * 8);
#define PG8_SA(b, h) (((b) * 2 + (h)) * HTB)
#define PG8_SB(b, h) ((4 + (b) * 2 + (h)) * HTB)
#define PG8_STAGE(bufoff, gbase, voff) do { _Pragma("unroll") for (int _i = 0; _i < 2; ++_i) \
        __builtin_amdgcn_global_load_lds((const unsigned*)((const char*)(gbase) + (voff)[_i]), (PG8_LAS unsigned*)(lds + (bufoff) + ldsw + _i * 8192), 16, 0, 0); } while (0)
#define PG8_LD32(p) ({ const u32x4 lo_ = *(const PG8_LAS u32x4*)(p), hi_ = *(const PG8_LAS u32x4*)((p) + 16); (i32x8){(int)lo_[0], (int)lo_[1], (int)lo_[2], (int)lo_[3], (int)hi_[0], (int)hi_[1], (int)hi_[2], (int)hi_[3]}; })
#define PG8_LDA(dst, b, h) do { if constexpr (MX) { _Pragma("unroll") for (int m = 0; m < 4; ++m) dst##X[m] = PG8_LD32(lds + PG8_SA(b, h) + aoff + m * 2048); } \
        else { _Pragma("unroll") for (int m = 0; m < 4; ++m) _Pragma("unroll") for (int k = 0; k < 2; ++k) dst[m][k] = *(const PG8_LAS bf16x8*)(lds + PG8_SA(b, h) + aoff + m * 2048 + k * 1024); } } while (0)
#define PG8_LDB(dst, b, h) do { if constexpr (MX) { _Pragma("unroll") for (int n = 0; n < 2; ++n) dst##X[n] = PG8_LD32(lds + PG8_SB(b, h) + boff + n * 2048); } \
        else { _Pragma("unroll") for (int n = 0; n < 2; ++n) _Pragma("unroll") for (int k = 0; k < 2; ++k) dst[n][k] = *(const PG8_LAS bf16x8*)(lds + PG8_SB(b, h) + boff + n * 2048 + k * 1024); } } while (0)
#define PG8_MMA(ai, bj, At, Bt) do { __builtin_amdgcn_s_setprio(1); if constexpr (MX) { _Pragma("unroll") for (int m = 0; m < 4; ++m) _Pragma("unroll") for (int n = 0; n < 2; ++n) \
        asm volatile("v_mfma_scale_f32_16x16x128_f8f6f4 %0, %1, %2, %0, %3, %3 op_sel_hi:[0,0,0]" : "+v"(acc[ai][bj][m][n]) : "v"(Bt##X[n]), "v"(At##X[m]), "v"(mxscale)); } \
        else if constexpr (I8) { _Pragma("unroll") for (int m = 0; m < 4; ++m) _Pragma("unroll") for (int n = 0; n < 2; ++n) _Pragma("unroll") for (int k = 0; k < 2; ++k) \
        acc[ai][bj][m][n] = __builtin_bit_cast(f32x4, __builtin_amdgcn_mfma_i32_16x16x64_i8(__builtin_bit_cast(i32x4, Bt[n][k]), __builtin_bit_cast(i32x4, At[m][k]), __builtin_bit_cast(i32x4, acc[ai][bj][m][n]), 0, 0, 0)); } \
        else { _Pragma("unroll") for (int m = 0; m < 4; ++m) _Pragma("unroll") for (int n = 0; n < 2; ++n) _Pragma("unroll") for (int k = 0; k < 2; ++k) \
        acc[ai][bj][m][n] = __builtin_amdgcn_mfma_f32_16x16x32_bf16(Bt[n][k], At[m][k], acc[ai][bj][m][n], 0, 0, 0); } __builtin_amdgcn_s_setprio(0); } while (0)
#define PG8_WAIT_V(n) asm volatile("s_waitcnt vmcnt(" #n ")" ::: "memory")
#define PG8_WAIT_VN(n) asm volatile("s_waitcnt vmcnt(%0)" :: "n"(n) : "memory")
#define PG8_ZERO(ai) do { _Pragma("unroll") for (int b_ = 0; b_ < 2; ++b_) _Pragma("unroll") for (int m_ = 0; m_ < 4; ++m_) _Pragma("unroll") for (int n_ = 0; n_ < 2; ++n_) acc[ai][b_][m_][n_] = (f32x4){0.f, 0.f, 0.f, 0.f}; } while (0)
#define PG8_TABP(u_) ((const PG8_LAS float*)(lds + TAB_OFF + ((u_) & 1) * 2048))
#define PG8_WAIT_L(n) asm volatile("s_waitcnt lgkmcnt(" #n ")" ::: "memory")
#define PG8_BAR __builtin_amdgcn_s_barrier()
#define PG8_SCHED __builtin_amdgcn_sched_barrier(0)
    static_assert(!ROLL || SP2, "rolling epilogue: eight-phase loop only");
    Unit cur, nxt; int ui = 0; bool pst = false;
    if (!S.next(0, cur)) return;
    f32x4 acc[2][2][4][2];
#pragma unroll
    for (int a = 0; a < 2; ++a)
#pragma unroll
        for (int b = 0; b < 2; ++b)
#pragma unroll
            for (int m = 0; m < 4; ++m)
#pragma unroll
                for (int n = 0; n < 2; ++n) acc[a][b][m][n] = (f32x4){0.f, 0.f, 0.f, 0.f};
    bf16x8 At[4][2], B0[2][2], B1[2][2]; i32x8 AtX[4], B0X[2], B1X[2]; const int mxscale = 0x7F7F7F7F;
    unsigned vc0[2], vc1[2], vn0[2], vn1[2];
    const char* cA = GATHER ? (const char*)g.A : (const char*)g.A + (size_t)cur.pm * tstep; const char* cB = (const char*)g.Bt + (size_t)cur.pn * tstep;
    if constexpr (GATHER) {
        if (tid < 256) rowtab[tid] = ROLL ? S.row_raw(cur, tid) : S.row_byteoff(cur, tid);
        asm volatile("s_waitcnt vmcnt(0) lgkmcnt(0)" ::: "memory"); PG8_BAR; asm volatile("" ::: "memory");
#pragma unroll
        for (int i = 0; i < 2; ++i) { vc0[i] = (ROLL ? S.row_off(rowtab[RA[i]]) : rowtab[RA[i]]) + (unsigned)CA[i]; vc1[i] = (ROLL ? S.row_off(rowtab[128 + RA[i]]) : rowtab[128 + RA[i]]) + (unsigned)CA[i]; vn0[i] = vc0[i]; vn1[i] = vc1[i]; }
    } else {
#pragma unroll
        for (int i = 0; i < 2; ++i) { vc0[i] = voffA[i]; vc1[i] = voffA[i]; vn0[i] = voffA[i]; vn1[i] = voffA[i]; }
    }
    S.a_ready(cur);
    if constexpr (SP2) {
        PG8_STAGE(PG8_SB(0, 0), cB, voffB); PG8_STAGE(PG8_SB(0, 1), cB + hstepB, voffB); PG8_STAGE(PG8_SA(0, 0), cA, vc0); PG8_STAGE(PG8_SA(0, 1), cA + hstepA, vc1);
        if (wr == 1) PG8_BAR;
        PG8_WAIT_V(2); PG8_BAR;
        PG8_STAGE(PG8_SB(1, 0), cB + kstep, voffB); PG8_STAGE(PG8_SA(1, 0), cA + kstep, vc0); PG8_STAGE(PG8_SB(1, 1), cB + hstepB + kstep, voffB);
        PG8_WAIT_V(6); PG8_BAR;
    } else {
        PG8_STAGE(PG8_SB(0, 0), cB, voffB); PG8_STAGE(PG8_SA(0, 0), cA, vc0); PG8_STAGE(PG8_SB(0, 1), cB + hstepB, voffB); PG8_STAGE(PG8_SA(0, 1), cA + hstepA, vc1);
        if (wr == 1) PG8_BAR;
        PG8_WAIT_V(4); PG8_BAR;
        PG8_STAGE(PG8_SB(1, 0), cB + kstep, voffB); PG8_STAGE(PG8_SA(1, 0), cA + kstep, vc0); PG8_STAGE(PG8_SB(1, 1), cB + hstepB + kstep, voffB);
        PG8_WAIT_V(6); PG8_BAR;
    }
    for (;;) {
        const bool has_next = S.next(ui + 1, nxt);
        const char* nA = GATHER ? (const char*)g.A : (has_next ? (const char*)g.A + (size_t)nxt.pm * tstep : cA); const char* nB = has_next ? (const char*)g.Bt + (size_t)nxt.pn * tstep : cB;
        if constexpr (GATHER && !ROLL) {
            if (has_next && tid < 256) rowtab[((ui + 1) & 1) * 256 + tid] = S.row_byteoff(nxt, tid);
        }
#pragma unroll 1
        for (int t = 0; t < nt; t += 2) {
            const bool last = (t == nt - 2);
            const char* a1 = cA + (size_t)(t + 1) * kstep;
            const char* a2 = last ? nA : cA + (size_t)(t + 2) * kstep; const char* b2 = last ? nB : cB + (size_t)(t + 2) * kstep;
            const char* a3 = a2 + kstep; const char* b3 = b2 + kstep;
            if (last && has_next) S.a_ready(nxt);
            if constexpr (GATHER) {
                if (last && has_next) {
                    PG8_LAS unsigned* rt = rowtab + ((ui + 1) & 1) * 256;
#pragma unroll
                    for (int i = 0; i < 2; ++i) { vn0[i] = (ROLL ? S.row_off(rt[RA[i]]) : rt[RA[i]]) + (unsigned)CA[i]; vn1[i] = (ROLL ? S.row_off(rt[128 + RA[i]]) : rt[128 + RA[i]]) + (unsigned)CA[i]; }
                }
            }
            unsigned w20[2], w21[2];
#pragma unroll
            for (int i = 0; i < 2; ++i) { w20[i] = last ? vn0[i] : vc0[i]; w21[i] = last ? vn1[i] : vc1[i]; }
            if constexpr (SP2 && ROLL) {
            const bool rf = (t == 0) && pst;
            PG8_LDB(B0, 0, 0); PG8_LDB(B1, 0, 1); PG8_SCHED; PG8_LDA(At, 0, 0); PG8_STAGE(PG8_SA(1, 1), a1 + hstepA, vc1);
            if (t == 2) {
                if constexpr (Epi::NTAB > 0) { if (Epi::NTAB > 1 || wid < 4) __builtin_amdgcn_global_load_lds((const unsigned*)E.tab_src(cur, tid), (PG8_LAS unsigned*)(lds + TAB_OFF + (ui & 1) * 2048 + wid * 256), 4, 0, 0); }
                if constexpr (GATHER) { if (has_next && wid < 4) __builtin_amdgcn_global_load_lds((const unsigned*)S.row_src(nxt, tid), (PG8_LAS unsigned*)(rowtab + ((ui + 1) & 1) * 256 + wid * 64), 4, 0, 0); }
            }
            if (rf) PG8_WAIT_VN(8 + 2 * Epi::NS); else PG8_WAIT_V(8);
            PG8_WAIT_L(0); PG8_BAR; PG8_MMA(0, 0, At, B0); PG8_MMA(0, 1, At, B1); PG8_BAR; PG8_SCHED;
            PG8_LDA(At, 0, 1); PG8_STAGE(PG8_SB(0, 0), b2, voffB); PG8_STAGE(PG8_SB(0, 1), b2 + hstepB, voffB); PG8_STAGE(PG8_SA(0, 0), a2, w20);
            if (rf) PG8_WAIT_VN(8 + 2 * Epi::NS); else PG8_WAIT_V(8);
            PG8_WAIT_L(0); PG8_BAR; PG8_MMA(1, 0, At, B0); PG8_MMA(1, 1, At, B1); PG8_BAR; PG8_SCHED;
            PG8_LDB(B0, 1, 0); PG8_LDB(B1, 1, 1); PG8_SCHED; PG8_LDA(At, 1, 0); PG8_STAGE(PG8_SA(0, 1), a2 + hstepA, w21);
            PG8_WAIT_V(8); PG8_WAIT_L(0); PG8_BAR; PG8_MMA(0, 0, At, B0); PG8_MMA(0, 1, At, B1); PG8_BAR; PG8_SCHED;
            PG8_LDA(At, 1, 1); PG8_STAGE(PG8_SB(1, 0), b3, voffB); PG8_STAGE(PG8_SB(1, 1), b3 + hstepB, voffB); PG8_STAGE(PG8_SA(1, 0), a3, w20);
            PG8_WAIT_V(8); PG8_WAIT_L(0); PG8_BAR; PG8_MMA(1, 0, At, B0); PG8_MMA(1, 1, At, B1); PG8_BAR; PG8_SCHED;
            } else if constexpr (SP2) {
            PG8_LDB(B0, 0, 0); PG8_LDB(B1, 0, 1); PG8_SCHED; PG8_LDA(At, 0, 0); PG8_STAGE(PG8_SA(1, 1), a1 + hstepA, vc1);
            PG8_WAIT_V(8); PG8_WAIT_L(0); PG8_BAR; PG8_MMA(0, 0, At, B0); PG8_MMA(0, 1, At, B1); PG8_BAR; PG8_SCHED;
            PG8_LDA(At, 0, 1); PG8_STAGE(PG8_SB(0, 0), b2, voffB); PG8_STAGE(PG8_SB(0, 1), b2 + hstepB, voffB); PG8_STAGE(PG8_SA(0, 0), a2, w20);
            PG8_WAIT_V(8); PG8_WAIT_L(0); PG8_BAR; PG8_MMA(1, 0, At, B0); PG8_MMA(1, 1, At, B1); PG8_BAR; PG8_SCHED;
            PG8_LDB(B0, 1, 0); PG8_LDB(B1, 1, 1); PG8_SCHED; PG8_LDA(At, 1, 0); PG8_STAGE(PG8_SA(0, 1), a2 + hstepA, w21);
            PG8_WAIT_V(8); PG8_WAIT_L(0); PG8_BAR; PG8_MMA(0, 0, At, B0); PG8_MMA(0, 1, At, B1); PG8_BAR; PG8_SCHED;
            PG8_LDA(At, 1, 1); PG8_STAGE(PG8_SB(1, 0), b3, voffB); PG8_STAGE(PG8_SB(1, 1), b3 + hstepB, voffB); PG8_STAGE(PG8_SA(1, 0), a3, w20);
            PG8_WAIT_V(8); PG8_WAIT_L(0); PG8_BAR; PG8_MMA(1, 0, At, B0); PG8_MMA(1, 1, At, B1); PG8_BAR; PG8_SCHED;
            } else {
            PG8_LDB(B0, 0, 0); PG8_SCHED; PG8_LDA(At, 0, 0); PG8_STAGE(PG8_SA(1, 1), a1 + hstepA, vc1);
            PG8_WAIT_L(8); PG8_BAR; PG8_WAIT_L(0); PG8_MMA(0, 0, At, B0); PG8_BAR; PG8_SCHED;
            PG8_LDB(B1, 0, 1); PG8_STAGE(PG8_SB(0, 0), b2, voffB);
            PG8_BAR; PG8_WAIT_L(0); PG8_MMA(0, 1, At, B1); PG8_BAR;
            PG8_LDA(At, 0, 1); PG8_STAGE(PG8_SA(0, 0), a2, w20);
            PG8_BAR; PG8_WAIT_L(0); PG8_MMA(1, 0, At, B0); PG8_BAR; PG8_SCHED;
            PG8_STAGE(PG8_SB(0, 1), b2 + hstepB, voffB);
            PG8_WAIT_V(6); PG8_BAR; PG8_MMA(1, 1, At, B1); PG8_BAR;
            PG8_LDB(B0, 1, 0); PG8_SCHED; PG8_LDA(At, 1, 0); PG8_STAGE(PG8_SA(0, 1), a2 + hstepA, w21);
            PG8_WAIT_L(8); PG8_BAR; PG8_WAIT_L(0); PG8_MMA(0, 0, At, B0); PG8_BAR; PG8_SCHED;
            PG8_LDB(B1, 1, 1); PG8_STAGE(PG8_SB(1, 0), b3, voffB);
            PG8_BAR; PG8_WAIT_L(0); PG8_MMA(0, 1, At, B1); PG8_BAR;
            PG8_LDA(At, 1, 1); PG8_STAGE(PG8_SA(1, 0), a3, w20);
            PG8_BAR; PG8_WAIT_L(0); PG8_MMA(1, 0, At, B0); PG8_BAR; PG8_SCHED;
            PG8_STAGE(PG8_SB(1, 1), b3 + hstepB, voffB);
            PG8_WAIT_V(6); PG8_BAR; PG8_MMA(1, 1, At, B1); PG8_BAR;
            }
        }
        if constexpr (ALIGN_EPI) { if (wr == 0) PG8_BAR; }
        if constexpr (ROLL) { int fr_ = fr, fq_ = fq; asm volatile("" : "+v"(fr_), "+v"(fq_)); E.half(acc, cur, 0, wr, wc, fr_, fq_, PG8_TABP(ui)); E.half(acc, cur, 1, wr, wc, fr_, fq_, PG8_TABP(ui)); pst = E.stores(cur, wc); }
        else E(acc, cur, wr, wc, fr, fq);
        S.done(cur);
        if (!has_next) break;
#pragma unroll
        for (int a = 0; a < 2; ++a)
#pragma unroll
            for (int b = 0; b < 2; ++b)
#pragma unroll
                for (int m = 0; m < 4; ++m)
#pragma unroll
                    for (int n = 0; n < 2; ++n) acc[a][b][m][n] = (f32x4){0.f, 0.f, 0.f, 0.f};
        cur = nxt; cA = nA; cB = nB; ++ui;
#pragma unroll
        for (int i = 0; i < 2; ++i) { vc0[i] = vn0[i]; vc1[i] = vn1[i]; }
        if constexpr (ALIGN_EPI) { if (wr == 1) PG8_BAR; }
    }
    PG8_WAIT_V(0);
    if constexpr (!ALIGN_EPI) { if (wr == 0) PG8_BAR; }
    PG8_BAR;
}
struct Gemm2 { const char* A0; const char* B0; unsigned rbA0, rbB0; int nt0; const char* A1; const char* B1; unsigned rbA1, rbB1; int nt1; };
constexpr int TAB2_BYTES = 4096;
template <class Epi, class Sched, bool ALIGN_EPI>
__device__ __forceinline__ void gemm_phase2(PG8_LAS unsigned char* lds, const Gemm2 g, const Sched& S, const Epi& E) {
    constexpr bool MX = false;
    const int tid = threadIdx.x, wid = __builtin_amdgcn_readfirstlane(tid >> 6), lane = tid & 63, wr = wid >> 2, wc = wid & 3, fr = lane & 15, fq = lane >> 4;
    unsigned vA0[2], vB0[2], vA1[2], vB1[2];
#pragma unroll
    for (int i = 0; i < 2; ++i) { int R, C; stage_rc(tid * 16 + i * 8192, R, C); const int Rb = Epi::PERM ? ((R & ~31) + perm32(R & 31)) : R;
        vA0[i] = (unsigned)R * g.rbA0 + (unsigned)C * 2u; vB0[i] = (unsigned)Rb * g.rbB0 + (unsigned)C * 2u; vA1[i] = (unsigned)R * g.rbA1 + (unsigned)C * 2u; vB1[i] = (unsigned)Rb * g.rbB1 + (unsigned)C * 2u; }
    const size_t kstep = (size_t)(BK * 2);
    const size_t hA0 = (size_t)HALF * g.rbA0, hB0 = (size_t)HALF * g.rbB0, hA1 = (size_t)HALF * g.rbA1, hB1 = (size_t)HALF * g.rbB1;
    const unsigned ldsw = (unsigned)wid * 1024u;
    const int aoff = lds_byte(wr * 64 + fr, fq * 8), boff = lds_byte(wc * 32 + fr, fq * 8);
#define PG8_MMA8(ai, bj, At, Bt) do { __builtin_amdgcn_s_setprio(1); _Pragma("unroll") for (int m = 0; m < 4; ++m) _Pragma("unroll") for (int n = 0; n < 2; ++n) _Pragma("unroll") for (int k = 0; k < 2; ++k) \
        acc[ai][bj][m][n] = __builtin_bit_cast(f32x4, __builtin_amdgcn_mfma_i32_16x16x64_i8(__builtin_bit_cast(i32x4, Bt[n][k]), __builtin_bit_cast(i32x4, At[m][k]), __builtin_bit_cast(i32x4, acc[ai][bj][m][n]), 0, 0, 0)); __builtin_amdgcn_s_setprio(0); } while (0)
#define PG8_MMAB(ai, bj, At, Bt) do { __builtin_amdgcn_s_setprio(1); _Pragma("unroll") for (int m = 0; m < 4; ++m) _Pragma("unroll") for (int n = 0; n < 2; ++n) _Pragma("unroll") for (int k = 0; k < 2; ++k) \
        acc[ai][bj][m][n] = __builtin_amdgcn_mfma_f32_16x16x32_bf16(Bt[n][k], At[m][k], acc[ai][bj][m][n], 0, 0, 0); __builtin_amdgcn_s_setprio(0); } while (0)
#define PG8_TAB2P(u_) ((const PG8_LAS float*)(lds + TAB_OFF + ((u_) & 1) * TAB2_BYTES))
#define PG8_SEG(NT, CA, CB, HA, HB, VA, VB, NA, NB, NHA, NHB, NVA, NVB, MMA, FIRSTSEG) \
    _Pragma("unroll 1") for (int t = 0; t < (NT); t += 2) { \
        const bool last = (t == (NT) - 2); \
        const char* a1 = (CA) + (size_t)(t + 1) * kstep; \
        const char* a2 = last ? (NA) : (CA) + (size_t)(t + 2) * kstep; const char* b2 = last ? (NB) : (CB) + (size_t)(t + 2) * kstep; \
        const char* a3 = a2 + kstep; const char* b3 = b2 + kstep; \
        const size_t hA2 = last ? (NHA) : (HA), hB2 = last ? (NHB) : (HB); \
        unsigned wa[2], wb[2]; \
        _Pragma("unroll") for (int i = 0; i < 2; ++i) { wa[i] = last ? (NVA)[i] : (VA)[i]; wb[i] = last ? (NVB)[i] : (VB)[i]; } \
        const bool rf = (FIRSTSEG) && (t == 0) && pst; \
        PG8_LDB(B0, 0, 0); PG8_LDB(B1, 0, 1); PG8_SCHED; PG8_LDA(At, 0, 0); PG8_STAGE(PG8_SA(1, 1), a1 + (HA), (VA)); \
        if ((FIRSTSEG) && t == 2) { for (int q = wid; q < 4 * Epi::NTAB; q += 8) __builtin_amdgcn_global_load_lds((const unsigned*)E.tab_src(cur, q * 64 + lane), (PG8_LAS unsigned*)(lds + TAB_OFF + (ui & 1) * TAB2_BYTES + q * 256), 4, 0, 0); } \
        if (rf) PG8_WAIT_VN(8 + 2 * Epi::NS); else PG8_WAIT_V(8); \
        PG8_WAIT_L(0); PG8_BAR; MMA(0, 0, At, B0); MMA(0, 1, At, B1); PG8_BAR; PG8_SCHED; \
        PG8_LDA(At, 0, 1); PG8_STAGE(PG8_SB(0, 0), b2, wb); PG8_STAGE(PG8_SB(0, 1), b2 + hB2, wb); PG8_STAGE(PG8_SA(0, 0), a2, wa); \
        if (rf) PG8_WAIT_VN(8 + 2 * Epi::NS); else PG8_WAIT_V(8); \
        PG8_WAIT_L(0); PG8_BAR; MMA(1, 0, At, B0); MMA(1, 1, At, B1); PG8_BAR; PG8_SCHED; \
        PG8_LDB(B0, 1, 0); PG8_LDB(B1, 1, 1); PG8_SCHED; PG8_LDA(At, 1, 0); PG8_STAGE(PG8_SA(0, 1), a2 + hA2, wa); \
        PG8_WAIT_V(8); PG8_WAIT_L(0); PG8_BAR; MMA(0, 0, At, B0); MMA(0, 1, At, B1); PG8_BAR; PG8_SCHED; \
        PG8_LDA(At, 1, 1); PG8_STAGE(PG8_SB(1, 0), b3, wb); PG8_STAGE(PG8_SB(1, 1), b3 + hB2, wb); PG8_STAGE(PG8_SA(1, 0), a3, wa); \
        PG8_WAIT_V(8); PG8_WAIT_L(0); PG8_BAR; MMA(1, 0, At, B0); MMA(1, 1, At, B1); PG8_BAR; PG8_SCHED; \
    }
    Unit cur, nxt; int ui = 0; bool pst = false;
    if (!S.next(0, cur)) return;
    f32x4 acc[2][2][4][2];
#pragma unroll
    for (int a = 0; a < 2; ++a) PG8_ZERO(a);
    bf16x8 At[4][2], B0[2][2], B1[2][2]; i32x8 AtX[4], B0X[2], B1X[2]; (void)AtX; (void)B0X; (void)B1X;
    const char* cA0 = g.A0 + (size_t)cur.pm * 2 * hA0; const char* cB0 = g.B0 + (size_t)cur.pn * 2 * hB0;
    const char* cA1 = g.A1 + (size_t)cur.pm * 2 * hA1; const char* cB1 = g.B1 + (size_t)cur.pn * 2 * hB1;
    PG8_STAGE(PG8_SB(0, 0), cB0, vB0); PG8_STAGE(PG8_SB(0, 1), cB0 + hB0, vB0); PG8_STAGE(PG8_SA(0, 0), cA0, vA0); PG8_STAGE(PG8_SA(0, 1), cA0 + hA0, vA0);
    if (wr == 1) PG8_BAR;
    PG8_WAIT_V(2); PG8_BAR;
    PG8_STAGE(PG8_SB(1, 0), cB0 + kstep, vB0); PG8_STAGE(PG8_SA(1, 0), cA0 + kstep, vA0); PG8_STAGE(PG8_SB(1, 1), cB0 + hB0 + kstep, vB0);
    PG8_WAIT_V(6); PG8_BAR;
    for (;;) {
        const bool has_next = S.next(ui + 1, nxt);
        const char* nA0 = has_next ? g.A0 + (size_t)nxt.pm * 2 * hA0 : cA0; const char* nB0 = has_next ? g.B0 + (size_t)nxt.pn * 2 * hB0 : cB0;
        PG8_SEG(g.nt0, cA0, cB0, hA0, hB0, vA0, vB0, cA1, cB1, hA1, hB1, vA1, vB1, PG8_MMA8, true)
        { int fr_ = fr, fq_ = fq; asm volatile("" : "+v"(fr_), "+v"(fq_)); E.mid(acc, cur, wr, wc, fr_, fq_, PG8_TAB2P(ui)); }
        PG8_SCHED;
        PG8_SEG(g.nt1, cA1, cB1, hA1, hB1, vA1, vB1, nA0, nB0, hA0, hB0, vA0, vB0, PG8_MMAB, false)
        if constexpr (ALIGN_EPI) { if (wr == 0) PG8_BAR; }
        { int fr_ = fr, fq_ = fq; asm volatile("" : "+v"(fr_), "+v"(fq_)); E.half(acc, cur, 0, wr, wc, fr_, fq_, PG8_TAB2P(ui)); E.half(acc, cur, 1, wr, wc, fr_, fq_, PG8_TAB2P(ui)); pst = E.stores(cur, wc); }
        if (!has_next) break;
#pragma unroll
        for (int a = 0; a < 2; ++a) PG8_ZERO(a);
        cur = nxt; cA0 = nA0; cB0 = nB0; cA1 = g.A1 + (size_t)cur.pm * 2 * hA1; cB1 = g.B1 + (size_t)cur.pn * 2 * hB1; ++ui;
        if constexpr (ALIGN_EPI) { if (wr == 1) PG8_BAR; }
    }
    PG8_WAIT_V(0);
    if constexpr (!ALIGN_EPI) { if (wr == 0) PG8_BAR; }
    PG8_BAR;
#undef PG8_SEG
#undef PG8_MMA8
#undef PG8_MMAB
#undef PG8_TAB2P
#undef PG8_SA
#undef PG8_SB
#undef PG8_STAGE
#undef PG8_LDA
#undef PG8_LD32
#undef PG8_LDB
#undef PG8_MMA
#undef PG8_WAIT_V
#undef PG8_WAIT_VN
#undef PG8_ZERO
#undef PG8_TABP
#undef PG8_WAIT_L
#undef PG8_BAR
#undef PG8_SCHED
}
}

#ifndef PG8_SP2
#define PG8_SP2 true
#endif
#ifndef PG8_ALIGN
#define PG8_ALIGN true
#endif
#ifndef PG8_ROLL
#define PG8_ROLL true
#endif
#ifndef PG8_ROLL2
#define PG8_ROLL2 PG8_ROLL
#endif
#ifndef PG8_ROLL5
#define PG8_ROLL5 PG8_ROLL
#endif
#ifndef PG8_ROLL7
#define PG8_ROLL7 PG8_ROLL
#endif
#ifndef PG8_ROLL8
#define PG8_ROLL8 PG8_ROLL
#endif

constexpr int NWAVES = 8, NTHR = 512;
constexpr int D = 4096, NB = 4, SEQ = 4096, T = NB * SEQ, CTXL = 256, TC = NB * CTXL, TA = T + TC;
constexpr int NH = 8, DK = 128, DV = 256;
constexpr int COL_Q = 0, COL_O = 1024, COL_CB = 3072, COL_CC = 5120, COL_CX = 7168, COL_K = 9216, COL_V = 10240, COL_G = 12288;
constexpr int NPROJ = 12288, IN_COLS = 12320, NPAD = 12544;
constexpr int NE = 16, FF = 1024, ADA_N = 6 * D;
constexpr int HM_ROWS = 2 * T + NE * 256;
constexpr float EPS = 1e-6f;

constexpr size_t MiB = 1u << 20;
constexpr size_t WS_CTL = 0, CTL_ZERO_BYTES = 1 * MiB;
constexpr size_t WS_ADA = 1 * MiB;
constexpr size_t WS_GATES = 2 * MiB;
constexpr size_t WS_ELIST = 5 * MiB;
constexpr size_t WS_EW = 6 * MiB;
constexpr size_t WS_WIN = 8 * MiB;
constexpr size_t WS_WOUT = 106 * MiB;
constexpr size_t WS_WE1 = 138 * MiB;
constexpr size_t WS_WE2 = 394 * MiB;
constexpr size_t WS_XM = 522 * MiB;
constexpr size_t WS_PROJ = 658 * MiB;
constexpr size_t WS_SLOT = WS_PROJ, WS_HMOE = WS_PROJ + 256 * MiB;
constexpr size_t WS_HF = 1066 * MiB, WS_HB = 1194 * MiB;
constexpr size_t WS_X1 = 1322 * MiB;
constexpr size_t WS_XM8 = 1578 * MiB;
constexpr size_t WS_WO8 = 1646 * MiB;
constexpr size_t WS_WI8 = 1646 * MiB;
constexpr size_t WS_SA = 1696 * MiB, WS_SB = WS_SA + 256 * 1024;
constexpr size_t WS_END = 1698 * MiB;
static_assert(WS_XM8 + (size_t)TA * D <= WS_WI8 && WS_WI8 + (size_t)NPAD * D <= WS_SA, "ws map int8");
static_assert(WS_GATES + (size_t)TA * 32 * 4 <= WS_ELIST && WS_WIN + (size_t)NPAD * D * 2 <= WS_WOUT && WS_XM + (size_t)TA * D * 2 <= WS_PROJ && WS_PROJ + (size_t)TA * NPROJ * 2 <= WS_HF, "ws map");
static_assert(WS_HMOE + (size_t)HM_ROWS * FF * 2 <= WS_HF, "ws map 2");
constexpr int CW_TMO = 0, CW_CODE = 1, CW_TQ = 1024, CW_CNT = 2048, CW_CMAX = 32768, CW_CMAX2 = 49152, CW_BAR = 4096, CW_RT = 16384;

constexpr int RING_BYTES = 131072;
constexpr int LDS_BYTES = 147456;
constexpr int LDSCTL_OFF = LDS_BYTES - 3072;
constexpr int MISC_OFF = LDSCTL_OFF + 320;
constexpr int MOE_OFF = LDSCTL_OFF + 512;
constexpr int ROWTAB_OFF = LDSCTL_OFF + 1024;

#define GAS __attribute__((address_space(1)))
#define LAS __attribute__((address_space(3)))
typedef unsigned short bf16;
typedef unsigned v4u __attribute__((ext_vector_type(4)));
typedef unsigned v2u __attribute__((ext_vector_type(2)));
typedef unsigned v3u __attribute__((ext_vector_type(3)));
typedef float f32x4 __attribute__((ext_vector_type(4)));
typedef GAS unsigned gu32;
#define RLX_AGENT __ATOMIC_RELAXED, __HIP_MEMORY_SCOPE_AGENT
#define LDS_WAIT() asm volatile("s_waitcnt lgkmcnt(0)" ::: "memory")
#define VM_WAIT() asm volatile("s_waitcnt vmcnt(0)" ::: "memory")
__device__ __forceinline__ unsigned pk2(float lo, float hi) { return pg8::cvt_pk_bf16(lo, hi); }
__device__ __forceinline__ float bf_lo(unsigned u) { return __uint_as_float(u << 16); }
__device__ __forceinline__ float bf_hi(unsigned u) { return __uint_as_float(u & 0xffff0000u); }
__device__ __forceinline__ float bf1(bf16 u) { return __uint_as_float(((unsigned)u) << 16); }
__device__ __forceinline__ unsigned pk4_fp8(float a, float b, float c, float d) { int p = __builtin_amdgcn_cvt_pk_fp8_f32(a, b, 0, false); p = __builtin_amdgcn_cvt_pk_fp8_f32(c, d, p, true); return (unsigned)p; }
__device__ __forceinline__ unsigned pk4_i8(float a, float b, float c, float d) { return ((unsigned)(int)rintf(a) & 255u) | (((unsigned)(int)rintf(b) & 255u) << 8) | (((unsigned)(int)rintf(c) & 255u) << 16) | ((unsigned)(int)rintf(d) << 24); }
constexpr float W1_SCALE = 64.f, W2_SCALE = 32.f, SLOT_SCALE = 16.f;
typedef float f32x2v __attribute__((ext_vector_type(2)));
__device__ __forceinline__ f32x4 fp8x4_to_f32(unsigned v) { const f32x2v lo = __builtin_amdgcn_cvt_pk_f32_fp8((int)v, false), hi = __builtin_amdgcn_cvt_pk_f32_fp8((int)v, true); return (f32x4){lo[0], lo[1], hi[0], hi[1]}; }
__device__ __forceinline__ v3u blk8_pack(const float (&v)[8]) {
    float mx = 0.f;
#pragma unroll
    for (int i = 0; i < 8; ++i) mx = fmaxf(mx, fabsf(v[i]));
    const unsigned sb = pk2(mx * (1.f / 126.f), 0.f) & 0xffffu; const float s = __uint_as_float(sb << 16), iv = s > 0.f ? __builtin_amdgcn_rcpf(s) : 0.f;
    return (v3u){pk4_i8(v[0] * iv, v[1] * iv, v[2] * iv, v[3] * iv), pk4_i8(v[4] * iv, v[5] * iv, v[6] * iv, v[7] * iv), sb};
}
__device__ __forceinline__ void blk8_unpack(const v3u r, float (&v)[8]) {
    const float s = __uint_as_float(r.z << 16);
#pragma unroll
    for (int i = 0; i < 4; ++i) { v[i] = (float)((int)(r.x << (24 - 8 * i)) >> 24) * s; v[4 + i] = (float)((int)(r.y << (24 - 8 * i)) >> 24) * s; }
}
__device__ __forceinline__ float sig255(float x) { return 255.f * __builtin_amdgcn_rcpf(1.f + __expf(-x)); }
__device__ __forceinline__ float sigmoidf_(float x) { return 1.f / (1.f + __expf(-x)); }

#define XB_TMO      128
#define XB_XCNT(j)  (256  + 64 * (j))
#define XB_XSUB(j)  (1280 + 64 * (j))
#define XB_XGEN(j)  (2304 + 64 * (j))
#define XB_TOP      3328
#define XB_TOPGEN   3392
#define XCD_BAR_WORDS 3456
#define XB_SPIN_CAP (1u << 22)
__device__ __forceinline__ unsigned xb_ld(unsigned* p)              { return __hip_atomic_load(p, __ATOMIC_RELAXED, __HIP_MEMORY_SCOPE_AGENT); }
__device__ __forceinline__ unsigned xb_add(unsigned* p, unsigned v) { return __hip_atomic_fetch_add(p, v, __ATOMIC_RELAXED, __HIP_MEMORY_SCOPE_AGENT); }
__device__ __forceinline__ unsigned xb_xcc_id() { return (unsigned)__builtin_amdgcn_s_getreg((3 << 11) | 20) & 0xFu; }
#define XB_SPIN(cond, bar) do { unsigned _sp = 0; while (cond) { __builtin_amdgcn_s_sleep(1); \
    if ((++_sp & 255u) == 0u) { if (xb_ld(&(bar)[XB_TMO])) break; if (_sp > XB_SPIN_CAP) { atomicAdd(&(bar)[XB_TMO], 1u); break; } } } } while (0)
struct XcdBarrier { unsigned* bar; unsigned x; volatile LAS unsigned* st; };
__device__ __forceinline__ XcdBarrier xcd_barrier_post(unsigned* bar, volatile LAS unsigned* st) {
    XcdBarrier b; b.bar = bar; b.x = xb_xcc_id(); b.st = st;
    if (threadIdx.x == 0) (void)xb_add(&bar[XB_XCNT(b.x)], 1u);
    return b;
}
__device__ __forceinline__ void xcd_barrier_complete(unsigned* bar, unsigned x, unsigned& nloc, unsigned& nx) {
    const unsigned G = gridDim.x * gridDim.y * gridDim.z;
    unsigned sum, cnt, mine, sp = 0u;
    for (;;) {
        sum = 0u; cnt = 0u; mine = 0u;
#pragma unroll
        for (unsigned j = 0; j < 16; ++j) { const unsigned c = xb_ld(&bar[XB_XCNT(j)]); sum += c; cnt += (c > 0u) ? 1u : 0u; mine = (j == x) ? c : mine; }
        if (sum == G) break;
        __builtin_amdgcn_s_sleep(1);
        if ((++sp & 255u) == 0u) { if (xb_ld(&bar[XB_TMO])) break; if (sp > XB_SPIN_CAP) { atomicAdd(&bar[XB_TMO], 1u); break; } }
    }
    nloc = mine > 0u ? mine : 1u; nx = cnt > 0u ? cnt : 1u;
}
__device__ __forceinline__ void xcd_barrier(const XcdBarrier& b) {
    asm volatile("s_waitcnt vmcnt(0)" ::: "memory");
    __syncthreads();
    if (threadIdx.x == 0) {
        unsigned* bar = b.bar;
        __builtin_amdgcn_s_waitcnt(0);
        unsigned nloc = b.st[0], nx = b.st[1];
        if (nloc == 0u) { xcd_barrier_complete(bar, b.x, nloc, nx); b.st[0] = nloc; b.st[1] = nx; }
        const unsigned old = xb_add(&bar[XB_XSUB(b.x)], 1u);
        const unsigned gen = old / nloc;
        if (old + 1u == (gen + 1u) * nloc) {
            __builtin_amdgcn_fence(__ATOMIC_RELEASE, "agent");
            asm volatile("s_waitcnt vmcnt(0)" ::: "memory");
            const unsigned og = xb_add(&bar[XB_TOP], 1u);
            const unsigned tg = og / nx;
            if (og + 1u == (tg + 1u) * nx) xb_add(&bar[XB_TOPGEN], 1u);
            else XB_SPIN(xb_ld(&bar[XB_TOPGEN]) == tg, bar);
            __builtin_amdgcn_fence(__ATOMIC_ACQUIRE, "agent");
            xb_add(&bar[XB_XGEN(b.x)], 1u);
            asm volatile("s_waitcnt vmcnt(0)" ::: "memory");
        } else {
            XB_SPIN(xb_ld(&bar[XB_XGEN(b.x)]) == gen, bar);
            __builtin_amdgcn_fence(__ATOMIC_ACQUIRE, "agent");
            asm volatile("s_waitcnt vmcnt(0)" ::: "memory");
        }
    }
    __syncthreads();
}

struct Frame {
    LAS unsigned char* lds;
    volatile LAS unsigned* MISC;
    gu32* ctl;
    int tid, lane, wave;
    int vcu, G;
    const float *x, *c, *ctx, *cctx, *w_ada, *b_ada, *norm1, *w_in, *b_gates, *conv_w, *head_norm, *w_out, *norm2, *w_rg, *b_rg, *w_re, *b_re, *w_e1, *w_e2, *fnorm;
    float* out;
    float *ADA, *GATES, *EW;
    bf16 *DELTA, *X1B;
    unsigned char *XM8, *WO8, *MIXA8, *WOA8; signed char* WI8; float *SA, *SB, *SB2;
    bf16 *HF, *HB;
    int* ELIST;
    bf16 *WIN, *WOUT, *WE1, *WE2, *XM, *PROJ, *MIX, *XF, *SLOT, *HMOE;
};

template <int CTRL, int ROWMASK> __device__ __forceinline__ float dpp_f(float old, float src) {
    return __builtin_bit_cast(float, __builtin_amdgcn_update_dpp(__builtin_bit_cast(int, old), __builtin_bit_cast(int, src), CTRL, ROWMASK, 0xf, false)); }
__device__ __forceinline__ float wave_incl_sum(float v) {
    v += dpp_f<0x111, 0xf>(0.f, v); v += dpp_f<0x112, 0xf>(0.f, v); v += dpp_f<0x114, 0xf>(0.f, v); v += dpp_f<0x118, 0xf>(0.f, v);
    v += dpp_f<0x142, 0xa>(0.f, v); v += dpp_f<0x143, 0xc>(0.f, v); return v; }
__device__ __forceinline__ float wave_incl_max(float v) {
    constexpr float NI = -3.0e38f;
    v = fmaxf(v, dpp_f<0x111, 0xf>(NI, v)); v = fmaxf(v, dpp_f<0x112, 0xf>(NI, v)); v = fmaxf(v, dpp_f<0x114, 0xf>(NI, v)); v = fmaxf(v, dpp_f<0x118, 0xf>(NI, v));
    v = fmaxf(v, dpp_f<0x142, 0xa>(NI, v)); v = fmaxf(v, dpp_f<0x143, 0xc>(NI, v)); return v; }
__device__ __forceinline__ float lane_bcast(float v, int l) { return __builtin_bit_cast(float, __builtin_amdgcn_readlane(__builtin_bit_cast(int, v), l)); }
__device__ __forceinline__ float wave_sum(float v) { return lane_bcast(wave_incl_sum(v), 63); }
__device__ __forceinline__ float wave_max(float v) { return lane_bcast(wave_incl_max(v), 63); }

__device__ __forceinline__ void p0_ada(Frame& F) {
    LAS float* sil = (LAS float*)F.lds;
    LAS float* red = (LAS float*)(F.lds + 81920);
    for (int i = F.tid; i < 5 * D; i += NTHR) { const int b = i >> 12, k = i & (D - 1); const float cv = b < 4 ? F.c[b * D + k] : F.cctx[k]; sil[i] = cv / (1.f + expf(-cv)); }
    __syncthreads();
    const int cq = F.tid % 24, rg = F.tid / 24;
    for (int item = F.vcu; item < ADA_N / 96; item += F.G) {
        const int col0 = item * 96;
        float acc[5][4];
#pragma unroll
        for (int b = 0; b < 5; ++b)
#pragma unroll
            for (int j = 0; j < 4; ++j) acc[b][j] = 0.f;
        if (rg < 21) {
            const float* wp = F.w_ada + col0 + 4 * cq;
#pragma unroll 13
            for (int r = rg; r < D; r += 21) {
                const f32x4 w = *(const f32x4*)(wp + (size_t)r * ADA_N);
#pragma unroll
                for (int b = 0; b < 5; ++b) { const float s = sil[b * D + r];
#pragma unroll
                    for (int j = 0; j < 4; ++j) acc[b][j] += s * w[j]; }
            }
#pragma unroll
            for (int b = 0; b < 5; ++b)
#pragma unroll
                for (int j = 0; j < 4; ++j) red[rg * 480 + b * 96 + 4 * cq + j] = acc[b][j];
        }
        __syncthreads();
        if (F.tid < 480) { const int b = F.tid / 96, cc = F.tid % 96; float s = 0.f;
#pragma unroll
            for (int q = 0; q < 21; ++q) s += red[q * 480 + F.tid];
            F.ADA[b * ADA_N + col0 + cc] = s + F.b_ada[col0 + cc]; }
        __syncthreads();
    }
}
__device__ __forceinline__ int win_row(int n) {
    if (n < COL_CC || n >= COL_K) return n;
    const int rel = n - COL_CC, au = rel >> 11, r = rel & 2047;
    return COL_CC + 256 * (r >> 7) + 128 * au + (r & 127);
}
struct TItem { const float* W; bf16* WT; const void* cmax; unsigned* cmo; int K, N, nblk, row_off, item, map, f8; float scale; };
template <int KIND>
__device__ __forceinline__ TItem titem_decode(Frame& F, int r) {
    constexpr int I_E1 = (D / 64) * (2 * FF / 32), I_E2 = (FF / 64) * (D / 32);
    TItem t; t.cmax = (const void*)(F.ctl + CW_CMAX); t.cmo = nullptr;
    if (KIND == 8) { t.W = F.w_in; t.WT = (bf16*)F.WI8; t.K = D; t.N = IN_COLS; t.nblk = IN_COLS / 32; t.row_off = 0; t.item = (D / 64) * (IN_COLS / 32) - 1 - r; t.map = 2; t.f8 = 2; t.scale = 1.f; }
    else if (KIND == 0) { t.W = F.w_in; t.WT = F.WIN; t.K = D; t.N = IN_COLS; t.nblk = IN_COLS / 32; t.row_off = 0; t.map = 0; t.f8 = 0; t.scale = 1.f;
        { constexpr int NBP = (IN_COLS - COL_K) / 32; const int kb = r / NBP, nbp = r % NBP; t.item = kb * (IN_COLS / 32) + COL_K / 32 + nbp; } }
    else if (KIND == 1) { t.W = F.w_out; t.WT = F.WOUT; t.K = D; t.N = D; t.nblk = D / 32; t.row_off = 0; t.item = r; t.map = 0; t.f8 = 0; t.scale = 1.f; t.cmo = (unsigned*)(F.ctl + CW_CMAX2); }
    else if (KIND == 2) { const int e = r / I_E1; t.W = F.w_e1 + (size_t)e * D * 2 * FF; t.WT = F.WE1; t.K = D; t.N = 2 * FF; t.nblk = 2 * FF / 32; t.row_off = e * 2 * FF; t.item = r % I_E1; t.map = 1; t.f8 = 1; t.scale = W1_SCALE; }
    else { const int e = r / I_E2; t.W = F.w_e2 + (size_t)e * FF * D; t.WT = F.WE2; t.K = FF; t.N = D; t.nblk = D / 32; t.row_off = e * D; t.item = r % I_E2; t.map = 0; t.f8 = 1; t.scale = W2_SCALE; }
    return t;
}
__device__ __forceinline__ void titem_load(const TItem& t, int lane, f32x4 (&v)[8]) {
    const int nblk = t.nblk, kb = t.item / nblk, nb = t.item % nblk, k0 = 64 * kb, n0 = 32 * nb;
    const float* p = t.W + (size_t)(k0 + (lane >> 3)) * t.N + n0 + 4 * (lane & 7);
#pragma unroll
    for (int i = 0; i < 8; ++i) v[i] = *(const f32x4*)(p + (size_t)(8 * i) * t.N);
}
__device__ __forceinline__ void titem_finish(const TItem& cur, LAS float* scr, int lane) {
    const int nblk = cur.nblk, kb = cur.item / nblk, nb = cur.item % nblk, k0 = 64 * kb, n0 = 32 * nb, c = lane & 7;
#pragma unroll
    for (int j = 0; j < 4; ++j) { const int n = (lane >> 3) + 8 * j; const LAS float* s = scr + (8 * c) * 33 + n;
        const int nn = n0 + n; int row;
        if (cur.map == 0) row = cur.row_off + nn;
        else if (cur.map == 2) row = win_row(nn);
        else { const int au = nn >> 10, r = nn & 1023; row = cur.row_off + 256 * (r >> 7) + 128 * au + (r & 127); }
        const float sc = cur.scale;
        if (cur.f8 == 2) { const float cm = __uint_as_float(((const unsigned*)cur.cmax)[nn]), iv = cm > 0.f ? 127.f / cm : 0.f;
            *(v2u*)((unsigned char*)cur.WT + (size_t)row * cur.K + k0 + 8 * c) = (v2u){pk4_i8(s[0 * 33] * iv, s[1 * 33] * iv, s[2 * 33] * iv, s[3 * 33] * iv), pk4_i8(s[4 * 33] * iv, s[5 * 33] * iv, s[6 * 33] * iv, s[7 * 33] * iv)}; }
        else if (cur.f8) { *(v2u*)((unsigned char*)cur.WT + (size_t)row * cur.K + k0 + 8 * c) = (v2u){pk4_fp8(s[0 * 33] * sc, s[1 * 33] * sc, s[2 * 33] * sc, s[3 * 33] * sc), pk4_fp8(s[4 * 33] * sc, s[5 * 33] * sc, s[6 * 33] * sc, s[7 * 33] * sc)}; }
        else { v4u o; o.x = pk2(s[0 * 33], s[1 * 33]); o.y = pk2(s[2 * 33], s[3 * 33]); o.z = pk2(s[4 * 33], s[5 * 33]); o.w = pk2(s[6 * 33], s[7 * 33]);
               *(v4u*)(cur.WT + (size_t)row * cur.K + k0 + 8 * c) = o;
               if (cur.cmo != nullptr && k0 < D / 2) {
                   unsigned mx = max(max(max((o.x & 0x7fffu) << 16, o.x & 0x7fff0000u), max((o.y & 0x7fffu) << 16, o.y & 0x7fff0000u)), max(max((o.z & 0x7fffu) << 16, o.z & 0x7fff0000u), max((o.w & 0x7fffu) << 16, o.w & 0x7fff0000u)));
                   mx = max(mx, (unsigned)__shfl_xor((int)mx, 1)); mx = max(mx, (unsigned)__shfl_xor((int)mx, 2)); mx = max(mx, (unsigned)__shfl_xor((int)mx, 4));
                   if (c == 0) (void)__hip_atomic_fetch_max(cur.cmo + nn, mx, RLX_AGENT); } } }
}
constexpr int TI_IN = (D / 64) * (IN_COLS / 32), TI_OUT = (D / 64) * (D / 32), TI_E1 = (D / 64) * (2 * FF / 32), TI_E2 = (FF / 64) * (D / 32);
template <int KIND>
__device__ __forceinline__ void transpose_range(Frame& F, LAS float* scr, int it0, int it_end, int stride) {
    const int lane = F.lane;
    f32x4 v[8];
    int it = it0;
    TItem cur = titem_decode<KIND>(F, it < it_end ? it : 0);
    if (it < it_end) titem_load(cur, lane, v);
    while (it < it_end) {
#pragma unroll
        for (int i = 0; i < 8; ++i) { const int kk = 8 * i + (lane >> 3); LAS float* s = scr + kk * 33 + 4 * (lane & 7); s[0] = v[i][0]; s[1] = v[i][1]; s[2] = v[i][2]; s[3] = v[i][3]; }
        const int nit = it + stride;
        TItem nxt = cur;
        if (nit < it_end) { nxt = titem_decode<KIND>(F, nit); titem_load(nxt, lane, v); }
        LDS_WAIT(); asm volatile("" ::: "memory");
        titem_finish(cur, scr, lane);
        LDS_WAIT(); asm volatile("" ::: "memory");
        cur = nxt; it = nit;
    }
}
__device__ __forceinline__ void p0_transposes(Frame& F) {
    LAS float* scr = (LAS float*)(F.lds + F.wave * 8704);
    const int gw = F.vcu * NWAVES + F.wave, NGW = F.G * NWAVES;
    transpose_range<1>(F, scr, gw, TI_OUT, NGW);
    {
        constexpr int NIT = (D / 64) * (IN_COLS / 32);
        const int lane = F.lane;
        auto cm_load = [&](int it, f32x4 (&w)[8]) __attribute__((always_inline)) {
            const int itc = it < NIT ? it : NIT - 1, kb = itc / (IN_COLS / 32), nb = itc % (IN_COLS / 32);
            const float* p = F.w_in + (size_t)(64 * kb + (lane >> 3)) * IN_COLS + 32 * nb + 4 * (lane & 7);
#pragma unroll
            for (int i = 0; i < 8; ++i) w[i] = *(const f32x4*)(p + (size_t)(8 * i) * IN_COLS);
        };
        auto cm_step = [&](int it, f32x4 (&cur)[8], f32x4 (&nxt)[8]) __attribute__((always_inline)) {
            cm_load(it + NGW, nxt);
            if (it < NIT) {
                const int nb = it % (IN_COLS / 32);
                f32x4 mx = (f32x4){0.f, 0.f, 0.f, 0.f};
#pragma unroll
                for (int i = 0; i < 8; ++i) { mx[0] = fmaxf(mx[0], fabsf(cur[i][0])); mx[1] = fmaxf(mx[1], fabsf(cur[i][1])); mx[2] = fmaxf(mx[2], fabsf(cur[i][2])); mx[3] = fmaxf(mx[3], fabsf(cur[i][3])); }
#pragma unroll
                for (int o = 8; o < 64; o <<= 1) { mx[0] = fmaxf(mx[0], __shfl_xor(mx[0], o)); mx[1] = fmaxf(mx[1], __shfl_xor(mx[1], o)); mx[2] = fmaxf(mx[2], __shfl_xor(mx[2], o)); mx[3] = fmaxf(mx[3], __shfl_xor(mx[3], o)); }
                if (lane < 8) { unsigned* cm = (unsigned*)(F.ctl + CW_CMAX) + 32 * nb + 4 * lane;
#pragma unroll
                    for (int j = 0; j < 4; ++j) asm volatile("global_atomic_umax %0, %1, off" :: "v"(cm + j), "v"(__float_as_uint(mx[j])) : "memory"); }
            }
        };
        f32x4 wa[8], wb[8];
        cm_load(gw, wa);
        for (int it = gw; it < NIT; it += 2 * NGW) { cm_step(it, wa, wb); cm_step(it + NGW, wb, wa); }
        asm volatile("s_waitcnt vmcnt(0) ; hidden atomics" ::: "memory");
    }
    { const size_t n16 = (size_t)(NPAD - IN_COLS) * D / 16; v4u* p = (v4u*)(F.WI8 + (size_t)IN_COLS * D);
      for (size_t i = (size_t)F.vcu * NTHR + F.tid; i < n16; i += (size_t)F.G * NTHR) p[i] = (v4u){0u, 0u, 0u, 0u}; }
}
__device__ __forceinline__ int expert_queue_items(int G) { const int tot = NE * (TI_E1 + TI_E2), p3 = (4 + SEQ / 64) * G * NWAVES / 2; return tot > p3 ? tot - p3 : 0; }
struct HItem { const float* src; unsigned char* dst; int N, Kb, map, row0; float scale; };
__device__ __forceinline__ HItem hitem_decode(Frame& F, int hi) {
    const int fi = hi >> 1, sub = hi & 1; HItem t;
    if (fi < NE * TI_E1) { const int e = fi / TI_E1, item = fi % TI_E1, kb = item >> 6, nb = item & 63, n0 = 32 * nb + 16 * sub;
        t.N = 2 * FF; t.Kb = D; t.map = 1; t.scale = W1_SCALE; t.src = F.w_e1 + (size_t)e * D * 2 * FF + (size_t)(64 * kb) * t.N + n0;
        const int au = n0 >> 10, r = n0 & 1023; t.row0 = e * 2 * FF + 256 * (r >> 7) + 128 * au + (r & 127); t.dst = (unsigned char*)F.WE1 + 64 * kb; }
    else { const int f2 = fi - NE * TI_E1, e = f2 / TI_E2, item = f2 % TI_E2, kb = item >> 7, nb = item & 127, n0 = 32 * nb + 16 * sub;
        t.N = D; t.Kb = FF; t.map = 0; t.scale = W2_SCALE; t.src = F.w_e2 + (size_t)e * FF * D + (size_t)(64 * kb) * t.N + n0;
        t.row0 = e * D + n0; t.dst = (unsigned char*)F.WE2 + 64 * kb; }
    return t;
}
__device__ __forceinline__ void hitem_load(const HItem& t, int lane, f32x4 (&v)[4]) {
    const float* p = t.src + (size_t)(lane >> 2) * t.N + 4 * (lane & 3);
#pragma unroll
    for (int i = 0; i < 4; ++i) v[i] = *(const f32x4*)(p + (size_t)(16 * i) * t.N);
}
__device__ __forceinline__ void hitem_to_lds(int lane, const f32x4 (&v)[4], LAS float* scr) {
#pragma unroll
    for (int i = 0; i < 4; ++i) { LAS float* s = scr + (16 * i + (lane >> 2)) * 17 + 4 * (lane & 3); s[0] = v[i][0]; s[1] = v[i][1]; s[2] = v[i][2]; s[3] = v[i][3]; }
}
__device__ __forceinline__ void hitem_store(const HItem& t, int lane, LAS float* scr) {
    LDS_WAIT(); asm volatile("" ::: "memory");
    const int n = lane & 15, kc = lane >> 4; const LAS float* s = scr + (16 * kc) * 17 + n; const float sc = t.scale;
    v4u o;
    o.x = pk4_fp8(s[0 * 17] * sc, s[1 * 17] * sc, s[2 * 17] * sc, s[3 * 17] * sc); o.y = pk4_fp8(s[4 * 17] * sc, s[5 * 17] * sc, s[6 * 17] * sc, s[7 * 17] * sc);
    o.z = pk4_fp8(s[8 * 17] * sc, s[9 * 17] * sc, s[10 * 17] * sc, s[11 * 17] * sc); o.w = pk4_fp8(s[12 * 17] * sc, s[13 * 17] * sc, s[14 * 17] * sc, s[15 * 17] * sc);
    *(v4u*)(t.dst + (size_t)(t.row0 + n) * t.Kb + 16 * kc) = o;
    LDS_WAIT(); asm volatile("" ::: "memory");
}
__device__ __forceinline__ void gstore8_hidden(void* p, v2u v) { asm volatile("global_store_dwordx2 %0, %1, off" :: "v"(p), "v"(v) : "memory"); }
__device__ __forceinline__ void gstore16_hidden(void* p, v4u v) { asm volatile("global_store_dwordx4 %0, %1, off" :: "v"(p), "v"(v) : "memory"); }
__device__ __forceinline__ void hitem_store_hidden(const HItem& t, int lane, LAS float* scr) {
    LDS_WAIT(); asm volatile("" ::: "memory");
    const int n = lane & 15, kc = lane >> 4; const LAS float* s = scr + (16 * kc) * 17 + n; const float sc = t.scale;
    v4u o;
    o.x = pk4_fp8(s[0 * 17] * sc, s[1 * 17] * sc, s[2 * 17] * sc, s[3 * 17] * sc); o.y = pk4_fp8(s[4 * 17] * sc, s[5 * 17] * sc, s[6 * 17] * sc, s[7 * 17] * sc);
    o.z = pk4_fp8(s[8 * 17] * sc, s[9 * 17] * sc, s[10 * 17] * sc, s[11 * 17] * sc); o.w = pk4_fp8(s[12 * 17] * sc, s[13 * 17] * sc, s[14 * 17] * sc, s[15 * 17] * sc);
    gstore16_hidden(t.dst + (size_t)(t.row0 + n) * t.Kb + 16 * kc, o);
    LDS_WAIT(); asm volatile("" ::: "memory");
}
__device__ __forceinline__ void hitem_read(int lane, const LAS float* scr, float (&hr)[16]) {
    const int n = lane & 15, kc = lane >> 4; const LAS float* s = scr + (16 * kc) * 17 + n;
#pragma unroll
    for (int j = 0; j < 16; ++j) hr[j] = s[j * 17];
}
__device__ __forceinline__ void hitem_pack_store(const HItem& t, int lane, const float (&hr)[16]) {
    const int n = lane & 15, kc = lane >> 4; const float sc = t.scale;
    v4u o;
    o.x = pk4_fp8(hr[0] * sc, hr[1] * sc, hr[2] * sc, hr[3] * sc); o.y = pk4_fp8(hr[4] * sc, hr[5] * sc, hr[6] * sc, hr[7] * sc);
    o.z = pk4_fp8(hr[8] * sc, hr[9] * sc, hr[10] * sc, hr[11] * sc); o.w = pk4_fp8(hr[12] * sc, hr[13] * sc, hr[14] * sc, hr[15] * sc);
    gstore16_hidden(t.dst + (size_t)(t.row0 + n) * t.Kb + 16 * kc, o);
}
constexpr int TQ_BATCH = 16;
static_assert((NE * TI_E1) % TQ_BATCH == 0 && (NE * TI_E2) % TQ_BATCH == 0, "queue batches stay inside one kind");
__device__ __forceinline__ void expert_transpose_queue(Frame& F) {
    LAS float* scr = (LAS float*)(F.lds + F.wave * 8704);
    for (;;) {
        int base = 0;
        if (F.lane == 0) base = (int)__hip_atomic_fetch_add((unsigned*)(F.ctl + CW_TQ), (unsigned)TQ_BATCH, RLX_AGENT);
        base = __builtin_amdgcn_readfirstlane(base);
        if (base >= expert_queue_items(F.G)) break;
        if (base < NE * TI_E1) transpose_range<2>(F, scr, base, base + TQ_BATCH, 1);
        else transpose_range<3>(F, scr, base - NE * TI_E1, base - NE * TI_E1 + TQ_BATCH, 1);
    }
}

__device__ __forceinline__ void p1_quant_weights(Frame& F) {
    __syncthreads();
    LAS float* scr = (LAS float*)(F.lds + F.wave * 8704);
    const int gw = F.vcu * NWAVES + F.wave, NGW = F.G * NWAVES;
    transpose_range<8>(F, scr, gw, (D / 64) * (IN_COLS / 32), NGW);
    for (int n = F.vcu * NTHR + F.tid; n < IN_COLS; n += F.G * NTHR) F.SB[win_row(n)] = __uint_as_float(((const unsigned*)(F.ctl + CW_CMAX))[n]) * (1.f / 127.f);
}
__device__ __forceinline__ void p1_quant_wout(Frame& F) {
    const int gw = F.vcu * NWAVES + F.wave, NGW = F.G * NWAVES, lane = F.lane;
    for (int n = gw; n < D; n += NGW) {
        const unsigned cmb = ((const unsigned*)(F.ctl + CW_CMAX2))[n]; const float cm = __uint_as_float(cmb), iv = cm > 0.f ? 127.f / cm : 0.f;
        const bf16* src = F.WOUT + (size_t)n * D; unsigned char* dst = F.WOA8 + (size_t)n * (D / 2);
        v4u v[4];
#pragma unroll
        for (int j = 0; j < 4; ++j) v[j] = *(const v4u*)(src + 512 * j + 8 * lane);
#pragma unroll
        for (int j = 0; j < 4; ++j) *(v2u*)(dst + 512 * j + 8 * lane) = (v2u){pk4_i8(bf_lo(v[j].x) * iv, bf_hi(v[j].x) * iv, bf_lo(v[j].y) * iv, bf_hi(v[j].y) * iv), pk4_i8(bf_lo(v[j].z) * iv, bf_hi(v[j].z) * iv, bf_lo(v[j].w) * iv, bf_hi(v[j].w) * iv)};
        if (lane == 0) F.SB2[n] = cm * (1.f / 127.f);
    }
}
__device__ __forceinline__ void p1_norm(Frame& F) {
    LAS float* fac = (LAS float*)F.lds; LAS float* sh = fac + D;
    const int gw = F.vcu * NWAVES + F.wave, NGW = F.G * NWAVES;
    for (int bb = 0; bb < 5; ++bb) {
        __syncthreads();
        for (int i = F.tid; i < D; i += NTHR) { fac[i] = F.norm1[i] * (1.f + F.ADA[bb * ADA_N + D + i]); sh[i] = F.ADA[bb * ADA_N + i]; }
        __syncthreads();
        const int nrows = bb < 4 ? SEQ : TC; const float* src = bb < 4 ? F.x + (size_t)bb * SEQ * D : F.ctx; const int drow0 = bb < 4 ? bb * SEQ : T;
        for (int r = gw; r < nrows; r += 2 * NGW) {
            int lane = F.lane; asm volatile("" : "+v"(lane));
            const int r2 = r + NGW; const bool has2 = r2 < nrows; const int r2c = has2 ? r2 : r;
            const f32x4* xa = (const f32x4*)(src + (size_t)r * D) + lane; const f32x4* xb = (const f32x4*)(src + (size_t)r2c * D) + lane;
            f32x4 va[16], vb[16]; float sa = 0.f, sb = 0.f;
#pragma unroll
            for (int j = 0; j < 16; ++j) { va[j] = xa[64 * j]; vb[j] = xb[64 * j]; }
#pragma unroll
            for (int j = 0; j < 16; ++j) { sa = fmaf(va[j][0], va[j][0], fmaf(va[j][1], va[j][1], fmaf(va[j][2], va[j][2], fmaf(va[j][3], va[j][3], sa))));
                                           sb = fmaf(vb[j][0], vb[j][0], fmaf(vb[j][1], vb[j][1], fmaf(vb[j][2], vb[j][2], fmaf(vb[j][3], vb[j][3], sb)))); }
            const float ra = rsqrtf(wave_sum(sa) * (1.f / D) + EPS), rb = rsqrtf(wave_sum(sb) * (1.f / D) + EPS);
#pragma unroll
            for (int j = 0; j < 16; ++j) { const f32x4 fa = *(const LAS f32x4*)(fac + 256 * j + 4 * lane), sv = *(const LAS f32x4*)(sh + 256 * j + 4 * lane);
                va[j] = va[j] * ra * fa + sv; vb[j] = vb[j] * rb * fa + sv; }
            {
                float ma = 0.f, mb = 0.f;
#pragma unroll
                for (int j = 0; j < 16; ++j) { ma = fmaxf(ma, fmaxf(fmaxf(fabsf(va[j][0]), fabsf(va[j][1])), fmaxf(fabsf(va[j][2]), fabsf(va[j][3])))); mb = fmaxf(mb, fmaxf(fmaxf(fabsf(vb[j][0]), fabsf(vb[j][1])), fmaxf(fabsf(vb[j][2]), fabsf(vb[j][3])))); }
                ma = wave_max(ma); mb = wave_max(mb);
                const float ia = ma > 0.f ? 127.f / ma : 0.f, ib = mb > 0.f ? 127.f / mb : 0.f;
                if (lane == 0) { F.SA[drow0 + r] = ma * (1.f / 127.f); if (has2) F.SA[drow0 + r2c] = mb * (1.f / 127.f); }
#pragma unroll
                for (int j = 0; j < 16; ++j) { ((unsigned*)(F.XM8 + (size_t)(drow0 + r) * D) + lane)[64 * j] = pk4_i8(va[j][0] * ia, va[j][1] * ia, va[j][2] * ia, va[j][3] * ia);
                    if (has2) ((unsigned*)(F.XM8 + (size_t)(drow0 + r2c) * D) + lane)[64 * j] = pk4_i8(vb[j][0] * ib, vb[j][1] * ib, vb[j][2] * ib, vb[j][3] * ib); }
            }
        }
    }
}

namespace ml {
constexpr int QP = 272, VP = 160, PP = 144, CP = 272;
constexpr int OFF_Q = 0, OFF_K = OFF_Q + 64 * QP, OFF_V = OFF_K + 64 * QP, OFF_VW = OFF_V + 64 * VP, OFF_P = OFF_VW + 64 * VP, OFF_CB = OFF_P + 64 * PP, CB_BYTES = 80 * CP, LDS_END = OFF_CB + 2 * CB_BYTES;
static_assert(LDS_END <= RING_BYTES, "mlstm LDS");
typedef short s16x4 __attribute__((ext_vector_type(4)));
typedef short bf16x8 __attribute__((ext_vector_type(8)));
__device__ __forceinline__ s16x4 tr(const LAS unsigned char* p) { return __builtin_bit_cast(s16x4, __builtin_amdgcn_ds_read_tr16_b64_v4i16((LAS s16x4*)p)); }
__device__ __forceinline__ bf16x8 trfrag(const LAS unsigned char* p, int pitch) { const s16x4 a = tr(p), b = tr(p + 4 * pitch); return (bf16x8){a[0], a[1], a[2], a[3], b[0], b[1], b[2], b[3]}; }
__device__ __forceinline__ bf16x8 ld16(const LAS unsigned char* p) { return *(const LAS bf16x8*)p; }
__device__ __forceinline__ int row_of(int c, int p, int dir, int b) {
    if (c < 4) { const int i = 64 * c + p; return T + b * CTXL + (dir ? (CTXL - 1 - i) : i); }
    const int i = 64 * (c - 4) + p; return b * SEQ + (dir ? (SEQ - 1 - i) : i);
}
}
#define ML_BAR() do { asm volatile("s_waitcnt lgkmcnt(0)" ::: "memory"); __builtin_amdgcn_s_barrier(); asm volatile("" ::: "memory"); } while (0)
__device__ __forceinline__ void p3_mlstm(Frame& F) {
    using namespace ml;
    LAS unsigned char* lds = F.lds;
    const int tid = F.tid, lane = F.lane, wave = F.wave, li = lane & 15, lg = lane >> 4, lq = (lane & 15) >> 2, lp = lane & 3;
    constexpr float QS = 0.08838834764831845f;
    constexpr int NCH = 4 + SEQ / 64;
    constexpr int SC_A = LDS_END, SC_M = SC_A + 256, SC_B = SC_M + 256;
    constexpr int HSCR_OFF = SC_B + 256;
    static_assert(HSCR_OFF + NWAVES * 4352 <= LDSCTL_OFF, "mlstm LDS");
    for (int unit = F.vcu; unit < NB * NH * 2 * 4; unit += F.G) {
        const int vq = unit & 3, dir = (unit >> 2) & 1, h = (unit >> 3) & 7, b = unit >> 6;
        bf16* HO = dir ? F.HB : F.HF;
        __syncthreads();
        unsigned z0 = 0u; asm volatile("" : "+v"(z0));
        for (int i = tid; i < CB_BYTES / 16; i += NTHR) *(LAS v4u*)(lds + OFF_CB + 16 * i) = (v4u){z0, z0, z0, z0};
        if (tid < 64) { *(LAS v4u*)(lds + OFF_V + tid * VP + 128) = (v4u){0x00003F80u | z0, z0, z0, z0}; *(LAS v4u*)(lds + OFF_V + tid * VP + 144) = (v4u){z0, z0, z0, z0};
                        *(LAS v4u*)(lds + OFF_VW + tid * VP + 128) = (v4u){z0, z0, z0, z0}; *(LAS v4u*)(lds + OFF_VW + tid * VP + 144) = (v4u){z0, z0, z0, z0}; }
        f32x4 Cacc[5];
#pragma unroll
        for (int i = 0; i < 5; ++i) Cacc[i] = (f32x4){0.f, 0.f, 0.f, 0.f};
        v4u rq[2], rk[2], rv; float ig, fp;
        rq[0] = rq[1] = (v4u){0u, 0u, 0u, 0u};
        const GAS bf16* pk_[2]; const GAS bf16* pv_; const GAS float* pg_;
#define ML_SETPTR(cc) do { const int cs_ = (cc); \
        _Pragma("unroll") for (int i = 0; i < 2; ++i) { const int id = tid + NTHR * i, p = id >> 4, ch = id & 15; pk_[i] = (const GAS bf16*)F.PROJ + (size_t)row_of(cs_, p, dir, b) * NPROJ + COL_K + h * DK + 8 * ch; } \
        { const int p = tid >> 3, ch = tid & 7; pv_ = (const GAS bf16*)F.PROJ + (size_t)row_of(cs_, p, dir, b) * NPROJ + COL_V + h * DV + vq * 64 + 8 * ch; } \
        pg_ = (const GAS float*)F.GATES + (size_t)row_of(cs_, lane, dir, b) * 32 + dir * 16 + h; } while (0)
#define ML_PREFETCH(cc) do { const int c_ = (cc); if (c_ == 0 || c_ == 4) ML_SETPTR(c_); \
        _Pragma("unroll") for (int i = 0; i < 2; ++i) { rk[i] = *(const GAS v4u*)pk_[i]; rq[i] = *(const GAS v4u*)(pk_[i] + (COL_Q - COL_K)); pk_[i] += pstep; } \
        rv = *(const GAS v4u*)pv_; pv_ += pstep; ig = pg_[0]; fp = pg_[8]; pg_ += gstep; } while (0)
        const long pstep = (dir ? -64 : 64) * (long)NPROJ, gstep = (dir ? -64 : 64) * 32;
        float bc, g, Ap, Mp, M63, wS, decay, wsv, m = 0.f;
#define ML_SCALARS(m_in) do { const float lf_ = fminf(fp, 0.f) - 0.6931471805599453f * __log2f(1.f + __expf(-fabsf(fp))); \
        bc = wave_incl_sum(lf_); g = lane_bcast(bc, 63); Ap = ig - bc; const float PA_ = wave_incl_max(Ap), Amax_ = lane_bcast(PA_, 63); \
        Mp = fmaxf((m_in), PA_); M63 = fmaxf((m_in), Amax_); wS = __expf(Ap - M63); decay = __expf((m_in) - M63); wsv = __shfl(wS, 8 * wave + (lane >> 3)); } while (0)
#define ML_STAGE() do { \
        _Pragma("unroll") for (int i = 0; i < 2; ++i) { const int id = tid + NTHR * i, p = id >> 4, ch = id & 15; \
            *(LAS v4u*)(lds + OFF_K + p * QP + 16 * ch) = rk[i]; *(LAS v4u*)(lds + OFF_Q + p * QP + 16 * ch) = rq[i]; } \
        { const int p = tid >> 3, ch = tid & 7; \
          *(LAS v4u*)(lds + OFF_V + p * VP + 16 * ch) = rv; \
          v4u o; o.x = pk2(bf_lo(rv.x) * wsv, bf_hi(rv.x) * wsv); o.y = pk2(bf_lo(rv.y) * wsv, bf_hi(rv.y) * wsv); o.z = pk2(bf_lo(rv.z) * wsv, bf_hi(rv.z) * wsv); o.w = pk2(bf_lo(rv.w) * wsv, bf_hi(rv.w) * wsv); \
          *(LAS v4u*)(lds + OFF_VW + p * VP + 16 * ch) = o; } \
        if (wave == 0) { *(LAS unsigned short*)(lds + OFF_VW + lane * VP + 128) = (unsigned short)(pk2(wS, 0.f) & 0xffffu); \
                         *(LAS float*)(lds + SC_A + 4 * lane) = Ap; *(LAS float*)(lds + SC_M + 4 * lane) = Mp; *(LAS float*)(lds + SC_B + 4 * lane) = bc; } } while (0)
        ML_PREFETCH(0);
        const int tt = wave >> 1, trow = 16 * tt + li, vt0 = (wave & 1) ? 2 : 0, dt = wave;
        const int hi0 = 2 * expert_queue_items(F.G) + (unit / F.G) * NCH * (F.G * NWAVES) + F.vcu * NWAVES + wave;
        LAS float* hscr = (LAS float*)(lds + HSCR_OFF + wave * 4352);
        ML_SCALARS(m);
        ML_BAR();
        ML_STAGE();
        constexpr int HLIM = 2 * NE * (TI_E1 + TI_E2);
        f32x4 hvA[4], hvB[4];
        { const int h0 = hi0 < HLIM ? hi0 : HLIM - 1; hitem_load(hitem_decode(F, h0), lane, hvA); }
        auto step = [&](const int c, f32x4 (&hvn)[4], f32x4 (&hvo)[4]) __attribute__((always_inline)) {
            const bool lat = c >= 4;
            ML_BAR();
            const float dec_c = decay, m_c = m, m_next = g + M63;
            ML_PREFETCH(c + 1);
            const int hi = hi0 + c * (F.G * NWAVES);
            const bool hact = hi < HLIM;
            f32x4 oacc[3];
#pragma unroll
            for (int j = 0; j < 3; ++j) oacc[j] = (f32x4){0.f, 0.f, 0.f, 0.f};
            float Mt = 0.f; v2u hout[2] = {(v2u){0u, 0u}, (v2u){0u, 0u}};
            if (lat) {
                bf16x8 Bq[4], Ak[2][4], Cf[3][4];
                const LAS unsigned char* cbo = lds + OFF_CB + (c & 1) * CB_BYTES;
#pragma unroll
                for (int ks = 0; ks < 4; ++ks) Bq[ks] = ld16(lds + OFF_Q + trow * QP + 64 * ks + 16 * lg);
#pragma unroll
                for (int sti = 0; sti < 2; ++sti)
#pragma unroll
                    for (int ks = 0; ks < 4; ++ks) Ak[sti][ks] = ld16(lds + OFF_K + (16 * (2 * (wave & 1) + sti) + li) * QP + 64 * ks + 16 * lg);
                Mt = *(const LAS float*)(lds + SC_M + 4 * trow);
                f32x4 A4[2];
#pragma unroll
                for (int sti = 0; sti < 2; ++sti) A4[sti] = *(const LAS f32x4*)(lds + SC_A + 4 * (16 * (2 * (wave & 1) + sti) + 4 * lg));
#pragma unroll
                for (int j = 0; j < 3; ++j)
#pragma unroll
                    for (int ks = 0; ks < 4; ++ks) Cf[j][ks] = ld16(cbo + (16 * (j < 2 ? vt0 + j : 4) + li) * CP + 64 * ks + 16 * lg);
                f32x4 sacc[2];
#pragma unroll
                for (int sti = 0; sti < 2; ++sti) { sacc[sti] = (f32x4){0.f, 0.f, 0.f, 0.f};
#pragma unroll
                    for (int ks = 0; ks < 4; ++ks) sacc[sti] = __builtin_amdgcn_mfma_f32_16x16x32_bf16(Ak[sti][ks], Bq[ks], sacc[sti], 0, 0, 0); }
#pragma unroll
                for (int ks = 0; ks < 4; ++ks)
#pragma unroll
                    for (int j = 0; j < 3; ++j) oacc[j] = __builtin_amdgcn_mfma_f32_16x16x32_bf16(Cf[j][ks], Bq[ks], oacc[j], 0, 0, 0);
#pragma unroll
                for (int sti = 0; sti < 2; ++sti) { const int st = 2 * (wave & 1) + sti; float v[4];
#pragma unroll
                    for (int r = 0; r < 4; ++r) { const int sp = 16 * st + 4 * lg + r; v[r] = sp <= trow ? sacc[sti][r] * QS * __expf(A4[sti][r] - Mt) : 0.f; }
                    *(LAS v2u*)(lds + OFF_P + trow * PP + 2 * (16 * st + 4 * lg)) = (v2u){pk2(v[0], v[1]), pk2(v[2], v[3])}; }
                const float e2 = __expf(m_c - Mt) * QS;
#pragma unroll
                for (int j = 0; j < 3; ++j) oacc[j] = oacc[j] * e2;
            }
            {
                bf16x8 At[2], Bt[5][2];
#pragma unroll
                for (int ks = 0; ks < 2; ++ks) At[ks] = trfrag(lds + OFF_K + (32 * ks + 8 * lg + lq) * QP + 32 * dt + 8 * lp, QP);
#pragma unroll
                for (int vt = 0; vt < 5; ++vt)
#pragma unroll
                    for (int ks = 0; ks < 2; ++ks) Bt[vt][ks] = trfrag(lds + OFF_VW + (32 * ks + 8 * lg + lq) * VP + 32 * vt + 8 * lp, VP);
#pragma unroll
                for (int vt = 0; vt < 5; ++vt) Cacc[vt] = Cacc[vt] * dec_c;
#pragma unroll
                for (int ks = 0; ks < 2; ++ks)
#pragma unroll
                    for (int vt = 0; vt < 5; ++vt) Cacc[vt] = __builtin_amdgcn_mfma_f32_16x16x32_bf16(At[ks], Bt[vt][ks], Cacc[vt], 0, 0, 0);
                LAS unsigned char* cbn = lds + OFF_CB + ((c + 1) & 1) * CB_BYTES;
#pragma unroll
                for (int vt = 0; vt < 5; ++vt) *(LAS v2u*)(cbn + (16 * vt + li) * CP + 2 * (16 * dt + 4 * lg)) = (v2u){pk2(Cacc[vt][0], Cacc[vt][1]), pk2(Cacc[vt][2], Cacc[vt][3])};
            }
            if (hact) hitem_to_lds(lane, hvo, hscr);
            { const int hn = hi + F.G * NWAVES; hitem_load(hitem_decode(F, hn < HLIM ? hn : HLIM - 1), lane, hvn); }
            ML_BAR();
            if (lat) {
                bf16x8 Pf[2], Vt[3][2];
#pragma unroll
                for (int ks = 0; ks < 2; ++ks) Pf[ks] = ld16(lds + OFF_P + trow * PP + 64 * ks + 16 * lg);
#pragma unroll
                for (int j = 0; j < 3; ++j)
#pragma unroll
                    for (int ks = 0; ks < 2; ++ks) Vt[j][ks] = trfrag(lds + OFF_V + (32 * ks + 8 * lg + lq) * VP + 32 * (j < 2 ? vt0 + j : 4) + 8 * lp, VP);
                const float bct = *(const LAS float*)(lds + SC_B + 4 * trow);
#pragma unroll
                for (int ks = 0; ks < 2; ++ks)
#pragma unroll
                    for (int j = 0; j < 3; ++j) oacc[j] = __builtin_amdgcn_mfma_f32_16x16x32_bf16(Vt[j][ks], Pf[ks], oacc[j], 0, 0, 0);
                const float den = __shfl(oacc[2][0], li);
                const float inv = 1.f / fmaxf(fabsf(den), __expf(-(bct + Mt)));
#pragma unroll
                for (int j = 0; j < 2; ++j) { const f32x4 o = oacc[j] * inv; hout[j] = (v2u){pk2(o[0], o[1]), pk2(o[2], o[3])}; }
            }
            float hr[16];
            if (hact) hitem_read(lane, hscr, hr);
            m = m_next;
            if (c + 1 < NCH) ML_SCALARS(m);
            asm volatile("; chunk c+1 pieces are used here so that the wait for them sits in front of this step's stores" : "+v"(rk[0]), "+v"(rk[1]), "+v"(rq[0]), "+v"(rq[1]), "+v"(rv) :: "memory");
            if (lat) { bf16* hp = HO + (size_t)row_of(c, trow, dir, b) * 2048 + h * DV + vq * 64 + 4 * lg;
#pragma unroll
                for (int j = 0; j < 2; ++j) gstore8_hidden(hp + 16 * (vt0 + j), hout[j]); }
            if (hact) hitem_pack_store(hitem_decode(F, hi), lane, hr);
            ML_BAR();
            if (c + 1 < NCH) ML_STAGE();
        };
        static_assert(NCH % 2 == 0, "two steps per trip");
        for (int c = 0; c < NCH; c += 2) { step(c, hvB, hvA); step(c + 1, hvA, hvB); }
        asm volatile("s_waitcnt vmcnt(0) ; the hidden stores of the loop" ::: "memory");
#undef ML_PREFETCH
#undef ML_SETPTR
#undef ML_SCALARS
#undef ML_STAGE
    }
}

__device__ __forceinline__ void p4_mix(Frame& F) {
    const int gw = F.vcu * NWAVES + F.wave, NGW = F.G * NWAVES;
    LAS float* cwl = (LAS float*)F.lds; LAS float* hnl = cwl + 3 * 2048;
    __syncthreads();
    for (int i = F.tid; i < 3 * 2048 / 4; i += NTHR) *(LAS f32x4*)(cwl + 4 * i) = *(const f32x4*)(F.conv_w + 4 * i);
    for (int i = F.tid; i < 2048 / 4; i += NTHR) *(LAS f32x4*)(hnl + 4 * i) = *(const f32x4*)(F.head_norm + 4 * i);
    __syncthreads();
    for (int r = gw; r < T; r += NGW) {
        int lane = F.lane; asm volatile("" : "+v"(lane));
        const int s = r & (SEQ - 1), gr = s >> 6, gc = s & 63;
        const bf16* pr = F.PROJ + (size_t)r * NPROJ;
        bf16* mr = F.MIX + (size_t)r * D;
        {
            v2u ha[NH], hb[NH]; unsigned og[NH];
#pragma unroll
            for (int hh = 0; hh < NH; ++hh) { const int idx = hh * DV + 4 * lane;
                ha[hh] = *(const v2u*)(F.HF + (size_t)r * 2048 + idx); hb[hh] = *(const v2u*)(F.HB + (size_t)r * 2048 + idx); og[hh] = *(const unsigned*)((const unsigned char*)(pr + COL_O) + idx); }
            f32x4 hs[NH]; float ss[NH];
#pragma unroll
            for (int hh = 0; hh < NH; ++hh) { hs[hh] = (f32x4){bf_lo(ha[hh].x) + bf_lo(hb[hh].x), bf_hi(ha[hh].x) + bf_hi(hb[hh].x), bf_lo(ha[hh].y) + bf_lo(hb[hh].y), bf_hi(ha[hh].y) + bf_hi(hb[hh].y)};
                ss[hh] = (hs[hh][0] * hs[hh][0] + hs[hh][1] * hs[hh][1]) + (hs[hh][2] * hs[hh][2] + hs[hh][3] * hs[hh][3]); }
#pragma unroll
            for (int hh = 0; hh < NH; ++hh) ss[hh] = wave_sum(ss[hh]);
            float ym = 0.f;
#pragma unroll
            for (int hh = 0; hh < NH; ++hh) { const float rs = rsqrtf(ss[hh] * (1.f / DV) + EPS); const f32x4 hw = *(const LAS f32x4*)(hnl + hh * DV + 4 * lane);
                const float rq = rs * (1.f / 255.f);
                hs[hh][0] = hs[hh][0] * rq * hw[0] * (float)(og[hh] & 255u); hs[hh][1] = hs[hh][1] * rq * hw[1] * (float)((og[hh] >> 8) & 255u);
                hs[hh][2] = hs[hh][2] * rq * hw[2] * (float)((og[hh] >> 16) & 255u); hs[hh][3] = hs[hh][3] * rq * hw[3] * (float)(og[hh] >> 24);
                ym = fmaxf(ym, fmaxf(fmaxf(fabsf(hs[hh][0]), fabsf(hs[hh][1])), fmaxf(fabsf(hs[hh][2]), fabsf(hs[hh][3])))); }
            ym = wave_max(ym);
            const float iy = ym > 0.f ? 127.f / ym : 0.f;
            if (lane == 0) F.SA[r] = ym * (1.f / 127.f);
#pragma unroll
            for (int hh = 0; hh < NH; ++hh) *(unsigned*)(F.MIXA8 + (size_t)r * (D / 2) + hh * DV + 4 * lane) = pk4_i8(hs[hh][0] * iy, hs[hh][1] * iy, hs[hh][2] * iy, hs[hh][3] * iy);
        }
#pragma unroll
        for (int jb = 0; jb < 2; ++jb) {
            const int dt = jb == 0 ? 1 : 64;
            const bool vm = jb == 0 ? (gc > 0) : (gr > 0), vp = jb == 0 ? (gc < 63) : (gr < 63);
            const bf16* pm = vm ? pr - (size_t)dt * NPROJ : pr; const bf16* pp = vp ? pr + (size_t)dt * NPROJ : pr;
            const float fm = vm ? 1.f : 0.f, fp = vp ? 1.f : 0.f;
            v3u cu0[2], cb0[2], cum[2], cup[2];
#pragma unroll
            for (int q = 0; q < 2; ++q) { const int bo = 12 * (64 * (2 * jb + q) + lane);
                cu0[q] = *(const v3u*)((const unsigned char*)(pr + COL_CC) + bo); cb0[q] = *(const v3u*)((const unsigned char*)(pr + COL_CB) + bo);
                cum[q] = *(const v3u*)((const unsigned char*)(pm + COL_CC) + bo); cup[q] = *(const v3u*)((const unsigned char*)(pp + COL_CC) + bo); }
#pragma unroll
            for (int q = 0; q < 2; ++q) { const int cch = 512 * (2 * jb + q) + 8 * lane;
                float u0[8], um[8], up[8], cbv[8];
                blk8_unpack(cu0[q], u0); blk8_unpack(cum[q], um); blk8_unpack(cup[q], up); blk8_unpack(cb0[q], cbv);
                unsigned o[4];
#pragma unroll
                for (int hq = 0; hq < 2; ++hq) { const f32x4 w0 = *(const LAS f32x4*)(cwl + cch + 4 * hq), w1 = *(const LAS f32x4*)(cwl + 2048 + cch + 4 * hq), w2 = *(const LAS f32x4*)(cwl + 4096 + cch + 4 * hq);
#pragma unroll
                    for (int e2 = 0; e2 < 2; ++e2) { const int wi = 2 * hq + e2, c0 = 4 * hq + 2 * e2;
                        const float ya = cbv[c0] * (w0[2 * e2] * (um[c0] * fm) + w1[2 * e2] * u0[c0] + w2[2 * e2] * (up[c0] * fp));
                        const float yb = cbv[c0 + 1] * (w0[2 * e2 + 1] * (um[c0 + 1] * fm) + w1[2 * e2 + 1] * u0[c0 + 1] + w2[2 * e2 + 1] * (up[c0 + 1] * fp));
                        o[wi] = pk2(ya, yb); } }
                *(v4u*)(mr + 2048 + cch) = (v4u){o[0], o[1], o[2], o[3]}; }
        }
    }
}

__device__ __forceinline__ float p6_row_pass1(Frame& F, int row0, bool act, const LAS float* fac, const LAS float* sh) {
    const int lane = F.lane;
    const v2u* da = (const v2u*)(F.X1B + (size_t)row0 * D) + lane;
    float sa = 0.f;
    v2u dd[16];
#pragma unroll
    for (int j = 0; j < 16; ++j) dd[j] = da[64 * j];
#pragma unroll
    for (int j = 0; j < 16; ++j) { const float a0 = bf_lo(dd[j].x), a1 = bf_hi(dd[j].x), a2 = bf_lo(dd[j].y), a3 = bf_hi(dd[j].y); sa = fmaf(a0, a0, fmaf(a1, a1, fmaf(a2, a2, fmaf(a3, a3, sa)))); }
    const float rsa = rsqrtf(wave_sum(sa) * (1.f / D) + EPS);
    unsigned* oa = (unsigned*)((unsigned char*)F.XF + (size_t)row0 * D) + lane;
#pragma unroll
    for (int j = 0; j < 16; ++j) { const f32x4 fa = *(const LAS f32x4*)(fac + 256 * j + 4 * lane), sv = *(const LAS f32x4*)(sh + 256 * j + 4 * lane);
        const f32x4 xn = (f32x4){bf_lo(dd[j].x), bf_hi(dd[j].x), bf_lo(dd[j].y), bf_hi(dd[j].y)} * rsa * fa + sv;
        if (act) oa[64 * j] = pk4_fp8(xn[0], xn[1], xn[2], xn[3]); }
    return rsa;
}
__device__ __forceinline__ void p6_xquarter(Frame& F, int row, float rs, int j0, int nj, const LAS float* fac, const LAS float* sh, f32x4 (&xo)[4]) {
    const int lane = F.lane;
    const v2u* d0 = (const v2u*)(F.X1B + (size_t)row * D) + lane;
    v2u q0[4];
#pragma unroll
    for (int jj = 0; jj < 4; ++jj) if (jj < nj) q0[jj] = d0[64 * (j0 + jj)];
#pragma unroll
    for (int jj = 0; jj < 4; ++jj) if (jj < nj) { const int j = j0 + jj; const f32x4 fa = *(const LAS f32x4*)(fac + 256 * j + 4 * lane), sv = *(const LAS f32x4*)(sh + 256 * j + 4 * lane);
        xo[jj] = (f32x4){bf_lo(q0[jj].x), bf_hi(q0[jj].x), bf_lo(q0[jj].y), bf_hi(q0[jj].y)} * rs * fa + sv; }
}
__device__ __forceinline__ void p6_pick_group(Frame& F, const float (&g)[4], int& gs, float& psel) {
    float gl[4];
#pragma unroll
    for (int o = 0; o < 4; ++o) gl[o] = g[o] + F.b_rg[o];
    gs = 0; float gm = gl[0];
#pragma unroll
    for (int o = 1; o < 4; ++o) if (gl[o] > gm) { gm = gl[o]; gs = o; }
    float den = 0.f;
#pragma unroll
    for (int o = 0; o < 4; ++o) den += expf(gl[o] - gm);
    psel = 1.f / den;
}
__device__ __forceinline__ void p6_pick_experts(Frame& F, const float (&ed)[4], int gs, float psel, bool act, LAS int* ri) {
    float ev[4];
#pragma unroll
    for (int o = 0; o < 4; ++o) ev[o] = ed[o] + F.b_re[gs * 4 + o];
    int i0 = 0; float v0 = ev[0];
#pragma unroll
    for (int o = 1; o < 4; ++o) if (ev[o] > v0) { v0 = ev[o]; i0 = o; }
    int i1 = -1; float v1 = -3.0e38f;
#pragma unroll
    for (int o = 0; o < 4; ++o) if (o != i0 && ev[o] > v1) { v1 = ev[o]; i1 = o; }
    const float e1x = expf(v1 - v0); const float w0 = psel / (1.f + e1x), w1 = psel * e1x / (1.f + e1x);
    if (F.lane == 0) { ri[0] = act ? gs * 4 + i0 : -1; ri[1] = act ? gs * 4 + i1 : -1; ri[2] = __float_as_int(w0); ri[3] = __float_as_int(w1); }
}
__device__ __forceinline__ void p6_norm_router(Frame& F) {
    constexpr int R = 8;
    LAS float* fac = (LAS float*)F.lds; LAS float* sh = fac + D;
    LAS float* wg = (LAS float*)(F.lds + 32768);
    LAS float* we = (LAS float*)(F.lds + 98304);
    LAS int* rinfo = (LAS int*)(F.lds + 131072);
    const int wave = F.wave, lane = F.lane;
    const int nblk = T / (8 * R), per = (nblk + F.G - 1) / F.G;
    __syncthreads();
    for (int c = F.tid; c < D; c += NTHR) { const f32x4 g4 = *(const f32x4*)(F.w_rg + (size_t)c * 4); wg[c] = g4[0]; wg[D + c] = g4[1]; wg[2 * D + c] = g4[2]; wg[3 * D + c] = g4[3]; }
    int curb = -1;
    for (int it = 0; it < per; ++it) {
        const int rb = F.vcu * per + it;
        const bool act = rb < nblk;
        const int rowb = (act ? rb : 0) * (8 * R) + wave;
        const int b = rowb >> 12;
        if (b != curb) {
            __syncthreads();
            for (int i = F.tid; i < D; i += NTHR) { fac[i] = F.norm2[i] * (1.f + F.ADA[b * ADA_N + 4 * D + i]); sh[i] = F.ADA[b * ADA_N + 3 * D + i]; }
            curb = b;
        }
        __syncthreads();
        float rs[R];
#pragma unroll
        for (int k = 0; k < R; ++k) rs[k] = p6_row_pass1(F, rowb + 8 * k, act, fac, sh);
        float gd[R][4];
#pragma unroll
        for (int k = 0; k < R; ++k)
#pragma unroll
            for (int o = 0; o < 4; ++o) gd[k][o] = 0.f;
#pragma unroll
        for (int kh = 0; kh < R; kh += 4) {
#pragma unroll 1
            for (int q = 0; q < 4; ++q) { f32x4 xv[4][4];
#pragma unroll
                for (int k = 0; k < 4; ++k) p6_xquarter(F, rowb + 8 * (kh + k), rs[kh + k], 4 * q, 4, fac, sh, xv[k]);
#pragma unroll
                for (int o = 0; o < 4; ++o)
#pragma unroll
                    for (int jj = 0; jj < 4; ++jj) { const f32x4 w4 = *(const LAS f32x4*)(wg + o * D + 256 * (4 * q + jj) + 4 * lane);
#pragma unroll
                        for (int k = 0; k < 4; ++k) { const f32x4 a4 = xv[k][jj]; gd[kh + k][o] = fmaf(a4[3], w4[3], fmaf(a4[2], w4[2], fmaf(a4[1], w4[1], fmaf(a4[0], w4[0], gd[kh + k][o])))); } } } }
        int gs[R]; float ps[R];
#pragma unroll
        for (int k = 0; k < R; ++k) {
#pragma unroll
            for (int o = 0; o < 4; ++o) gd[k][o] = wave_sum(gd[k][o]);
            p6_pick_group(F, gd[k], gs[k], ps[k]); gs[k] = __builtin_amdgcn_readfirstlane(gs[k]); }
        float ed[R][4];
#pragma unroll
        for (int k = 0; k < R; ++k)
#pragma unroll
            for (int o = 0; o < 4; ++o) ed[k][o] = 0.f;
#pragma unroll 1
        for (int ch = 0; ch < 8; ++ch) {
            __syncthreads();
            { const int c = 512 * ch + F.tid;
#pragma unroll
              for (int p = 0; p < 4; ++p) { const f32x4 e4 = *(const f32x4*)(F.w_re + (size_t)c * 16 + 4 * p);
                  we[(4 * p + 0) * 512 + F.tid] = e4[0]; we[(4 * p + 1) * 512 + F.tid] = e4[1]; we[(4 * p + 2) * 512 + F.tid] = e4[2]; we[(4 * p + 3) * 512 + F.tid] = e4[3]; } }
            f32x4 xv[4][4];
#pragma unroll
            for (int k = 0; k < 4; ++k) p6_xquarter(F, rowb + 8 * k, rs[k], 2 * ch, 2, fac, sh, xv[k]);
            __syncthreads();
#pragma unroll
            for (int kh = 0; kh < R; kh += 4) {
                if (kh > 0) {
#pragma unroll
                    for (int k = 0; k < 4; ++k) p6_xquarter(F, rowb + 8 * (kh + k), rs[kh + k], 2 * ch, 2, fac, sh, xv[k]); }
#pragma unroll
                for (int k = 0; k < 4; ++k)
#pragma unroll
                    for (int o = 0; o < 4; ++o)
#pragma unroll
                        for (int jl = 0; jl < 2; ++jl) { const f32x4 w4 = *(const LAS f32x4*)(we + (gs[kh + k] * 4 + o) * 512 + 256 * jl + 4 * lane); const f32x4 a4 = xv[k][jl];
                            ed[kh + k][o] = fmaf(a4[3], w4[3], fmaf(a4[2], w4[2], fmaf(a4[1], w4[1], fmaf(a4[0], w4[0], ed[kh + k][o])))); }
            }
        }
#pragma unroll
        for (int k = 0; k < R; ++k) {
#pragma unroll
            for (int o = 0; o < 4; ++o) ed[k][o] = wave_sum(ed[k][o]);
            p6_pick_experts(F, ed[k], gs[k], ps[k], act, rinfo + (8 * k + wave) * 4); }
        __syncthreads();
        if (F.tid < NE && act) {
            int e = F.tid; asm volatile("" : "+v"(e)); int n = 0;
            for (int q = 0; q < 16 * R; ++q) n += (rinfo[(q >> 1) * 4 + (q & 1)] == e) ? 1 : 0;
            if (n > 0) {
                int base = (int)__hip_atomic_fetch_add((unsigned*)(F.ctl + CW_CNT + 64 * e), (unsigned)n, RLX_AGENT);
                for (int q = 0; q < 16 * R; ++q) if (rinfo[(q >> 1) * 4 + (q & 1)] == e) {
                    const int tok = rb * (8 * R) + (q >> 1);
                    F.ELIST[e * T + base] = tok * 2 + (q & 1); F.EW[e * T + base] = __int_as_float(rinfo[(q >> 1) * 4 + 2 + (q & 1)]); ++base; }
            }
        }
        __syncthreads();
    }
}

__device__ __forceinline__ void p9_final(Frame& F) {
    LAS float* fnl = (LAS float*)F.lds; LAS float* g2l = fnl + D;
    __syncthreads();
    for (int i = F.tid; i < D / 4; i += NTHR) { *(LAS f32x4*)(fnl + 4 * i) = *(const f32x4*)(F.fnorm + 4 * i);
#pragma unroll
        for (int b = 0; b < NB; ++b) *(LAS f32x4*)(g2l + b * D + 4 * i) = *(const f32x4*)(F.ADA + b * ADA_N + 5 * D + 4 * i) * (1.f / SLOT_SCALE); }
    __syncthreads();
    const int gw = F.vcu * NWAVES + F.wave, NGW = F.G * NWAVES;
    for (int r = gw; r < T; r += NGW) {
        int lane = F.lane; asm volatile("" : "+v"(lane));
        const int b = r >> 12;
        const v4u* xr = (const v4u*)(F.X1B + (size_t)r * D) + lane;
        const v2u* s0 = (const v2u*)((const unsigned char*)F.SLOT + (size_t)r * D) + lane; const v2u* s1 = (const v2u*)((const unsigned char*)F.SLOT + (size_t)(T + r) * D) + lane;
        v4u xx[8]; v2u a0[8], a1[8];
#pragma unroll
        for (int j = 0; j < 8; ++j) { xx[j] = xr[64 * j]; a0[j] = s0[64 * j]; a1[j] = s1[64 * j]; }
        f32x4 v[16]; float s = 0.f;
#pragma unroll
        for (int j = 0; j < 8; ++j) {
            const f32x4 g0 = *(const LAS f32x4*)(g2l + b * D + 512 * j + 8 * lane), g1 = *(const LAS f32x4*)(g2l + b * D + 512 * j + 8 * lane + 4);
            const f32x4 x0 = (f32x4){bf_lo(xx[j].x), bf_hi(xx[j].x), bf_lo(xx[j].y), bf_hi(xx[j].y)}, x1 = (f32x4){bf_lo(xx[j].z), bf_hi(xx[j].z), bf_lo(xx[j].w), bf_hi(xx[j].w)};
            v[2 * j] = x0 + g0 * (fp8x4_to_f32(a0[j].x) + fp8x4_to_f32(a1[j].x)); v[2 * j + 1] = x1 + g1 * (fp8x4_to_f32(a0[j].y) + fp8x4_to_f32(a1[j].y));
            s = fmaf(v[2 * j][0], v[2 * j][0], fmaf(v[2 * j][1], v[2 * j][1], fmaf(v[2 * j][2], v[2 * j][2], fmaf(v[2 * j][3], v[2 * j][3], s))));
            s = fmaf(v[2 * j + 1][0], v[2 * j + 1][0], fmaf(v[2 * j + 1][1], v[2 * j + 1][1], fmaf(v[2 * j + 1][2], v[2 * j + 1][2], fmaf(v[2 * j + 1][3], v[2 * j + 1][3], s)))); }
        const float rstd = rsqrtf(wave_sum(s) * (1.f / D) + EPS);
        float* o = F.out + (size_t)r * D + 8 * lane;
#pragma unroll
        for (int j = 0; j < 8; ++j) { *(f32x4*)(o + 512 * j) = v[2 * j] * rstd * *(const LAS f32x4*)(fnl + 512 * j + 8 * lane); *(f32x4*)(o + 512 * j + 4) = v[2 * j + 1] * rstd * *(const LAS f32x4*)(fnl + 512 * j + 8 * lane + 4);
            if ((j & 1) == 1) asm volatile("" ::: "memory"); }
    }
}

struct SchedProj {
    int G, c;
    __device__ bool next(int i, pg8::Unit& u) const {
        const int L = i * G + c; constexpr int nM = 64, nN = 48, nwg = nM * nN;
        if (L < nwg) {
            int wgid = L; { const int q = nwg / 8, xcd = wgid % 8, off = wgid / 8; wgid = xcd * q + off; }
            const int nig = 8 * nN, gid = wgid / nig, fm = gid * 8;
            u.pm = fm + ((wgid % nig) % 8); u.pn = (wgid % nig) / 8; return true; }
        const int L2 = L - nwg;
        if (L2 < 48) { u.pm = 64 + (L2 & 3); u.pn = 36 + (L2 >> 2); return true; }
        const int L3 = L2 - 48;
        if (L3 < 68) { u.pm = L3; u.pn = 48; return true; }
        return false;
    }
    __device__ __forceinline__ void a_ready(const pg8::Unit&) const {}
    __device__ __forceinline__ void done(const pg8::Unit&) const {}
    __device__ __forceinline__ unsigned row_byteoff(const pg8::Unit&, int) const { return 0u; }
};
struct EpiProj {
    static constexpr bool PERM = true;
    bf16* P; float* Gt; const float* bg;
    __device__ __forceinline__ void operator()(const pg8::f32x4 (&acc)[2][2][4][2], const pg8::Unit& u, int wr, int wc, int fr, int fq) const {
        const int row0 = u.pm * 256 + wr * 64 + fr;
        if (u.pn < 48) {
            const int col0 = u.pn * 256 + wc * 32 + 8 * fq;
#pragma unroll
            for (int ai = 0; ai < 2; ++ai)
#pragma unroll
                for (int m = 0; m < 4; ++m) { bf16* rowp = P + (size_t)(row0 + ai * 128 + m * 16) * NPROJ + col0;
#pragma unroll
                    for (int bj = 0; bj < 2; ++bj) { const pg8::f32x4 v0 = acc[ai][bj][m][0], v1 = acc[ai][bj][m][1];
                        v4u w; w.x = pk2(v0[0], v0[1]); w.y = pk2(v0[2], v0[3]); w.z = pk2(v1[0], v1[1]); w.w = pk2(v1[2], v1[3]);
                        *(v4u*)(rowp + bj * 128) = w; } }
        } else if (wc == 0) {
            const f32x4 b0 = *(const f32x4*)(bg + 8 * fq), b1 = *(const f32x4*)(bg + 8 * fq + 4);
#pragma unroll
            for (int ai = 0; ai < 2; ++ai)
#pragma unroll
                for (int m = 0; m < 4; ++m) { float* gp = Gt + (size_t)(row0 + ai * 128 + m * 16) * 32 + 8 * fq;
                    *(f32x4*)gp = acc[ai][0][m][0] + b0; *(f32x4*)(gp + 4) = acc[ai][0][m][1] + b1; }
        }
    }
};
struct EpiProjI8 {
    static constexpr bool PERM = true;
    bf16* P; const float* sa; const float* sb; float* Gt; const float* bg;
    __device__ __forceinline__ void operator()(const pg8::f32x4 (&acc)[2][2][4][2], const pg8::Unit& u, int wr, int wc, int fr, int fq) const {
        const int row0 = u.pm * 256 + wr * 64 + fr, col0 = u.pn * 256 + wc * 32 + 8 * fq;
        if (u.pn == 48) {
            if (wc == 0) {
                const f32x4 b0 = *(const f32x4*)(bg + 8 * fq), b1 = *(const f32x4*)(bg + 8 * fq + 4), q0 = *(const f32x4*)(sb + NPROJ + 8 * fq), q1 = *(const f32x4*)(sb + NPROJ + 8 * fq + 4);
#pragma unroll
                for (int ai = 0; ai < 2; ++ai)
#pragma unroll
                    for (int m = 0; m < 4; ++m) { const int row = row0 + ai * 128 + m * 16; const float ra = sa[row]; float* gp = Gt + (size_t)row * 32 + 8 * fq;
                        const pg8::i32x4 i0 = __builtin_bit_cast(pg8::i32x4, acc[ai][0][m][0]), i1 = __builtin_bit_cast(pg8::i32x4, acc[ai][0][m][1]);
                        *(f32x4*)gp = (f32x4){(float)i0[0], (float)i0[1], (float)i0[2], (float)i0[3]} * (q0 * ra) + b0; *(f32x4*)(gp + 4) = (f32x4){(float)i1[0], (float)i1[1], (float)i1[2], (float)i1[3]} * (q1 * ra) + b1; }
            }
            return;
        }
        f32x4 sbv[2][2]; float sav[2][4];
#pragma unroll
        for (int bj = 0; bj < 2; ++bj)
#pragma unroll
            for (int n = 0; n < 2; ++n) sbv[bj][n] = *(const f32x4*)(sb + col0 + bj * 128 + 4 * n);
#pragma unroll
        for (int ai = 0; ai < 2; ++ai)
#pragma unroll
            for (int m = 0; m < 4; ++m) sav[ai][m] = sa[row0 + ai * 128 + m * 16];
#pragma unroll
        for (int ai = 0; ai < 2; ++ai)
#pragma unroll
            for (int m = 0; m < 4; ++m) { bf16* rowp = P + (size_t)(row0 + ai * 128 + m * 16) * NPROJ + col0; const float ra = sav[ai][m];
#pragma unroll
                for (int bj = 0; bj < 2; ++bj) { const pg8::i32x4 i0 = __builtin_bit_cast(pg8::i32x4, acc[ai][bj][m][0]), i1 = __builtin_bit_cast(pg8::i32x4, acc[ai][bj][m][1]);
                    const f32x4 s0 = sbv[bj][0] * ra, s1 = sbv[bj][1] * ra;
                    v4u w; w.x = pk2((float)i0[0] * s0[0], (float)i0[1] * s0[1]); w.y = pk2((float)i0[2] * s0[2], (float)i0[3] * s0[3]);
                    w.z = pk2((float)i1[0] * s1[0], (float)i1[1] * s1[1]); w.w = pk2((float)i1[2] * s1[2], (float)i1[3] * s1[3]);
                    *(v4u*)(rowp + bj * 128) = w; } }
    }
    static constexpr int NS = 8, NTAB = 2;
    __device__ __forceinline__ bool stores(const pg8::Unit& u, int wc) const { return u.pn != 48 || wc == 0; }
    __device__ __forceinline__ const void* tab_src(const pg8::Unit& u, int idx) const {
        const int i = idx & 255;
        if (idx < 256) return sa + u.pm * 256 + i;
        if (u.pn == 48) return (i >= 32 && i < 64) ? bg + (i - 32) : sb + NPROJ + (i & 31);
        return sb + u.pn * 256 + i;
    }
    __device__ __forceinline__ void half(const pg8::f32x4 (&acc)[2][2][4][2], const pg8::Unit& u, const int ai, int wr, int wc, int fr, int fq, const LAS float* tab) const {
        const int lrow0 = wr * 64 + fr + ai * 128, row0 = u.pm * 256 + lrow0, col0 = u.pn * 256 + wc * 32 + 8 * fq;
        const LAS float* tb2 = tab + 256;
        if (u.pn == 48) {
            if (wc == 0) {
                const f32x4 q0 = *(const LAS f32x4*)(tb2 + 8 * fq), q1 = *(const LAS f32x4*)(tb2 + 8 * fq + 4), b0 = *(const LAS f32x4*)(tb2 + 32 + 8 * fq), b1 = *(const LAS f32x4*)(tb2 + 36 + 8 * fq);
#pragma unroll
                for (int m = 0; m < 4; ++m) { const float ra = tab[lrow0 + m * 16]; float* gp = Gt + (size_t)(row0 + m * 16) * 32 + 8 * fq;
                    const pg8::i32x4 i0 = __builtin_bit_cast(pg8::i32x4, acc[ai][0][m][0]), i1 = __builtin_bit_cast(pg8::i32x4, acc[ai][0][m][1]);
                    *(f32x4*)gp = (f32x4){(float)i0[0], (float)i0[1], (float)i0[2], (float)i0[3]} * (q0 * ra) + b0; *(f32x4*)(gp + 4) = (f32x4){(float)i1[0], (float)i1[1], (float)i1[2], (float)i1[3]} * (q1 * ra) + b1; }
            }
            return;
        }
        f32x4 sbv[2][2];
#pragma unroll
        for (int bj = 0; bj < 2; ++bj)
#pragma unroll
            for (int n = 0; n < 2; ++n) sbv[bj][n] = *(const LAS f32x4*)(tb2 + wc * 32 + 8 * fq + bj * 128 + 4 * n);
        if (u.pn >= COL_O / 256 && u.pn < COL_CB / 256) {
            const int ch0 = (u.pn - COL_O / 256) * 256 + wc * 32 + 8 * fq;
#pragma unroll
            for (int m = 0; m < 4; ++m) { unsigned char* rowp = (unsigned char*)(P + (size_t)(row0 + m * 16) * NPROJ + COL_O) + ch0; const float ra = tab[lrow0 + m * 16];
#pragma unroll
                for (int bj = 0; bj < 2; ++bj) { const pg8::i32x4 i0 = __builtin_bit_cast(pg8::i32x4, acc[ai][bj][m][0]), i1 = __builtin_bit_cast(pg8::i32x4, acc[ai][bj][m][1]);
                    const f32x4 s0 = sbv[bj][0] * ra, s1 = sbv[bj][1] * ra;
                    *(v2u*)(rowp + bj * 128) = (v2u){pk4_i8(sig255((float)i0[0] * s0[0]), sig255((float)i0[1] * s0[1]), sig255((float)i0[2] * s0[2]), sig255((float)i0[3] * s0[3])),
                                                   pk4_i8(sig255((float)i1[0] * s1[0]), sig255((float)i1[1] * s1[1]), sig255((float)i1[2] * s1[2]), sig255((float)i1[3] * s1[3]))}; } }
            return;
        }
        if (u.pn >= COL_CC / 256 && u.pn < COL_K / 256) {
            const int blk = (u.pn - COL_CC / 256) * 16 + wc * 4 + fq;
#pragma unroll
            for (int m = 0; m < 4; ++m) { unsigned char* rowp = (unsigned char*)(P + (size_t)(row0 + m * 16) * NPROJ + COL_CC) + 12 * blk; const float ra = tab[lrow0 + m * 16];
                float v[8];
#pragma unroll
                for (int n = 0; n < 2; ++n) { const pg8::i32x4 ic = __builtin_bit_cast(pg8::i32x4, acc[ai][0][m][n]), ix = __builtin_bit_cast(pg8::i32x4, acc[ai][1][m][n]);
                    const f32x4 sc = sbv[0][n] * ra, sx = sbv[1][n] * ra;
#pragma unroll
                    for (int j = 0; j < 4; ++j) v[4 * n + j] = ((float)ic[j] * sc[j]) * ((float)ix[j] * sx[j]); }
                const v3u r = blk8_pack(v);
                *(v2u*)rowp = (v2u){r.x, r.y}; *(unsigned*)(rowp + 8) = r.z; }
            return;
        }
        if (u.pn >= COL_CB / 256 && u.pn < COL_CC / 256) {
            const int blk = (u.pn - COL_CB / 256) * 32 + wc * 4 + fq;
#pragma unroll
            for (int m = 0; m < 4; ++m) { unsigned char* rowp = (unsigned char*)(P + (size_t)(row0 + m * 16) * NPROJ + COL_CB) + 12 * blk; const float ra = tab[lrow0 + m * 16];
#pragma unroll
                for (int bj = 0; bj < 2; ++bj) { float v[8];
#pragma unroll
                    for (int n = 0; n < 2; ++n) { const pg8::i32x4 iq = __builtin_bit_cast(pg8::i32x4, acc[ai][bj][m][n]); const f32x4 s = sbv[bj][n] * ra;
#pragma unroll
                        for (int j = 0; j < 4; ++j) v[4 * n + j] = (float)iq[j] * s[j]; }
                    *(v3u*)(rowp + 12 * 16 * bj) = blk8_pack(v); } }
            return;
        }
#pragma unroll
        for (int m = 0; m < 4; ++m) { bf16* rowp = P + (size_t)(row0 + m * 16) * NPROJ + col0; const float ra = tab[lrow0 + m * 16];
#pragma unroll
            for (int bj = 0; bj < 2; ++bj) { const pg8::i32x4 i0 = __builtin_bit_cast(pg8::i32x4, acc[ai][bj][m][0]), i1 = __builtin_bit_cast(pg8::i32x4, acc[ai][bj][m][1]);
                const f32x4 s0 = sbv[bj][0] * ra, s1 = sbv[bj][1] * ra;
                v4u w; w.x = pk2((float)i0[0] * s0[0], (float)i0[1] * s0[1]); w.y = pk2((float)i0[2] * s0[2], (float)i0[3] * s0[3]);
                w.z = pk2((float)i1[0] * s1[0], (float)i1[1] * s1[1]); w.w = pk2((float)i1[2] * s1[2], (float)i1[3] * s1[3]);
                *(v4u*)(rowp + bj * 128) = w; } }
    }
};
struct SchedStatic {
    int nM, nN, nwg, G, c;
    __device__ void init(int M, int N, int G_, int c_) { nM = M / 256; nN = N / 256; nwg = nM * nN; G = G_; c = c_; }
    __device__ bool next(int i, pg8::Unit& u) const {
        const long L = (long)i * G + c; if (L >= nwg) return false;
        int wgid = (int)L; { const int q = nwg / 8, r = nwg % 8, xcd = wgid % 8, off = wgid / 8; wgid = (xcd < r ? xcd * (q + 1) : r * (q + 1) + (xcd - r) * q) + off; }
        const int nig = 8 * nN, gid = wgid / nig, fm = gid * 8, gsz = (nM - fm) < 8 ? (nM - fm) : 8;
        u.pm = fm + ((wgid % nig) % gsz); u.pn = (wgid % nig) / gsz; return true;
    }
    __device__ __forceinline__ void a_ready(const pg8::Unit&) const {}
    __device__ __forceinline__ void done(const pg8::Unit&) const {}
    __device__ __forceinline__ unsigned row_byteoff(const pg8::Unit&, int) const { return 0u; }
};
struct EpiOut {
    static constexpr bool PERM = true;
    const float* ada; bf16* DL;
    __device__ __forceinline__ void operator()(const pg8::f32x4 (&acc)[2][2][4][2], const pg8::Unit& u, int wr, int wc, int fr, int fq) const {
        const int row0 = u.pm * 256 + wr * 64 + fr, col0 = u.pn * 256 + wc * 32 + 8 * fq;
        const float* g1 = ada + (size_t)(u.pm >> 4) * ADA_N + 2 * D + col0;
        f32x4 gv[2][2];
#pragma unroll
        for (int bj = 0; bj < 2; ++bj)
#pragma unroll
            for (int n = 0; n < 2; ++n) gv[bj][n] = *(const f32x4*)(g1 + bj * 128 + 4 * n);
#pragma unroll
        for (int ai = 0; ai < 2; ++ai)
#pragma unroll
            for (int m = 0; m < 4; ++m) { bf16* rowp = DL + (size_t)(row0 + ai * 128 + m * 16) * D + col0;
#pragma unroll
                for (int bj = 0; bj < 2; ++bj) { const pg8::f32x4 v0 = acc[ai][bj][m][0] * gv[bj][0], v1 = acc[ai][bj][m][1] * gv[bj][1];
                    v4u w; w.x = pk2(v0[0], v0[1]); w.y = pk2(v0[2], v0[3]); w.z = pk2(v1[0], v1[1]); w.w = pk2(v1[2], v1[3]);
                    *(v4u*)(rowp + bj * 128) = w; } }
    }
    static constexpr int NS = 8, NTAB = 1;
    __device__ __forceinline__ bool stores(const pg8::Unit&, int) const { return true; }
    __device__ __forceinline__ const void* tab_src(const pg8::Unit& u, int idx) const { return ada + (size_t)(u.pm >> 4) * ADA_N + 2 * D + u.pn * 256 + (idx & 255); }
    __device__ __forceinline__ void half(const pg8::f32x4 (&acc)[2][2][4][2], const pg8::Unit& u, const int ai, int wr, int wc, int fr, int fq, const LAS float* tab) const {
        const int row0 = u.pm * 256 + wr * 64 + fr + ai * 128, col0 = u.pn * 256 + wc * 32 + 8 * fq;
        f32x4 gv[2][2];
#pragma unroll
        for (int bj = 0; bj < 2; ++bj)
#pragma unroll
            for (int n = 0; n < 2; ++n) gv[bj][n] = *(const LAS f32x4*)(tab + wc * 32 + 8 * fq + bj * 128 + 4 * n);
#pragma unroll
        for (int m = 0; m < 4; ++m) { bf16* rowp = DL + (size_t)(row0 + m * 16) * D + col0;
#pragma unroll
            for (int bj = 0; bj < 2; ++bj) { const pg8::f32x4 v0 = acc[ai][bj][m][0] * gv[bj][0], v1 = acc[ai][bj][m][1] * gv[bj][1];
                v4u w; w.x = pk2(v0[0], v0[1]); w.y = pk2(v0[2], v0[3]); w.z = pk2(v1[0], v1[1]); w.w = pk2(v1[2], v1[3]);
                *(v4u*)(rowp + bj * 128) = w; } }
    }
};
struct EpiOut2 {
    static constexpr bool PERM = true;
    static constexpr int NS = 8, NTAB = 3;
    const float* ada; bf16* DL; const float* sa; const float* sb; const float* xin;
    __device__ __forceinline__ bool stores(const pg8::Unit&, int) const { return true; }
    __device__ __forceinline__ const void* tab_src(const pg8::Unit& u, int idx) const {
        const int i = idx & 255, w = idx >> 8;
        if (w == 0) return ada + (size_t)(u.pm >> 4) * ADA_N + 2 * D + u.pn * 256 + i;
        if (w == 1) return sa + u.pm * 256 + i;
        return sb + u.pn * 256 + i;
    }
    __device__ __forceinline__ void mid(pg8::f32x4 (&acc)[2][2][4][2], const pg8::Unit&, int wr, int wc, int fr, int fq, const LAS float* tab) const {
        f32x4 sbv[2][2];
#pragma unroll
        for (int bj = 0; bj < 2; ++bj)
#pragma unroll
            for (int n = 0; n < 2; ++n) sbv[bj][n] = *(const LAS f32x4*)(tab + 512 + wc * 32 + 8 * fq + bj * 128 + 4 * n);
#pragma unroll
        for (int ai = 0; ai < 2; ++ai)
#pragma unroll
            for (int m = 0; m < 4; ++m) { const float ra = tab[256 + wr * 64 + fr + ai * 128 + m * 16];
#pragma unroll
                for (int bj = 0; bj < 2; ++bj)
#pragma unroll
                    for (int n = 0; n < 2; ++n) { const pg8::i32x4 iv = __builtin_bit_cast(pg8::i32x4, acc[ai][bj][m][n]); const f32x4 s = sbv[bj][n] * ra;
                        acc[ai][bj][m][n] = (f32x4){(float)iv[0] * s[0], (float)iv[1] * s[1], (float)iv[2] * s[2], (float)iv[3] * s[3]}; } }
    }
    __device__ __forceinline__ void half(const pg8::f32x4 (&acc)[2][2][4][2], const pg8::Unit& u, const int ai, int wr, int wc, int fr, int fq, const LAS float* tab) const {
        const int row0 = u.pm * 256 + wr * 64 + fr + ai * 128, col0 = u.pn * 256 + wc * 32 + 8 * fq;
        f32x4 xv[4][2][2];
#pragma unroll
        for (int m = 0; m < 4; ++m) { const float* xr = xin + (size_t)(row0 + m * 16) * D + col0;
#pragma unroll
            for (int bj = 0; bj < 2; ++bj)
#pragma unroll
                for (int n = 0; n < 2; ++n) xv[m][bj][n] = *(const f32x4*)(xr + bj * 128 + 4 * n); }
        f32x4 gv[2][2];
#pragma unroll
        for (int bj = 0; bj < 2; ++bj)
#pragma unroll
            for (int n = 0; n < 2; ++n) gv[bj][n] = *(const LAS f32x4*)(tab + wc * 32 + 8 * fq + bj * 128 + 4 * n);
#pragma unroll
        for (int m = 0; m < 4; ++m) { bf16* rowp = DL + (size_t)(row0 + m * 16) * D + col0;
#pragma unroll
            for (int bj = 0; bj < 2; ++bj) { const pg8::f32x4 v0 = acc[ai][bj][m][0] * gv[bj][0] + xv[m][bj][0], v1 = acc[ai][bj][m][1] * gv[bj][1] + xv[m][bj][1];
                v4u w; w.x = pk2(v0[0], v0[1]); w.y = pk2(v0[2], v0[3]); w.z = pk2(v1[0], v1[1]); w.w = pk2(v1[2], v1[3]);
                *(v4u*)(rowp + bj * 128) = w; } }
    }
};
typedef GAS unsigned long long gu64;
constexpr unsigned RT_FULL = 64u, RT_SPIN_CAP = 1u << 22;
template <int NCT>
struct SchedMoe {
    int G, c; const LAS int* tb; const LAS int* cnt; const int* elist; unsigned rowbytes; gu32* rtc;
    __device__ bool next(int i, pg8::Unit& u) const {
        const int L = i * G + c, rt = L / NCT, ct = L % NCT;
        if (rt >= tb[NE]) return false;
        int e = 0;
#pragma unroll
        for (int q = 1; q < NE; ++q) e += (rt >= tb[q]) ? 1 : 0;
        u.pm = rt; u.pn = e * NCT + ct; return true;
    }
    __device__ __forceinline__ void a_ready(const pg8::Unit&) const {}
    __device__ __forceinline__ void done(const pg8::Unit& u) const {
        if (rtc == nullptr) return;
        asm volatile("s_waitcnt vmcnt(0) ; publish" ::: "memory");
        if ((threadIdx.x & 63) == 0) (void)__hip_atomic_fetch_add(rtc + 16 * u.pm, 1u, RLX_AGENT);
    }
    __device__ __forceinline__ unsigned row_byteoff(const pg8::Unit& u, int lr) const {
        const int e = u.pn / NCT; int l = (u.pm - tb[e]) * 256 + lr; const int n = cnt[e]; l = l < n ? l : n - 1;
        return (unsigned)(elist[e * T + l] >> 1) * rowbytes;
    }
    __device__ __forceinline__ const int* row_src(const pg8::Unit& u, int lr) const {
        const int e = u.pn / NCT; int l = (u.pm - tb[e]) * 256 + lr; const int n = cnt[e]; l = l < n ? l : n - 1;
        return elist + e * T + l;
    }
    __device__ __forceinline__ unsigned row_raw(const pg8::Unit& u, int lr) const { return (unsigned)*row_src(u, lr); }
    __device__ __forceinline__ unsigned row_off(unsigned raw) const { return (raw >> 1) * rowbytes; }
};
struct SchedMoe2 {
    static constexpr int NCT = 16, BON = 3;
    int G, c, n7; const LAS int* tb; const LAS int* cnt; gu32* rtc; gu32* tmo;
    __device__ bool next(int i, pg8::Unit& u) const {
        const int A = n7 % G, nl = G - A; int L;
        if (A == 0) L = i * G + c;
        else if (c >= A) L = (i < BON) ? i * nl + (c - A) : BON * nl + (i - BON) * G + c;
        else L = BON * nl + i * G + c;
        const int rt = L / NCT, ct = L % NCT;
        if (rt >= tb[NE]) return false;
        int e = 0;
#pragma unroll
        for (int q = 1; q < NE; ++q) e += (rt >= tb[q]) ? 1 : 0;
        u.pm = rt; u.pn = e * NCT + ct; return true;
    }
    __device__ __forceinline__ void a_ready(const pg8::Unit& u) const {
        unsigned sp = 0;
        while ((unsigned)__builtin_amdgcn_readfirstlane((int)__hip_atomic_load(rtc + 16 * u.pm, RLX_AGENT)) < RT_FULL) {
            __builtin_amdgcn_s_sleep(1);
            if (++sp > RT_SPIN_CAP) { if ((threadIdx.x & 63) == 0) __hip_atomic_store(tmo, 1u, RLX_AGENT); break; }
        }
    }
    __device__ __forceinline__ void done(const pg8::Unit&) const {}
    __device__ __forceinline__ unsigned row_byteoff(const pg8::Unit&, int) const { return 0u; }
};
struct EpiMoe1 {
    static constexpr bool PERM = true;
    unsigned char* H;
    __device__ __forceinline__ void operator()(const pg8::f32x4 (&acc)[2][2][4][2], const pg8::Unit& u, int wr, int wc, int fr, int fq) const {
        const int row0 = u.pm * 256 + wr * 64 + fr, col0 = (u.pn & 7) * 128 + wc * 32 + 8 * fq;
        constexpr float IS = 1.f / W1_SCALE;
#pragma unroll
        for (int ai = 0; ai < 2; ++ai)
#pragma unroll
            for (int m = 0; m < 4; ++m) { float h[8];
#pragma unroll
                for (int n = 0; n < 2; ++n)
#pragma unroll
                    for (int j = 0; j < 4; ++j) { const float a = acc[ai][0][m][n][j] * IS, uu = acc[ai][1][m][n][j] * IS; h[4 * n + j] = a * uu / (1.f + __expf(-a)); }
                *(v2u*)(H + (size_t)(row0 + ai * 128 + m * 16) * FF + col0) = (v2u){pk4_fp8(h[0], h[1], h[2], h[3]), pk4_fp8(h[4], h[5], h[6], h[7])}; }
    }
    static constexpr int NS = 4, NTAB = 0;
    __device__ __forceinline__ bool stores(const pg8::Unit&, int) const { return true; }
    __device__ __forceinline__ const void* tab_src(const pg8::Unit&, int) const { return nullptr; }
    __device__ __forceinline__ void half(const pg8::f32x4 (&acc)[2][2][4][2], const pg8::Unit& u, const int ai, int wr, int wc, int fr, int fq, const LAS float*) const {
        const int row0 = u.pm * 256 + wr * 64 + fr + ai * 128, col0 = (u.pn & 7) * 128 + wc * 32 + 8 * fq;
        constexpr float IS = 1.f / W1_SCALE;
#pragma unroll
        for (int m = 0; m < 4; ++m) { float h[8];
#pragma unroll
            for (int n = 0; n < 2; ++n)
#pragma unroll
                for (int j = 0; j < 4; ++j) { const float a = acc[ai][0][m][n][j] * IS, uu = acc[ai][1][m][n][j] * IS; h[4 * n + j] = a * uu / (1.f + __expf(-a)); }
            __hip_atomic_store((gu64*)(H + (size_t)(row0 + m * 16) * FF + col0), (unsigned long long)pk4_fp8(h[0], h[1], h[2], h[3]) | ((unsigned long long)pk4_fp8(h[4], h[5], h[6], h[7]) << 32), RLX_AGENT); }
    }
};
struct EpiMoe2 {
    static constexpr int PERM = 2;
    unsigned char* SL; const int* elist; const float* ew; const LAS int* tb; const LAS int* cnt;
    static constexpr int NS = 4, NTAB = 2;
    unsigned char* dump;
    __device__ __forceinline__ bool stores(const pg8::Unit&, int) const { return true; }
    __device__ __forceinline__ const void* tab_src(const pg8::Unit& u, int idx) const {
        const int e = u.pn >> 4, n_e = cnt[e]; int l = (u.pm - tb[e]) * 256 + (idx & 255); l = l < n_e ? l : n_e - 1;
        return idx < 256 ? (const void*)(elist + e * T + l) : (const void*)(ew + e * T + l);
    }
    __device__ __forceinline__ void half(const pg8::f32x4 (&acc)[2][2][4][2], const pg8::Unit& u, const int ai, int wr, int wc, int fr, int fq, const LAS float* tab) const {
        const int e = u.pn >> 4, ct = u.pn & 15, n_e = cnt[e], lrow0 = wr * 64 + fr + ai * 128, lr0 = (u.pm - tb[e]) * 256 + lrow0, col0 = ct * 256 + wc * 64 + 16 * fq;
#pragma unroll
        for (int m = 0; m < 4; ++m) { const int lr = lr0 + m * 16, ent = ((const LAS int*)tab)[lrow0 + m * 16]; const float w = tab[256 + lrow0 + m * 16] * (SLOT_SCALE / W2_SCALE);
            unsigned char* rowp = (lr < n_e) ? SL + ((size_t)(ent & 1) * T + (size_t)(ent >> 1)) * D + col0 : dump + (size_t)((u.pm & 63) * 256 + lrow0 + m * 16) * D + col0;
            const pg8::f32x4 v0 = acc[ai][0][m][0] * w, v1 = acc[ai][0][m][1] * w, v2 = acc[ai][1][m][0] * w, v3 = acc[ai][1][m][1] * w;
            *(v4u*)rowp = (v4u){pk4_fp8(v0[0], v0[1], v0[2], v0[3]), pk4_fp8(v1[0], v1[1], v1[2], v1[3]), pk4_fp8(v2[0], v2[1], v2[2], v2[3]), pk4_fp8(v3[0], v3[1], v3[2], v3[3])}; }
    }
};
__device__ __forceinline__ void moe_tables(Frame& F) {
    LAS int* tb = (LAS int*)(F.lds + MOE_OFF); LAS int* cnt = tb + 32;
    __syncthreads();
    if (F.tid == 0) { int acc = 0;
        for (int e = 0; e < NE; ++e) { const int n = (int)__hip_atomic_load((unsigned*)(F.ctl + CW_CNT + 64 * e), RLX_AGENT); cnt[e] = n; tb[e] = acc; acc += (n + 255) >> 8; }
        tb[NE] = acc; }
    __syncthreads();
}

struct Args { const float* in[20]; float* out; unsigned char* ws; int ph_lo, ph_hi, li, pad; };
__global__ void __launch_bounds__(NTHR, 2) mk_fwd(Args args) {
    extern __shared__ __attribute__((aligned(16))) unsigned char lds[];
    Frame F;
    F.lds = (LAS unsigned char*)lds;
    F.MISC = (volatile LAS unsigned*)(F.lds + MISC_OFF);
    F.tid = threadIdx.x; F.lane = F.tid & 63; F.wave = __builtin_amdgcn_readfirstlane(F.tid >> 6);
    F.G = gridDim.x; { const int bx = blockIdx.x; F.vcu = (F.G % 8 == 0) ? (bx % 8) * (F.G / 8) + bx / 8 : bx; }
    unsigned char* ws = args.ws;
    F.ctl = (gu32*)(ws + WS_CTL);
    F.x = args.in[0]; F.c = args.in[1]; F.ctx = args.in[2]; F.cctx = args.in[3]; F.w_ada = args.in[4]; F.b_ada = args.in[5]; F.norm1 = args.in[6]; F.w_in = args.in[7];
    F.b_gates = args.in[8]; F.conv_w = args.in[9]; F.head_norm = args.in[10]; F.w_out = args.in[11]; F.norm2 = args.in[12]; F.w_rg = args.in[13]; F.b_rg = args.in[14];
    F.w_re = args.in[15]; F.b_re = args.in[16]; F.w_e1 = args.in[17]; F.w_e2 = args.in[18]; F.fnorm = args.in[19]; F.out = args.out;
    F.ADA = (float*)(ws + WS_ADA); F.GATES = (float*)(ws + WS_GATES); F.EW = (float*)(ws + WS_EW); F.HF = (bf16*)(ws + WS_HF); F.HB = (bf16*)(ws + WS_HB); F.DELTA = (bf16*)(ws + WS_X1); F.X1B = (bf16*)(ws + WS_X1 + 128 * MiB); F.XM8 = ws + WS_XM8; F.WO8 = ws + WS_WO8; F.WI8 = (signed char*)(ws + WS_WI8); F.SA = (float*)(ws + WS_SA); F.SB = (float*)(ws + WS_SB); F.SB2 = F.SB + 16384; F.MIXA8 = ws + WS_XM8; F.WOA8 = ws + WS_WIN + 64 * MiB;
    F.ELIST = (int*)(ws + WS_ELIST);
    F.WIN = (bf16*)(ws + WS_WIN); F.WOUT = (bf16*)(ws + WS_WOUT); F.WE1 = (bf16*)(ws + WS_WE1); F.WE2 = (bf16*)(ws + WS_WE2);
    F.XM = (bf16*)(ws + WS_XM); F.MIX = F.XM; F.XF = F.XM; F.PROJ = (bf16*)(ws + WS_PROJ); F.SLOT = (bf16*)(ws + WS_SLOT); F.HMOE = (bf16*)(ws + WS_HMOE);
    for (int u = F.tid; u < (LDS_BYTES - LDSCTL_OFF) / 4; u += NTHR) ((LAS unsigned*)(F.lds + LDSCTL_OFF))[u] = 0u;
    __syncthreads();
    const int lo = args.ph_lo, hi = args.ph_hi;
    XcdBarrier bar; bar.bar = (unsigned*)(F.ctl + CW_BAR) + args.li * XCD_BAR_WORDS; bar.x = 0; bar.st = nullptr;
    if (hi - lo > 1) bar = xcd_barrier_post((unsigned*)(F.ctl + CW_BAR) + args.li * XCD_BAR_WORDS, F.MISC + 8);
#ifndef PHASE_MASK
#define PHASE_MASK 0xFFFF
#endif
#define IN(k) (((PHASE_MASK >> (k)) & 1) && lo <= (k) && (k) < hi)
#define BOTH(k) (IN(k) && IN((k) + 1))
#define GRID_BAR() xcd_barrier(bar)
    LAS unsigned* rowtab = (LAS unsigned*)(F.lds + ROWTAB_OFF);

#ifndef PROBE_DUP
#define PROBE_DUP -1
#endif
#define RUNPH(k, ...) if (IN(k)) { __VA_ARGS__ if (PROBE_DUP == (k)) { GRID_BAR(); __VA_ARGS__ } if (BOTH(k)) GRID_BAR(); }
    RUNPH(0, { p0_ada(F); __syncthreads(); p0_transposes(F); })
    RUNPH(1, { p1_quant_weights(F); p1_quant_wout(F); p1_norm(F); })
    RUNPH(2, {
        __syncthreads();
        { pg8::Gemm gi{(const bf16*)F.XM8, (const bf16*)F.WI8, TA, NPAD, D / 2}; SchedProj Si{F.G, (int)blockIdx.x}; EpiProjI8 Ei{F.PROJ, F.SA, F.SB, F.GATES, F.b_gates};
          pg8::gemm_phase<EpiProjI8, SchedProj, PG8_ALIGN, PG8_SP2, false, false, true, PG8_ROLL2>(F.lds, gi, Si, Ei, rowtab); }
        expert_transpose_queue(F); })
    RUNPH(3, { p3_mlstm(F); })
    RUNPH(4, { p4_mix(F); })
    RUNPH(5, {
        pg8::Gemm2 g{(const char*)F.MIXA8, (const char*)F.WOA8, (unsigned)(D / 2), (unsigned)(D / 2), D / 2 / 128, (const char*)(F.MIX + D / 2), (const char*)(F.WOUT + D / 2), (unsigned)(D * 2), (unsigned)(D * 2), D / 2 * 2 / 128};
        SchedStatic S; S.init(T, D, F.G, (int)blockIdx.x); EpiOut2 E{F.ADA, F.X1B, F.SA, F.SB2, F.x};
        __syncthreads();
        pg8::gemm_phase2<EpiOut2, SchedStatic, PG8_ALIGN>(F.lds, g, S, E); })
    RUNPH(6, { p6_norm_router(F); })
    RUNPH(7, {
        moe_tables(F);
        const LAS int* tb = (const LAS int*)(F.lds + MOE_OFF);
        gu32* rtc = F.ctl + CW_RT;
        { pg8::Gemm g{F.XF, F.WE1, T, NE * 2 * FF, D / 2}; SchedMoe<8> S{F.G, F.vcu, tb, tb + 32, F.ELIST, (unsigned)D, rtc}; EpiMoe1 E{(unsigned char*)F.HMOE};
          pg8::gemm_phase<EpiMoe1, SchedMoe<8>, PG8_ALIGN, PG8_SP2, true, true, false, PG8_ROLL7>(F.lds, g, S, E, rowtab); }
        if (F.wave == 0) __builtin_amdgcn_fence(__ATOMIC_ACQUIRE, "agent");
        __syncthreads();
        { pg8::Gemm g{F.HMOE, F.WE2, HM_ROWS, NE * D, FF / 2}; SchedMoe2 S{F.G, F.vcu, tb[NE] * 8, tb, tb + 32, rtc, F.ctl + CW_TMO}; EpiMoe2 E{(unsigned char*)F.SLOT, F.ELIST, F.EW, tb, tb + 32, (unsigned char*)F.WIN};
          pg8::gemm_phase<EpiMoe2, SchedMoe2, PG8_ALIGN, PG8_SP2, false, true, false, PG8_ROLL8>(F.lds, g, S, E, rowtab); } })
    RUNPH(9, { p9_final(F); })
#undef IN
#undef BOTH
}

__global__ void __launch_bounds__(320) mlstm_naive(const bf16* __restrict__ PROJ, const float* __restrict__ GATES, bf16* __restrict__ HF, bf16* __restrict__ HB) {
    __shared__ float kq[2][256];
    __shared__ float sc[2][4];
    __shared__ float dens[2];
    const int bid = blockIdx.x, dir = bid & 1, h = (bid >> 1) & 7, b = bid >> 4, tid = threadIdx.x;
    float C[128];
#pragma unroll
    for (int i = 0; i < 128; ++i) C[i] = 0.f;
    float m = 0.f;
    bf16* HO = dir ? HB : HF;
    const int NSTEP = CTXL + SEQ;
    for (int st = 0; st < NSTEP; ++st) {
        int row;
        if (st < CTXL) { const int j = dir ? (CTXL - 1 - st) : st; row = T + b * CTXL + j; }
        else { const int s = dir ? (SEQ - 1 - (st - CTXL)) : (st - CTXL); row = b * SEQ + s; }
        const bf16* pr = PROJ + (size_t)row * NPROJ;
        const int buf = st & 1;
        if (tid < 128) kq[buf][tid] = bf1(pr[COL_K + h * DK + tid]);
        else if (tid < 256) kq[buf][tid] = bf1(pr[COL_Q + h * DK + (tid - 128)]) * 0.08838834764831845f;
        const float ig = GATES[(size_t)row * 32 + (dir ? 16 : 0) + h], fp = GATES[(size_t)row * 32 + (dir ? 24 : 8) + h];
        const float lf = fminf(fp, 0.f) - log1pf(expf(-fabsf(fp)));
        const float mn = fmaxf(lf + m, ig);
        const float fdec = expf(lf + m - mn), iw = expf(ig - mn);
        m = mn;
        const float vv = tid < 256 ? bf1(pr[COL_V + h * DV + tid]) : 1.f;
        __syncthreads();
        const bool isq = st >= CTXL;
        float dot = 0.f;
        if (tid <= 256) {
            const float a = iw * vv;
#pragma unroll
            for (int i = 0; i < 128; ++i) { C[i] = fdec * C[i] + a * kq[buf][i]; dot += C[i] * kq[buf][128 + i]; }
        }
        if (isq) {
            if (tid == 256) dens[buf] = dot;
            __syncthreads();
            if (tid < 256) { const float dn = fmaxf(fabsf(dens[buf]), expf(-m)); HO[(size_t)row * 2048 + h * DV + tid] = (bf16)(pk2(dot / dn, 0.f) & 0xffffu); }
        }
    }
}

extern "C" void kernel_launch(void* const* d_in, const int* in_sizes, int n_in, void* d_out, int out_size, void* d_ws, size_t ws_size, hipStream_t stream) {
    static int grid = 0;
    if (grid == 0) {
        if (n_in != 20 || out_size != T * D || ws_size < WS_END) { fprintf(stderr, "kernel_launch: unexpected shapes (n_in %d, out %d, ws %zu)\n", n_in, out_size, ws_size); grid = -1; return; }
        int dev = 0, cus = 0, per_cu = 0;
        if (hipGetDevice(&dev) != hipSuccess || hipDeviceGetAttribute(&cus, hipDeviceAttributeMultiprocessorCount, dev) != hipSuccess) { grid = -1; return; }
        if (hipFuncSetAttribute((const void*)mk_fwd, hipFuncAttributeMaxDynamicSharedMemorySize, LDS_BYTES) != hipSuccess) { fprintf(stderr, "kernel_launch: hipFuncSetAttribute failed\n"); grid = -1; return; }
        if (hipOccupancyMaxActiveBlocksPerMultiprocessor(&per_cu, (const void*)mk_fwd, NTHR, LDS_BYTES) != hipSuccess || per_cu < 1) fprintf(stderr, "kernel_launch: occupancy query says %d\n", per_cu);
        (void)hipGetLastError();
        grid = cus;
    }
    if (grid < 0) return;
    (void)hipMemsetAsync((char*)d_ws + WS_CTL, 0, CTL_ZERO_BYTES, stream);
    Args a{};
    for (int i = 0; i < 20; ++i) a.in[i] = (const float*)d_in[i];
    a.out = (float*)d_out; a.ws = (unsigned char*)d_ws;
    int nl = 0;
    auto launch = [&](int lo, int hi) { a.ph_lo = lo; a.ph_hi = hi; a.li = nl++; hipLaunchKernelGGL(mk_fwd, dim3(grid), dim3(NTHR), LDS_BYTES, stream, a); };
#if MK_MODE == 0
    launch(0, 1); launch(1, 2); launch(2, 3);
    hipLaunchKernelGGL(mlstm_naive, dim3(NB * NH * 2), dim3(320), 0, stream, (const bf16*)((char*)d_ws + WS_PROJ), (const float*)((char*)d_ws + WS_GATES), (bf16*)((char*)d_ws + WS_HF), (bf16*)((char*)d_ws + WS_HB));
    launch(4, 5); launch(5, 6); launch(6, 7); launch(7, 8); launch(8, 9); launch(9, 10);
#elif MK_MODE == 2
    launch(0, 10);
#else
    launch(0, 3);
    hipLaunchKernelGGL(mlstm_naive, dim3(NB * NH * 2), dim3(320), 0, stream, (const bf16*)((char*)d_ws + WS_PROJ), (const float*)((char*)d_ws + WS_GATES), (bf16*)((char*)d_ws + WS_HF), (bf16*)((char*)d_ws + WS_HB));
    launch(4, 10);
#endif
}
```
